# Optimizing an MI355X kernel written in HIP

```python
import math
import jax
import jax.numpy as jnp
from jax import lax
import numpy as np

D_MODEL = 2048
BATCH = 2
SEQ = 4096
DEPTH = 4

CTX_LEN = 256
GRID_W = 64

GROUP_DIM = D_MODEL // 4
HEAD_DIM = 64
N_GROUP_HEADS = GROUP_DIM // HEAD_DIM
D_MIX = 4 * GROUP_DIM

RW_W_LORA = 64
RW_A_LORA = 64
RW_G_LORA = 128
RW_DECAY_SCALE = 0.606531
RW_GN_EPS = 64e-5
RW_IN = 3 * GROUP_DIM + 2 * RW_W_LORA + 2 * RW_A_LORA + RW_G_LORA
RW_SPLITS = [GROUP_DIM, 2 * GROUP_DIM, 3 * GROUP_DIM, 3 * GROUP_DIM + 2 * RW_W_LORA, 3 * GROUP_DIM + 2 * RW_W_LORA + 2 * RW_A_LORA]

MB_GROUPS = 2
MB_HEADS_PER_GROUP = N_GROUP_HEADS // MB_GROUPS
MB_STATE = 128
MB_CONV = 5
MB_CHUNK = 128
MB_CONV_DIM = GROUP_DIM + 2 * MB_GROUPS * MB_STATE
MB_IN = GROUP_DIM + MB_CONV_DIM + 2 * N_GROUP_HEADS
MB_SPLITS = [GROUP_DIM, GROUP_DIM + MB_CONV_DIM]

MLA_Q_LORA = 3 * D_MODEL // 16
MLA_KV_LORA = D_MODEL // 16
MLA_NOPE = 64
MLA_ROPE = 32
MLA_V = HEAD_DIM
MLA_IN = MLA_Q_LORA + MLA_KV_LORA + MLA_ROPE
MLA_SPLITS = [MLA_Q_LORA, MLA_Q_LORA + MLA_KV_LORA]
ROPE_BASE = 10000.0

NA_WIN_ROWS = 8
NA_WIN_COLS = 16
NA_IN = 3 * GROUP_DIM
NA_SPLITS = [GROUP_DIM, 2 * GROUP_DIM]

N_IN = RW_IN + MB_IN + MLA_IN + NA_IN
GROUP_SPLITS = [RW_IN, RW_IN + MB_IN, RW_IN + MB_IN + MLA_IN]

N_EXPERTS = 16
N_EXPERT_GROUPS = 4
EXPERTS_PER_GROUP = N_EXPERTS // N_EXPERT_GROUPS
TOP_K = 2
D_EXPERT = D_MODEL // 4
ROUTED_SCALE = 2.5

DEEPNORM_ALPHA = (2 * DEPTH) ** 0.25
DEEPNORM_BETA = (8 * DEPTH) ** -0.25
Q_BLOCK = 128
LN_EPS = 1e-6
RMS_EPS = 1e-6

kernel_name = 'hybrid_dit_rwkv7_ssd_mla_natten_moe'


def layer_norm(x, g, b):
    xf = x.astype(jnp.float32)
    mu = jnp.mean(xf, -1, keepdims=True)
    var = jnp.mean(jnp.square(xf - mu), -1, keepdims=True)
    return ((xf - mu) * lax.rsqrt(var + LN_EPS)).astype(x.dtype) * g + b


def rms_norm(x, g):
    xf = x.astype(jnp.float32)
    return (xf * lax.rsqrt(jnp.mean(xf * xf, -1, keepdims=True) + RMS_EPS)).astype(x.dtype) * g


def shift_prev(x):
    return jnp.pad(x, ((0, 0), (1, 0), (0, 0)))[:, :-1]


def shift_next(x):
    return jnp.pad(x, ((0, 0), (0, 1), (0, 0)))[:, 1:]


def centred_depthwise_conv(x, w, b):
    k = w.shape[0]
    y = lax.conv_general_dilated(x, w[:, None, :], window_strides=(1,), padding=[(k // 2, k // 2)],
                                 dimension_numbers=('NWC', 'WIO', 'NWC'), feature_group_count=x.shape[-1])
    return y + b


def axial_rope(x):
    bsz, length, n_heads, dim = x.shape
    n_freq = dim // 4
    t = jnp.arange(length)
    pos = jnp.stack([t // GRID_W, t % GRID_W], axis=-1).astype(jnp.float32)
    inv_freq = ROPE_BASE ** (-jnp.arange(n_freq, dtype=jnp.float32) / n_freq)
    ang = pos[:, :, None] * inv_freq
    cos = jnp.cos(ang)[None, :, None]
    sin = jnp.sin(ang)[None, :, None]
    xr = x.astype(jnp.float32).reshape(bsz, length, n_heads, 2, 2, n_freq)
    x1, x2 = xr[..., 0, :], xr[..., 1, :]
    out = jnp.stack([x1 * cos - x2 * sin, x2 * cos + x1 * sin], axis=-2)
    return out.reshape(x.shape).astype(x.dtype)


def block_attention(q, k, v, scale):
    bsz, lq, n_heads, dq = q.shape
    qb = jnp.moveaxis(q.reshape(bsz, lq // Q_BLOCK, Q_BLOCK, n_heads, dq), 1, 0)

    def one(q_blk):
        s = jnp.einsum('bqhd,bkhd->bhqk', q_blk, k).astype(jnp.float32) * scale
        p = jax.nn.softmax(s, axis=-1).astype(v.dtype)
        return jnp.einsum('bhqk,bkhd->bqhd', p, v)

    o = lax.map(one, qb)
    return jnp.moveaxis(o, 0, 1).reshape(bsz, lq, n_heads, v.shape[-1])


def neighborhood_attention(q, k, v, k_ctx, v_ctx, rpb, scale):
    bsz, length, n_heads, dim = q.shape
    rows = length // GRID_W
    wr = min(NA_WIN_ROWS, rows)
    grid = lambda t: t.reshape(bsz, rows, GRID_W, n_heads, dim)
    kg, vg = grid(k), grid(v)
    cols = np.arange(GRID_W)
    col_start = np.clip(cols - NA_WIN_COLS // 2, 0, GRID_W - NA_WIN_COLS)
    col_idx = col_start[:, None] + np.arange(NA_WIN_COLS)[None, :]
    col_off = col_idx - cols[:, None] + (NA_WIN_COLS - 1)
    n_loc = wr * NA_WIN_COLS

    def one_row(args):
        r, q_row = args
        rs = jnp.clip(r - wr // 2, 0, rows - wr)
        k_rows = lax.dynamic_slice_in_dim(kg, rs, wr, axis=1)
        v_rows = lax.dynamic_slice_in_dim(vg, rs, wr, axis=1)
        k_win = k_rows[:, :, col_idx]
        v_win = v_rows[:, :, col_idx]
        row_off = rs + jnp.arange(wr) - r + (NA_WIN_ROWS - 1)
        bias = jnp.transpose(rpb[:, row_off][:, :, col_off], (0, 2, 1, 3))
        s_loc = jnp.einsum('bqhd,brqchd->bhqrc', q_row, k_win).astype(jnp.float32) * scale + bias
        s_ctx = jnp.einsum('bqhd,bkhd->bhqk', q_row, k_ctx).astype(jnp.float32) * scale
        s = jnp.concatenate([s_loc.reshape(bsz, n_heads, GRID_W, n_loc), s_ctx], axis=-1)
        p = jax.nn.softmax(s, axis=-1).astype(v.dtype)
        p_loc = p[..., :n_loc].reshape(bsz, n_heads, GRID_W, wr, NA_WIN_COLS)
        return (jnp.einsum('bhqrc,brqchd->bqhd', p_loc, v_win)
                + jnp.einsum('bhqk,bkhd->bqhd', p[..., n_loc:], v_ctx))

    out = lax.map(one_row, (jnp.arange(rows), jnp.moveaxis(grid(q), 1, 0)))
    return jnp.moveaxis(out, 0, 1).reshape(bsz, length, n_heads, dim)


def rwkv_prep(p, mu, w0, w_up, a0, a_up, g_up, k_k, k_a):
    f32 = jnp.float32
    bsz, length = p.shape[:2]
    p = p + mu[0] * (shift_prev(p) - p) + mu[1] * (shift_next(p) - p)
    r, k, v, wd, ad, gd = jnp.split(p, RW_SPLITS, axis=-1)
    heads = lambda t: t.astype(f32).reshape(t.shape[:-1] + (N_GROUP_HEADS, HEAD_DIM))
    w_pre = w0 + jnp.einsum('bldr,drc->bldc', jnp.tanh(wd.reshape(bsz, length, 2, RW_W_LORA)), w_up)
    decay = jnp.exp(-RW_DECAY_SCALE * jax.nn.sigmoid(w_pre.astype(f32)))
    a = jax.nn.sigmoid((a0 + jnp.einsum('bldr,drc->bldc', ad.reshape(bsz, length, 2, RW_A_LORA), a_up)).astype(f32))
    g = jax.nn.sigmoid(gd) @ g_up
    kk = heads(k * k_k)
    kk = kk * lax.rsqrt(jnp.maximum(jnp.sum(kk * kk, -1, keepdims=True), 1e-12))
    k_dir = k.astype(f32)[:, :, None] * (1 + (a - 1) * k_a)
    return heads(r), heads(k), heads(v), kk, heads(decay), heads(a), heads(k_dir), g


def rwkv_scan(r, w, kk, a, v, k, s0, reverse):
    def step(s, inp):
        r_t, w_t, kk_t, a_t, v_t, k_t = inp
        sa = jnp.einsum('bhij,bhj->bhi', s, -kk_t)
        s = s * w_t[:, :, None, :] + sa[..., None] * (kk_t * a_t)[:, :, None, :] + v_t[..., None] * k_t[:, :, None, :]
        return s, jnp.einsum('bhij,bhj->bhi', s, r_t)

    xs = tuple(jnp.moveaxis(t, 1, 0) for t in (r, w, kk, a, v, k))
    s_final, y = lax.scan(step, s0, xs, reverse=reverse)
    return jnp.moveaxis(y, 0, 1), s_final


def rwkv_output(y, r, k, v, g, r_k, gn_g, gn_b):
    mu = jnp.mean(y, -1, keepdims=True)
    var = jnp.mean(jnp.square(y - mu), -1, keepdims=True)
    y = (y - mu) * lax.rsqrt(var + RW_GN_EPS) * gn_g.reshape(N_GROUP_HEADS, HEAD_DIM) + gn_b.reshape(N_GROUP_HEADS, HEAD_DIM)
    y = y + jnp.sum(r * k * r_k, -1, keepdims=True) * v
    bsz, length = y.shape[:2]
    return y.reshape(bsz, length, GROUP_DIM).astype(g.dtype) * g


def rwkv_mixer(p_ctx, p_lat, mu, w0, w_up, a0, a_up, g_up, k_k, k_a, r_k, gn_g, gn_b, need_ctx):
    rc, kc, vc, kkc, wc, ac, kdc, gc = rwkv_prep(p_ctx, mu, w0, w_up, a0, a_up, g_up, k_k, k_a)
    rl, kl, vl, kkl, wl, al, kdl, gl = rwkv_prep(p_lat, mu, w0, w_up, a0, a_up, g_up, k_k, k_a)
    s0 = jnp.zeros((p_lat.shape[0], N_GROUP_HEADS, HEAD_DIM, HEAD_DIM), jnp.float32)
    y_c, s_f = rwkv_scan(rc, wc[:, :, 0], kkc, ac[:, :, 0], vc, kdc[:, :, 0], s0, False)
    y_cb, s_b = rwkv_scan(rc, wc[:, :, 1], kkc, ac[:, :, 1], vc, kdc[:, :, 1], s0, True)
    y_lf, _ = rwkv_scan(rl, wl[:, :, 0], kkl, al[:, :, 0], vl, kdl[:, :, 0], s_f, False)
    y_lb, _ = rwkv_scan(rl, wl[:, :, 1], kkl, al[:, :, 1], vl, kdl[:, :, 1], s_b, True)
    y_lat = rwkv_output(y_lf + y_lb, rl, kl, vl, gl, r_k, gn_g, gn_b)
    y_ctx = rwkv_output(y_c + y_cb, rc, kc, vc, gc, r_k, gn_g, gn_b) if need_ctx else None
    return y_lat, y_ctx


def segsum(x):
    t = x.shape[-1]
    xr = jnp.broadcast_to(x[..., :, None], x.shape + (t,))
    cs = jnp.cumsum(jnp.where(jnp.tril(jnp.ones((t, t), bool), -1), xr, 0.0), axis=-2)
    return jnp.where(jnp.tril(jnp.ones((t, t), bool)), cs, -jnp.inf)


def ssd_scan(xs, dt, a, bm, cm, s0):
    bsz, length, n_heads, hdim = xs.shape
    nc = length // MB_CHUNK
    chunk = lambda t: t.reshape((bsz, nc, MB_CHUNK) + t.shape[2:])
    xdt = chunk(xs * dt[..., None])
    bc, cc = chunk(bm), chunk(cm)
    da = jnp.transpose(chunk(dt * a), (0, 3, 1, 2))
    da_cs = jnp.cumsum(da, axis=-1)
    l_mat = jnp.exp(segsum(da))
    y_diag = jnp.einsum('bclhn,bcshn,bhcls,bcshp->bclhp', cc, bc, l_mat, xdt)
    decay_states = jnp.exp(da_cs[..., -1:] - da_cs)
    states = jnp.einsum('bclhn,bhcl,bclhp->bchpn', bc, decay_states, xdt)
    states = jnp.concatenate([s0[:, None], states], axis=1)
    decay_chunk = jnp.exp(segsum(jnp.pad(da_cs[..., -1], ((0, 0), (0, 0), (1, 0)))))
    new_states = jnp.einsum('bhzc,bchpn->bzhpn', decay_chunk, states)
    y_off = jnp.einsum('bclhn,bchpn,bhcl->bclhp', cc, new_states[:, :-1], jnp.exp(da_cs))
    return (y_diag + y_off).reshape(bsz, length, n_heads, hdim), new_states[:, -1]


def ssd_direction(xs, dt, bm, cm, a, s0, reverse):
    if reverse:
        xs, dt, bm, cm = (jnp.flip(t, 1) for t in (xs, dt, bm, cm))
    y, s = ssd_scan(xs, dt, a, bm, cm, s0)
    return (jnp.flip(y, 1) if reverse else y), s


def mamba_prep(p, conv_w, conv_b, dt_bias):
    bsz, length = p.shape[:2]
    z, xbc, dt_raw = jnp.split(p, MB_SPLITS, axis=-1)
    xbc = jax.nn.silu(centred_depthwise_conv(xbc, conv_w, conv_b))
    xs, bm, cm = jnp.split(xbc, [GROUP_DIM, GROUP_DIM + MB_GROUPS * MB_STATE], axis=-1)
    xs = xs.reshape(bsz, length, N_GROUP_HEADS, HEAD_DIM)
    bm = jnp.repeat(bm.reshape(bsz, length, MB_GROUPS, MB_STATE), MB_HEADS_PER_GROUP, axis=2)
    cm = jnp.repeat(cm.reshape(bsz, length, MB_GROUPS, MB_STATE), MB_HEADS_PER_GROUP, axis=2)
    dt = jax.nn.softplus(dt_raw.reshape(bsz, length, 2, N_GROUP_HEADS).astype(jnp.float32) + dt_bias)
    return z, xs, bm, cm, dt


def mamba_output(y, z, norm_g):
    bsz, length = y.shape[:2]
    y = y.reshape(bsz, length, GROUP_DIM) * jax.nn.silu(z.astype(jnp.float32))
    y = y.reshape(bsz, length, MB_GROUPS, GROUP_DIM // MB_GROUPS)
    y = y * lax.rsqrt(jnp.mean(y * y, -1, keepdims=True) + RMS_EPS)
    return (y.reshape(bsz, length, GROUP_DIM) * norm_g).astype(z.dtype)


def mamba_mixer(p_ctx, p_lat, conv_w, conv_b, a_log, dt_bias, d_skip, norm_g, need_ctx):
    zc, xc, bc, cc, dtc = mamba_prep(p_ctx, conv_w, conv_b, dt_bias)
    zl, xl, bl, cl, dtl = mamba_prep(p_lat, conv_w, conv_b, dt_bias)
    s0 = jnp.zeros((p_lat.shape[0], N_GROUP_HEADS, HEAD_DIM, MB_STATE), jnp.float32)
    a_f = -jnp.exp(a_log[0].astype(jnp.float32))
    a_b = -jnp.exp(a_log[1].astype(jnp.float32))
    y_cf, s_f = ssd_direction(xc, dtc[:, :, 0], bc, cc, a_f, s0, False)
    y_cb, s_b = ssd_direction(xc, dtc[:, :, 1], bc, cc, a_b, s0, True)
    y_lf, _ = ssd_direction(xl, dtl[:, :, 0], bl, cl, a_f, s_f, False)
    y_lb, _ = ssd_direction(xl, dtl[:, :, 1], bl, cl, a_b, s_b, True)
    y_lat = mamba_output(y_lf + y_lb + d_skip[:, None] * xl, zl, norm_g)
    y_ctx = mamba_output(y_cf + y_cb + d_skip[:, None] * xc, zc, norm_g) if need_ctx else None
    return y_lat, y_ctx


def mla_mixer(p_ctx, p_lat, q_norm, w_uq, kv_norm, w_ukv, need_ctx):
    def keys_values(p, rotate):
        bsz, length = p.shape[:2]
        _, kv_d, k_pe = jnp.split(p, MLA_SPLITS, axis=-1)
        kv = (rms_norm(kv_d, kv_norm) @ w_ukv).reshape(bsz, length, N_GROUP_HEADS, MLA_NOPE + MLA_V)
        k_nope, v = jnp.split(kv, [MLA_NOPE], axis=-1)
        k_pe = k_pe[:, :, None, :]
        if rotate:
            k_pe = axial_rope(k_pe)
        k_pe = jnp.broadcast_to(k_pe, (bsz, length, N_GROUP_HEADS, MLA_ROPE))
        return jnp.concatenate([k_nope, k_pe], axis=-1), v

    def queries(p, rotate):
        bsz, length = p.shape[:2]
        q = (rms_norm(p[..., :MLA_Q_LORA], q_norm) @ w_uq).reshape(bsz, length, N_GROUP_HEADS, MLA_NOPE + MLA_ROPE)
        q_nope, q_pe = jnp.split(q, [MLA_NOPE], axis=-1)
        if rotate:
            q_pe = axial_rope(q_pe)
        return jnp.concatenate([q_nope, q_pe], axis=-1)

    scale = (MLA_NOPE + MLA_ROPE) ** -0.5
    k_c, v_c = keys_values(p_ctx, False)
    k_l, v_l = keys_values(p_lat, True)
    bsz, length = p_lat.shape[:2]
    y_lat = block_attention(queries(p_lat, True), jnp.concatenate([k_l, k_c], axis=1),
                            jnp.concatenate([v_l, v_c], axis=1), scale).reshape(bsz, length, GROUP_DIM)
    y_ctx = None
    if need_ctx:
        y_ctx = block_attention(queries(p_ctx, False), k_c, v_c, scale).reshape(bsz, p_ctx.shape[1], GROUP_DIM)
    return y_lat, y_ctx


def natten_mixer(p_ctx, p_lat, rpb, need_ctx):
    heads = lambda t: t.reshape(t.shape[:-1] + (N_GROUP_HEADS, HEAD_DIM))
    q_c, k_c, v_c = (heads(t) for t in jnp.split(p_ctx, NA_SPLITS, axis=-1))
    q_l, k_l, v_l = (heads(t) for t in jnp.split(p_lat, NA_SPLITS, axis=-1))
    scale = HEAD_DIM ** -0.5
    bsz, length = p_lat.shape[:2]
    y_lat = neighborhood_attention(q_l, k_l, v_l, k_c, v_c, rpb, scale).reshape(bsz, length, GROUP_DIM)
    y_ctx = None
    if need_ctx:
        y_ctx = block_attention(q_c, k_c, v_c, scale).reshape(bsz, p_ctx.shape[1], GROUP_DIM)
    return y_lat, y_ctx


def moe_ffn(h, router_w, router_b, w_gate, w_up, w_down):
    n_tok = h.shape[0]
    scores = jax.nn.sigmoid((h @ router_w).astype(jnp.float32))
    grouped = (scores + router_b).reshape(n_tok, N_EXPERT_GROUPS, EXPERTS_PER_GROUP)
    group_score = jnp.sum(lax.top_k(grouped, TOP_K)[0], axis=-1)
    g_sel = jnp.argmax(group_score, axis=-1)
    in_group = jnp.take_along_axis(grouped, g_sel[:, None, None], axis=1)[:, 0]
    _, local = lax.top_k(in_group, TOP_K)
    idx = g_sel[:, None] * EXPERTS_PER_GROUP + local
    w_sel = jnp.take_along_axis(scores, idx, axis=-1)
    w_sel = w_sel / jnp.sum(w_sel, -1, keepdims=True) * ROUTED_SCALE
    gate = jnp.sum(jax.nn.one_hot(idx, N_EXPERTS, dtype=jnp.float32) * w_sel[..., None], axis=1).astype(h.dtype)
    out = jnp.zeros_like(h)
    for e in range(N_EXPERTS):
        hid = jax.nn.silu(h @ w_gate[e]) * (h @ w_up[e])
        out = out + gate[:, e:e + 1] * (hid @ w_down[e])
    return out


def setup_inputs(seed: int = 0) -> dict:
    key = jax.random.key(seed)
    ks = iter(jax.random.split(key, 64))
    f32 = jnp.float32

    def nrm(shape, scale):
        return jax.random.normal(next(ks), shape, f32) * scale

    def unif(shape, lo, hi):
        return jax.random.uniform(next(ks), shape, f32, lo, hi)

    nl, d, gd, nh = DEPTH, D_MODEL, GROUP_DIM, N_GROUP_HEADS
    dt0 = jnp.exp(unif((nl, 2, nh), math.log(1e-3), math.log(1e-1)))
    return {
        'x': nrm((BATCH, SEQ, d), 1.0),
        'c': nrm((BATCH, d), 1.0),
        'ctx': nrm((BATCH, CTX_LEN, d), 1.0),
        'c_ctx': nrm((d,), 1.0),
        'ada_w': nrm((nl, d, 6 * d), 0.5 * d ** -0.5),
        'ada_b': nrm((nl, 6 * d), 0.02),
        'w_in': nrm((nl, d, N_IN), d ** -0.5),
        'w_out': nrm((nl, D_MIX, d), DEEPNORM_BETA * D_MIX ** -0.5),
        'ln1_g': 1.0 + nrm((nl, d), 0.02),
        'ln1_b': nrm((nl, d), 0.02),
        'ln2_g': 1.0 + nrm((nl, d), 0.02),
        'ln2_b': nrm((nl, d), 0.02),
        'rw_mu': unif((nl, 2, RW_IN), 0.0, 0.5),
        'rw_w0': nrm((nl, 2, gd), 1.0),
        'rw_w_up': nrm((nl, 2, RW_W_LORA, gd), 0.1 * RW_W_LORA ** -0.5),
        'rw_a0': nrm((nl, 2, gd), 0.5),
        'rw_a_up': nrm((nl, 2, RW_A_LORA, gd), 0.1 * RW_A_LORA ** -0.5),
        'rw_g_up': nrm((nl, RW_G_LORA, gd), RW_G_LORA ** -0.5),
        'rw_k_k': 0.85 + nrm((nl, gd), 0.02),
        'rw_k_a': 1.0 + nrm((nl, gd), 0.02),
        'rw_r_k': nrm((nl, nh, HEAD_DIM), 0.1),
        'rw_gn_g': 1.0 + nrm((nl, gd), 0.02),
        'rw_gn_b': nrm((nl, gd), 0.02),
        'mb_conv_w': nrm((nl, MB_CONV, MB_CONV_DIM), MB_CONV ** -0.5),
        'mb_conv_b': nrm((nl, MB_CONV_DIM), 0.02),
        'mb_a_log': jnp.log(unif((nl, 2, nh), 1.0, 16.0)),
        'mb_dt_bias': dt0 + jnp.log(-jnp.expm1(-dt0)),
        'mb_d': 1.0 + nrm((nl, nh), 0.02),
        'mb_norm_g': 1.0 + nrm((nl, gd), 0.02),
        'mla_q_norm': 1.0 + nrm((nl, MLA_Q_LORA), 0.02),
        'mla_w_uq': nrm((nl, MLA_Q_LORA, nh * (MLA_NOPE + MLA_ROPE)), MLA_Q_LORA ** -0.5),
        'mla_kv_norm': 1.0 + nrm((nl, MLA_KV_LORA), 0.02),
        'mla_w_ukv': nrm((nl, MLA_KV_LORA, nh * (MLA_NOPE + MLA_V)), MLA_KV_LORA ** -0.5),
        'na_rpb': nrm((nl, nh, 2 * NA_WIN_ROWS - 1, 2 * NA_WIN_COLS - 1), 0.1),
        'router_w': nrm((d, N_EXPERTS), d ** -0.5),
        'router_b': nrm((N_EXPERTS,), 0.01),
        'exp_w_gate': nrm((nl, N_EXPERTS, d, D_EXPERT), d ** -0.5),
        'exp_w_up': nrm((nl, N_EXPERTS, d, D_EXPERT), d ** -0.5),
        'exp_w_down': nrm((nl, N_EXPERTS, D_EXPERT, d), DEEPNORM_BETA * D_EXPERT ** -0.5),
    }


def reference(x, c, ctx, c_ctx, ada_w, ada_b, w_in, w_out, ln1_g, ln1_b, ln2_g, ln2_b,
              rw_mu, rw_w0, rw_w_up, rw_a0, rw_a_up, rw_g_up, rw_k_k, rw_k_a, rw_r_k, rw_gn_g, rw_gn_b,
              mb_conv_w, mb_conv_b, mb_a_log, mb_dt_bias, mb_d, mb_norm_g,
              mla_q_norm, mla_w_uq, mla_kv_norm, mla_w_ukv, na_rpb,
              router_w, router_b, exp_w_gate, exp_w_up, exp_w_down):
    silu_c = jax.nn.silu(c)
    silu_cc = jax.nn.silu(c_ctx)
    for l in range(DEPTH):
        need_ctx = l < DEPTH - 1
        mod = silu_c @ ada_w[l] + ada_b[l]
        mod_c = silu_cc @ ada_w[l] + ada_b[l]
        sh1, sc1, g1, sh2, sc2, g2 = jnp.split(mod[:, None, :], 6, axis=-1)
        csh1, csc1, cg1, csh2, csc2, cg2 = jnp.split(mod_c, 6, axis=-1)

        p_lat = (x * (1 + sc1) + sh1) @ w_in[l]
        p_ctx = (ctx * (1 + csc1) + csh1) @ w_in[l]
        rw_l, mb_l, mla_l, na_l = jnp.split(p_lat, GROUP_SPLITS, axis=-1)
        rw_c, mb_c, mla_c, na_c = jnp.split(p_ctx, GROUP_SPLITS, axis=-1)
        o_rw_l, o_rw_c = rwkv_mixer(rw_c, rw_l, rw_mu[l], rw_w0[l], rw_w_up[l], rw_a0[l], rw_a_up[l], rw_g_up[l],
                                    rw_k_k[l], rw_k_a[l], rw_r_k[l], rw_gn_g[l], rw_gn_b[l], need_ctx)
        o_mb_l, o_mb_c = mamba_mixer(mb_c, mb_l, mb_conv_w[l], mb_conv_b[l], mb_a_log[l], mb_dt_bias[l],
                                     mb_d[l], mb_norm_g[l], need_ctx)
        o_mla_l, o_mla_c = mla_mixer(mla_c, mla_l, mla_q_norm[l], mla_w_uq[l], mla_kv_norm[l], mla_w_ukv[l], need_ctx)
        o_na_l, o_na_c = natten_mixer(na_c, na_l, na_rpb[l], need_ctx)
        y_lat = jnp.concatenate([o_rw_l, o_mb_l, o_mla_l, o_na_l], axis=-1).astype(x.dtype) @ w_out[l]
        x = layer_norm(DEEPNORM_ALPHA * x + g1 * y_lat, ln1_g[l], ln1_b[l])
        if need_ctx:
            y_ctx = jnp.concatenate([o_rw_c, o_mb_c, o_mla_c, o_na_c], axis=-1).astype(ctx.dtype) @ w_out[l]
            ctx = layer_norm(DEEPNORM_ALPHA * ctx + cg1 * y_ctx, ln1_g[l], ln1_b[l])

        h_lat = (x * (1 + sc2) + sh2).reshape(-1, D_MODEL)
        if need_ctx:
            h_ctx = (ctx * (1 + csc2) + csh2).reshape(-1, D_MODEL)
            f = moe_ffn(jnp.concatenate([h_ctx, h_lat], axis=0), router_w, router_b,
                        exp_w_gate[l], exp_w_up[l], exp_w_down[l])
            n_c = h_ctx.shape[0]
            f_lat = f[n_c:].reshape(x.shape)
            ctx = layer_norm(DEEPNORM_ALPHA * ctx + cg2 * f[:n_c].reshape(ctx.shape), ln2_g[l], ln2_b[l])
        else:
            f_lat = moe_ffn(h_lat, router_w, router_b, exp_w_gate[l], exp_w_up[l], exp_w_down[l]).reshape(x.shape)
        x = layer_norm(DEEPNORM_ALPHA * x + g2 * f_lat, ln2_g[l], ln2_b[l])
    return x
```

```cpp
#ifndef CPU_TEST
#include <hip/hip_runtime.h>
#endif
#include <stdint.h>
#include <stddef.h>
#include <math.h>

#ifndef CFG_SMALL
constexpr int D = 2048, NB = 2, SEQ = 4096, DEPTH = 4, CTX = 256, GRID_W = 64;
constexpr int HD = 64;
constexpr int RW_WL = 64, RW_AL = 64, RW_GL = 128;
constexpr int MB_STATE = 128, MB_GROUPS = 2, MB_CONV = 5;
constexpr int MLA_NOPE = 64, MLA_ROPE = 32;
constexpr int NA_WR = 8, NA_WC = 16;
constexpr int NE = 16, NEG = 4;
#else
constexpr int D = 256, NB = 2, SEQ = 64, DEPTH = 2, CTX = 16, GRID_W = 8;
constexpr int HD = 16;
constexpr int RW_WL = 8, RW_AL = 8, RW_GL = 16;
constexpr int MB_STATE = 16, MB_GROUPS = 2, MB_CONV = 5;
constexpr int MLA_NOPE = 16, MLA_ROPE = 8;
constexpr int NA_WR = 4, NA_WC = 4;
constexpr int NE = 16, NEG = 4;
#endif
constexpr int GD = D / 4, NH = GD / HD, D_MIX = 4 * GD;
constexpr int MLA_QL = 3 * D / 16, MLA_KVL = D / 16;
constexpr int D_EXP = D / 4, EPG = NE / NEG;
constexpr int RW_IN = 3 * GD + 2 * RW_WL + 2 * RW_AL + RW_GL;
constexpr int MB_CONV_DIM = GD + 2 * MB_GROUPS * MB_STATE;
constexpr int MB_IN = GD + MB_CONV_DIM + 2 * NH;
constexpr int MLA_V = HD, MLA_QK = MLA_NOPE + MLA_ROPE;
constexpr int MLA_IN = MLA_QL + MLA_KVL + MLA_ROPE;
constexpr int NA_IN = 3 * GD;
constexpr int N_IN = RW_IN + MB_IN + MLA_IN + NA_IN;
constexpr int OFF_RW = 0, OFF_MB = RW_IN, OFF_MLA = RW_IN + MB_IN, OFF_NA = OFF_MLA + MLA_IN;
constexpr int LL = CTX + SEQ, TT = NB * LL;
constexpr int NMOD = NB + 1;
constexpr int CAP = TT;
constexpr float LN_EPS = 1e-6f, RMS_EPS = 1e-6f, RW_GN_EPS = 64e-5f, RW_DECAY_SCALE = 0.606531f, ROUTED_SCALE = 2.5f;
constexpr float ROPE_BASE = 10000.0f;
#define DN_ALPHA (sqrtf(sqrtf(2.0f * (float)DEPTH)))

typedef unsigned short bf16_t;

#ifndef CPU_TEST
#define LAUNCH(kern, grid, block, stream, ...) kern<<<dim3(grid), dim3(block), 0, stream>>>(__VA_ARGS__)
#define DEVFN __device__ __forceinline__
#else
#define DEVFN static inline
#endif


DEVFN uint32_t f_as_u(float f) { union { float f; uint32_t u; } c; c.f = f; return c.u; }
DEVFN float u_as_f(uint32_t u) { union { float f; uint32_t u; } c; c.u = u; return c.f; }
DEVFN bf16_t f2bf(float f) { uint32_t u = f_as_u(f); u += 0x7fffu + ((u >> 16) & 1u); return (bf16_t)(u >> 16); }
DEVFN float bf2f(bf16_t h) { return u_as_f(((uint32_t)h) << 16); }
DEVFN float sigmoidf_(float x) { return 1.0f / (1.0f + expf(-x)); }
DEVFN float siluf_(float x) { return x * sigmoidf_(x); }
DEVFN float softplusf_(float x) { return x > 20.0f ? x : log1pf(expf(x)); }
DEVFN size_t gtid_() { return (size_t)blockIdx.x * blockDim.x + threadIdx.x; }
DEVFN size_t gstr_() { return (size_t)gridDim.x * blockDim.x; }

struct Params {
    const float *x, *c, *ctx, *c_ctx, *ada_w, *ada_b, *w_in, *w_out, *ln1_g, *ln1_b, *ln2_g, *ln2_b;
    const float *rw_mu, *rw_w0, *rw_w_up, *rw_a0, *rw_a_up, *rw_g_up, *rw_k_k, *rw_k_a, *rw_r_k, *rw_gn_g, *rw_gn_b;
    const float *mb_conv_w, *mb_conv_b, *mb_a_log, *mb_dt_bias, *mb_d, *mb_norm_g;
    const float *mla_q_norm, *mla_w_uq, *mla_kv_norm, *mla_w_ukv, *na_rpb, *router_w, *router_b, *exp_w_gate, *exp_w_up, *exp_w_down;
    float* out;
    bf16_t *WinT, *WoutT, *WguT, *WdT, *WuqT, *WukvT;
    float* xs;
    bf16_t* xm;
    float* mod;
    float* P;
    float* pm;
    float *rwW, *rwB, *rwKD;
    float *rwKK, *rwG;
    float* rwY;
    float* xc;
    float* dt;
    float* mbY;
    bf16_t *qn, *kvn;
    float *Qraw, *KVraw;
    float *Qf, *Kf, *Vf;
    bf16_t* Ymix;
    float* yo;
    bf16_t* hb;
    float* GU;
    bf16_t* hid;
    float* F;
    int* cnt;
    int *ent_tok, *ent_row, *ent_dst;
    float* ent_w;
};

__global__ void k_init(Params p) {
    const size_t n = (size_t)TT * D;
    for (size_t i = gtid_(); i < n; i += gstr_()) {
        const int d = (int)(i % D); const int t = (int)(i / D); const int b = t / LL, s = t % LL;
        p.xs[i] = s < CTX ? p.ctx[((size_t)b * CTX + s) * D + d] : p.x[((size_t)b * SEQ + (s - CTX)) * D + d];
    }
    for (size_t i = gtid_(); i < (size_t)DEPTH * NE; i += gstr_()) p.cnt[i] = 0;
}

__global__ void k_transpose(const float* src, bf16_t* dst, int K, int N, int batch, size_t dst_bstride, int dst_row0) {
    const size_t total = (size_t)batch * (K / 8) * N;
    for (size_t idx = gtid_(); idx < total; idx += gstr_()) {
        const int n = (int)(idx % N); const int k8 = (int)((idx / N) % (K / 8)); const int bt = (int)(idx / ((size_t)N * (K / 8)));
        bf16_t* o = dst + (size_t)bt * dst_bstride + (size_t)(dst_row0 + n) * K + k8 * 8;
        for (int j = 0; j < 8; ++j) o[j] = f2bf(src[((size_t)bt * K + k8 * 8 + j) * N + n]);
    }
}

__global__ void __launch_bounds__(64) k_mod(Params p) {
    const size_t total = (size_t)DEPTH * 6 * D;
    for (size_t idx = gtid_(); idx < total; idx += gstr_()) {
        const int l = (int)(idx / (6 * D)), j = (int)(idx % (6 * D));
        float acc[NMOD];
#pragma unroll
        for (int r = 0; r < NMOD; ++r) acc[r] = p.ada_b[(size_t)l * 6 * D + j];
        for (int i = 0; i < D; ++i) {
            const float w = p.ada_w[((size_t)l * D + i) * 6 * D + j];
#pragma unroll
            for (int r = 0; r < NMOD; ++r) { const float cv = r < NB ? p.c[r * D + i] : p.c_ctx[i]; acc[r] += siluf_(cv) * w; }
        }
#pragma unroll
        for (int r = 0; r < NMOD; ++r) p.mod[((size_t)l * NMOD + r) * 6 * D + j] = acc[r];
    }
}

__global__ void k_modulate(Params p, int l) {
    const size_t n = (size_t)TT * D;
    for (size_t i = gtid_(); i < n; i += gstr_()) {
        const int d = (int)(i % D); const int t = (int)(i / D); const int b = t / LL, s = t % LL; const int r = s < CTX ? NB : b;
        const float* m = p.mod + ((size_t)l * NMOD + r) * 6 * D;
        p.xm[i] = f2bf(p.xs[i] * (1.0f + m[D + d]) + m[d]);
    }
}

__global__ void k_rw_mix(Params p, int l) {
    const size_t n = (size_t)TT * RW_IN;
    for (size_t i = gtid_(); i < n; i += gstr_()) {
        const int col = (int)(i % RW_IN); const int t = (int)(i / RW_IN); const int s = t % LL;
        const bool first = (s == 0 || s == CTX), last = (s == CTX - 1 || s == LL - 1);
        const float v = p.P[(size_t)t * N_IN + OFF_RW + col];
        const float pv = first ? 0.f : p.P[(size_t)(t - 1) * N_IN + OFF_RW + col];
        const float nx = last ? 0.f : p.P[(size_t)(t + 1) * N_IN + OFF_RW + col];
        float o = v + p.rw_mu[((size_t)l * 2 + 0) * RW_IN + col] * (pv - v) + p.rw_mu[((size_t)l * 2 + 1) * RW_IN + col] * (nx - v);
        if (col >= 3 * GD && col < 3 * GD + 2 * RW_WL) o = tanhf(o);
        else if (col >= 3 * GD + 2 * RW_WL + 2 * RW_AL) o = sigmoidf_(o);
        p.pm[i] = o;
    }
}

__global__ void k_rw_prep(Params p, int l) {
    const size_t n = (size_t)TT * GD;
    for (size_t i = gtid_(); i < n; i += gstr_()) {
        const int c = (int)(i % GD); const int t = (int)(i / GD); const int h = c / HD;
        const float* pr = p.pm + (size_t)t * RW_IN;
        const float k = pr[GD + c];
        float a[2], dec[2];
#pragma unroll
        for (int dir = 0; dir < 2; ++dir) {
            float wp = p.rw_w0[((size_t)l * 2 + dir) * GD + c];
            for (int r = 0; r < RW_WL; ++r) wp += pr[3 * GD + dir * RW_WL + r] * p.rw_w_up[(((size_t)l * 2 + dir) * RW_WL + r) * GD + c];
            dec[dir] = expf(-RW_DECAY_SCALE * sigmoidf_(wp));
            float ap = p.rw_a0[((size_t)l * 2 + dir) * GD + c];
            for (int r = 0; r < RW_AL; ++r) ap += pr[3 * GD + 2 * RW_WL + dir * RW_AL + r] * p.rw_a_up[(((size_t)l * 2 + dir) * RW_AL + r) * GD + c];
            a[dir] = sigmoidf_(ap);
        }
        float g = 0.f;
        for (int r = 0; r < RW_GL; ++r) g += pr[3 * GD + 2 * RW_WL + 2 * RW_AL + r] * p.rw_g_up[((size_t)l * RW_GL + r) * GD + c];
        float ss = 0.f;
        for (int j = 0; j < HD; ++j) { const float q = pr[GD + h * HD + j] * p.rw_k_k[(size_t)l * GD + h * HD + j]; ss += q * q; }
        const float kk = k * p.rw_k_k[(size_t)l * GD + c] / sqrtf(fmaxf(ss, 1e-12f));
#pragma unroll
        for (int dir = 0; dir < 2; ++dir) {
            const size_t o = ((size_t)dir * TT + t) * GD + c;
            p.rwW[o] = dec[dir]; p.rwB[o] = kk * a[dir]; p.rwKD[o] = k * (1.0f + (a[dir] - 1.0f) * p.rw_k_a[(size_t)l * GD + c]);
        }
        p.rwKK[i] = kk; p.rwG[i] = g;
    }
}

DEVFN int scan_pos(int dir, int step) {
    if (dir == 0) return step;
    return step < CTX ? (CTX - 1 - step) : (CTX + (SEQ - 1) - (step - CTX));
}

__global__ void __launch_bounds__(64) k_rw_scan(Params p) {
    const size_t total = (size_t)NB * NH * 2 * HD;
    for (size_t id = gtid_(); id < total; id += gstr_()) {
        const int i = (int)(id % HD); const int u = (int)(id / HD); const int dir = u % 2, h = (u / 2) % NH, b = u / (2 * NH);
        float S[HD];
#pragma unroll
        for (int j = 0; j < HD; ++j) S[j] = 0.f;
        for (int step = 0; step < LL; ++step) {
            const int t = b * LL + scan_pos(dir, step);
            const float* W = p.rwW + ((size_t)dir * TT + t) * GD + h * HD;
            const float* Bv = p.rwB + ((size_t)dir * TT + t) * GD + h * HD;
            const float* KD = p.rwKD + ((size_t)dir * TT + t) * GD + h * HD;
            const float* KK = p.rwKK + (size_t)t * GD + h * HD;
            const float* R = p.pm + (size_t)t * RW_IN + h * HD;
            const float vi = p.pm[(size_t)t * RW_IN + 2 * GD + h * HD + i];
            float sa = 0.f;
#pragma unroll
            for (int j = 0; j < HD; ++j) sa -= S[j] * KK[j];
            float y = 0.f;
#pragma unroll
            for (int j = 0; j < HD; ++j) { S[j] = S[j] * W[j] + sa * Bv[j] + vi * KD[j]; y += S[j] * R[j]; }
            p.rwY[((size_t)dir * TT + t) * GD + h * HD + i] = y;
        }
    }
}

__global__ void __launch_bounds__(64) k_rw_out(Params p, int l) {
    const size_t n = (size_t)TT * NH;
    for (size_t id = gtid_(); id < n; id += gstr_()) {
        const int h = (int)(id % NH); const int t = (int)(id / NH);
        const float* yf = p.rwY + ((size_t)0 * TT + t) * GD + h * HD;
        const float* yb = p.rwY + ((size_t)1 * TT + t) * GD + h * HD;
        const float* pr = p.pm + (size_t)t * RW_IN;
        float mu = 0.f, bonus = 0.f;
        for (int j = 0; j < HD; ++j) { mu += yf[j] + yb[j]; bonus += pr[h * HD + j] * pr[GD + h * HD + j] * p.rw_r_k[(size_t)l * GD + h * HD + j]; }
        mu /= HD;
        float var = 0.f;
        for (int j = 0; j < HD; ++j) { const float d = yf[j] + yb[j] - mu; var += d * d; }
        var /= HD;
        const float rs = 1.0f / sqrtf(var + RW_GN_EPS);
        for (int j = 0; j < HD; ++j) {
            const int c = h * HD + j;
            float y = (yf[j] + yb[j] - mu) * rs * p.rw_gn_g[(size_t)l * GD + c] + p.rw_gn_b[(size_t)l * GD + c];
            y += bonus * pr[2 * GD + c];
            p.Ymix[(size_t)t * D_MIX + 0 * GD + c] = f2bf(y * p.rwG[(size_t)t * GD + c]);
        }
    }
}

__global__ void k_mb_prep(Params p, int l) {
    const size_t n = (size_t)TT * MB_CONV_DIM;
    for (size_t i = gtid_(); i < n; i += gstr_()) {
        const int c = (int)(i % MB_CONV_DIM); const int t = (int)(i / MB_CONV_DIM); const int s = t % LL;
        const int lo = s < CTX ? 0 : CTX, hi = s < CTX ? CTX : LL;
        float acc = p.mb_conv_b[(size_t)l * MB_CONV_DIM + c];
        for (int j = 0; j < MB_CONV; ++j) {
            const int so = s + j - MB_CONV / 2;
            if (so >= lo && so < hi) acc += p.mb_conv_w[((size_t)l * MB_CONV + j) * MB_CONV_DIM + c] * p.P[(size_t)(t + j - MB_CONV / 2) * N_IN + OFF_MB + GD + c];
        }
        p.xc[i] = siluf_(acc);
    }
    const size_t n2 = (size_t)TT * 2 * NH;
    for (size_t i = gtid_(); i < n2; i += gstr_()) {
        const int q = (int)(i % (2 * NH)); const int t = (int)(i / (2 * NH));
        p.dt[i] = softplusf_(p.P[(size_t)t * N_IN + OFF_MB + GD + MB_CONV_DIM + q] + p.mb_dt_bias[(size_t)l * 2 * NH + q]);
    }
}

__global__ void __launch_bounds__(64) k_mb_scan(Params p, int l) {
    const size_t total = (size_t)NB * NH * 2 * HD;
    for (size_t id = gtid_(); id < total; id += gstr_()) {
        const int pi = (int)(id % HD); const int u = (int)(id / HD); const int dir = u % 2, h = (u / 2) % NH, b = u / (2 * NH);
        const int grp = h / (NH / MB_GROUPS);
        const float A = -expf(p.mb_a_log[((size_t)l * 2 + dir) * NH + h]);
        float H[MB_STATE];
#pragma unroll
        for (int n = 0; n < MB_STATE; ++n) H[n] = 0.f;
        for (int step = 0; step < LL; ++step) {
            const int t = b * LL + scan_pos(dir, step);
            const float dtv = p.dt[(size_t)t * 2 * NH + dir * NH + h];
            const float dA = expf(dtv * A);
            const float xdt = p.xc[(size_t)t * MB_CONV_DIM + h * HD + pi] * dtv;
            const float* Bn = p.xc + (size_t)t * MB_CONV_DIM + GD + grp * MB_STATE;
            const float* Cn = p.xc + (size_t)t * MB_CONV_DIM + GD + MB_GROUPS * MB_STATE + grp * MB_STATE;
            float y = 0.f;
#pragma unroll
            for (int n = 0; n < MB_STATE; ++n) { H[n] = dA * H[n] + xdt * Bn[n]; y += Cn[n] * H[n]; }
            p.mbY[((size_t)dir * TT + t) * GD + h * HD + pi] = y;
        }
    }
}

__global__ void __launch_bounds__(64) k_mb_out(Params p, int l) {
    constexpr int GW = GD / MB_GROUPS;
    const size_t n = (size_t)TT * MB_GROUPS;
    for (size_t id = gtid_(); id < n; id += gstr_()) {
        const int g = (int)(id % MB_GROUPS); const int t = (int)(id / MB_GROUPS);
        float ss = 0.f;
        for (int j = 0; j < GW; ++j) {
            const int c = g * GW + j;
            const float y = p.mbY[((size_t)0 * TT + t) * GD + c] + p.mbY[((size_t)1 * TT + t) * GD + c] + p.mb_d[(size_t)l * NH + c / HD] * p.xc[(size_t)t * MB_CONV_DIM + c];
            const float v = y * siluf_(p.P[(size_t)t * N_IN + OFF_MB + c]);
            ss += v * v;
        }
        const float rs = 1.0f / sqrtf(ss / GW + RMS_EPS);
        for (int j = 0; j < GW; ++j) {
            const int c = g * GW + j;
            const float y = p.mbY[((size_t)0 * TT + t) * GD + c] + p.mbY[((size_t)1 * TT + t) * GD + c] + p.mb_d[(size_t)l * NH + c / HD] * p.xc[(size_t)t * MB_CONV_DIM + c];
            const float v = y * siluf_(p.P[(size_t)t * N_IN + OFF_MB + c]);
            p.Ymix[(size_t)t * D_MIX + 1 * GD + c] = f2bf(v * rs * p.mb_norm_g[(size_t)l * GD + c]);
        }
    }
}

__global__ void __launch_bounds__(64) k_mla_norm(Params p, int l) {
    for (size_t t = gtid_(); t < (size_t)TT; t += gstr_()) {
        const float* pr = p.P + t * N_IN + OFF_MLA;
        float ss = 0.f;
        for (int i = 0; i < MLA_QL; ++i) ss += pr[i] * pr[i];
        float rs = 1.0f / sqrtf(ss / MLA_QL + RMS_EPS);
        for (int i = 0; i < MLA_QL; ++i) p.qn[t * MLA_QL + i] = f2bf(pr[i] * rs * p.mla_q_norm[(size_t)l * MLA_QL + i]);
        ss = 0.f;
        for (int i = 0; i < MLA_KVL; ++i) ss += pr[MLA_QL + i] * pr[MLA_QL + i];
        rs = 1.0f / sqrtf(ss / MLA_KVL + RMS_EPS);
        for (int i = 0; i < MLA_KVL; ++i) p.kvn[t * MLA_KVL + i] = f2bf(pr[MLA_QL + i] * rs * p.mla_kv_norm[(size_t)l * MLA_KVL + i]);
    }
}

DEVFN float rope_elem(const float* xv, int e, int tl) {
    constexpr int NF = MLA_ROPE / 4;
    const int axis = e / (2 * NF), half = (e / NF) % 2, f = e % NF;
    const float pos = (float)(axis == 0 ? tl / GRID_W : tl % GRID_W);
    const float ang = pos * powf(ROPE_BASE, -(float)f / (float)NF);
    const float cs = cosf(ang), sn = sinf(ang);
    const float x1 = xv[axis * 2 * NF + f], x2 = xv[axis * 2 * NF + NF + f];
    return half == 0 ? x1 * cs - x2 * sn : x2 * cs + x1 * sn;
}

__global__ void __launch_bounds__(64) k_mla_rope(Params p) {
    const size_t n = (size_t)TT * NH;
    for (size_t id = gtid_(); id < n; id += gstr_()) {
        const int h = (int)(id % NH); const int t = (int)(id / NH); const int s = t % LL; const bool lat = s >= CTX; const int tl = s - CTX;
        const float* q = p.Qraw + (size_t)t * NH * MLA_QK + h * MLA_QK;
        const float* kv = p.KVraw + (size_t)t * NH * (MLA_NOPE + MLA_V) + h * (MLA_NOPE + MLA_V);
        const float* kpe = p.P + (size_t)t * N_IN + OFF_MLA + MLA_QL + MLA_KVL;
        float* qo = p.Qf + id * MLA_QK; float* ko = p.Kf + id * MLA_QK; float* vo = p.Vf + id * MLA_V;
        for (int d = 0; d < MLA_NOPE; ++d) { qo[d] = q[d]; ko[d] = kv[d]; }
        for (int e = 0; e < MLA_ROPE; ++e) {
            qo[MLA_NOPE + e] = lat ? rope_elem(q + MLA_NOPE, e, tl) : q[MLA_NOPE + e];
            ko[MLA_NOPE + e] = lat ? rope_elem(kpe, e, tl) : kpe[e];
        }
        for (int d = 0; d < MLA_V; ++d) vo[d] = kv[MLA_NOPE + d];
    }
}

__global__ void __launch_bounds__(64) k_mla_attn(Params p) {
    const size_t n = (size_t)TT * NH;
    const float scale = 1.0f / sqrtf((float)MLA_QK);
    for (size_t id = gtid_(); id < n; id += gstr_()) {
        const int s = (int)(id % LL); const int h = (int)((id / LL) % NH); const int b = (int)(id / ((size_t)LL * NH));
        const int t = b * LL + s;
        const int nkeys = s < CTX ? CTX : LL;
        float q[MLA_QK], acc[MLA_V];
#pragma unroll
        for (int d = 0; d < MLA_QK; ++d) q[d] = p.Qf[((size_t)t * NH + h) * MLA_QK + d] * scale;
#pragma unroll
        for (int d = 0; d < MLA_V; ++d) acc[d] = 0.f;
        float m = -1e30f, lsum = 0.f;
        for (int j = 0; j < nkeys; ++j) {
            const float* kr = p.Kf + ((size_t)(b * LL + j) * NH + h) * MLA_QK;
            const float* vr = p.Vf + ((size_t)(b * LL + j) * NH + h) * MLA_V;
            float sc = 0.f;
#pragma unroll
            for (int d = 0; d < MLA_QK; ++d) sc += q[d] * kr[d];
            const float mn = fmaxf(m, sc);
            const float corr = expf(m - mn), pj = expf(sc - mn);
            lsum = lsum * corr + pj;
#pragma unroll
            for (int d = 0; d < MLA_V; ++d) acc[d] = acc[d] * corr + pj * vr[d];
            m = mn;
        }
        const float inv = 1.0f / lsum;
#pragma unroll
        for (int d = 0; d < MLA_V; ++d) p.Ymix[(size_t)t * D_MIX + 2 * GD + h * MLA_V + d] = f2bf(acc[d] * inv);
    }
}

__global__ void __launch_bounds__(64) k_na_attn(Params p, int l) {
    const size_t n = (size_t)TT * NH;
    const float scale = 1.0f / sqrtf((float)HD);
    constexpr int ROWS = SEQ / GRID_W;
    constexpr int WR = NA_WR < ROWS ? NA_WR : ROWS;
    for (size_t id = gtid_(); id < n; id += gstr_()) {
        const int s = (int)(id % LL); const int h = (int)((id / LL) % NH); const int b = (int)(id / ((size_t)LL * NH));
        const int t = b * LL + s;
        float q[HD], acc[HD];
#pragma unroll
        for (int d = 0; d < HD; ++d) { q[d] = p.P[(size_t)t * N_IN + OFF_NA + h * HD + d] * scale; acc[d] = 0.f; }
        float m = -1e30f, lsum = 0.f;
        const bool lat = s >= CTX;
        const int tl = s - CTX; const int r = tl / GRID_W, c = tl % GRID_W;
        int rs = r - WR / 2; rs = rs < 0 ? 0 : (rs > ROWS - WR ? ROWS - WR : rs);
        int cs = c - NA_WC / 2; cs = cs < 0 ? 0 : (cs > GRID_W - NA_WC ? GRID_W - NA_WC : cs);
        const int nloc = lat ? WR * NA_WC : 0;
        for (int j = 0; j < nloc + CTX; ++j) {
            int tk; float bias = 0.f;
            if (j < nloc) {
                const int i2 = j / NA_WC, j2 = j % NA_WC;
                tk = b * LL + CTX + (rs + i2) * GRID_W + cs + j2;
                bias = p.na_rpb[(((size_t)l * NH + h) * (2 * NA_WR - 1) + (rs + i2 - r + NA_WR - 1)) * (2 * NA_WC - 1) + (cs + j2 - c + NA_WC - 1)];
            } else tk = b * LL + (j - nloc);
            const float* kr = p.P + (size_t)tk * N_IN + OFF_NA + GD + h * HD;
            const float* vr = p.P + (size_t)tk * N_IN + OFF_NA + 2 * GD + h * HD;
            float sc = bias;
#pragma unroll
            for (int d = 0; d < HD; ++d) sc += q[d] * kr[d];
            const float mn = fmaxf(m, sc);
            const float corr = expf(m - mn), pj = expf(sc - mn);
            lsum = lsum * corr + pj;
#pragma unroll
            for (int d = 0; d < HD; ++d) acc[d] = acc[d] * corr + pj * vr[d];
            m = mn;
        }
        const float inv = 1.0f / lsum;
#pragma unroll
        for (int d = 0; d < HD; ++d) p.Ymix[(size_t)t * D_MIX + 3 * GD + h * HD + d] = f2bf(acc[d] * inv);
    }
}

__global__ void __launch_bounds__(64) k_ln1_route(Params p, int l) {
    const float alpha = DN_ALPHA;
    for (size_t t = gtid_(); t < (size_t)TT; t += gstr_()) {
        const int b = (int)(t / LL), s = (int)(t % LL); const int r = s < CTX ? NB : b;
        const float* m = p.mod + ((size_t)l * NMOD + r) * 6 * D;
        float* xr = p.xs + t * D; const float* yr = p.yo + t * D;
        float mu = 0.f;
        for (int d = 0; d < D; ++d) mu += alpha * xr[d] + m[2 * D + d] * yr[d];
        mu /= D;
        float var = 0.f;
        for (int d = 0; d < D; ++d) { const float u = alpha * xr[d] + m[2 * D + d] * yr[d] - mu; var += u * u; }
        var /= D;
        const float rs = 1.0f / sqrtf(var + LN_EPS);
        float lg[NE];
#pragma unroll
        for (int e = 0; e < NE; ++e) lg[e] = 0.f;
        for (int d = 0; d < D; ++d) {
            const float u = alpha * xr[d] + m[2 * D + d] * yr[d];
            const float xn = (u - mu) * rs * p.ln1_g[(size_t)l * D + d] + p.ln1_b[(size_t)l * D + d];
            xr[d] = xn;
            const float hv = xn * (1.0f + m[4 * D + d]) + m[3 * D + d];
            p.hb[t * D + d] = f2bf(hv);
#pragma unroll
            for (int e = 0; e < NE; ++e) lg[e] += hv * p.router_w[(size_t)d * NE + e];
        }
        float gbest = -1e30f; int e1 = 0, e2 = 1; float w1 = 0.f, w2 = 0.f;
#pragma unroll
        for (int g = 0; g < NEG; ++g) {
            float m1 = -1e30f, m2 = -1e30f, s1 = 0.f, s2 = 0.f; int i1 = 0, i2 = 0;
#pragma unroll
            for (int i = 0; i < EPG; ++i) {
                const float scv = sigmoidf_(lg[g * EPG + i]); const float v = scv + p.router_b[g * EPG + i];
                if (v > m1) { m2 = m1; i2 = i1; s2 = s1; m1 = v; i1 = g * EPG + i; s1 = scv; }
                else if (v > m2) { m2 = v; i2 = g * EPG + i; s2 = scv; }
            }
            if (m1 + m2 > gbest) { gbest = m1 + m2; e1 = i1; e2 = i2; w1 = s1; w2 = s2; }
        }
        const float wn = ROUTED_SCALE / (w1 + w2);
        for (int k = 0; k < 2; ++k) {
            const int e = k == 0 ? e1 : e2; const float w = (k == 0 ? w1 : w2) * wn;
            const int pos = atomicAdd(&p.cnt[l * NE + e], 1);
            const size_t o = (size_t)e * CAP + pos;
            p.ent_tok[o] = (int)t; p.ent_row[o] = (int)t * 2 + k; p.ent_dst[o] = k * TT + (int)t; p.ent_w[o] = w;
        }
    }
}

__global__ void k_hid(Params p) {
    const size_t n = (size_t)2 * TT * D_EXP;
    for (size_t i = gtid_(); i < n; i += gstr_()) {
        const int j = (int)(i % D_EXP); const size_t row = i / D_EXP;
        p.hid[i] = f2bf(siluf_(p.GU[row * 2 * D_EXP + j]) * p.GU[row * 2 * D_EXP + D_EXP + j]);
    }
}

__global__ void __launch_bounds__(64) k_ln2(Params p, int l) {
    const float alpha = DN_ALPHA;
    for (size_t t = gtid_(); t < (size_t)TT; t += gstr_()) {
        const int b = (int)(t / LL), s = (int)(t % LL); const int r = s < CTX ? NB : b;
        const float* m = p.mod + ((size_t)l * NMOD + r) * 6 * D;
        float* xr = p.xs + t * D; const float* f0 = p.F + t * D; const float* f1 = p.F + ((size_t)TT + t) * D;
        float mu = 0.f;
        for (int d = 0; d < D; ++d) mu += alpha * xr[d] + m[5 * D + d] * (f0[d] + f1[d]);
        mu /= D;
        float var = 0.f;
        for (int d = 0; d < D; ++d) { const float u = alpha * xr[d] + m[5 * D + d] * (f0[d] + f1[d]) - mu; var += u * u; }
        var /= D;
        const float rs = 1.0f / sqrtf(var + LN_EPS);
        for (int d = 0; d < D; ++d) {
            const float u = alpha * xr[d] + m[5 * D + d] * (f0[d] + f1[d]);
            const float xn = (u - mu) * rs * p.ln2_g[(size_t)l * D + d] + p.ln2_b[(size_t)l * D + d];
            xr[d] = xn;
            if (l == DEPTH - 1 && s >= CTX) p.out[((size_t)b * SEQ + (s - CTX)) * D + d] = xn;
        }
    }
}

struct GemmArgs {
    const bf16_t* A; int lda; const int* a_rows;
    const bf16_t* Bt; int ldb; size_t b_gstride;
    float* C; int ldc; const int* c_rows; const float* row_scale;
    int M, N, K; const int* m_count; size_t idx_gstride;
    int groups, pad;
};

#ifndef CPU_TEST
typedef short bf16x8_t __attribute__((ext_vector_type(8)));
typedef float f32x16_t __attribute__((ext_vector_type(16)));
constexpr int GT = 128, GK = 32, GLD = 40;

__global__ void __launch_bounds__(256) k_gemm(GemmArgs g) {
    __shared__ __attribute__((aligned(16))) bf16_t sA[GT * GLD];
    __shared__ __attribute__((aligned(16))) bf16_t sB[GT * GLD];
    const int tid = threadIdx.x, lane = tid & 63, wave = tid >> 6, wr = wave >> 1, wc = wave & 1;
    const int mt_n = (g.M + GT - 1) / GT, nt_n = (g.N + GT - 1) / GT;
    const int total = g.groups * mt_n * nt_n;
    for (int tile = blockIdx.x; tile < total; tile += gridDim.x) {
        const int grp = tile / (mt_n * nt_n); const int rem = tile % (mt_n * nt_n); const int mt = rem / nt_n, nt = rem % nt_n;
        const int M = g.m_count ? g.m_count[grp] : g.M;
        const int m0 = mt * GT, n0 = nt * GT;
        if (m0 >= M) continue;
        const int* a_rows = g.a_rows ? g.a_rows + (size_t)grp * g.idx_gstride : nullptr;
        const int* c_rows = g.c_rows ? g.c_rows + (size_t)grp * g.idx_gstride : nullptr;
        const float* rsc = g.row_scale ? g.row_scale + (size_t)grp * g.idx_gstride : nullptr;
        const bf16_t* Bt = g.Bt + (size_t)grp * g.b_gstride;
        const int r0 = tid >> 2, ch = tid & 3;
        const int gm0 = m0 + r0, gm1 = m0 + r0 + 64;
        const int ar0 = gm0 < M ? (a_rows ? a_rows[gm0] : gm0) : (a_rows ? a_rows[m0] : m0);
        const int ar1 = gm1 < M ? (a_rows ? a_rows[gm1] : gm1) : (a_rows ? a_rows[m0] : m0);
        const int gn0 = n0 + r0, gn1 = n0 + r0 + 64;
        const int br0 = gn0 < g.N ? gn0 : n0, br1 = gn1 < g.N ? gn1 : n0;
        const bf16_t* ap0 = g.A + (size_t)ar0 * g.lda + ch * 8; const bf16_t* ap1 = g.A + (size_t)ar1 * g.lda + ch * 8;
        const bf16_t* bp0 = Bt + (size_t)br0 * g.ldb + ch * 8; const bf16_t* bp1 = Bt + (size_t)br1 * g.ldb + ch * 8;
        const int lo0 = r0 * GLD + ch * 8, lo1 = (r0 + 64) * GLD + ch * 8;
        f32x16_t acc[2][2];
#pragma unroll
        for (int i = 0; i < 2; ++i)
#pragma unroll
            for (int j = 0; j < 2; ++j)
#pragma unroll
                for (int r = 0; r < 16; ++r) acc[i][j][r] = 0.f;
        for (int k0 = 0; k0 < g.K; k0 += GK) {
            const uint4 va0 = *(const uint4*)(ap0 + k0), va1 = *(const uint4*)(ap1 + k0), vb0 = *(const uint4*)(bp0 + k0), vb1 = *(const uint4*)(bp1 + k0);
            __syncthreads();
            *(uint4*)(sA + lo0) = va0; *(uint4*)(sA + lo1) = va1; *(uint4*)(sB + lo0) = vb0; *(uint4*)(sB + lo1) = vb1;
            __syncthreads();
#pragma unroll
            for (int kk = 0; kk < GK; kk += 16) {
                bf16x8_t af[2], bfr[2];
#pragma unroll
                for (int i = 0; i < 2; ++i) af[i] = *(const bf16x8_t*)(sA + (wr * 64 + i * 32 + (lane & 31)) * GLD + kk + (lane >> 5) * 8);
#pragma unroll
                for (int j = 0; j < 2; ++j) bfr[j] = *(const bf16x8_t*)(sB + (wc * 64 + j * 32 + (lane & 31)) * GLD + kk + (lane >> 5) * 8);
#pragma unroll
                for (int i = 0; i < 2; ++i)
#pragma unroll
                    for (int j = 0; j < 2; ++j) acc[i][j] = __builtin_amdgcn_mfma_f32_32x32x16_bf16(af[i], bfr[j], acc[i][j], 0, 0, 0);
            }
        }
#pragma unroll
        for (int i = 0; i < 2; ++i)
#pragma unroll
            for (int r = 0; r < 16; ++r) {
                const int row = m0 + wr * 64 + i * 32 + (r & 3) + 8 * (r >> 2) + 4 * (lane >> 5);
                if (row < M) {
                    const int crow = c_rows ? c_rows[row] : row; const float sc = rsc ? rsc[row] : 1.0f;
#pragma unroll
                    for (int j = 0; j < 2; ++j) {
                        const int col = n0 + wc * 64 + j * 32 + (lane & 31);
                        if (col < g.N) g.C[(size_t)crow * g.ldc + col] = acc[i][j][r] * sc;
                    }
                }
            }
        __syncthreads();
    }
}
#else
__global__ void k_gemm(GemmArgs g) {
    for (int grp = 0; grp < g.groups; ++grp) {
        const int M = g.m_count ? g.m_count[grp] : g.M;
        const int* a_rows = g.a_rows ? g.a_rows + (size_t)grp * g.idx_gstride : nullptr;
        const int* c_rows = g.c_rows ? g.c_rows + (size_t)grp * g.idx_gstride : nullptr;
        const float* rsc = g.row_scale ? g.row_scale + (size_t)grp * g.idx_gstride : nullptr;
        const bf16_t* Bt = g.Bt + (size_t)grp * g.b_gstride;
        const size_t total = (size_t)M * g.N;
        for (size_t id = gtid_(); id < total; id += gstr_()) {
            const int n = (int)(id % g.N), m = (int)(id / g.N);
            const int ar = a_rows ? a_rows[m] : m;
            float acc = 0.f;
            for (int k = 0; k < g.K; ++k) acc += bf2f(g.A[(size_t)ar * g.lda + k]) * bf2f(Bt[(size_t)n * g.ldb + k]);
            const int crow = c_rows ? c_rows[m] : m;
            g.C[(size_t)crow * g.ldc + n] = acc * (rsc ? rsc[m] : 1.0f);
        }
    }
}
#endif

static void run_gemm(hipStream_t stream, const bf16_t* A, int lda, const int* a_rows, const bf16_t* Bt, int ldb, size_t b_gstride,
                     float* C, int ldc, const int* c_rows, const float* row_scale, int M, int N, int K, const int* m_count, size_t idx_gstride, int groups) {
    GemmArgs g{};
    g.A = A; g.lda = lda; g.a_rows = a_rows; g.Bt = Bt; g.ldb = ldb; g.b_gstride = b_gstride; g.C = C; g.ldc = ldc; g.c_rows = c_rows; g.row_scale = row_scale;
    g.M = M; g.N = N; g.K = K; g.m_count = m_count; g.idx_gstride = idx_gstride; g.groups = groups; g.pad = 0;
#ifndef CPU_TEST
    const int tiles = groups * ((M + 127) / 128) * ((N + 127) / 128);
    LAUNCH(k_gemm, tiles < 4096 ? tiles : 4096, 256, stream, g);
#else
    LAUNCH(k_gemm, 1, 1, stream, g);
#endif
}

static size_t carve(size_t& off, size_t bytes) { const size_t o = off; off += (bytes + 255) & ~(size_t)255; return o; }

extern "C" void kernel_launch(void* const* d_in, const int* in_sizes, int n_in, void* d_out, int out_size, void* d_ws, size_t ws_size, hipStream_t stream) {
    (void)in_sizes; (void)n_in; (void)out_size;
    Params p{};
    const float* const* in = (const float* const*)d_in;
    p.x = in[0]; p.c = in[1]; p.ctx = in[2]; p.c_ctx = in[3]; p.ada_w = in[4]; p.ada_b = in[5]; p.w_in = in[6]; p.w_out = in[7];
    p.ln1_g = in[8]; p.ln1_b = in[9]; p.ln2_g = in[10]; p.ln2_b = in[11];
    p.rw_mu = in[12]; p.rw_w0 = in[13]; p.rw_w_up = in[14]; p.rw_a0 = in[15]; p.rw_a_up = in[16]; p.rw_g_up = in[17]; p.rw_k_k = in[18]; p.rw_k_a = in[19];
    p.rw_r_k = in[20]; p.rw_gn_g = in[21]; p.rw_gn_b = in[22];
    p.mb_conv_w = in[23]; p.mb_conv_b = in[24]; p.mb_a_log = in[25]; p.mb_dt_bias = in[26]; p.mb_d = in[27]; p.mb_norm_g = in[28];
    p.mla_q_norm = in[29]; p.mla_w_uq = in[30]; p.mla_kv_norm = in[31]; p.mla_w_ukv = in[32]; p.na_rpb = in[33];
    p.router_w = in[34]; p.router_b = in[35]; p.exp_w_gate = in[36]; p.exp_w_up = in[37]; p.exp_w_down = in[38];
    p.out = (float*)d_out;

    char* ws = (char*)d_ws; size_t off = 0;
    p.WinT = (bf16_t*)(ws + carve(off, (size_t)DEPTH * N_IN * D * 2));
    p.WoutT = (bf16_t*)(ws + carve(off, (size_t)DEPTH * D * D_MIX * 2));
    p.WguT = (bf16_t*)(ws + carve(off, (size_t)DEPTH * NE * 2 * D_EXP * D * 2));
    p.WdT = (bf16_t*)(ws + carve(off, (size_t)DEPTH * NE * D * D_EXP * 2));
    p.WuqT = (bf16_t*)(ws + carve(off, (size_t)DEPTH * NH * MLA_QK * MLA_QL * 2));
    p.WukvT = (bf16_t*)(ws + carve(off, (size_t)DEPTH * NH * (MLA_NOPE + MLA_V) * MLA_KVL * 2));
    p.xs = (float*)(ws + carve(off, (size_t)TT * D * 4));
    p.xm = (bf16_t*)(ws + carve(off, (size_t)TT * D * 2));
    p.mod = (float*)(ws + carve(off, (size_t)DEPTH * NMOD * 6 * D * 4));
    p.cnt = (int*)(ws + carve(off, (size_t)DEPTH * NE * 4));
    p.ent_tok = (int*)(ws + carve(off, (size_t)NE * CAP * 4));
    p.ent_row = (int*)(ws + carve(off, (size_t)NE * CAP * 4));
    p.ent_dst = (int*)(ws + carve(off, (size_t)NE * CAP * 4));
    p.ent_w = (float*)(ws + carve(off, (size_t)NE * CAP * 4));
    p.Ymix = (bf16_t*)(ws + carve(off, (size_t)TT * D_MIX * 2));
    p.hb = (bf16_t*)(ws + carve(off, (size_t)TT * D * 2));
    p.hid = (bf16_t*)(ws + carve(off, (size_t)2 * TT * D_EXP * 2));
    const size_t regA = off;
    p.P = (float*)(ws + carve(off, (size_t)TT * N_IN * 4));
    p.pm = (float*)(ws + carve(off, (size_t)TT * RW_IN * 4));
    p.rwW = (float*)(ws + carve(off, (size_t)2 * TT * GD * 4));
    p.rwB = (float*)(ws + carve(off, (size_t)2 * TT * GD * 4));
    p.rwKD = (float*)(ws + carve(off, (size_t)2 * TT * GD * 4));
    p.rwKK = (float*)(ws + carve(off, (size_t)TT * GD * 4));
    p.rwG = (float*)(ws + carve(off, (size_t)TT * GD * 4));
    p.rwY = (float*)(ws + carve(off, (size_t)2 * TT * GD * 4));
    p.xc = (float*)(ws + carve(off, (size_t)TT * MB_CONV_DIM * 4));
    p.dt = (float*)(ws + carve(off, (size_t)TT * 2 * NH * 4));
    p.mbY = (float*)(ws + carve(off, (size_t)2 * TT * GD * 4));
    p.qn = (bf16_t*)(ws + carve(off, (size_t)TT * MLA_QL * 2));
    p.kvn = (bf16_t*)(ws + carve(off, (size_t)TT * MLA_KVL * 2));
    p.Qraw = (float*)(ws + carve(off, (size_t)TT * NH * MLA_QK * 4));
    p.KVraw = (float*)(ws + carve(off, (size_t)TT * NH * (MLA_NOPE + MLA_V) * 4));
    p.Qf = (float*)(ws + carve(off, (size_t)TT * NH * MLA_QK * 4));
    p.Kf = (float*)(ws + carve(off, (size_t)TT * NH * MLA_QK * 4));
    p.Vf = (float*)(ws + carve(off, (size_t)TT * NH * MLA_V * 4));
    const size_t endA = off;
    off = regA;
    p.yo = (float*)(ws + carve(off, (size_t)TT * D * 4));
    p.GU = (float*)(ws + carve(off, (size_t)2 * TT * 2 * D_EXP * 4));
    p.F = (float*)(ws + carve(off, (size_t)2 * TT * D * 4));
    const size_t endB = off;
    const size_t need = endA > endB ? endA : endB;
    if (need > ws_size) return;

    const int EB = 2048, ET = 256;
    LAUNCH(k_init, EB, ET, stream, p);
    LAUNCH(k_mod, (DEPTH * 6 * D + 63) / 64, 64, stream, p);
    LAUNCH(k_transpose, EB, ET, stream, p.w_in, p.WinT, D, N_IN, DEPTH, (size_t)N_IN * D, 0);
    LAUNCH(k_transpose, EB, ET, stream, p.w_out, p.WoutT, D_MIX, D, DEPTH, (size_t)D * D_MIX, 0);
    LAUNCH(k_transpose, EB, ET, stream, p.exp_w_gate, p.WguT, D, D_EXP, DEPTH * NE, (size_t)2 * D_EXP * D, 0);
    LAUNCH(k_transpose, EB, ET, stream, p.exp_w_up, p.WguT, D, D_EXP, DEPTH * NE, (size_t)2 * D_EXP * D, D_EXP);
    LAUNCH(k_transpose, EB, ET, stream, p.exp_w_down, p.WdT, D_EXP, D, DEPTH * NE, (size_t)D * D_EXP, 0);
    LAUNCH(k_transpose, EB, ET, stream, p.mla_w_uq, p.WuqT, MLA_QL, NH * MLA_QK, DEPTH, (size_t)NH * MLA_QK * MLA_QL, 0);
    LAUNCH(k_transpose, EB, ET, stream, p.mla_w_ukv, p.WukvT, MLA_KVL, NH * (MLA_NOPE + MLA_V), DEPTH, (size_t)NH * (MLA_NOPE + MLA_V) * MLA_KVL, 0);

    for (int l = 0; l < DEPTH; ++l) {
        LAUNCH(k_modulate, EB, ET, stream, p, l);
        run_gemm(stream, p.xm, D, nullptr, p.WinT + (size_t)l * N_IN * D, D, 0, p.P, N_IN, nullptr, nullptr, TT, N_IN, D, nullptr, 0, 1);
        LAUNCH(k_rw_mix, EB, ET, stream, p, l);
        LAUNCH(k_rw_prep, EB, ET, stream, p, l);
        LAUNCH(k_rw_scan, NB * NH * 2, HD, stream, p);
        LAUNCH(k_rw_out, (TT * NH + 63) / 64, 64, stream, p, l);
        LAUNCH(k_mb_prep, EB, ET, stream, p, l);
        LAUNCH(k_mb_scan, NB * NH * 2, HD, stream, p, l);
        LAUNCH(k_mb_out, (TT * MB_GROUPS + 63) / 64, 64, stream, p, l);
        LAUNCH(k_mla_norm, (TT + 63) / 64, 64, stream, p, l);
        run_gemm(stream, p.qn, MLA_QL, nullptr, p.WuqT + (size_t)l * NH * MLA_QK * MLA_QL, MLA_QL, 0, p.Qraw, NH * MLA_QK, nullptr, nullptr, TT, NH * MLA_QK, MLA_QL, nullptr, 0, 1);
        run_gemm(stream, p.kvn, MLA_KVL, nullptr, p.WukvT + (size_t)l * NH * (MLA_NOPE + MLA_V) * MLA_KVL, MLA_KVL, 0, p.KVraw, NH * (MLA_NOPE + MLA_V), nullptr, nullptr, TT, NH * (MLA_NOPE + MLA_V), MLA_KVL, nullptr, 0, 1);
        LAUNCH(k_mla_rope, (TT * NH + 63) / 64, 64, stream, p);
        LAUNCH(k_mla_attn, (TT * NH + 63) / 64, 64, stream, p);
        LAUNCH(k_na_attn, (TT * NH + 63) / 64, 64, stream, p, l);
        run_gemm(stream, p.Ymix, D_MIX, nullptr, p.WoutT + (size_t)l * D * D_MIX, D_MIX, 0, p.yo, D, nullptr, nullptr, TT, D, D_MIX, nullptr, 0, 1);
        LAUNCH(k_ln1_route, (TT + 63) / 64, 64, stream, p, l);
        run_gemm(stream, p.hb, D, p.ent_tok, p.WguT + (size_t)l * NE * 2 * D_EXP * D, D, (size_t)2 * D_EXP * D, p.GU, 2 * D_EXP, p.ent_row, nullptr, CAP, 2 * D_EXP, D, p.cnt + l * NE, CAP, NE);
        LAUNCH(k_hid, EB, ET, stream, p);
        run_gemm(stream, p.hid, D_EXP, p.ent_row, p.WdT + (size_t)l * NE * D * D_EXP, D_EXP, (size_t)D * D_EXP, p.F, D, p.ent_dst, p.ent_w, CAP, D, D_EXP, p.cnt + l * NE, CAP, NE);
        LAUNCH(k_ln2, (TT + 63) / 64, 64, stream, p, l);
    }
}
```

```cpp
#include <hip/hip_runtime.h>
#include <stdint.h>
#include <stddef.h>
#include <math.h>

#ifndef CFG_SMALL
constexpr int D = 2048, NB = 2, SEQ = 4096, DEPTH = 4, CTX = 256, GRID_W = 64;
constexpr int HD = 64;
constexpr int RW_WL = 64, RW_AL = 64, RW_GL = 128;
constexpr int MB_STATE = 128, MB_GROUPS = 2, MB_CONV = 5;
constexpr int MLA_NOPE = 64, MLA_ROPE = 32;
constexpr int NA_WR = 8, NA_WC = 16;
constexpr int NE = 16, NEG = 4;
#else
constexpr int D = 256, NB = 2, SEQ = 64, DEPTH = 2, CTX = 16, GRID_W = 8;
constexpr int HD = 16;
constexpr int RW_WL = 8, RW_AL = 8, RW_GL = 16;
constexpr int MB_STATE = 16, MB_GROUPS = 2, MB_CONV = 5;
constexpr int MLA_NOPE = 16, MLA_ROPE = 8;
constexpr int NA_WR = 4, NA_WC = 4;
constexpr int NE = 16, NEG = 4;
#endif
constexpr int GD = D / 4, NH = GD / HD, D_MIX = 4 * GD;
constexpr int MLA_QL = 3 * D / 16, MLA_KVL = D / 16;
constexpr int D_EXP = D / 4, EPG = NE / NEG;
constexpr int RW_IN = 3 * GD + 2 * RW_WL + 2 * RW_AL + RW_GL;
constexpr int MB_CONV_DIM = GD + 2 * MB_GROUPS * MB_STATE;
constexpr int MB_IN = GD + MB_CONV_DIM + 2 * NH;
constexpr int MLA_V = HD, MLA_QK = MLA_NOPE + MLA_ROPE;
constexpr int MLA_IN = MLA_QL + MLA_KVL + MLA_ROPE;
constexpr int NA_IN = 3 * GD;
constexpr int N_IN = RW_IN + MB_IN + MLA_IN + NA_IN;
constexpr int OFF_RW = 0, OFF_MB = RW_IN, OFF_MLA = RW_IN + MB_IN, OFF_NA = OFF_MLA + MLA_IN;
constexpr int LL = CTX + SEQ, TT = NB * LL;
constexpr int NMOD = NB + 1;
constexpr int CAP = TT;
constexpr float LN_EPS = 1e-6f, RMS_EPS = 1e-6f, RW_GN_EPS = 64e-5f, RW_DECAY_SCALE = 0.606531f, ROUTED_SCALE = 2.5f;
constexpr float ROPE_BASE = 10000.0f;
#define DN_ALPHA (sqrtf(sqrtf(2.0f * (float)DEPTH)))

typedef unsigned short bf16_t;

#define DEVFN __device__ __forceinline__


DEVFN uint32_t f_as_u(float f) { union { float f; uint32_t u; } c; c.f = f; return c.u; }
DEVFN float u_as_f(uint32_t u) { union { float f; uint32_t u; } c; c.u = u; return c.f; }
DEVFN bf16_t f2bf(float f) { uint32_t u = f_as_u(f); u += 0x7fffu + ((u >> 16) & 1u); return (bf16_t)(u >> 16); }
DEVFN float bf2f(bf16_t h) { return u_as_f(((uint32_t)h) << 16); }
DEVFN float sigmoidf_(float x) { return 1.0f / (1.0f + expf(-x)); }
DEVFN float siluf_(float x) { return x * sigmoidf_(x); }
DEVFN float softplusf_(float x) { return x > 20.0f ? x : log1pf(expf(x)); }

struct Params {
    const float *x, *c, *ctx, *c_ctx, *ada_w, *ada_b, *w_in, *w_out, *ln1_g, *ln1_b, *ln2_g, *ln2_b;
    const float *rw_mu, *rw_w0, *rw_w_up, *rw_a0, *rw_a_up, *rw_g_up, *rw_k_k, *rw_k_a, *rw_r_k, *rw_gn_g, *rw_gn_b;
    const float *mb_conv_w, *mb_conv_b, *mb_a_log, *mb_dt_bias, *mb_d, *mb_norm_g;
    const float *mla_q_norm, *mla_w_uq, *mla_kv_norm, *mla_w_ukv, *na_rpb, *router_w, *router_b, *exp_w_gate, *exp_w_up, *exp_w_down;
    float* out;
    bf16_t *WinT, *WoutT, *WguT, *WdT, *WuqT, *WukvT;
    float* xs;
    bf16_t* xm;
    float* mod;
    float* P;
    float* pm;
    float *rwW, *rwB, *rwKD;
    float *rwKK, *rwG;
    float* rwY;
    float* xc;
    float* dt;
    float* mbY;
    bf16_t *qn, *kvn;
    float *Qraw, *KVraw;
    float *Qf, *Kf, *Vf;
    bf16_t* Ymix;
    float* yo;
    bf16_t* hb;
    float* GU;
    bf16_t* hid;
    float* F;
    int* cnt;
    int *ent_tok, *ent_row, *ent_dst;
    float* ent_w;
};

DEVFN void ph_init(const Params& p, int l, size_t vt, size_t vs) {
    const size_t n = (size_t)TT * D;
    for (size_t i = vt; i < n; i += vs) {
        const int d = (int)(i % D); const int t = (int)(i / D); const int b = t / LL, s = t % LL;
        p.xs[i] = s < CTX ? p.ctx[((size_t)b * CTX + s) * D + d] : p.x[((size_t)b * SEQ + (s - CTX)) * D + d];
    }
    for (size_t i = vt; i < (size_t)DEPTH * NE; i += vs) p.cnt[i] = 0;
}

DEVFN void ph_transpose(const float* src, bf16_t* dst, int K, int N, int batch, size_t dst_bstride, int dst_row0, size_t vt, size_t vs) {
    const size_t total = (size_t)batch * (K / 8) * N;
    for (size_t idx = vt; idx < total; idx += vs) {
        const int n = (int)(idx % N); const int k8 = (int)((idx / N) % (K / 8)); const int bt = (int)(idx / ((size_t)N * (K / 8)));
        bf16_t* o = dst + (size_t)bt * dst_bstride + (size_t)(dst_row0 + n) * K + k8 * 8;
        for (int j = 0; j < 8; ++j) o[j] = f2bf(src[((size_t)bt * K + k8 * 8 + j) * N + n]);
    }
}

DEVFN void ph_mod(const Params& p, int l, size_t vt, size_t vs) {
    const size_t total = (size_t)DEPTH * 6 * D;
    for (size_t idx = vt; idx < total; idx += vs) {
        const int l = (int)(idx / (6 * D)), j = (int)(idx % (6 * D));
        float acc[NMOD];
#pragma unroll
        for (int r = 0; r < NMOD; ++r) acc[r] = p.ada_b[(size_t)l * 6 * D + j];
        for (int i = 0; i < D; ++i) {
            const float w = p.ada_w[((size_t)l * D + i) * 6 * D + j];
#pragma unroll
            for (int r = 0; r < NMOD; ++r) { const float cv = r < NB ? p.c[r * D + i] : p.c_ctx[i]; acc[r] += siluf_(cv) * w; }
        }
#pragma unroll
        for (int r = 0; r < NMOD; ++r) p.mod[((size_t)l * NMOD + r) * 6 * D + j] = acc[r];
    }
}

DEVFN void ph_modulate(const Params& p, int l, size_t vt, size_t vs) {
    const size_t n = (size_t)TT * D;
    for (size_t i = vt; i < n; i += vs) {
        const int d = (int)(i % D); const int t = (int)(i / D); const int b = t / LL, s = t % LL; const int r = s < CTX ? NB : b;
        const float* m = p.mod + ((size_t)l * NMOD + r) * 6 * D;
        p.xm[i] = f2bf(p.xs[i] * (1.0f + m[D + d]) + m[d]);
    }
}

DEVFN void ph_rw_mix(const Params& p, int l, size_t vt, size_t vs) {
    const size_t n = (size_t)TT * RW_IN;
    for (size_t i = vt; i < n; i += vs) {
        const int col = (int)(i % RW_IN); const int t = (int)(i / RW_IN); const int s = t % LL;
        const bool first = (s == 0 || s == CTX), last = (s == CTX - 1 || s == LL - 1);
        const float v = p.P[(size_t)t * N_IN + OFF_RW + col];
        const float pv = first ? 0.f : p.P[(size_t)(t - 1) * N_IN + OFF_RW + col];
        const float nx = last ? 0.f : p.P[(size_t)(t + 1) * N_IN + OFF_RW + col];
        float o = v + p.rw_mu[((size_t)l * 2 + 0) * RW_IN + col] * (pv - v) + p.rw_mu[((size_t)l * 2 + 1) * RW_IN + col] * (nx - v);
        if (col >= 3 * GD && col < 3 * GD + 2 * RW_WL) o = tanhf(o);
        else if (col >= 3 * GD + 2 * RW_WL + 2 * RW_AL) o = sigmoidf_(o);
        p.pm[i] = o;
    }
}

DEVFN void ph_rw_prep(const Params& p, int l, size_t vt, size_t vs) {
    const size_t n = (size_t)TT * GD;
    for (size_t i = vt; i < n; i += vs) {
        const int c = (int)(i % GD); const int t = (int)(i / GD); const int h = c / HD;
        const float* pr = p.pm + (size_t)t * RW_IN;
        const float k = pr[GD + c];
        float a[2], dec[2];
#pragma unroll
        for (int dir = 0; dir < 2; ++dir) {
            float wp = p.rw_w0[((size_t)l * 2 + dir) * GD + c];
            for (int r = 0; r < RW_WL; ++r) wp += pr[3 * GD + dir * RW_WL + r] * p.rw_w_up[(((size_t)l * 2 + dir) * RW_WL + r) * GD + c];
            dec[dir] = expf(-RW_DECAY_SCALE * sigmoidf_(wp));
            float ap = p.rw_a0[((size_t)l * 2 + dir) * GD + c];
            for (int r = 0; r < RW_AL; ++r) ap += pr[3 * GD + 2 * RW_WL + dir * RW_AL + r] * p.rw_a_up[(((size_t)l * 2 + dir) * RW_AL + r) * GD + c];
            a[dir] = sigmoidf_(ap);
        }
        float g = 0.f;
        for (int r = 0; r < RW_GL; ++r) g += pr[3 * GD + 2 * RW_WL + 2 * RW_AL + r] * p.rw_g_up[((size_t)l * RW_GL + r) * GD + c];
        float ss = 0.f;
        for (int j = 0; j < HD; ++j) { const float q = pr[GD + h * HD + j] * p.rw_k_k[(size_t)l * GD + h * HD + j]; ss += q * q; }
        const float kk = k * p.rw_k_k[(size_t)l * GD + c] / sqrtf(fmaxf(ss, 1e-12f));
#pragma unroll
        for (int dir = 0; dir < 2; ++dir) {
            const size_t o = ((size_t)dir * TT + t) * GD + c;
            p.rwW[o] = dec[dir]; p.rwB[o] = kk * a[dir]; p.rwKD[o] = k * (1.0f + (a[dir] - 1.0f) * p.rw_k_a[(size_t)l * GD + c]);
        }
        p.rwKK[i] = kk; p.rwG[i] = g;
    }
}

DEVFN int scan_pos(int dir, int step) {
    if (dir == 0) return step;
    return step < CTX ? (CTX - 1 - step) : (CTX + (SEQ - 1) - (step - CTX));
}

DEVFN void ph_rw_scan(const Params& p, int l, size_t vt, size_t vs) {
    const size_t total = (size_t)NB * NH * 2 * HD;
    for (size_t id = vt; id < total; id += vs) {
        const int i = (int)(id % HD); const int u = (int)(id / HD); const int dir = u % 2, h = (u / 2) % NH, b = u / (2 * NH);
        float S[HD];
#pragma unroll
        for (int j = 0; j < HD; ++j) S[j] = 0.f;
        for (int step = 0; step < LL; ++step) {
            const int t = b * LL + scan_pos(dir, step);
            const float* W = p.rwW + ((size_t)dir * TT + t) * GD + h * HD;
            const float* Bv = p.rwB + ((size_t)dir * TT + t) * GD + h * HD;
            const float* KD = p.rwKD + ((size_t)dir * TT + t) * GD + h * HD;
            const float* KK = p.rwKK + (size_t)t * GD + h * HD;
            const float* R = p.pm + (size_t)t * RW_IN + h * HD;
            const float vi = p.pm[(size_t)t * RW_IN + 2 * GD + h * HD + i];
            float sa = 0.f;
#pragma unroll
            for (int j = 0; j < HD; ++j) sa -= S[j] * KK[j];
            float y = 0.f;
#pragma unroll
            for (int j = 0; j < HD; ++j) { S[j] = S[j] * W[j] + sa * Bv[j] + vi * KD[j]; y += S[j] * R[j]; }
            p.rwY[((size_t)dir * TT + t) * GD + h * HD + i] = y;
        }
    }
}

DEVFN void ph_rw_out(const Params& p, int l, size_t vt, size_t vs) {
    const size_t n = (size_t)TT * NH;
    for (size_t id = vt; id < n; id += vs) {
        const int h = (int)(id % NH); const int t = (int)(id / NH);
        const float* yf = p.rwY + ((size_t)0 * TT + t) * GD + h * HD;
        const float* yb = p.rwY + ((size_t)1 * TT + t) * GD + h * HD;
        const float* pr = p.pm + (size_t)t * RW_IN;
        float mu = 0.f, bonus = 0.f;
        for (int j = 0; j < HD; ++j) { mu += yf[j] + yb[j]; bonus += pr[h * HD + j] * pr[GD + h * HD + j] * p.rw_r_k[(size_t)l * GD + h * HD + j]; }
        mu /= HD;
        float var = 0.f;
        for (int j = 0; j < HD; ++j) { const float d = yf[j] + yb[j] - mu; var += d * d; }
        var /= HD;
        const float rs = 1.0f / sqrtf(var + RW_GN_EPS);
        for (int j = 0; j < HD; ++j) {
            const int c = h * HD + j;
            float y = (yf[j] + yb[j] - mu) * rs * p.rw_gn_g[(size_t)l * GD + c] + p.rw_gn_b[(size_t)l * GD + c];
            y += bonus * pr[2 * GD + c];
            p.Ymix[(size_t)t * D_MIX + 0 * GD + c] = f2bf(y * p.rwG[(size_t)t * GD + c]);
        }
    }
}

DEVFN void ph_mb_prep(const Params& p, int l, size_t vt, size_t vs) {
    const size_t n = (size_t)TT * MB_CONV_DIM;
    for (size_t i = vt; i < n; i += vs) {
        const int c = (int)(i % MB_CONV_DIM); const int t = (int)(i / MB_CONV_DIM); const int s = t % LL;
        const int lo = s < CTX ? 0 : CTX, hi = s < CTX ? CTX : LL;
        float acc = p.mb_conv_b[(size_t)l * MB_CONV_DIM + c];
        for (int j = 0; j < MB_CONV; ++j) {
            const int so = s + j - MB_CONV / 2;
            if (so >= lo && so < hi) acc += p.mb_conv_w[((size_t)l * MB_CONV + j) * MB_CONV_DIM + c] * p.P[(size_t)(t + j - MB_CONV / 2) * N_IN + OFF_MB + GD + c];
        }
        p.xc[i] = siluf_(acc);
    }
    const size_t n2 = (size_t)TT * 2 * NH;
    for (size_t i = vt; i < n2; i += vs) {
        const int q = (int)(i % (2 * NH)); const int t = (int)(i / (2 * NH));
        p.dt[i] = softplusf_(p.P[(size_t)t * N_IN + OFF_MB + GD + MB_CONV_DIM + q] + p.mb_dt_bias[(size_t)l * 2 * NH + q]);
    }
}

DEVFN void ph_mb_scan(const Params& p, int l, size_t vt, size_t vs) {
    const size_t total = (size_t)NB * NH * 2 * HD;
    for (size_t id = vt; id < total; id += vs) {
        const int pi = (int)(id % HD); const int u = (int)(id / HD); const int dir = u % 2, h = (u / 2) % NH, b = u / (2 * NH);
        const int grp = h / (NH / MB_GROUPS);
        const float A = -expf(p.mb_a_log[((size_t)l * 2 + dir) * NH + h]);
        float H[MB_STATE];
#pragma unroll
        for (int n = 0; n < MB_STATE; ++n) H[n] = 0.f;
        for (int step = 0; step < LL; ++step) {
            const int t = b * LL + scan_pos(dir, step);
            const float dtv = p.dt[(size_t)t * 2 * NH + dir * NH + h];
            const float dA = expf(dtv * A);
            const float xdt = p.xc[(size_t)t * MB_CONV_DIM + h * HD + pi] * dtv;
            const float* Bn = p.xc + (size_t)t * MB_CONV_DIM + GD + grp * MB_STATE;
            const float* Cn = p.xc + (size_t)t * MB_CONV_DIM + GD + MB_GROUPS * MB_STATE + grp * MB_STATE;
            float y = 0.f;
#pragma unroll
            for (int n = 0; n < MB_STATE; ++n) { H[n] = dA * H[n] + xdt * Bn[n]; y += Cn[n] * H[n]; }
            p.mbY[((size_t)dir * TT + t) * GD + h * HD + pi] = y;
        }
    }
}

DEVFN void ph_mb_out(const Params& p, int l, size_t vt, size_t vs) {
    constexpr int GW = GD / MB_GROUPS;
    const size_t n = (size_t)TT * MB_GROUPS;
    for (size_t id = vt; id < n; id += vs) {
        const int g = (int)(id % MB_GROUPS); const int t = (int)(id / MB_GROUPS);
        float ss = 0.f;
        for (int j = 0; j < GW; ++j) {
            const int c = g * GW + j;
            const float y = p.mbY[((size_t)0 * TT + t) * GD + c] + p.mbY[((size_t)1 * TT + t) * GD + c] + p.mb_d[(size_t)l * NH + c / HD] * p.xc[(size_t)t * MB_CONV_DIM + c];
            const float v = y * siluf_(p.P[(size_t)t * N_IN + OFF_MB + c]);
            ss += v * v;
        }
        const float rs = 1.0f / sqrtf(ss / GW + RMS_EPS);
        for (int j = 0; j < GW; ++j) {
            const int c = g * GW + j;
            const float y = p.mbY[((size_t)0 * TT + t) * GD + c] + p.mbY[((size_t)1 * TT + t) * GD + c] + p.mb_d[(size_t)l * NH + c / HD] * p.xc[(size_t)t * MB_CONV_DIM + c];
            const float v = y * siluf_(p.P[(size_t)t * N_IN + OFF_MB + c]);
            p.Ymix[(size_t)t * D_MIX + 1 * GD + c] = f2bf(v * rs * p.mb_norm_g[(size_t)l * GD + c]);
        }
    }
}

DEVFN void ph_mla_norm(const Params& p, int l, size_t vt, size_t vs) {
    for (size_t t = vt; t < (size_t)TT; t += vs) {
        const float* pr = p.P + t * N_IN + OFF_MLA;
        float ss = 0.f;
        for (int i = 0; i < MLA_QL; ++i) ss += pr[i] * pr[i];
        float rs = 1.0f / sqrtf(ss / MLA_QL + RMS_EPS);
        for (int i = 0; i < MLA_QL; ++i) p.qn[t * MLA_QL + i] = f2bf(pr[i] * rs * p.mla_q_norm[(size_t)l * MLA_QL + i]);
        ss = 0.f;
        for (int i = 0; i < MLA_KVL; ++i) ss += pr[MLA_QL + i] * pr[MLA_QL + i];
        rs = 1.0f / sqrtf(ss / MLA_KVL + RMS_EPS);
        for (int i = 0; i < MLA_KVL; ++i) p.kvn[t * MLA_KVL + i] = f2bf(pr[MLA_QL + i] * rs * p.mla_kv_norm[(size_t)l * MLA_KVL + i]);
    }
}

DEVFN float rope_elem(const float* xv, int e, int tl) {
    constexpr int NF = MLA_ROPE / 4;
    const int axis = e / (2 * NF), half = (e / NF) % 2, f = e % NF;
    const float pos = (float)(axis == 0 ? tl / GRID_W : tl % GRID_W);
    const float ang = pos * powf(ROPE_BASE, -(float)f / (float)NF);
    const float cs = cosf(ang), sn = sinf(ang);
    const float x1 = xv[axis * 2 * NF + f], x2 = xv[axis * 2 * NF + NF + f];
    return half == 0 ? x1 * cs - x2 * sn : x2 * cs + x1 * sn;
}

DEVFN void ph_mla_rope(const Params& p, int l, size_t vt, size_t vs) {
    const size_t n = (size_t)TT * NH;
    for (size_t id = vt; id < n; id += vs) {
        const int h = (int)(id % NH); const int t = (int)(id / NH); const int s = t % LL; const bool lat = s >= CTX; const int tl = s - CTX;
        const float* q = p.Qraw + (size_t)t * NH * MLA_QK + h * MLA_QK;
        const float* kv = p.KVraw + (size_t)t * NH * (MLA_NOPE + MLA_V) + h * (MLA_NOPE + MLA_V);
        const float* kpe = p.P + (size_t)t * N_IN + OFF_MLA + MLA_QL + MLA_KVL;
        float* qo = p.Qf + id * MLA_QK; float* ko = p.Kf + id * MLA_QK; float* vo = p.Vf + id * MLA_V;
        for (int d = 0; d < MLA_NOPE; ++d) { qo[d] = q[d]; ko[d] = kv[d]; }
        for (int e = 0; e < MLA_ROPE; ++e) {
            qo[MLA_NOPE + e] = lat ? rope_elem(q + MLA_NOPE, e, tl) : q[MLA_NOPE + e];
            ko[MLA_NOPE + e] = lat ? rope_elem(kpe, e, tl) : kpe[e];
        }
        for (int d = 0; d < MLA_V; ++d) vo[d] = kv[MLA_NOPE + d];
    }
}

DEVFN void ph_mla_attn(const Params& p, int l, size_t vt, size_t vs) {
    const size_t n = (size_t)TT * NH;
    const float scale = 1.0f / sqrtf((float)MLA_QK);
    for (size_t id = vt; id < n; id += vs) {
        const int s = (int)(id % LL); const int h = (int)((id / LL) % NH); const int b = (int)(id / ((size_t)LL * NH));
        const int t = b * LL + s;
        const int nkeys = s < CTX ? CTX : LL;
        float q[MLA_QK], acc[MLA_V];
#pragma unroll
        for (int d = 0; d < MLA_QK; ++d) q[d] = p.Qf[((size_t)t * NH + h) * MLA_QK + d] * scale;
#pragma unroll
        for (int d = 0; d < MLA_V; ++d) acc[d] = 0.f;
        float m = -1e30f, lsum = 0.f;
        for (int j = 0; j < nkeys; ++j) {
            const float* kr = p.Kf + ((size_t)(b * LL + j) * NH + h) * MLA_QK;
            const float* vr = p.Vf + ((size_t)(b * LL + j) * NH + h) * MLA_V;
            float sc = 0.f;
#pragma unroll
            for (int d = 0; d < MLA_QK; ++d) sc += q[d] * kr[d];
            const float mn = fmaxf(m, sc);
            const float corr = expf(m - mn), pj = expf(sc - mn);
            lsum = lsum * corr + pj;
#pragma unroll
            for (int d = 0; d < MLA_V; ++d) acc[d] = acc[d] * corr + pj * vr[d];
            m = mn;
        }
        const float inv = 1.0f / lsum;
#pragma unroll
        for (int d = 0; d < MLA_V; ++d) p.Ymix[(size_t)t * D_MIX + 2 * GD + h * MLA_V + d] = f2bf(acc[d] * inv);
    }
}

DEVFN void ph_na_attn(const Params& p, int l, size_t vt, size_t vs) {
    const size_t n = (size_t)TT * NH;
    const float scale = 1.0f / sqrtf((float)HD);
    constexpr int ROWS = SEQ / GRID_W;
    constexpr int WR = NA_WR < ROWS ? NA_WR : ROWS;
    for (size_t id = vt; id < n; id += vs) {
        const int s = (int)(id % LL); const int h = (int)((id / LL) % NH); const int b = (int)(id / ((size_t)LL * NH));
        const int t = b * LL + s;
        float q[HD], acc[HD];
#pragma unroll
        for (int d = 0; d < HD; ++d) { q[d] = p.P[(size_t)t * N_IN + OFF_NA + h * HD + d] * scale; acc[d] = 0.f; }
        float m = -1e30f, lsum = 0.f;
        const bool lat = s >= CTX;
        const int tl = s - CTX; const int r = tl / GRID_W, c = tl % GRID_W;
        int rs = r - WR / 2; rs = rs < 0 ? 0 : (rs > ROWS - WR ? ROWS - WR : rs);
        int cs = c - NA_WC / 2; cs = cs < 0 ? 0 : (cs > GRID_W - NA_WC ? GRID_W - NA_WC : cs);
        const int nloc = lat ? WR * NA_WC : 0;
        for (int j = 0; j < nloc + CTX; ++j) {
            int tk; float bias = 0.f;
            if (j < nloc) {
                const int i2 = j / NA_WC, j2 = j % NA_WC;
                tk = b * LL + CTX + (rs + i2) * GRID_W + cs + j2;
                bias = p.na_rpb[(((size_t)l * NH + h) * (2 * NA_WR - 1) + (rs + i2 - r + NA_WR - 1)) * (2 * NA_WC - 1) + (cs + j2 - c + NA_WC - 1)];
            } else tk = b * LL + (j - nloc);
            const float* kr = p.P + (size_t)tk * N_IN + OFF_NA + GD + h * HD;
            const float* vr = p.P + (size_t)tk * N_IN + OFF_NA + 2 * GD + h * HD;
            float sc = bias;
#pragma unroll
            for (int d = 0; d < HD; ++d) sc += q[d] * kr[d];
            const float mn = fmaxf(m, sc);
            const float corr = expf(m - mn), pj = expf(sc - mn);
            lsum = lsum * corr + pj;
#pragma unroll
            for (int d = 0; d < HD; ++d) acc[d] = acc[d] * corr + pj * vr[d];
            m = mn;
        }
        const float inv = 1.0f / lsum;
#pragma unroll
        for (int d = 0; d < HD; ++d) p.Ymix[(size_t)t * D_MIX + 3 * GD + h * HD + d] = f2bf(acc[d] * inv);
    }
}

DEVFN void ph_ln1_route(const Params& p, int l, size_t vt, size_t vs) {
    const float alpha = DN_ALPHA;
    for (size_t t = vt; t < (size_t)TT; t += vs) {
        const int b = (int)(t / LL), s = (int)(t % LL); const int r = s < CTX ? NB : b;
        const float* m = p.mod + ((size_t)l * NMOD + r) * 6 * D;
        float* xr = p.xs + t * D; const float* yr = p.yo + t * D;
        float mu = 0.f;
        for (int d = 0; d < D; ++d) mu += alpha * xr[d] + m[2 * D + d] * yr[d];
        mu /= D;
        float var = 0.f;
        for (int d = 0; d < D; ++d) { const float u = alpha * xr[d] + m[2 * D + d] * yr[d] - mu; var += u * u; }
        var /= D;
        const float rs = 1.0f / sqrtf(var + LN_EPS);
        float lg[NE];
#pragma unroll
        for (int e = 0; e < NE; ++e) lg[e] = 0.f;
        for (int d = 0; d < D; ++d) {
            const float u = alpha * xr[d] + m[2 * D + d] * yr[d];
            const float xn = (u - mu) * rs * p.ln1_g[(size_t)l * D + d] + p.ln1_b[(size_t)l * D + d];
            xr[d] = xn;
            const float hv = xn * (1.0f + m[4 * D + d]) + m[3 * D + d];
            p.hb[t * D + d] = f2bf(hv);
#pragma unroll
            for (int e = 0; e < NE; ++e) lg[e] += hv * p.router_w[(size_t)d * NE + e];
        }
        float gbest = -1e30f; int e1 = 0, e2 = 1; float w1 = 0.f, w2 = 0.f;
#pragma unroll
        for (int g = 0; g < NEG; ++g) {
            float m1 = -1e30f, m2 = -1e30f, s1 = 0.f, s2 = 0.f; int i1 = 0, i2 = 0;
#pragma unroll
            for (int i = 0; i < EPG; ++i) {
                const float scv = sigmoidf_(lg[g * EPG + i]); const float v = scv + p.router_b[g * EPG + i];
                if (v > m1) { m2 = m1; i2 = i1; s2 = s1; m1 = v; i1 = g * EPG + i; s1 = scv; }
                else if (v > m2) { m2 = v; i2 = g * EPG + i; s2 = scv; }
            }
            if (m1 + m2 > gbest) { gbest = m1 + m2; e1 = i1; e2 = i2; w1 = s1; w2 = s2; }
        }
        const float wn = ROUTED_SCALE / (w1 + w2);
        for (int k = 0; k < 2; ++k) {
            const int e = k == 0 ? e1 : e2; const float w = (k == 0 ? w1 : w2) * wn;
            const int pos = atomicAdd(&p.cnt[l * NE + e], 1);
            const size_t o = (size_t)e * CAP + pos;
            p.ent_tok[o] = (int)t; p.ent_row[o] = (int)t * 2 + k; p.ent_dst[o] = k * TT + (int)t; p.ent_w[o] = w;
        }
    }
}

DEVFN void ph_hid(const Params& p, int l, size_t vt, size_t vs) {
    const size_t n = (size_t)2 * TT * D_EXP;
    for (size_t i = vt; i < n; i += vs) {
        const int j = (int)(i % D_EXP); const size_t row = i / D_EXP;
        p.hid[i] = f2bf(siluf_(p.GU[row * 2 * D_EXP + j]) * p.GU[row * 2 * D_EXP + D_EXP + j]);
    }
}

DEVFN void ph_ln2(const Params& p, int l, size_t vt, size_t vs) {
    const float alpha = DN_ALPHA;
    for (size_t t = vt; t < (size_t)TT; t += vs) {
        const int b = (int)(t / LL), s = (int)(t % LL); const int r = s < CTX ? NB : b;
        const float* m = p.mod + ((size_t)l * NMOD + r) * 6 * D;
        float* xr = p.xs + t * D; const float* f0 = p.F + t * D; const float* f1 = p.F + ((size_t)TT + t) * D;
        float mu = 0.f;
        for (int d = 0; d < D; ++d) mu += alpha * xr[d] + m[5 * D + d] * (f0[d] + f1[d]);
        mu /= D;
        float var = 0.f;
        for (int d = 0; d < D; ++d) { const float u = alpha * xr[d] + m[5 * D + d] * (f0[d] + f1[d]) - mu; var += u * u; }
        var /= D;
        const float rs = 1.0f / sqrtf(var + LN_EPS);
        for (int d = 0; d < D; ++d) {
            const float u = alpha * xr[d] + m[5 * D + d] * (f0[d] + f1[d]);
            const float xn = (u - mu) * rs * p.ln2_g[(size_t)l * D + d] + p.ln2_b[(size_t)l * D + d];
            xr[d] = xn;
            if (l == DEPTH - 1 && s >= CTX) p.out[((size_t)b * SEQ + (s - CTX)) * D + d] = xn;
        }
    }
}

struct GemmArgs {
    const bf16_t* A; int lda; const int* a_rows;
    const bf16_t* Bt; int ldb; size_t b_gstride;
    float* C; int ldc; const int* c_rows; const float* row_scale;
    int M, N, K; const int* m_count; size_t idx_gstride;
    int groups;
};

typedef short bf16x8_t __attribute__((ext_vector_type(8)));
typedef float f32x16_t __attribute__((ext_vector_type(16)));
constexpr int GT = 128, GK = 32, GLD = 40;

DEVFN void ph_gemm(const GemmArgs& g, bf16_t* sA, bf16_t* sB, int vb, int nvb) {
    const int tid = threadIdx.x, lane = tid & 63, wave = tid >> 6, wr = wave >> 1, wc = wave & 1;
    const int mt_n = (g.M + GT - 1) / GT, nt_n = (g.N + GT - 1) / GT;
    const int total = g.groups * mt_n * nt_n;
    for (int tile = vb; tile < total; tile += nvb) {
        const int grp = tile / (mt_n * nt_n); const int rem = tile % (mt_n * nt_n); const int mt = rem / nt_n, nt = rem % nt_n;
        const int M = g.m_count ? g.m_count[grp] : g.M;
        const int m0 = mt * GT, n0 = nt * GT;
        if (m0 >= M) continue;
        const int* a_rows = g.a_rows ? g.a_rows + (size_t)grp * g.idx_gstride : nullptr;
        const int* c_rows = g.c_rows ? g.c_rows + (size_t)grp * g.idx_gstride : nullptr;
        const float* rsc = g.row_scale ? g.row_scale + (size_t)grp * g.idx_gstride : nullptr;
        const bf16_t* Bt = g.Bt + (size_t)grp * g.b_gstride;
        const int r0 = tid >> 2, ch = tid & 3;
        const int gm0 = m0 + r0, gm1 = m0 + r0 + 64;
        const int ar0 = gm0 < M ? (a_rows ? a_rows[gm0] : gm0) : (a_rows ? a_rows[m0] : m0);
        const int ar1 = gm1 < M ? (a_rows ? a_rows[gm1] : gm1) : (a_rows ? a_rows[m0] : m0);
        const int gn0 = n0 + r0, gn1 = n0 + r0 + 64;
        const int br0 = gn0 < g.N ? gn0 : n0, br1 = gn1 < g.N ? gn1 : n0;
        const bf16_t* ap0 = g.A + (size_t)ar0 * g.lda + ch * 8; const bf16_t* ap1 = g.A + (size_t)ar1 * g.lda + ch * 8;
        const bf16_t* bp0 = Bt + (size_t)br0 * g.ldb + ch * 8; const bf16_t* bp1 = Bt + (size_t)br1 * g.ldb + ch * 8;
        const int lo0 = r0 * GLD + ch * 8, lo1 = (r0 + 64) * GLD + ch * 8;
        f32x16_t acc[2][2];
#pragma unroll
        for (int i = 0; i < 2; ++i)
#pragma unroll
            for (int j = 0; j < 2; ++j)
#pragma unroll
                for (int r = 0; r < 16; ++r) acc[i][j][r] = 0.f;
        for (int k0 = 0; k0 < g.K; k0 += GK) {
            const uint4 va0 = *(const uint4*)(ap0 + k0), va1 = *(const uint4*)(ap1 + k0), vb0 = *(const uint4*)(bp0 + k0), vb1 = *(const uint4*)(bp1 + k0);
            __syncthreads();
            *(uint4*)(sA + lo0) = va0; *(uint4*)(sA + lo1) = va1; *(uint4*)(sB + lo0) = vb0; *(uint4*)(sB + lo1) = vb1;
            __syncthreads();
#pragma unroll
            for (int kk = 0; kk < GK; kk += 16) {
                bf16x8_t af[2], bfr[2];
#pragma unroll
                for (int i = 0; i < 2; ++i) af[i] = *(const bf16x8_t*)(sA + (wr * 64 + i * 32 + (lane & 31)) * GLD + kk + (lane >> 5) * 8);
#pragma unroll
                for (int j = 0; j < 2; ++j) bfr[j] = *(const bf16x8_t*)(sB + (wc * 64 + j * 32 + (lane & 31)) * GLD + kk + (lane >> 5) * 8);
#pragma unroll
                for (int i = 0; i < 2; ++i)
#pragma unroll
                    for (int j = 0; j < 2; ++j) acc[i][j] = __builtin_amdgcn_mfma_f32_32x32x16_bf16(af[i], bfr[j], acc[i][j], 0, 0, 0);
            }
        }
#pragma unroll
        for (int i = 0; i < 2; ++i)
#pragma unroll
            for (int r = 0; r < 16; ++r) {
                const int row = m0 + wr * 64 + i * 32 + (r & 3) + 8 * (r >> 2) + 4 * (lane >> 5);
                if (row < M) {
                    const int crow = c_rows ? c_rows[row] : row; const float sc = rsc ? rsc[row] : 1.0f;
#pragma unroll
                    for (int j = 0; j < 2; ++j) {
                        const int col = n0 + wc * 64 + j * 32 + (lane & 31);
                        if (col < g.N) g.C[(size_t)crow * g.ldc + col] = acc[i][j][r] * sc;
                    }
                }
            }
        __syncthreads();
    }
}

DEVFN GemmArgs mk_gemm(const bf16_t* A, int lda, const int* a_rows, const bf16_t* Bt, int ldb, size_t b_gstride,
                       float* C, int ldc, const int* c_rows, const float* row_scale, int M, int N, int K, const int* m_count, size_t idx_gstride, int groups) {
    GemmArgs g;
    g.A = A; g.lda = lda; g.a_rows = a_rows; g.Bt = Bt; g.ldb = ldb; g.b_gstride = b_gstride; g.C = C; g.ldc = ldc; g.c_rows = c_rows; g.row_scale = row_scale;
    g.M = M; g.N = N; g.K = K; g.m_count = m_count; g.idx_gstride = idx_gstride; g.groups = groups;
    return g;
}

#define XB_TMO      128
#define XB_XCNT(j)  (256  + 64 * (j))
#define XB_XSUB(j)  (1280 + 64 * (j))
#define XB_XGEN(j)  (2304 + 64 * (j))
#define XB_TOP      3328
#define XB_TOPGEN   3392
#define XCD_BAR_WORDS 3456
#define XB_SPIN_CAP (1u << 18)
#define LAS __attribute__((address_space(3)))

__device__ __forceinline__ unsigned xb_ld(unsigned* p)              { return __hip_atomic_load(p, __ATOMIC_RELAXED, __HIP_MEMORY_SCOPE_AGENT); }
__device__ __forceinline__ unsigned xb_add(unsigned* p, unsigned v) { return __hip_atomic_fetch_add(p, v, __ATOMIC_RELAXED, __HIP_MEMORY_SCOPE_AGENT); }
__device__ __forceinline__ unsigned xb_xcc_id() { return (unsigned)__builtin_amdgcn_s_getreg((3 << 11) | 20) & 0xFu; }
#define XB_SPIN(cond, bar) do { unsigned _sp = 0; while (cond) { __builtin_amdgcn_s_sleep(1); \
    if ((++_sp & 255u) == 0u) { if (xb_ld(&(bar)[XB_TMO])) break; if (_sp > XB_SPIN_CAP) { atomicAdd(&(bar)[XB_TMO], 1u); break; } } } } while (0)

struct XcdBarrier {
    unsigned* bar; unsigned x;
    volatile LAS unsigned* st;
};

__device__ __forceinline__ XcdBarrier xcd_barrier_post(unsigned* bar, volatile LAS unsigned* st) {
    XcdBarrier b; b.bar = bar; b.x = xb_xcc_id(); b.st = st;
    if (threadIdx.x == 0) (void)xb_add(&bar[XB_XCNT(b.x)], 1u);
    return b;
}
__device__ __forceinline__ void xcd_barrier_complete(unsigned* bar, unsigned x, unsigned& nloc, unsigned& nx) {
    const unsigned G = gridDim.x * gridDim.y * gridDim.z;
    unsigned sum, cnt, mine, sp = 0u;
    for (;;) {
        sum = 0u; cnt = 0u; mine = 0u;
#pragma unroll
        for (unsigned j = 0; j < 16; ++j) { const unsigned c = xb_ld(&bar[XB_XCNT(j)]); sum += c; cnt += (c > 0u) ? 1u : 0u; mine = (j == x) ? c : mine; }
        if (sum == G) break;
        __builtin_amdgcn_s_sleep(1);
        if ((++sp & 255u) == 0u) { if (xb_ld(&bar[XB_TMO])) break; if (sp > XB_SPIN_CAP) { atomicAdd(&bar[XB_TMO], 1u); break; } }
    }
    nloc = mine > 0u ? mine : 1u; nx = cnt > 0u ? cnt : 1u;
}

__device__ __forceinline__ void xcd_barrier(const XcdBarrier& b) {
    asm volatile("s_waitcnt vmcnt(0)" ::: "memory");
    __syncthreads();
    if (threadIdx.x == 0) {
        unsigned* bar = b.bar;
        __builtin_amdgcn_s_waitcnt(0);
        unsigned nloc = b.st[0], nx = b.st[1];
        if (nloc == 0u) { xcd_barrier_complete(bar, b.x, nloc, nx); b.st[0] = nloc; b.st[1] = nx; }
        const unsigned old = xb_add(&bar[XB_XSUB(b.x)], 1u);
        const unsigned gen = old / nloc;
        if (old + 1u == (gen + 1u) * nloc) {
            __builtin_amdgcn_fence(__ATOMIC_RELEASE, "agent");
            asm volatile("s_waitcnt vmcnt(0)" ::: "memory");
            const unsigned og = xb_add(&bar[XB_TOP], 1u);
            const unsigned tg = og / nx;
            if (og + 1u == (tg + 1u) * nx) xb_add(&bar[XB_TOPGEN], 1u);
            else XB_SPIN(xb_ld(&bar[XB_TOPGEN]) == tg, bar);
            __builtin_amdgcn_fence(__ATOMIC_ACQUIRE, "agent");
            xb_add(&bar[XB_XGEN(b.x)], 1u);
            asm volatile("s_waitcnt vmcnt(0)" ::: "memory");
        } else {
            XB_SPIN(xb_ld(&bar[XB_XGEN(b.x)]) == gen, bar);
            __builtin_amdgcn_fence(__ATOMIC_ACQUIRE, "agent");
            asm volatile("s_waitcnt vmcnt(0)" ::: "memory");
        }
    }
    __syncthreads();
}

constexpr int NT = 256;
struct MegaArgs { Params p; unsigned* bar; };

__global__ void __launch_bounds__(NT, 1) k_mega(MegaArgs a) {
    __shared__ uint4 xb_words;
    __shared__ __attribute__((aligned(16))) bf16_t sA[GT * GLD];
    __shared__ __attribute__((aligned(16))) bf16_t sB[GT * GLD];
    if (threadIdx.x == 0) xb_words = make_uint4(0u, 0u, 0u, 0u);
    __syncthreads();
    XcdBarrier bar = xcd_barrier_post(a.bar, (volatile LAS unsigned*)&xb_words);
    const Params& p = a.p;
    const int nb = gridDim.x, bx = blockIdx.x;
    const size_t vt = (size_t)bx * NT + threadIdx.x, vs = (size_t)nb * NT;

    ph_init(p, 0, vt, vs);
    ph_mod(p, 0, vt, vs);
    ph_transpose(p.w_in, p.WinT, D, N_IN, DEPTH, (size_t)N_IN * D, 0, vt, vs);
    ph_transpose(p.w_out, p.WoutT, D_MIX, D, DEPTH, (size_t)D * D_MIX, 0, vt, vs);
    ph_transpose(p.exp_w_gate, p.WguT, D, D_EXP, DEPTH * NE, (size_t)2 * D_EXP * D, 0, vt, vs);
    ph_transpose(p.exp_w_up, p.WguT, D, D_EXP, DEPTH * NE, (size_t)2 * D_EXP * D, D_EXP, vt, vs);
    ph_transpose(p.exp_w_down, p.WdT, D_EXP, D, DEPTH * NE, (size_t)D * D_EXP, 0, vt, vs);
    ph_transpose(p.mla_w_uq, p.WuqT, MLA_QL, NH * MLA_QK, DEPTH, (size_t)NH * MLA_QK * MLA_QL, 0, vt, vs);
    ph_transpose(p.mla_w_ukv, p.WukvT, MLA_KVL, NH * (MLA_NOPE + MLA_V), DEPTH, (size_t)NH * (MLA_NOPE + MLA_V) * MLA_KVL, 0, vt, vs);
    xcd_barrier(bar);

    for (int l = 0; l < DEPTH; ++l) {
        ph_modulate(p, l, vt, vs);
        xcd_barrier(bar);
        { const GemmArgs g = mk_gemm(p.xm, D, nullptr, p.WinT + (size_t)l * N_IN * D, D, 0, p.P, N_IN, nullptr, nullptr, TT, N_IN, D, nullptr, 0, 1); ph_gemm(g, sA, sB, bx, nb); }
        xcd_barrier(bar);
        ph_rw_mix(p, l, vt, vs);
        ph_mb_prep(p, l, vt, vs);
        ph_mla_norm(p, l, vt, vs);
        xcd_barrier(bar);
        ph_rw_prep(p, l, vt, vs);
        { const GemmArgs g = mk_gemm(p.qn, MLA_QL, nullptr, p.WuqT + (size_t)l * NH * MLA_QK * MLA_QL, MLA_QL, 0, p.Qraw, NH * MLA_QK, nullptr, nullptr, TT, NH * MLA_QK, MLA_QL, nullptr, 0, 1); ph_gemm(g, sA, sB, bx, nb); }
        { const GemmArgs g = mk_gemm(p.kvn, MLA_KVL, nullptr, p.WukvT + (size_t)l * NH * (MLA_NOPE + MLA_V) * MLA_KVL, MLA_KVL, 0, p.KVraw, NH * (MLA_NOPE + MLA_V), nullptr, nullptr, TT, NH * (MLA_NOPE + MLA_V), MLA_KVL, nullptr, 0, 1); ph_gemm(g, sA, sB, bx, nb); }
        xcd_barrier(bar);
        ph_mla_rope(p, l, vt, vs);
        xcd_barrier(bar);
        {
            constexpr int SCAN_BLOCKS = (NB * NH * 2 * HD + NT - 1) / NT;
            if (bx < SCAN_BLOCKS) ph_rw_scan(p, l, vt, (size_t)SCAN_BLOCKS * NT);
            else if (bx < 2 * SCAN_BLOCKS) ph_mb_scan(p, l, vt - (size_t)SCAN_BLOCKS * NT, (size_t)SCAN_BLOCKS * NT);
            else {
                const size_t vt2 = vt - (size_t)2 * SCAN_BLOCKS * NT, vs2 = vs - (size_t)2 * SCAN_BLOCKS * NT;
                ph_mla_attn(p, l, vt2, vs2);
                ph_na_attn(p, l, vt2, vs2);
            }
        }
        xcd_barrier(bar);
        ph_rw_out(p, l, vt, vs);
        ph_mb_out(p, l, vt, vs);
        xcd_barrier(bar);
        { const GemmArgs g = mk_gemm(p.Ymix, D_MIX, nullptr, p.WoutT + (size_t)l * D * D_MIX, D_MIX, 0, p.yo, D, nullptr, nullptr, TT, D, D_MIX, nullptr, 0, 1); ph_gemm(g, sA, sB, bx, nb); }
        xcd_barrier(bar);
        ph_ln1_route(p, l, vt, vs);
        xcd_barrier(bar);
        { const GemmArgs g = mk_gemm(p.hb, D, p.ent_tok, p.WguT + (size_t)l * NE * 2 * D_EXP * D, D, (size_t)2 * D_EXP * D, p.GU, 2 * D_EXP, p.ent_row, nullptr, CAP, 2 * D_EXP, D, p.cnt + l * NE, CAP, NE); ph_gemm(g, sA, sB, bx, nb); }
        xcd_barrier(bar);
        ph_hid(p, l, vt, vs);
        xcd_barrier(bar);
        { const GemmArgs g = mk_gemm(p.hid, D_EXP, p.ent_row, p.WdT + (size_t)l * NE * D * D_EXP, D_EXP, (size_t)D * D_EXP, p.F, D, p.ent_dst, p.ent_w, CAP, D, D_EXP, p.cnt + l * NE, CAP, NE); ph_gemm(g, sA, sB, bx, nb); }
        xcd_barrier(bar);
        ph_ln2(p, l, vt, vs);
        xcd_barrier(bar);
    }
}

static size_t carve(size_t& off, size_t bytes) { const size_t o = off; off += (bytes + 255) & ~(size_t)255; return o; }

extern "C" void kernel_launch(void* const* d_in, const int* in_sizes, int n_in, void* d_out, int out_size, void* d_ws, size_t ws_size, hipStream_t stream) {
    (void)in_sizes; (void)n_in; (void)out_size;
    MegaArgs a{};
    Params& p = a.p;
    const float* const* in = (const float* const*)d_in;
    p.x = in[0]; p.c = in[1]; p.ctx = in[2]; p.c_ctx = in[3]; p.ada_w = in[4]; p.ada_b = in[5]; p.w_in = in[6]; p.w_out = in[7];
    p.ln1_g = in[8]; p.ln1_b = in[9]; p.ln2_g = in[10]; p.ln2_b = in[11];
    p.rw_mu = in[12]; p.rw_w0 = in[13]; p.rw_w_up = in[14]; p.rw_a0 = in[15]; p.rw_a_up = in[16]; p.rw_g_up = in[17]; p.rw_k_k = in[18]; p.rw_k_a = in[19];
    p.rw_r_k = in[20]; p.rw_gn_g = in[21]; p.rw_gn_b = in[22];
    p.mb_conv_w = in[23]; p.mb_conv_b = in[24]; p.mb_a_log = in[25]; p.mb_dt_bias = in[26]; p.mb_d = in[27]; p.mb_norm_g = in[28];
    p.mla_q_norm = in[29]; p.mla_w_uq = in[30]; p.mla_kv_norm = in[31]; p.mla_w_ukv = in[32]; p.na_rpb = in[33];
    p.router_w = in[34]; p.router_b = in[35]; p.exp_w_gate = in[36]; p.exp_w_up = in[37]; p.exp_w_down = in[38];
    p.out = (float*)d_out;

    char* ws = (char*)d_ws; size_t off = 0;
    a.bar = (unsigned*)(ws + carve(off, (size_t)XCD_BAR_WORDS * 4));
    p.WinT = (bf16_t*)(ws + carve(off, (size_t)DEPTH * N_IN * D * 2));
    p.WoutT = (bf16_t*)(ws + carve(off, (size_t)DEPTH * D * D_MIX * 2));
    p.WguT = (bf16_t*)(ws + carve(off, (size_t)DEPTH * NE * 2 * D_EXP * D * 2));
    p.WdT = (bf16_t*)(ws + carve(off, (size_t)DEPTH * NE * D * D_EXP * 2));
    p.WuqT = (bf16_t*)(ws + carve(off, (size_t)DEPTH * NH * MLA_QK * MLA_QL * 2));
    p.WukvT = (bf16_t*)(ws + carve(off, (size_t)DEPTH * NH * (MLA_NOPE + MLA_V) * MLA_KVL * 2));
    p.xs = (float*)(ws + carve(off, (size_t)TT * D * 4));
    p.xm = (bf16_t*)(ws + carve(off, (size_t)TT * D * 2));
    p.mod = (float*)(ws + carve(off, (size_t)DEPTH * NMOD * 6 * D * 4));
    p.cnt = (int*)(ws + carve(off, (size_t)DEPTH * NE * 4));
    p.ent_tok = (int*)(ws + carve(off, (size_t)NE * CAP * 4));
    p.ent_row = (int*)(ws + carve(off, (size_t)NE * CAP * 4));
    p.ent_dst = (int*)(ws + carve(off, (size_t)NE * CAP * 4));
    p.ent_w = (float*)(ws + carve(off, (size_t)NE * CAP * 4));
    p.Ymix = (bf16_t*)(ws + carve(off, (size_t)TT * D_MIX * 2));
    p.hb = (bf16_t*)(ws + carve(off, (size_t)TT * D * 2));
    p.hid = (bf16_t*)(ws + carve(off, (size_t)2 * TT * D_EXP * 2));
    const size_t regA = off;
    p.P = (float*)(ws + carve(off, (size_t)TT * N_IN * 4));
    p.pm = (float*)(ws + carve(off, (size_t)TT * RW_IN * 4));
    p.rwW = (float*)(ws + carve(off, (size_t)2 * TT * GD * 4));
    p.rwB = (float*)(ws + carve(off, (size_t)2 * TT * GD * 4));
    p.rwKD = (float*)(ws + carve(off, (size_t)2 * TT * GD * 4));
    p.rwKK = (float*)(ws + carve(off, (size_t)TT * GD * 4));
    p.rwG = (float*)(ws + carve(off, (size_t)TT * GD * 4));
    p.rwY = (float*)(ws + carve(off, (size_t)2 * TT * GD * 4));
    p.xc = (float*)(ws + carve(off, (size_t)TT * MB_CONV_DIM * 4));
    p.dt = (float*)(ws + carve(off, (size_t)TT * 2 * NH * 4));
    p.mbY = (float*)(ws + carve(off, (size_t)2 * TT * GD * 4));
    p.qn = (bf16_t*)(ws + carve(off, (size_t)TT * MLA_QL * 2));
    p.kvn = (bf16_t*)(ws + carve(off, (size_t)TT * MLA_KVL * 2));
    p.Qraw = (float*)(ws + carve(off, (size_t)TT * NH * MLA_QK * 4));
    p.KVraw = (float*)(ws + carve(off, (size_t)TT * NH * (MLA_NOPE + MLA_V) * 4));
    p.Qf = (float*)(ws + carve(off, (size_t)TT * NH * MLA_QK * 4));
    p.Kf = (float*)(ws + carve(off, (size_t)TT * NH * MLA_QK * 4));
    p.Vf = (float*)(ws + carve(off, (size_t)TT * NH * MLA_V * 4));
    const size_t endA = off;
    off = regA;
    p.yo = (float*)(ws + carve(off, (size_t)TT * D * 4));
    p.GU = (float*)(ws + carve(off, (size_t)2 * TT * 2 * D_EXP * 4));
    p.F = (float*)(ws + carve(off, (size_t)2 * TT * D * 4));
    const size_t endB = off;
    const size_t need = endA > endB ? endA : endB;
    if (need > ws_size) return;

    static int grid = 0;
    if (!grid) {
        int dev = 0, cus = 0, per_cu = 0;
        hipGetDevice(&dev);
        hipDeviceGetAttribute(&cus, hipDeviceAttributeMultiprocessorCount, dev);
        hipOccupancyMaxActiveBlocksPerMultiprocessor(&per_cu, (const void*)k_mega, NT, 0);
        grid = cus * (per_cu < 1 ? per_cu : 1);
    }
    if (grid <= 0) return;
    hipMemsetAsync(a.bar, 0, (size_t)XCD_BAR_WORDS * 4, stream);
    hipLaunchKernelGGL(k_mega, dim3(grid), dim3(NT), 0, stream, a);
}
```

```cpp
#include <hip/hip_runtime.h>
#include <stdint.h>
#include <stddef.h>
#include <math.h>

#ifndef CFG_SMALL
constexpr int D = 2048, NB = 2, SEQ = 4096, DEPTH = 4, CTX = 256, GRID_W = 64;
constexpr int HD = 64;
constexpr int RW_WL = 64, RW_AL = 64, RW_GL = 128;
constexpr int MB_STATE = 128, MB_GROUPS = 2, MB_CONV = 5;
constexpr int MLA_NOPE = 64, MLA_ROPE = 32;
constexpr int NA_WR = 8, NA_WC = 16;
constexpr int NE = 16, NEG = 4;
#else
constexpr int D = 256, NB = 2, SEQ = 64, DEPTH = 2, CTX = 16, GRID_W = 8;
constexpr int HD = 16;
constexpr int RW_WL = 8, RW_AL = 8, RW_GL = 16;
constexpr int MB_STATE = 16, MB_GROUPS = 2, MB_CONV = 5;
constexpr int MLA_NOPE = 16, MLA_ROPE = 8;
constexpr int NA_WR = 4, NA_WC = 4;
constexpr int NE = 16, NEG = 4;
#endif
constexpr int GD = D / 4, NH = GD / HD, D_MIX = 4 * GD;
constexpr int MLA_QL = 3 * D / 16, MLA_KVL = D / 16;
constexpr int D_EXP = D / 4, EPG = NE / NEG;
constexpr int RW_IN = 3 * GD + 2 * RW_WL + 2 * RW_AL + RW_GL;
constexpr int MB_CONV_DIM = GD + 2 * MB_GROUPS * MB_STATE;
constexpr int MB_IN = GD + MB_CONV_DIM + 2 * NH;
constexpr int MLA_V = HD, MLA_QK = MLA_NOPE + MLA_ROPE;
constexpr int MLA_IN = MLA_QL + MLA_KVL + MLA_ROPE;
constexpr int NA_IN = 3 * GD;
constexpr int N_IN = RW_IN + MB_IN + MLA_IN + NA_IN;
constexpr int OFF_RW = 0, OFF_MB = RW_IN, OFF_MLA = RW_IN + MB_IN, OFF_NA = OFF_MLA + MLA_IN;
constexpr int LL = CTX + SEQ, TT = NB * LL;
constexpr int NMOD = NB + 1;
constexpr int MPAD = ((2 * TT + 255) / 256 + NE) * 256;
constexpr int N_INP = ((N_IN + 255) / 256) * 256;
constexpr int KLO = 2 * RW_WL + 2 * RW_AL + RW_GL, NLO = 5 * GD;
constexpr int KUP = MLA_QL + MLA_KVL, NUPQ = NH * MLA_QK, NUP = NUPQ + NH * (MLA_NOPE + MLA_V);
constexpr float LN_EPS = 1e-6f, RMS_EPS = 1e-6f, RW_GN_EPS = 64e-5f, RW_DECAY_SCALE = 0.606531f, ROUTED_SCALE = 2.5f;
constexpr float ROPE_BASE = 10000.0f;
#define DN_ALPHA (sqrtf(sqrtf(2.0f * (float)DEPTH)))

typedef unsigned short bf16_t;

#define DEVFN __device__ __forceinline__


DEVFN uint32_t f_as_u(float f) { union { float f; uint32_t u; } c; c.f = f; return c.u; }
DEVFN float u_as_f(uint32_t u) { union { float f; uint32_t u; } c; c.u = u; return c.f; }
DEVFN bf16_t f2bf(float f) { uint32_t u = f_as_u(f); u += 0x7fffu + ((u >> 16) & 1u); return (bf16_t)(u >> 16); }
DEVFN float bf2f(bf16_t h) { return u_as_f(((uint32_t)h) << 16); }
DEVFN int TIDX() { int t = (int)threadIdx.x; asm volatile("" : "+v"(t)); return t; }
DEVFN float bflo(unsigned w) { return u_as_f(w << 16); }
DEVFN float bfhi(unsigned w) { return u_as_f(w & 0xffff0000u); }
DEVFN unsigned pk2(float a, float b) { return (unsigned)f2bf(a) | ((unsigned)f2bf(b) << 16); }
DEVFN float sigmoidf_(float x) { return 1.0f / (1.0f + expf(-x)); }
DEVFN float siluf_(float x) { return x * sigmoidf_(x); }
DEVFN float softplusf_(float x) { return x > 20.0f ? x : log1pf(expf(x)); }

struct Params {
    const float *x, *c, *ctx, *c_ctx, *ada_w, *ada_b, *w_in, *w_out, *ln1_g, *ln1_b, *ln2_g, *ln2_b;
    const float *rw_mu, *rw_w0, *rw_w_up, *rw_a0, *rw_a_up, *rw_g_up, *rw_k_k, *rw_k_a, *rw_r_k, *rw_gn_g, *rw_gn_b;
    const float *mb_conv_w, *mb_conv_b, *mb_a_log, *mb_dt_bias, *mb_d, *mb_norm_g;
    const float *mla_q_norm, *mla_w_uq, *mla_kv_norm, *mla_w_ukv, *na_rpb, *router_w, *router_b, *exp_w_gate, *exp_w_up, *exp_w_down;
    float* out;
    bf16_t *WinT, *WoutT, *WguT, *WdT, *WupT;
    float* xs;
    bf16_t* xm;
    float* mod;
    float* modp;
    float2* ropecs;
    bf16_t* P;
    float* pm;
    bf16_t* pmb;
    bf16_t* LO;
    bf16_t* WloT;
    float *rwW, *rwB, *rwKD;
    float *rwKK, *rwG;
    bf16_t* rwMsT;
    float* rwSloc;
    bf16_t* rwYI;
    float* rwYloc;
    float* xc;
    float* dt;
    bf16_t* mbC;
    bf16_t* mbB;
    bf16_t* mbXT;
    bf16_t* mbBT;
    bf16_t* mbCS;
    bf16_t* mbYloc;
    float* mbCum;
    bf16_t* qkvn;
    float* QKVraw;
    int* qctr;
    bf16_t *Qm, *Km, *Vt;
    bf16_t* naVt;
    float* mlaO;
    float* mlaML;
    bf16_t* Ymix;
    bf16_t* yo;
    bf16_t* hb;
    int* cnt;
    int2 *tok_e, *tok_pos, *tok_row;
    float2* tok_w;
    bf16_t *hperm, *hidp, *Fperm;
};

DEVFN void ph_init(const Params& p, int l, size_t vt, size_t vs) {
    const size_t n = (size_t)TT * D;
    for (size_t i = vt; i < n; i += vs) {
        const int d = (int)(i % D); const int t = (int)(i / D); const int b = t / LL, s = t % LL;
        p.xs[i] = s < CTX ? p.ctx[((size_t)b * CTX + s) * D + d] : p.x[((size_t)b * SEQ + (s - CTX)) * D + d];
    }
    for (size_t i = vt; i < (size_t)GRID_W * (MLA_ROPE / 4); i += vs) {
        const int f = (int)(i % (MLA_ROPE / 4)), pos = (int)(i / (MLA_ROPE / 4));
        const float ang = (float)pos * powf(ROPE_BASE, -(float)f / (float)(MLA_ROPE / 4));
        p.ropecs[i] = make_float2(cosf(ang), sinf(ang));
    }
    for (size_t i = vt; i < (size_t)DEPTH * NE; i += vs) p.cnt[i] = 0;
    for (size_t i = vt; i < (size_t)DEPTH * 16; i += vs) p.qctr[i] = 0;
}

DEVFN void ph_transpose(const float* src, bf16_t* dst, int K, int N, int batch, size_t dst_bstride, int dst_row0, int ldd, int col0, size_t vt, size_t vs, size_t src_bstride = 0, int src_ld = 0) {
    if (src_ld == 0) src_ld = N;
    if (src_bstride == 0) src_bstride = (size_t)K * src_ld;
    const size_t total = (size_t)batch * (K / 8) * N;
    for (size_t idx = vt; idx < total; idx += vs) {
        const int n = (int)(idx % N); const int k8 = (int)((idx / N) % (K / 8)); const int bt = (int)(idx / ((size_t)N * (K / 8)));
        const float* sp = src + (size_t)bt * src_bstride + (size_t)(k8 * 8) * src_ld + n;
        uint4 w;
        const size_t sl_ = (size_t)src_ld;
        w.x = (unsigned)f2bf(sp[0]) | ((unsigned)f2bf(sp[sl_]) << 16); w.y = (unsigned)f2bf(sp[2 * sl_]) | ((unsigned)f2bf(sp[3 * sl_]) << 16);
        w.z = (unsigned)f2bf(sp[4 * sl_]) | ((unsigned)f2bf(sp[5 * sl_]) << 16); w.w = (unsigned)f2bf(sp[6 * sl_]) | ((unsigned)f2bf(sp[7 * sl_]) << 16);
        *(uint4*)(dst + (size_t)bt * dst_bstride + (size_t)(dst_row0 + n) * ldd + col0 + k8 * 8) = w;
    }
}
DEVFN void ph_zero16(uint4* dst, size_t n16, size_t vt, size_t vs) { for (size_t i = vt; i < n16; i += vs) dst[i] = make_uint4(0u, 0u, 0u, 0u); }
DEVFN void ph_transpose_t(const float* src, bf16_t* dst, int K, int N, int batch, size_t dst_bstride, int dst_row0, int ldd, int col0, bf16_t* smem, int vb, int nvb, size_t src_bstride = 0, int src_ld = 0) {
    constexpr int TQ = 8, TLD = 72;
    if (src_ld == 0) src_ld = N;
    if (src_bstride == 0) src_bstride = (size_t)K * src_ld;
    const int tid = TIDX(); const int r = tid >> 3, pc = tid & 7;
    const int kt = K / 64, nt = (N + 63) / 64; const int total = batch * kt * nt;
    for (int t0 = vb * TQ; t0 < total; t0 += nvb * TQ) {
        float4 va[TQ], vb4[TQ];
#pragma unroll
        for (int q = 0; q < TQ; ++q) {
            const int tile = t0 + q; const int tc = tile < total ? tile : total - 1;
            const int nti = tc % nt, kti = (tc / nt) % kt, bt = tc / (nt * kt);
            const int n0 = nti * 64 + pc * 8; const int nc = n0 + 8 <= N ? n0 : 0;
            const float* sp = src + (size_t)bt * src_bstride + (size_t)(kti * 64 + r) * src_ld + nc;
            va[q] = *(const float4*)sp; vb4[q] = *(const float4*)(sp + 4);
        }
        __syncthreads();
#pragma unroll
        for (int q = 0; q < TQ; ++q) {
            bf16_t* sm = smem + q * 64 * TLD + (pc * 8) * TLD + r;
            sm[0] = f2bf(va[q].x); sm[TLD] = f2bf(va[q].y); sm[2 * TLD] = f2bf(va[q].z); sm[3 * TLD] = f2bf(va[q].w);
            sm[4 * TLD] = f2bf(vb4[q].x); sm[5 * TLD] = f2bf(vb4[q].y); sm[6 * TLD] = f2bf(vb4[q].z); sm[7 * TLD] = f2bf(vb4[q].w);
        }
        __syncthreads();
#pragma unroll
        for (int q = 0; q < TQ; ++q) {
            const int tile = t0 + q;
            if (tile < total) {
                const int nti = tile % nt, kti = (tile / nt) % kt, bt = tile / (nt * kt);
                const int n = nti * 64 + r;
                if (n < N) *(uint4*)(dst + (size_t)bt * dst_bstride + (size_t)(dst_row0 + n) * ldd + col0 + kti * 64 + pc * 8) = *(const uint4*)(smem + q * 64 * TLD + r * TLD + pc * 8);
            }
        }
    }
    __syncthreads();
}

constexpr int MOD_IC = 128, MOD_NC = D / MOD_IC;
DEVFN void ph_mod_partial(const Params& p, size_t vt, size_t vs) {
    constexpr int J4 = 6 * D / 4;
    const size_t total = (size_t)DEPTH * MOD_NC * J4;
    for (size_t idx = vt; idx < total; idx += vs) {
        const int j4 = (int)(idx % J4); const int ic = (int)((idx / J4) % MOD_NC); const int l = (int)(idx / ((size_t)J4 * MOD_NC));
        float4 acc[NMOD];
#pragma unroll
        for (int r = 0; r < NMOD; ++r) acc[r] = make_float4(0.f, 0.f, 0.f, 0.f);
        const float* wp = p.ada_w + ((size_t)l * D + (size_t)ic * MOD_IC) * 6 * D + j4 * 4;
#pragma unroll 8
        for (int i = 0; i < MOD_IC; ++i) {
            const float4 w = *(const float4*)(wp + (size_t)i * 6 * D);
#pragma unroll
            for (int r = 0; r < NMOD; ++r) { const float cv = r < NB ? p.c[r * D + ic * MOD_IC + i] : p.c_ctx[ic * MOD_IC + i]; const float sv = siluf_(cv);
                acc[r].x += sv * w.x; acc[r].y += sv * w.y; acc[r].z += sv * w.z; acc[r].w += sv * w.w; }
        }
#pragma unroll
        for (int r = 0; r < NMOD; ++r) *(float4*)(p.modp + ((((size_t)l * MOD_NC + ic) * NMOD + r) * 6 * D) + j4 * 4) = acc[r];
    }
}
DEVFN void ph_mod_final(const Params& p, size_t vt, size_t vs) {
    const size_t total = (size_t)DEPTH * NMOD * 6 * D;
    for (size_t idx = vt; idx < total; idx += vs) {
        const int j = (int)(idx % (6 * D)); const int r = (int)((idx / (6 * D)) % NMOD); const int l = (int)(idx / ((size_t)6 * D * NMOD));
        float acc = p.ada_b[(size_t)l * 6 * D + j];
        for (int ic = 0; ic < MOD_NC; ++ic) acc += p.modp[(((size_t)l * MOD_NC + ic) * NMOD + r) * 6 * D + j];
        p.mod[idx] = acc;
    }
}

DEVFN void ph_modulate(const Params& p, int l, size_t vt, size_t vs) {
    const size_t n = (size_t)TT * D;
    for (size_t i = vt; i < n; i += vs) {
        const int d = (int)(i % D); const int t = (int)(i / D); const int b = t / LL, s = t % LL; const int r = s < CTX ? NB : b;
        const float* m = p.mod + ((size_t)l * NMOD + r) * 6 * D;
        p.xm[i] = f2bf(p.xs[i] * (1.0f + m[D + d]) + m[d]);
    }
}

typedef short bf16x8_t __attribute__((ext_vector_type(8)));
typedef float f32x16_t __attribute__((ext_vector_type(16)));
typedef __bf16 bf16v2_t __attribute__((ext_vector_type(2)));
typedef float f32v2_t __attribute__((ext_vector_type(2)));
DEVFN unsigned cvt_pk_bf16_h(float lo, float hi) { const f32v2_t v = {lo, hi}; const bf16v2_t r = __builtin_convertvector(v, bf16v2_t); return __builtin_bit_cast(unsigned, r); }
DEVFN unsigned cvt_pk_bf16(float lo, float hi) { unsigned r; asm volatile("v_cvt_pk_bf16_f32 %0, %1, %2" : "=v"(r) : "v"(lo), "v"(hi)); return r; }
union Frag8 { bf16x8_t v; unsigned u[4]; uint2 d2[2]; uint4 q; };


DEVFN void ph_rw_mix(const Params& p, int l, size_t vt, size_t vs) {
    static_assert(RW_IN % 8 == 0 && (3 * GD) % 8 == 0 && (2 * RW_WL) % 8 == 0 && (2 * RW_AL) % 8 == 0, "8-column groups");
    constexpr int NG = RW_IN / 8;
    const size_t n = (size_t)TT * NG;
    for (size_t i = vt; i < n; i += vs) {
        const int col = (int)(i % NG) * 8; const int t = (int)(i / NG); const int s_ = t % LL;
        const bool first = (s_ == 0 || s_ == CTX), last = (s_ == CTX - 1 || s_ == LL - 1);
        const bf16_t* pc = p.P + (size_t)t * N_IN + OFF_RW + col;
        const uint4 cv = *(const uint4*)pc;
        const uint4 pv = first ? make_uint4(0, 0, 0, 0) : *(const uint4*)(pc - N_IN);
        const uint4 nv = last ? make_uint4(0, 0, 0, 0) : *(const uint4*)(pc + N_IN);
        const float* m0 = p.rw_mu + ((size_t)l * 2 + 0) * RW_IN + col; const float* m1 = p.rw_mu + ((size_t)l * 2 + 1) * RW_IN + col;
        const float4 a0 = *(const float4*)m0, a1 = *(const float4*)(m0 + 4), b0 = *(const float4*)m1, b1 = *(const float4*)(m1 + 4);
        const float mu0[8] = {a0.x, a0.y, a0.z, a0.w, a1.x, a1.y, a1.z, a1.w}, mu1[8] = {b0.x, b0.y, b0.z, b0.w, b1.x, b1.y, b1.z, b1.w};
        const unsigned cw[4] = {cv.x, cv.y, cv.z, cv.w}, pw[4] = {pv.x, pv.y, pv.z, pv.w}, nw[4] = {nv.x, nv.y, nv.z, nv.w};
        float o[8];
#pragma unroll
        for (int k = 0; k < 4; ++k) {
            const float v0 = bflo(cw[k]), v1 = bfhi(cw[k]);
            o[2 * k] = v0 + mu0[2 * k] * (bflo(pw[k]) - v0) + mu1[2 * k] * (bflo(nw[k]) - v0);
            o[2 * k + 1] = v1 + mu0[2 * k + 1] * (bfhi(pw[k]) - v1) + mu1[2 * k + 1] * (bfhi(nw[k]) - v1);
        }
        if (col >= 3 * GD && col < 3 * GD + 2 * RW_WL) {
#pragma unroll
            for (int k = 0; k < 8; ++k) o[k] = tanhf(o[k]);
        } else if (col >= 3 * GD + 2 * RW_WL + 2 * RW_AL) {
#pragma unroll
            for (int k = 0; k < 8; ++k) o[k] = sigmoidf_(o[k]);
        }
        float* po = p.pm + (size_t)t * RW_IN + col;
        *(float4*)po = make_float4(o[0], o[1], o[2], o[3]); *(float4*)(po + 4) = make_float4(o[4], o[5], o[6], o[7]);
        if (col >= 3 * GD) *(uint4*)(p.pmb + (size_t)t * KLO + (col - 3 * GD)) = make_uint4(pk2(o[0], o[1]), pk2(o[2], o[3]), pk2(o[4], o[5]), pk2(o[6], o[7]));
    }
}

DEVFN void ph_rw_prep(const Params& p, int l, size_t vt, size_t vs) {
    static_assert(HD == 64, "one head = 16 lanes x 4 columns");
    constexpr int NG = GD / 4;
    const size_t n = (size_t)TT * NG;
    for (size_t i = vt; i < n; i += vs) {
        const int c = (int)(i % NG) * 4; const int t = (int)(i / NG);
        const float4 k4 = *(const float4*)(p.pm + (size_t)t * RW_IN + GD + c);
        const float4 kk4 = *(const float4*)(p.rw_k_k + (size_t)l * GD + c), ka4 = *(const float4*)(p.rw_k_a + (size_t)l * GD + c);
        const float k[4] = {k4.x, k4.y, k4.z, k4.w}, kkw[4] = {kk4.x, kk4.y, kk4.z, kk4.w}, ka[4] = {ka4.x, ka4.y, ka4.z, ka4.w};
        float kkr[4], ss = 0.f;
#pragma unroll
        for (int q = 0; q < 4; ++q) { kkr[q] = k[q] * kkw[q]; ss += kkr[q] * kkr[q]; }
#pragma unroll
        for (int o = 8; o > 0; o >>= 1) ss += __shfl_xor(ss, o);
        const float rn = 1.0f / sqrtf(fmaxf(ss, 1e-12f));
        const bf16_t* lo = p.LO + (size_t)t * NLO + c;
        float kkv[4];
#pragma unroll
        for (int q = 0; q < 4; ++q) kkv[q] = kkr[q] * rn;
#pragma unroll
        for (int dir = 0; dir < 2; ++dir) {
            const uint2 wl = *(const uint2*)(lo + dir * GD), al = *(const uint2*)(lo + 2 * GD + dir * GD);
            const float4 w0 = *(const float4*)(p.rw_w0 + ((size_t)l * 2 + dir) * GD + c), a0 = *(const float4*)(p.rw_a0 + ((size_t)l * 2 + dir) * GD + c);
            const float wp[4] = {w0.x + bflo(wl.x), w0.y + bfhi(wl.x), w0.z + bflo(wl.y), w0.w + bfhi(wl.y)};
            const float ap[4] = {a0.x + bflo(al.x), a0.y + bfhi(al.x), a0.z + bflo(al.y), a0.w + bfhi(al.y)};
            float dec[4], bv[4], kd[4];
#pragma unroll
            for (int q = 0; q < 4; ++q) { const float av = sigmoidf_(ap[q]); dec[q] = expf(-RW_DECAY_SCALE * sigmoidf_(wp[q])); bv[q] = kkv[q] * av; kd[q] = k[q] * (1.0f + (av - 1.0f) * ka[q]); }
            const size_t o = ((size_t)dir * TT + t) * GD + c;
            *(float4*)(p.rwW + o) = make_float4(dec[0], dec[1], dec[2], dec[3]); *(float4*)(p.rwB + o) = make_float4(bv[0], bv[1], bv[2], bv[3]); *(float4*)(p.rwKD + o) = make_float4(kd[0], kd[1], kd[2], kd[3]);
        }
        const uint2 gl = *(const uint2*)(lo + 4 * GD);
        *(float4*)(p.rwKK + (size_t)t * GD + c) = make_float4(kkv[0], kkv[1], kkv[2], kkv[3]);
        *(float4*)(p.rwG + (size_t)t * GD + c) = make_float4(bflo(gl.x), bfhi(gl.x), bflo(gl.y), bfhi(gl.y));
    }
}

DEVFN int scan_pos(int dir, int step) {
    if (dir == 0) return step;
    return step < CTX ? (CTX - 1 - step) : (CTX + (SEQ - 1) - (step - CTX));
}

constexpr int CK = 64, NCHK = LL / CK, NU = NB * NH * 2;
constexpr int RWS = 8;
constexpr int RW_ROW = 6 * HD;
constexpr int RW_STG = RWS * RW_ROW;
typedef float f2v __attribute__((ext_vector_type(2)));
template <int MODE>
DEVFN void rw_chunk_item(const Params& p, float* lds_f, const int item) {
    constexpr bool DO_T = MODE != 2, DO_L = MODE != 1;
    static_assert(HD == 64 && CTX % CK == 0 && SEQ % CK == 0 && CK % RWS == 0, "chunking");
    const int lane = (TIDX() & 63);
    float* stg = lds_f + (size_t)__builtin_amdgcn_readfirstlane((TIDX() >> 6)) * RW_STG;
    {
        const int c = item % NCHK, u = item / NCHK;
        const int dir = u % 2, h = (u / 2) % NH, b = u / (2 * NH);
        f2v ST[HD / 2], SL[HD / 2];
#pragma unroll
        for (int j = 0; j < HD / 2; ++j) { ST[j] = (f2v){(2 * j == lane) ? 1.f : 0.f, (2 * j + 1 == lane) ? 1.f : 0.f}; SL[j] = (f2v){0.f, 0.f}; }
        float4 na0, na1, na2, na3, na4, na5, nb0, nb1, nb2, nb3, nb4, nb5;
#define RWC_LOAD1(q_, sub_, X0, X1, X2, X3, X4, X5) do { const int t_ = b * LL + scan_pos(dir, c * CK + (sub_) * RWS + (q_) * 4 + lrow_); \
                X0 = *(const float4*)(p.rwW + ((size_t)dir * TT + t_) * GD + h * HD + lcol_); X1 = *(const float4*)(p.rwB + ((size_t)dir * TT + t_) * GD + h * HD + lcol_); \
                X2 = *(const float4*)(p.rwKD + ((size_t)dir * TT + t_) * GD + h * HD + lcol_); X3 = *(const float4*)(p.rwKK + (size_t)t_ * GD + h * HD + lcol_); \
                X4 = *(const float4*)(p.pm + (size_t)t_ * RW_IN + h * HD + lcol_); X5 = *(const float4*)(p.pm + (size_t)t_ * RW_IN + 2 * GD + h * HD + lcol_); } while (0)
#define RWC_LOAD(sub_) do { int lrow_ = lane >> 4, lcol_ = (lane & 15) * 4; asm volatile("" : "+v"(lrow_), "+v"(lcol_)); \
            RWC_LOAD1(0, sub_, na0, na1, na2, na3, na4, na5); RWC_LOAD1(1, sub_, nb0, nb1, nb2, nb3, nb4, nb5); } while (0)
        RWC_LOAD(0);
#pragma unroll 1
        for (int sub = 0; sub < CK / RWS; ++sub) {
            __builtin_amdgcn_wave_barrier();
            {
                int lrow = lane >> 4, lcol = (lane & 15) * 4;
                asm volatile("" : "+v"(lrow), "+v"(lcol));
                float* d0 = stg + (lrow) * RW_ROW + lcol; float* d1 = stg + (4 + lrow) * RW_ROW + lcol;
                *(float4*)(d0) = na0; *(float4*)(d0 + HD) = na1; *(float4*)(d0 + 2 * HD) = na2; *(float4*)(d0 + 3 * HD) = na3; *(float4*)(d0 + 4 * HD) = na4; *(float4*)(d0 + 5 * HD) = na5;
                *(float4*)(d1) = nb0; *(float4*)(d1 + HD) = nb1; *(float4*)(d1 + 2 * HD) = nb2; *(float4*)(d1 + 3 * HD) = nb3; *(float4*)(d1 + 4 * HD) = nb4; *(float4*)(d1 + 5 * HD) = nb5;
            }
            if (sub + 1 < CK / RWS) RWC_LOAD(sub + 1);
            __builtin_amdgcn_wave_barrier();
#pragma unroll 1
            for (int st = 0; st < RWS; ++st) {
                const float* sv = stg + st * RW_ROW;
                const int gs = c * CK + sub * RWS + st;
                f2v aT = {0.f, 0.f}, aL = {0.f, 0.f};
                float4 kkn = *(const float4*)(sv + 3 * HD);
#pragma unroll
                for (int j = 0; j < HD; j += 4) {
                    const float4 kk = kkn;
                    if (j + 4 < HD) kkn = *(const float4*)(sv + 3 * HD + j + 4);
                    asm volatile("" ::: "memory");
                    const f2v k0 = {kk.x, kk.y}, k1 = {kk.z, kk.w};
                    if (DO_T) { aT += ST[j / 2] * k0; aT += ST[j / 2 + 1] * k1; }
                    if (DO_L) { aL += SL[j / 2] * k0; aL += SL[j / 2 + 1] * k1; }
                }
                const float saT = -(aT.x + aT.y), saL = -(aL.x + aL.y);
                const f2v saT2 = {saT, saT}, saL2 = {saL, saL};
                int ln0 = lane; asm volatile("" : "+v"(ln0));
                const float vi = sv[5 * HD + ln0];
                const f2v vi2 = {vi, vi};
                f2v yT2 = {0.f, 0.f}, yL2 = {0.f, 0.f};
                float4 wn = *(const float4*)(sv), bn = *(const float4*)(sv + HD), kdn = *(const float4*)(sv + 2 * HD), rn = *(const float4*)(sv + 4 * HD);
#pragma unroll
                for (int j = 0; j < HD; j += 4) {
                    const float4 w = wn, bb = bn, kd = kdn, r = rn;
                    if (j + 4 < HD) { wn = *(const float4*)(sv + j + 4); bn = *(const float4*)(sv + HD + j + 4); if (DO_L) kdn = *(const float4*)(sv + 2 * HD + j + 4); rn = *(const float4*)(sv + 4 * HD + j + 4); }
                    asm volatile("" ::: "memory");
                    const f2v w0 = {w.x, w.y}, w1 = {w.z, w.w}, b0 = {bb.x, bb.y}, b1 = {bb.z, bb.w}, r0 = {r.x, r.y}, r1 = {r.z, r.w};
                    if (DO_T) {
                        ST[j / 2] = ST[j / 2] * w0 + saT2 * b0; ST[j / 2 + 1] = ST[j / 2 + 1] * w1 + saT2 * b1;
                        yT2 += ST[j / 2] * r0; yT2 += ST[j / 2 + 1] * r1;
                    }
                    if (DO_L) {
                        const f2v d0 = {kd.x, kd.y}, d1 = {kd.z, kd.w};
                        SL[j / 2] = SL[j / 2] * w0 + saL2 * b0 + vi2 * d0; SL[j / 2 + 1] = SL[j / 2 + 1] * w1 + saL2 * b1 + vi2 * d1;
                        yL2 += SL[j / 2] * r0; yL2 += SL[j / 2 + 1] * r1;
                    }
                }
                int ln = lane; asm volatile("" : "+v"(ln));
                if (DO_T) p.rwYI[((size_t)u * LL + gs) * HD + ln] = f2bf(yT2.x + yT2.y);
                if (DO_L) p.rwYloc[((size_t)u * LL + gs) * HD + ln] = yL2.x + yL2.y;
            }
        }
#undef RWC_LOAD
#undef RWC_LOAD1
        if (DO_T) {
        bf16_t* oT = p.rwMsT + ((size_t)u * NCHK + c) * HD * HD;
#pragma unroll
        for (int j = 0; j < HD; ++j) oT[(size_t)j * HD + lane] = f2bf((j & 1) ? ST[j / 2].y : ST[j / 2].x);
        }
        if (DO_L) {
        float* oL = p.rwSloc + (((size_t)u * NCHK + c) * HD + lane) * HD;
#pragma unroll
        for (int j = 0; j < HD; j += 4) *(float4*)(oL + j) = make_float4(SL[j / 2].x, SL[j / 2].y, SL[j / 2 + 1].x, SL[j / 2 + 1].y);
        }
    }
}

template <bool ISL>
DEVFN void rw_chunk_quarter(const Params& p, float* lds_f, const int item, const int rh) {
    const int lane = (TIDX() & 63);
    float* stg = lds_f + (size_t)__builtin_amdgcn_readfirstlane((TIDX() >> 6)) * RW_STG;
    const int c = item % NCHK, u = item / NCHK;
    const int dir = u % 2, h = (u / 2) % NH, b = u / (2 * NH);
    const int row = rh * 32 + (lane & 31), co = 32 * (lane >> 5);
    f2v S[16];
#pragma unroll
    for (int j = 0; j < 16; ++j) S[j] = ISL ? (f2v){0.f, 0.f} : (f2v){(co + 2 * j == row) ? 1.f : 0.f, (co + 2 * j + 1 == row) ? 1.f : 0.f};
    float4 na0, na1, na2, na3, na4, na5, nb0, nb1, nb2, nb3, nb4, nb5;
#define RWC_LOAD1(q_, sub_, X0, X1, X2, X3, X4, X5) do { const int t_ = b * LL + scan_pos(dir, c * CK + (sub_) * RWS + (q_) * 4 + lrow_); \
            X0 = *(const float4*)(p.rwW + ((size_t)dir * TT + t_) * GD + h * HD + lcol_); X1 = *(const float4*)(p.rwB + ((size_t)dir * TT + t_) * GD + h * HD + lcol_); \
            X2 = *(const float4*)(p.rwKD + ((size_t)dir * TT + t_) * GD + h * HD + lcol_); X3 = *(const float4*)(p.rwKK + (size_t)t_ * GD + h * HD + lcol_); \
            X4 = *(const float4*)(p.pm + (size_t)t_ * RW_IN + h * HD + lcol_); X5 = *(const float4*)(p.pm + (size_t)t_ * RW_IN + 2 * GD + h * HD + lcol_); } while (0)
#define RWC_LOAD(sub_) do { int lrow_ = lane >> 4, lcol_ = (lane & 15) * 4; asm volatile("" : "+v"(lrow_), "+v"(lcol_)); \
        RWC_LOAD1(0, sub_, na0, na1, na2, na3, na4, na5); RWC_LOAD1(1, sub_, nb0, nb1, nb2, nb3, nb4, nb5); } while (0)
    RWC_LOAD(0);
#pragma unroll 1
    for (int sub = 0; sub < CK / RWS; ++sub) {
        __builtin_amdgcn_wave_barrier();
        {
            int lrow = lane >> 4, lcol = (lane & 15) * 4;
            asm volatile("" : "+v"(lrow), "+v"(lcol));
            float* d0 = stg + (lrow) * RW_ROW + lcol; float* d1 = stg + (4 + lrow) * RW_ROW + lcol;
            *(float4*)(d0) = na0; *(float4*)(d0 + HD) = na1; *(float4*)(d0 + 2 * HD) = na2; *(float4*)(d0 + 3 * HD) = na3; *(float4*)(d0 + 4 * HD) = na4; *(float4*)(d0 + 5 * HD) = na5;
            *(float4*)(d1) = nb0; *(float4*)(d1 + HD) = nb1; *(float4*)(d1 + 2 * HD) = nb2; *(float4*)(d1 + 3 * HD) = nb3; *(float4*)(d1 + 4 * HD) = nb4; *(float4*)(d1 + 5 * HD) = nb5;
        }
        if (sub + 1 < CK / RWS) RWC_LOAD(sub + 1);
        __builtin_amdgcn_wave_barrier();
#pragma unroll 1
        for (int st = 0; st < RWS; ++st) {
            int co_ = co; asm volatile("" : "+v"(co_));
            const float* sv = stg + st * RW_ROW + co_;
            const int gs = c * CK + sub * RWS + st;
            f2v a2 = {0.f, 0.f};
#pragma unroll
            for (int j = 0; j < 32; j += 4) {
                const float4 kk = *(const float4*)(sv + 3 * HD + j);
                a2 += S[j / 2] * (f2v){kk.x, kk.y}; a2 += S[j / 2 + 1] * (f2v){kk.z, kk.w};
            }
            float sap = a2.x + a2.y; sap += __shfl_xor(sap, 32);
            const f2v sa2 = {-sap, -sap};
            int rw_ = row; asm volatile("" : "+v"(rw_));
            const float vi = ISL ? stg[st * RW_ROW + 5 * HD + rw_] : 0.f;
            const f2v vi2 = {vi, vi};
            f2v y2 = {0.f, 0.f};
#pragma unroll
            for (int j = 0; j < 32; j += 4) {
                asm volatile("" ::: "memory");
                const float4 w = *(const float4*)(sv + j), bb = *(const float4*)(sv + HD + j), r = *(const float4*)(sv + 4 * HD + j);
                const f2v w0 = {w.x, w.y}, w1 = {w.z, w.w}, b0 = {bb.x, bb.y}, b1 = {bb.z, bb.w}, r0 = {r.x, r.y}, r1 = {r.z, r.w};
                if (ISL) { const float4 kd = *(const float4*)(sv + 2 * HD + j); S[j / 2] = S[j / 2] * w0 + sa2 * b0 + vi2 * (f2v){kd.x, kd.y}; S[j / 2 + 1] = S[j / 2 + 1] * w1 + sa2 * b1 + vi2 * (f2v){kd.z, kd.w}; }
                else { S[j / 2] = S[j / 2] * w0 + sa2 * b0; S[j / 2 + 1] = S[j / 2 + 1] * w1 + sa2 * b1; }
                y2 += S[j / 2] * r0; y2 += S[j / 2 + 1] * r1;
            }
            float yp = y2.x + y2.y; yp += __shfl_xor(yp, 32);
            if (lane < 32) { if (ISL) p.rwYloc[((size_t)u * LL + gs) * HD + rw_] = yp; else p.rwYI[((size_t)u * LL + gs) * HD + rw_] = f2bf(yp); }
        }
    }
#undef RWC_LOAD
#undef RWC_LOAD1
    if (!ISL) {
        bf16_t* oT = p.rwMsT + ((size_t)u * NCHK + c) * HD * HD;
#pragma unroll
        for (int j = 0; j < 32; ++j) oT[(size_t)(co + j) * HD + row] = f2bf((j & 1) ? S[j / 2].y : S[j / 2].x);
    } else {
        float* oL = p.rwSloc + (((size_t)u * NCHK + c) * HD + row) * HD + co;
#pragma unroll
        for (int j = 0; j < 32; j += 4) *(float4*)(oL + j) = make_float4(S[j / 2].x, S[j / 2].y, S[j / 2 + 1].x, S[j / 2 + 1].y);
    }
}

constexpr int RSQ_D = 4;
constexpr int RSQ_SLOT = HD * HD * 2 + HD * HD * 4;
DEVFN void ph_rw_seq(const Params& p, unsigned char* lds_b, int vb, int nvb) {
    static_assert(NCHK % RSQ_D == 0 && RSQ_D == 4 && RSQ_SLOT == 3 * 512 * 16, "chain geometry: 3 x 16 B per thread per chunk");
    const int tid = TIDX(), lane = tid & 63, wave = tid >> 6, li = lane & 31, lh = lane >> 5;
    for (int u = vb; u < NU; u += nvb) {
        const unsigned char* gM = (const unsigned char*)(p.rwMsT + (size_t)u * NCHK * HD * HD);
        const unsigned char* gS = (const unsigned char*)(p.rwSloc + (size_t)u * NCHK * HD * HD);
        uint4 pf[RSQ_D][3];
#define RSQ_LOAD(d, c_) do { pf[d][0] = *(const uint4*)(gM + (size_t)(c_) * (HD * HD * 2) + tid * 16); \
            pf[d][1] = *(const uint4*)(gS + (size_t)(c_) * (HD * HD * 4) + tid * 16); pf[d][2] = *(const uint4*)(gS + (size_t)(c_) * (HD * HD * 4) + 8192 + tid * 16); } while (0)
#pragma unroll
        for (int d = 0; d < RSQ_D; ++d) RSQ_LOAD(d, d);
        f32x16_t X0, X1;
#pragma unroll
        for (int r = 0; r < 16; ++r) { X0[r] = 0.f; X1[r] = 0.f; }
        const int i = wave * 32 + li;
        __syncthreads();
#define RSQ_STEP(d, P0, P1, P2) { \
                const int c = c0 + d; \
                unsigned char* slot = lds_b + (c & 1) * RSQ_SLOT; \
                *(uint4*)(slot + tid * 16) = P0; *(uint4*)(slot + HD * HD * 2 + tid * 16) = P1; *(uint4*)(slot + HD * HD * 2 + 8192 + tid * 16) = P2; \
                if (c + RSQ_D < NCHK) { P0 = *(const uint4*)(gM + (size_t)(c + RSQ_D) * (HD * HD * 2) + tid * 16); P1 = *(const uint4*)(gS + (size_t)(c + RSQ_D) * (HD * HD * 4) + tid * 16); P2 = *(const uint4*)(gS + (size_t)(c + RSQ_D) * (HD * HD * 4) + 8192 + tid * 16); } \
                __syncthreads(); \
                if (wave < 2) { \
                    const bf16_t* ms = (const bf16_t*)slot; const float* sl = (const float*)(slot + HD * HD * 2) + (size_t)i * HD; \
                    Frag8 xb[2][2]; \
_Pragma("unroll") \
                    for (int sp = 0; sp < 2; ++sp) \
_Pragma("unroll") \
                        for (int q = 0; q < 4; ++q) { \
                            xb[0][sp].u[q] = cvt_pk_bf16_h(X0[8 * sp + 2 * q], X0[8 * sp + 2 * q + 1]); \
                            xb[1][sp].u[q] = cvt_pk_bf16_h(X1[8 * sp + 2 * q], X1[8 * sp + 2 * q + 1]); \
                        } \
                    f32x16_t N0, N1; \
_Pragma("unroll") \
                    for (int g = 0; g < 4; ++g) { \
                        const float4 v0 = *(const float4*)(sl + 8 * g + 4 * lh), v1 = *(const float4*)(sl + 32 + 8 * g + 4 * lh); \
                        N0[4 * g] = v0.x; N0[4 * g + 1] = v0.y; N0[4 * g + 2] = v0.z; N0[4 * g + 3] = v0.w; \
                        N1[4 * g] = v1.x; N1[4 * g + 1] = v1.y; N1[4 * g + 2] = v1.z; N1[4 * g + 3] = v1.w; \
                    } \
_Pragma("unroll") \
                    for (int jb = 0; jb < 2; ++jb) \
_Pragma("unroll") \
                        for (int sp = 0; sp < 2; ++sp) { \
                            Frag8 a0, a1; \
                            a0.d2[0] = *(const uint2*)(ms + (li) * HD + 32 * jb + 16 * sp + 4 * lh); a0.d2[1] = *(const uint2*)(ms + (li) * HD + 32 * jb + 16 * sp + 4 * lh + 8); \
                            a1.d2[0] = *(const uint2*)(ms + (32 + li) * HD + 32 * jb + 16 * sp + 4 * lh); a1.d2[1] = *(const uint2*)(ms + (32 + li) * HD + 32 * jb + 16 * sp + 4 * lh + 8); \
                            N0 = __builtin_amdgcn_mfma_f32_32x32x16_bf16(a0.v, xb[jb][sp].v, N0, 0, 0, 0); \
                            N1 = __builtin_amdgcn_mfma_f32_32x32x16_bf16(a1.v, xb[jb][sp].v, N1, 0, 0, 0); \
                        } \
                    float* so = p.rwSloc + (((size_t)u * NCHK + c) * HD + i) * HD; \
_Pragma("unroll") \
                    for (int g = 0; g < 4; ++g) { \
                        *(float4*)(so + 8 * g + 4 * lh) = make_float4(N0[4 * g], N0[4 * g + 1], N0[4 * g + 2], N0[4 * g + 3]); \
                        *(float4*)(so + 32 + 8 * g + 4 * lh) = make_float4(N1[4 * g], N1[4 * g + 1], N1[4 * g + 2], N1[4 * g + 3]); \
                    } \
                    X0 = N0; X1 = N1; \
                } \
 \
            }
        uint4 pa0, pa1, pa2, pb0, pb1, pb2, pc0, pc1, pc2, pd0, pd1, pd2;
        pa0 = pf[0][0]; pa1 = pf[0][1]; pa2 = pf[0][2]; pb0 = pf[1][0]; pb1 = pf[1][1]; pb2 = pf[1][2]; pc0 = pf[2][0]; pc1 = pf[2][1]; pc2 = pf[2][2]; pd0 = pf[3][0]; pd1 = pf[3][1]; pd2 = pf[3][2];
        for (int c0 = 0; c0 < NCHK; c0 += RSQ_D) {
            RSQ_STEP(0, pa0, pa1, pa2) RSQ_STEP(1, pb0, pb1, pb2) RSQ_STEP(2, pc0, pc1, pc2) RSQ_STEP(3, pd0, pd1, pd2)
        }
#undef RSQ_LOAD
#undef RSQ_STEP
        __syncthreads();
    }
}

DEVFN int rev_gs(int s) { return s < CTX ? (CTX - 1 - s) : (CTX + (SEQ - 1) - (s - CTX)); }
DEVFN int rev_chunk(int pbk) { return pbk < CTX / CK ? (CTX / CK - 1 - pbk) : (CTX / CK + (SEQ / CK - 1) - (pbk - CTX / CK)); }

DEVFN void ph_rw_yout(const Params& p, int l, size_t vt, size_t vs) {
    const int lane = (TIDX() & 63), lq = lane & 31, lh = lane >> 5;
    const int wv = __builtin_amdgcn_readfirstlane((int)(vt >> 6)), nwv = (int)(vs >> 6);
    const int wvs = (wv & 7) * (nwv >> 3) + (wv >> 3);
    for (int item = wvs; item < NB * NH * NCHK; item += nwv) {
        const int pbk = item % NCHK, h = (item / NCHK) % NH, b = item / (NCHK * NH);
        f32x16_t acc[2][2];
#pragma unroll
        for (int dir = 0; dir < 2; ++dir) {
            const int u = (b * NH + h) * 2 + dir;
            const int c = dir == 0 ? pbk : rev_chunk(pbk);
            int gs[2];
#pragma unroll
            for (int tb = 0; tb < 2; ++tb) { const int s_ = CK * pbk + 32 * tb + lq; gs[tb] = dir == 0 ? s_ : rev_gs(s_); }
#pragma unroll
            for (int tb = 0; tb < 2; ++tb) {
                const float* yl = p.rwYloc + ((size_t)u * LL + gs[tb]) * HD;
#pragma unroll
                for (int ib = 0; ib < 2; ++ib)
#pragma unroll
                    for (int g = 0; g < 4; ++g) {
                        const float4 v = *(const float4*)(yl + 32 * ib + 8 * g + 4 * lh);
                        if (dir == 0) { acc[ib][tb][4 * g] = v.x; acc[ib][tb][4 * g + 1] = v.y; acc[ib][tb][4 * g + 2] = v.z; acc[ib][tb][4 * g + 3] = v.w; }
                        else { acc[ib][tb][4 * g] += v.x; acc[ib][tb][4 * g + 1] += v.y; acc[ib][tb][4 * g + 2] += v.z; acc[ib][tb][4 * g + 3] += v.w; }
                    }
            }
            if (c > 0) {
                const float* st = p.rwSloc + ((size_t)u * NCHK + (c - 1)) * HD * HD;
#pragma unroll
                for (int ks = 0; ks < 4; ++ks) {
                    Frag8 a[2];
#pragma unroll
                    for (int ib = 0; ib < 2; ++ib) {
                        const float4 lo = *(const float4*)(st + (size_t)(32 * ib + lq) * HD + 16 * ks + 8 * lh), hi = *(const float4*)(st + (size_t)(32 * ib + lq) * HD + 16 * ks + 8 * lh + 4);
                        a[ib].u[0] = cvt_pk_bf16_h(lo.x, lo.y); a[ib].u[1] = cvt_pk_bf16_h(lo.z, lo.w); a[ib].u[2] = cvt_pk_bf16_h(hi.x, hi.y); a[ib].u[3] = cvt_pk_bf16_h(hi.z, hi.w);
                    }
#pragma unroll
                    for (int tb = 0; tb < 2; ++tb) {
                        const bf16x8_t bq = *(const bf16x8_t*)(p.rwYI + ((size_t)u * LL + gs[tb]) * HD + 16 * ks + 8 * lh);
#pragma unroll
                        for (int ib = 0; ib < 2; ++ib) acc[ib][tb] = __builtin_amdgcn_mfma_f32_32x32x16_bf16(a[ib].v, bq, acc[ib][tb], 0, 0, 0);
                    }
                }
            }
        }
#pragma unroll
        for (int tb = 0; tb < 2; ++tb) {
            const int t = b * LL + CK * pbk + 32 * tb + lq;
            float sum = 0.f;
#pragma unroll
            for (int ib = 0; ib < 2; ++ib)
#pragma unroll
                for (int r = 0; r < 16; ++r) sum += acc[ib][tb][r];
            sum += __shfl_xor(sum, 32);
            const float mu = sum * (1.0f / HD);
            float sq = 0.f;
#pragma unroll
            for (int ib = 0; ib < 2; ++ib)
#pragma unroll
                for (int r = 0; r < 16; ++r) { const float d = acc[ib][tb][r] - mu; sq += d * d; }
            sq += __shfl_xor(sq, 32);
            const float rs = 1.0f / sqrtf(sq * (1.0f / HD) + RW_GN_EPS);
            const float* pr = p.pm + (size_t)t * RW_IN + h * HD;
            float bon = 0.f;
#pragma unroll
            for (int ib = 0; ib < 2; ++ib)
#pragma unroll
                for (int g = 0; g < 4; ++g) {
                    const int i0 = 32 * ib + 8 * g + 4 * lh;
                    const float4 r4 = *(const float4*)(pr + i0), k4 = *(const float4*)(pr + GD + i0), rk = *(const float4*)(p.rw_r_k + (size_t)l * GD + h * HD + i0);
                    bon += r4.x * k4.x * rk.x + r4.y * k4.y * rk.y + r4.z * k4.z * rk.z + r4.w * k4.w * rk.w;
                }
            bon += __shfl_xor(bon, 32);
#pragma unroll
            for (int ib = 0; ib < 2; ++ib)
#pragma unroll
                for (int g = 0; g < 4; ++g) {
                    const int i0 = 32 * ib + 8 * g + 4 * lh;
                    const float4 v4 = *(const float4*)(pr + 2 * GD + i0), g4 = *(const float4*)(p.rwG + (size_t)t * GD + h * HD + i0);
                    const float4 gg = *(const float4*)(p.rw_gn_g + (size_t)l * GD + h * HD + i0), gb = *(const float4*)(p.rw_gn_b + (size_t)l * GD + h * HD + i0);
                    const float o0 = ((acc[ib][tb][4 * g] - mu) * rs * gg.x + gb.x + bon * v4.x) * g4.x, o1 = ((acc[ib][tb][4 * g + 1] - mu) * rs * gg.y + gb.y + bon * v4.y) * g4.y;
                    const float o2 = ((acc[ib][tb][4 * g + 2] - mu) * rs * gg.z + gb.z + bon * v4.z) * g4.z, o3 = ((acc[ib][tb][4 * g + 3] - mu) * rs * gg.w + gb.w + bon * v4.w) * g4.w;
                    uint2 w; w.x = cvt_pk_bf16(o0, o1); w.y = cvt_pk_bf16(o2, o3);
                    *(uint2*)(p.Ymix + (size_t)t * D_MIX + 0 * GD + h * HD + i0) = w;
                }
        }
    }
}

DEVFN void ph_mb_prep(const Params& p, int l, size_t vt, size_t vs) {
    static_assert(MB_CONV_DIM % 8 == 0 && MB_CONV == 5 && (GD + MB_GROUPS * MB_STATE) % 8 == 0, "8-channel groups");
    constexpr int NG = MB_CONV_DIM / 8;
    const size_t n = (size_t)TT * NG;
    for (size_t i = vt; i < n; i += vs) {
        const int c = (int)(i % NG) * 8; const int t = (int)(i / NG); const int s_ = t % LL;
        const int lo = s_ < CTX ? 0 : CTX, hi = s_ < CTX ? CTX : LL;
        const float4 b0 = *(const float4*)(p.mb_conv_b + (size_t)l * MB_CONV_DIM + c), b1 = *(const float4*)(p.mb_conv_b + (size_t)l * MB_CONV_DIM + c + 4);
        float acc[8] = {b0.x, b0.y, b0.z, b0.w, b1.x, b1.y, b1.z, b1.w};
#pragma unroll
        for (int j = 0; j < MB_CONV; ++j) {
            const int so = s_ + j - MB_CONV / 2;
            if (so >= lo && so < hi) {
                const uint4 xv = *(const uint4*)(p.P + (size_t)(t + j - MB_CONV / 2) * N_IN + OFF_MB + GD + c);
                const float* wp = p.mb_conv_w + ((size_t)l * MB_CONV + j) * MB_CONV_DIM + c;
                const float4 w0 = *(const float4*)wp, w1 = *(const float4*)(wp + 4);
                acc[0] += w0.x * bflo(xv.x); acc[1] += w0.y * bfhi(xv.x); acc[2] += w0.z * bflo(xv.y); acc[3] += w0.w * bfhi(xv.y);
                acc[4] += w1.x * bflo(xv.z); acc[5] += w1.y * bfhi(xv.z); acc[6] += w1.z * bflo(xv.w); acc[7] += w1.w * bfhi(xv.w);
            }
        }
#pragma unroll
        for (int k = 0; k < 8; ++k) acc[k] = siluf_(acc[k]);
        float* xo = p.xc + (size_t)t * MB_CONV_DIM + c;
        *(float4*)xo = make_float4(acc[0], acc[1], acc[2], acc[3]); *(float4*)(xo + 4) = make_float4(acc[4], acc[5], acc[6], acc[7]);
        if (c >= GD && c < GD + MB_GROUPS * MB_STATE) *(uint4*)(p.mbB + (size_t)t * (MB_GROUPS * MB_STATE) + (c - GD)) = make_uint4(pk2(acc[0], acc[1]), pk2(acc[2], acc[3]), pk2(acc[4], acc[5]), pk2(acc[6], acc[7]));
        if (c >= GD + MB_GROUPS * MB_STATE) *(uint4*)(p.mbC + (size_t)t * (MB_GROUPS * MB_STATE) + (c - GD - MB_GROUPS * MB_STATE)) = make_uint4(pk2(acc[0], acc[1]), pk2(acc[2], acc[3]), pk2(acc[4], acc[5]), pk2(acc[6], acc[7]));
    }
    const size_t n2 = (size_t)TT * 2 * NH;
    for (size_t i = vt; i < n2; i += vs) {
        const int q = (int)(i % (2 * NH)); const int t = (int)(i / (2 * NH));
        p.dt[i] = softplusf_(bf2f(p.P[(size_t)t * N_IN + OFF_MB + GD + MB_CONV_DIM + q]) + p.mb_dt_bias[(size_t)l * 2 * NH + q]);
    }
}

constexpr int MB_STG = 256;
DEVFN void mb_chunk_item(const Params& p, int l, float* lds_f, const int item) {
    static_assert(MB_STATE == 128 && HD == 64 && CK == 64, "mamba chunk geometry");
    const int lane = (TIDX() & 63), lq = lane & 31, lh = lane >> 5;
    (void)lds_f;
    const int pbk = item % NCHK, dir = (item / NCHK) & 1, h = (item / (2 * NCHK)) % NH, b = item / (2 * NCHK * NH);
    const int grp = h / (NH / MB_GROUPS), u = (b * NH + h) * 2 + dir;
    const int c = dir == 0 ? pbk : rev_chunk(pbk);
    const int t0 = b * LL + CK * pbk;
    const float A = -expf(p.mb_a_log[((size_t)l * 2 + dir) * NH + h]);
    const float dtv = p.dt[(size_t)(t0 + lane) * 2 * NH + dir * NH + h];
    float cum = dtv * A;
#pragma unroll
    for (int o = 1; o < 64; o <<= 1) { const float v = __shfl(cum, dir == 0 ? lane - o : lane + o); if (dir == 0 ? lane >= o : lane + o < 64) cum += v; }
    const float ctot = __shfl(cum, dir == 0 ? 63 : 0);
    const int gs = dir == 0 ? CK * pbk + lane : rev_gs(CK * pbk + lane);
    p.mbCum[(size_t)u * LL + gs] = cum;
    const float wsc = expf(ctot - cum) * dtv;
    f32x16_t G[2][2];
#pragma unroll
    for (int st = 0; st < 2; ++st)
#pragma unroll
        for (int tt = 0; tt < 2; ++tt)
#pragma unroll
            for (int r = 0; r < 16; ++r) G[st][tt][r] = 0.f;
    const bf16_t* Bg = p.mbB + (size_t)t0 * (MB_GROUPS * MB_STATE) + grp * MB_STATE; const bf16_t* Cg = p.mbC + (size_t)t0 * (MB_GROUPS * MB_STATE) + grp * MB_STATE;
#pragma unroll
    for (int ks = 0; ks < 8; ++ks) {
        bf16x8_t af[2], bfg[2];
#pragma unroll
        for (int q = 0; q < 2; ++q) { af[q] = *(const bf16x8_t*)(Bg + (size_t)(32 * q + lq) * (MB_GROUPS * MB_STATE) + 16 * ks + 8 * lh); bfg[q] = *(const bf16x8_t*)(Cg + (size_t)(32 * q + lq) * (MB_GROUPS * MB_STATE) + 16 * ks + 8 * lh); }
#pragma unroll
        for (int st = 0; st < 2; ++st)
#pragma unroll
            for (int tt = 0; tt < 2; ++tt) G[st][tt] = __builtin_amdgcn_mfma_f32_32x32x16_bf16(af[st], bfg[tt], G[st][tt], 0, 0, 0);
    }
    Frag8 pf[2][2][2];
#pragma unroll
    for (int tt = 0; tt < 2; ++tt) {
        const int et = 32 * tt + lq; const float cumt = __shfl(cum, et);
#pragma unroll
        for (int st = 0; st < 2; ++st) {
            float mv[16];
#pragma unroll
            for (int g = 0; g < 4; ++g) {
                const int es0 = 32 * st + 8 * g + 4 * lh;
                const float csv[4] = {__shfl(cum, es0), __shfl(cum, es0 + 1), __shfl(cum, es0 + 2), __shfl(cum, es0 + 3)};
                const float dtq[4] = {__shfl(dtv, es0), __shfl(dtv, es0 + 1), __shfl(dtv, es0 + 2), __shfl(dtv, es0 + 3)};
#pragma unroll
                for (int q = 0; q < 4; ++q) { const int es = es0 + q; const bool on = dir == 0 ? es <= et : es >= et; mv[4 * g + q] = on ? G[st][tt][4 * g + q] * expf(fminf(cumt - csv[q], 0.f)) * dtq[q] : 0.f; }
            }
#pragma unroll
            for (int sp = 0; sp < 2; ++sp)
#pragma unroll
                for (int j = 0; j < 4; ++j) pf[st][tt][sp].u[j] = cvt_pk_bf16_h(mv[8 * sp + 2 * j], mv[8 * sp + 2 * j + 1]);
        }
    }
    const bf16_t* Xg = p.mbXT + ((size_t)(b * NH + h) * HD) * LL + (size_t)CK * pbk;
    {
        f32x16_t Y[2][2];
#pragma unroll
        for (int pt = 0; pt < 2; ++pt)
#pragma unroll
            for (int tt = 0; tt < 2; ++tt)
#pragma unroll
                for (int r = 0; r < 16; ++r) Y[pt][tt][r] = 0.f;
#pragma unroll
        for (int st = 0; st < 2; ++st)
#pragma unroll
            for (int sp = 0; sp < 2; ++sp) {
                Frag8 xa[2];
#pragma unroll
                for (int pt = 0; pt < 2; ++pt) { const bf16_t* xr = Xg + (size_t)(32 * pt + lq) * LL + 32 * st + 16 * sp + 4 * lh; xa[pt].d2[0] = *(const uint2*)xr; xa[pt].d2[1] = *(const uint2*)(xr + 8); }
#pragma unroll
                for (int pt = 0; pt < 2; ++pt)
#pragma unroll
                    for (int tt = 0; tt < 2; ++tt) Y[pt][tt] = __builtin_amdgcn_mfma_f32_32x32x16_bf16(xa[pt].v, pf[st][tt][sp].v, Y[pt][tt], 0, 0, 0);
            }
#pragma unroll
        for (int tt = 0; tt < 2; ++tt) {
            const int e = 32 * tt + lq; const int gse = dir == 0 ? CK * pbk + e : rev_gs(CK * pbk + e);
            bf16_t* yo = p.mbYloc + ((size_t)u * LL + gse) * HD;
#pragma unroll
            for (int pt = 0; pt < 2; ++pt)
#pragma unroll
                for (int g = 0; g < 4; ++g) { uint2 w; w.x = cvt_pk_bf16_h(Y[pt][tt][4 * g], Y[pt][tt][4 * g + 1]); w.y = cvt_pk_bf16_h(Y[pt][tt][4 * g + 2], Y[pt][tt][4 * g + 3]); *(uint2*)(yo + 32 * pt + 8 * g + 4 * lh) = w; }
        }
    }
    {
        const bf16_t* BTg = p.mbBT + ((size_t)(b * MB_GROUPS + grp) * MB_STATE) * LL + (size_t)CK * pbk;
        f32x16_t Cs[4][2];
#pragma unroll
        for (int nt = 0; nt < 4; ++nt)
#pragma unroll
            for (int pt = 0; pt < 2; ++pt)
#pragma unroll
                for (int r = 0; r < 16; ++r) Cs[nt][pt][r] = 0.f;
#pragma unroll
        for (int ks = 0; ks < 4; ++ks) {
            const int ew = 16 * ks + 8 * lh;
            const float4 w0 = make_float4(__shfl(wsc, ew), __shfl(wsc, ew + 1), __shfl(wsc, ew + 2), __shfl(wsc, ew + 3)), w1 = make_float4(__shfl(wsc, ew + 4), __shfl(wsc, ew + 5), __shfl(wsc, ew + 6), __shfl(wsc, ew + 7));
            bf16x8_t xb[2];
#pragma unroll
            for (int pt = 0; pt < 2; ++pt) xb[pt] = *(const bf16x8_t*)(Xg + (size_t)(32 * pt + lq) * LL + 16 * ks + 8 * lh);
#pragma unroll
            for (int nt = 0; nt < 4; ++nt) {
                const uint4 bw = *(const uint4*)(BTg + (size_t)(32 * nt + lq) * LL + 16 * ks + 8 * lh);
                Frag8 a; a.u[0] = cvt_pk_bf16_h(bflo(bw.x) * w0.x, bfhi(bw.x) * w0.y); a.u[1] = cvt_pk_bf16_h(bflo(bw.y) * w0.z, bfhi(bw.y) * w0.w);
                a.u[2] = cvt_pk_bf16_h(bflo(bw.z) * w1.x, bfhi(bw.z) * w1.y); a.u[3] = cvt_pk_bf16_h(bflo(bw.w) * w1.z, bfhi(bw.w) * w1.w);
#pragma unroll
                for (int pt = 0; pt < 2; ++pt) Cs[nt][pt] = __builtin_amdgcn_mfma_f32_32x32x16_bf16(a.v, xb[pt], Cs[nt][pt], 0, 0, 0);
            }
        }
#pragma unroll
        for (int pt = 0; pt < 2; ++pt) {
            bf16_t* o = p.mbCS + (((size_t)u * NCHK + c) * HD + 32 * pt + lq) * MB_STATE;
#pragma unroll
            for (int nt = 0; nt < 4; ++nt)
#pragma unroll
                for (int g = 0; g < 4; ++g) { uint2 w; w.x = cvt_pk_bf16_h(Cs[nt][pt][4 * g], Cs[nt][pt][4 * g + 1]); w.y = cvt_pk_bf16_h(Cs[nt][pt][4 * g + 2], Cs[nt][pt][4 * g + 3]); *(uint2*)(o + 32 * nt + 8 * g + 4 * lh) = w; }
        }
    }
}

constexpr int N_RW_PAIRS = NU * NCHK, N_RW_MERGED = 2048 < N_RW_PAIRS ? 2048 : N_RW_PAIRS;
constexpr int N_RW_ITEMS = N_RW_MERGED + 4 * (N_RW_PAIRS - N_RW_MERGED), N_MB_ITEMS = NB * NH * 2 * NCHK;
DEVFN void ph_chunks(const Params& p, int l, float* lds_f, int* ctr) {
    const int lane = (TIDX() & 63);
    for (;;) {
        int it = 0;
        if (lane == 0) it = atomicAdd(ctr, 1);
        it = __builtin_amdgcn_readfirstlane(it);
        if (it >= N_RW_ITEMS + N_MB_ITEMS) break;
        if (it < N_RW_MERGED) rw_chunk_item<0>(p, lds_f, it);
        else if (it < N_RW_ITEMS) { const int h4 = it - N_RW_MERGED; if (h4 & 2) rw_chunk_quarter<true>(p, lds_f, N_RW_MERGED + (h4 >> 2), h4 & 1); else rw_chunk_quarter<false>(p, lds_f, N_RW_MERGED + (h4 >> 2), h4 & 1); }
        else mb_chunk_item(p, l, lds_f, it - N_RW_ITEMS);
    }
}

DEVFN void ph_mb_seq(const Params& p, int wv, int nwv) {
    constexpr int DQ = 4;
    static_assert(NCHK % DQ == 0, "ring depth");
    const int lane = (TIDX() & 63);
    for (int item = wv; item < NU * 4; item += nwv) {
        const int q4 = item & 3, u = item >> 2;
        float X[32];
#pragma unroll
        for (int k = 0; k < 32; ++k) X[k] = 0.f;
        const size_t eo = (size_t)q4 * 2048 + (size_t)lane * 32;
        uint4 pf[DQ][4]; float dq[DQ];
#define MSQ_LOAD(d, c_) do { const uint4* src_ = (const uint4*)(p.mbCS + ((size_t)u * NCHK + (c_)) * HD * MB_STATE + eo); \
            _Pragma("unroll") for (int k = 0; k < 4; ++k) pf[d][k] = src_[k]; dq[d] = p.mbCum[(size_t)u * LL + (c_) * CK + CK - 1]; } while (0)
#pragma unroll
        for (int d = 0; d < DQ; ++d) MSQ_LOAD(d, d);
        for (int c0 = 0; c0 < NCHK; c0 += DQ) {
#pragma unroll
            for (int d = 0; d < DQ; ++d) {
                const int c = c0 + d;
                const float dtot = expf(dq[d]);
                uint4 o[4];
#pragma unroll
                for (int k = 0; k < 4; ++k) {
                    const unsigned w[4] = {pf[d][k].x, pf[d][k].y, pf[d][k].z, pf[d][k].w}; unsigned ow[4];
#pragma unroll
                    for (int m = 0; m < 4; ++m) {
                        X[8 * k + 2 * m] = dtot * X[8 * k + 2 * m] + u_as_f(w[m] << 16); X[8 * k + 2 * m + 1] = dtot * X[8 * k + 2 * m + 1] + u_as_f(w[m] & 0xffff0000u);
                        ow[m] = cvt_pk_bf16(X[8 * k + 2 * m], X[8 * k + 2 * m + 1]);
                    }
                    o[k] = make_uint4(ow[0], ow[1], ow[2], ow[3]);
                }
                if (c + DQ < NCHK) MSQ_LOAD(d, c + DQ);
                uint4* dst = (uint4*)(p.mbCS + ((size_t)u * NCHK + c) * HD * MB_STATE + eo);
#pragma unroll
                for (int k = 0; k < 4; ++k) dst[k] = o[k];
            }
        }
#undef MSQ_LOAD
    }
}

DEVFN void ph_mb_yout(const Params& p, int l, size_t vt, size_t vs) {
    constexpr int HPG = NH / MB_GROUPS;
    const int lane = (TIDX() & 63), lq = lane & 31, lh = lane >> 5;
    const int wv = __builtin_amdgcn_readfirstlane((int)(vt >> 6)), nwv = (int)(vs >> 6);
    const int wvs = (wv & 7) * (nwv >> 3) + (wv >> 3);
    for (int item = nwv - 1 - wvs; item < NB * MB_GROUPS * NCHK * 2; item += nwv) {
        const int tb = item & 1, pbk = (item >> 1) % NCHK, grp = ((item >> 1) / NCHK) % MB_GROUPS, b = (item >> 1) / (NCHK * MB_GROUPS);
        const int s_ = CK * pbk + 32 * tb + lq, t = b * LL + s_;
        const int gsd[2] = {s_, rev_gs(s_)};
        const int cd[2] = {pbk, rev_chunk(pbk)};
        const bf16_t* cfp = p.mbC + (size_t)t * (MB_GROUPS * MB_STATE) + grp * MB_STATE + 8 * lh;
        f32x16_t acc[HPG][2];
#pragma unroll
        for (int hh = 0; hh < HPG; ++hh)
#pragma unroll
            for (int pt = 0; pt < 2; ++pt)
#pragma unroll
                for (int r = 0; r < 16; ++r) acc[hh][pt][r] = 0.f;
#pragma unroll
        for (int hh = 0; hh < HPG; ++hh) {
            const int h = grp * HPG + hh;
#pragma unroll
            for (int dir = 0; dir < 2; ++dir) {
                const int u = (b * NH + h) * 2 + dir, c = cd[dir];
                if (c > 0) {
                    const bf16_t* st = p.mbCS + ((size_t)u * NCHK + (c - 1)) * HD * MB_STATE;
                    f32x16_t d0, d1;
#pragma unroll
                    for (int r = 0; r < 16; ++r) { d0[r] = 0.f; d1[r] = 0.f; }
#pragma unroll
                    for (int ks = 0; ks < 8; ++ks) {
                        if ((ks & 1) == 0) asm volatile("" ::: "memory");
                        const bf16x8_t a0 = *(const bf16x8_t*)(st + (size_t)(lq) * MB_STATE + 16 * ks + 8 * lh), a1 = *(const bf16x8_t*)(st + (size_t)(32 + lq) * MB_STATE + 16 * ks + 8 * lh);
                        const bf16x8_t cfk = *(const bf16x8_t*)(cfp + 16 * ks);
                        d0 = __builtin_amdgcn_mfma_f32_32x32x16_bf16(a0, cfk, d0, 0, 0, 0);
                        d1 = __builtin_amdgcn_mfma_f32_32x32x16_bf16(a1, cfk, d1, 0, 0, 0);
                    }
                    const float ec = expf(p.mbCum[(size_t)u * LL + gsd[dir]]);
#pragma unroll
                    for (int r = 0; r < 16; ++r) { acc[hh][0][r] += ec * d0[r]; acc[hh][1][r] += ec * d1[r]; }
                }
            }
        }
        float ss = 0.f;
#pragma unroll
        for (int hh = 0; hh < HPG; ++hh) {
            const int h = grp * HPG + hh;
            const float dsk = p.mb_d[(size_t)l * NH + h];
#pragma unroll
            for (int pt = 0; pt < 2; ++pt)
#pragma unroll
                for (int g = 0; g < 4; ++g) {
                    asm volatile("" ::: "memory");
                    const int p0 = 32 * pt + 8 * g + 4 * lh, ch = h * HD + p0;
                    float yl[4] = {0.f, 0.f, 0.f, 0.f};
#pragma unroll
                    for (int dir = 0; dir < 2; ++dir) {
                            const int u = (b * NH + h) * 2 + dir;
                            const uint2 w = *(const uint2*)(p.mbYloc + ((size_t)u * LL + gsd[dir]) * HD + p0);
                            yl[0] += u_as_f(w.x << 16); yl[1] += u_as_f(w.x & 0xffff0000u); yl[2] += u_as_f(w.y << 16); yl[3] += u_as_f(w.y & 0xffff0000u);
                        }
                    const float4 x4 = *(const float4*)(p.xc + (size_t)t * MB_CONV_DIM + ch);
                    const uint2 zw = *(const uint2*)(p.P + (size_t)t * N_IN + OFF_MB + ch);
                    const float z0 = u_as_f(zw.x << 16), z1 = u_as_f(zw.x & 0xffff0000u), z2 = u_as_f(zw.y << 16), z3 = u_as_f(zw.y & 0xffff0000u);
                    const float v0 = (acc[hh][pt][4 * g] + yl[0] + dsk * x4.x) * siluf_(z0), v1 = (acc[hh][pt][4 * g + 1] + yl[1] + dsk * x4.y) * siluf_(z1);
                    const float v2 = (acc[hh][pt][4 * g + 2] + yl[2] + dsk * x4.z) * siluf_(z2), v3 = (acc[hh][pt][4 * g + 3] + yl[3] + dsk * x4.w) * siluf_(z3);
                    acc[hh][pt][4 * g] = v0; acc[hh][pt][4 * g + 1] = v1; acc[hh][pt][4 * g + 2] = v2; acc[hh][pt][4 * g + 3] = v3;
                    ss += v0 * v0 + v1 * v1 + v2 * v2 + v3 * v3;
                }
        }
        ss += __shfl_xor(ss, 32);
        const float rs = 1.0f / sqrtf(ss * (1.0f / (GD / MB_GROUPS)) + RMS_EPS);
#pragma unroll
        for (int hh = 0; hh < HPG; ++hh)
#pragma unroll
            for (int pt = 0; pt < 2; ++pt)
#pragma unroll
                for (int g = 0; g < 4; ++g) {
                    asm volatile("" ::: "memory");
                    const int ch = (grp * HPG + hh) * HD + 32 * pt + 8 * g + 4 * lh;
                    const float4 ng = *(const float4*)(p.mb_norm_g + (size_t)l * GD + ch);
                    uint2 w; w.x = cvt_pk_bf16(acc[hh][pt][4 * g] * rs * ng.x, acc[hh][pt][4 * g + 1] * rs * ng.y); w.y = cvt_pk_bf16(acc[hh][pt][4 * g + 2] * rs * ng.z, acc[hh][pt][4 * g + 3] * rs * ng.w);
                    *(uint2*)(p.Ymix + (size_t)t * D_MIX + 1 * GD + ch) = w;
                }
    }
}

DEVFN void ph_mla_norm(const Params& p, int l, size_t vt, size_t vs) {
    static_assert(KUP == 512 && MLA_QL % 8 == 0, "one wave = one token: 64 lanes x 8 lora channels (q | kv)");
    const int lane = (TIDX() & 63);
    const size_t wv = vt >> 6, nwv = vs >> 6;
    const bool isq = lane * 8 < MLA_QL;
    for (size_t t = wv; t < (size_t)TT; t += nwv) {
        const uint4 xv = *(const uint4*)(p.P + t * N_IN + OFF_MLA + lane * 8);
        float x[8] = {bflo(xv.x), bfhi(xv.x), bflo(xv.y), bfhi(xv.y), bflo(xv.z), bfhi(xv.z), bflo(xv.w), bfhi(xv.w)};
        float ss = 0.f;
#pragma unroll
        for (int k = 0; k < 8; ++k) ss += x[k] * x[k];
        float sq = isq ? ss : 0.f, sk = isq ? 0.f : ss;
#pragma unroll
        for (int o = 32; o > 0; o >>= 1) { sq += __shfl_xor(sq, o); sk += __shfl_xor(sk, o); }
        const float rs = isq ? 1.0f / sqrtf(sq / MLA_QL + RMS_EPS) : 1.0f / sqrtf(sk / MLA_KVL + RMS_EPS);
        const float* gp = isq ? p.mla_q_norm + (size_t)l * MLA_QL + lane * 8 : p.mla_kv_norm + (size_t)l * MLA_KVL + (lane * 8 - MLA_QL);
        const float4 g0 = *(const float4*)gp, g1 = *(const float4*)(gp + 4);
        *(uint4*)(p.qkvn + t * KUP + lane * 8) = make_uint4(pk2(x[0] * rs * g0.x, x[1] * rs * g0.y), pk2(x[2] * rs * g0.z, x[3] * rs * g0.w), pk2(x[4] * rs * g1.x, x[5] * rs * g1.y), pk2(x[6] * rs * g1.z, x[7] * rs * g1.w));
    }
}

DEVFN void ph_mla_rope(const Params& p, int l, size_t vt, size_t vs) {
    static_assert(MLA_NOPE % 8 == 0 && MLA_ROPE == 32 && MLA_ROPE / 4 == 8, "rope groups: [axis][half][8 freqs]");
    constexpr int NGQ = MLA_QK / 8, NGN = MLA_NOPE / 8;
    const float qscale = 1.4426950408889634f / sqrtf((float)MLA_QK);
    const size_t n = (size_t)TT * NH * NGQ;
    for (size_t id = vt; id < n; id += vs) {
        const int g = (int)(id % NGQ); const int h = (int)((id / NGQ) % NH); const int t = (int)(id / ((size_t)NGQ * NH)); const int b = t / LL, s_ = t % LL; const bool lat = s_ >= CTX; const int tl = s_ - CTX;
        bf16_t* qo = p.Qm + ((size_t)(b * NH + h) * LL + s_) * MLA_QK + g * 8; bf16_t* ko = p.Km + ((size_t)(b * NH + h) * LL + s_) * MLA_QK + g * 8;
        const float* q = p.QKVraw + (size_t)t * NUP + h * MLA_QK;
        if (g < NGN) {
            const float4 q0 = *(const float4*)(q + g * 8), q1 = *(const float4*)(q + g * 8 + 4);
            const float* kv = p.QKVraw + (size_t)t * NUP + NUPQ + h * (MLA_NOPE + MLA_V) + g * 8;
            const float4 k0 = *(const float4*)kv, k1 = *(const float4*)(kv + 4);
            *(uint4*)qo = make_uint4(pk2(q0.x * qscale, q0.y * qscale), pk2(q0.z * qscale, q0.w * qscale), pk2(q1.x * qscale, q1.y * qscale), pk2(q1.z * qscale, q1.w * qscale));
            *(uint4*)ko = make_uint4(pk2(k0.x, k0.y), pk2(k0.z, k0.w), pk2(k1.x, k1.y), pk2(k1.z, k1.w));
        } else {
            const int e0 = (g - NGN) * 8; const int axis = e0 / 16, half = (e0 / 8) & 1;
            const float* qa = q + MLA_NOPE + axis * 16;
            const float4 x10 = *(const float4*)qa, x11 = *(const float4*)(qa + 4), x20 = *(const float4*)(qa + 8), x21 = *(const float4*)(qa + 12);
            const float qx1[8] = {x10.x, x10.y, x10.z, x10.w, x11.x, x11.y, x11.z, x11.w}, qx2[8] = {x20.x, x20.y, x20.z, x20.w, x21.x, x21.y, x21.z, x21.w};
            const bf16_t* kp = p.P + (size_t)t * N_IN + OFF_MLA + MLA_QL + MLA_KVL + axis * 16;
            const uint4 kw1 = *(const uint4*)kp, kw2 = *(const uint4*)(kp + 8);
            const float kx1[8] = {bflo(kw1.x), bfhi(kw1.x), bflo(kw1.y), bfhi(kw1.y), bflo(kw1.z), bfhi(kw1.z), bflo(kw1.w), bfhi(kw1.w)};
            const float kx2[8] = {bflo(kw2.x), bfhi(kw2.x), bflo(kw2.y), bfhi(kw2.y), bflo(kw2.z), bfhi(kw2.z), bflo(kw2.w), bfhi(kw2.w)};
            float qv[8], kvv[8];
            const int pos = lat ? (axis == 0 ? tl / GRID_W : tl % GRID_W) : 0;
#pragma unroll
            for (int f = 0; f < 8; ++f) {
                float cs = 1.f, sn = 0.f;
                if (lat) { const float2 t2 = p.ropecs[pos * 8 + f]; cs = t2.x; sn = t2.y; }
                qv[f] = (half == 0 ? qx1[f] * cs - qx2[f] * sn : qx2[f] * cs + qx1[f] * sn) * qscale;
                kvv[f] = half == 0 ? kx1[f] * cs - kx2[f] * sn : kx2[f] * cs + kx1[f] * sn;
            }
            *(uint4*)qo = make_uint4(pk2(qv[0], qv[1]), pk2(qv[2], qv[3]), pk2(qv[4], qv[5]), pk2(qv[6], qv[7]));
            *(uint4*)ko = make_uint4(pk2(kvv[0], kvv[1]), pk2(kvv[2], kvv[3]), pk2(kvv[4], kvv[5]), pk2(kvv[6], kvv[7]));
        }
    }
}

DEVFN void ph_vt_tiles(const Params& p, int mode, bf16_t* smem, int vb, int nvb) {
    static_assert(HD == 64 && MLA_V == 64 && LL % 64 == 0 && MB_STATE == 128, "64 x 64 tiles");
    const int tid = TIDX(); const int r = tid >> 3, pc = tid & 7;
    const int nrow = mode == 3 ? NB * MB_GROUPS * 2 : NB * NH;
    const int NTL = nrow * (LL / 64);
    constexpr int TLD = 72;
    for (int u = vb; u < NTL; u += nvb) {
        const int tb = u % (LL / 64), bh = u / (LL / 64);
        int b, h;
        if (mode == 3) { b = bh / (MB_GROUPS * 2); h = bh % (MB_GROUPS * 2); } else { b = bh / NH; h = bh % NH; }
        const int t = b * LL + tb * 64 + r;
        unsigned w[4];
        if (mode == 0) { const uint4 v = *(const uint4*)(p.P + (size_t)t * N_IN + OFF_NA + 2 * GD + h * HD + pc * 8); w[0] = v.x; w[1] = v.y; w[2] = v.z; w[3] = v.w; }
        else {
            const float* src = mode == 1 ? p.QKVraw + (size_t)t * NUP + NUPQ + h * (MLA_NOPE + MLA_V) + MLA_NOPE + pc * 8
                             : mode == 2 ? p.xc + (size_t)t * MB_CONV_DIM + h * HD + pc * 8
                                         : p.xc + (size_t)t * MB_CONV_DIM + GD + h * 64 + pc * 8;
            const float4 a = *(const float4*)src, c4 = *(const float4*)(src + 4);
            w[0] = pk2(a.x, a.y); w[1] = pk2(a.z, a.w); w[2] = pk2(c4.x, c4.y); w[3] = pk2(c4.z, c4.w);
        }
        __syncthreads();
#pragma unroll
        for (int k = 0; k < 4; ++k) { smem[(pc * 8 + 2 * k) * TLD + r] = (bf16_t)(w[k] & 0xffffu); smem[(pc * 8 + 2 * k + 1) * TLD + r] = (bf16_t)(w[k] >> 16); }
        __syncthreads();
        const uint4 o = *(const uint4*)(smem + r * TLD + pc * 8);
        bf16_t* base = mode == 0 ? p.naVt : mode == 1 ? p.Vt : mode == 2 ? p.mbXT : p.mbBT;
        *(uint4*)(base + ((size_t)bh * 64 + r) * LL + tb * 64 + pc * 8) = o;
    }
    __syncthreads();
}

constexpr int AT_KLD = 104, AT_VLD = 68, AT_TK = 64;
constexpr int AT_BUF = AT_TK * AT_KLD + MLA_V * AT_VLD;
constexpr int AT_NSUB = 2;
template <int NTH>
DEVFN void mla_unit(const Params& p, bf16_t* smem, const int u2) {
    const int u = u2 >> 1, kh = u2 & 1;
    static_assert(MLA_QK == 96 && MLA_V == 64, "attention tiles are written for d_qk 96 / d_v 64");
    constexpr int NWV = NTH / 64, QB = NWV * 32;
    constexpr int NCHUNK1 = AT_TK * (MLA_QK / 8) + MLA_V * (AT_TK / 8);
    constexpr int NCHUNK = AT_NSUB * NCHUNK1;
    constexpr int NCH = (NCHUNK + NTH - 1) / NTH;
    constexpr int STAGE = AT_NSUB * AT_BUF;
    static_assert((CTX / AT_TK) % AT_NSUB == 0 && (LL / AT_TK) % AT_NSUB == 0, "whole stages");
    const int tid = TIDX(), lane = tid & 63, wave = tid >> 6, lq = lane & 31, lh = lane >> 5;
    const int n_lat = NB * NH * (SEQ / QB);
    {
        int bh, qbase, nkeys;
        if (u < n_lat) { bh = u / (SEQ / QB); qbase = CTX + (u % (SEQ / QB)) * QB; nkeys = LL; }
        else { const int u2 = u - n_lat; bh = u2 / (CTX / QB); qbase = (u2 % (CTX / QB)) * QB; nkeys = CTX; }
        const bf16_t* Kg = p.Km + (size_t)bh * LL * MLA_QK; const bf16_t* Vg = p.Vt + (size_t)bh * MLA_V * LL;
        const int q0 = qbase + wave * 32;
        bf16x8_t qf[6];
#pragma unroll
        for (int ks = 0; ks < 6; ++ks) qf[ks] = *(const bf16x8_t*)(p.Qm + ((size_t)bh * LL + q0 + lq) * MLA_QK + ks * 16 + lh * 8);
        f32x16_t o0, o1;
#pragma unroll
        for (int r = 0; r < 16; ++r) { o0[r] = 0.f; o1[r] = 0.f; }
        float m_i = -1e30f, l_i = 0.f;
        const int nst_all = nkeys / (AT_TK * AT_NSUB); const int nstages = nst_all / 2 + ((nst_all & 1) && kh == 0 ? 1 : 0);
        const int st_base = kh == 0 ? 0 : nst_all - nstages;
        uint4 stg[NCH];
#define MLA_LOAD(st_) do { _Pragma("unroll") for (int i = 0; i < NCH; ++i) { const int c = tid + i * NTH; const int sub = c / NCHUNK1, cc = c % NCHUNK1; const int k1 = ((st_base + (st_)) * AT_NSUB + sub) * AT_TK; \
            if (c < NCHUNK) { if (cc < AT_TK * 12) { const int key = cc / 12, ch = cc % 12; stg[i] = *(const uint4*)(Kg + (size_t)(k1 + key) * MLA_QK + ch * 8); } \
                              else { const int c2 = cc - AT_TK * 12; const int d = c2 / 8, ch = c2 % 8; stg[i] = *(const uint4*)(Vg + (size_t)d * LL + k1 + ch * 8); } } } } while (0)
#define MLA_STORE(buf_) do { _Pragma("unroll") for (int i = 0; i < NCH; ++i) { const int c = tid + i * NTH; const int sub = c / NCHUNK1, cc = c % NCHUNK1; bf16_t* dK = smem + (buf_) * STAGE + sub * AT_BUF; \
            if (c < NCHUNK) { if (cc < AT_TK * 12) { const int key = cc / 12, ch = cc % 12; *(uint4*)(dK + key * AT_KLD + ch * 8) = stg[i]; } \
                              else { const int c2 = cc - AT_TK * 12; const int d = c2 / 8, ch = c2 % 8; uint2* dst = (uint2*)(dK + AT_TK * AT_KLD + d * AT_VLD + ch * 8); dst[0] = make_uint2(stg[i].x, stg[i].y); dst[1] = make_uint2(stg[i].z, stg[i].w); } } } } while (0)
        MLA_LOAD(0);
        __syncthreads();
        MLA_STORE(0);
        __syncthreads();
        for (int st = 0; st < nstages; ++st) {
            const bool more = st + 1 < nstages;
            if (more) MLA_LOAD(st + 1);
            static_assert(AT_NSUB == 2, "two sub-tiles per stage");
            const bf16_t* sKa = smem + (st & 1) * STAGE; const bf16_t* sKb = sKa + AT_BUF;
            f32x16_t sa0, sa1, sb0, sb1;
#pragma unroll
            for (int r = 0; r < 16; ++r) { sa0[r] = 0.f; sa1[r] = 0.f; sb0[r] = 0.f; sb1[r] = 0.f; }
#pragma unroll
            for (int ks = 0; ks < 6; ++ks) {
                const bf16x8_t a0 = *(const bf16x8_t*)(sKa + (lq) * AT_KLD + ks * 16 + lh * 8), a1 = *(const bf16x8_t*)(sKa + (32 + lq) * AT_KLD + ks * 16 + lh * 8);
                sa0 = __builtin_amdgcn_mfma_f32_32x32x16_bf16(a0, qf[ks], sa0, 0, 0, 0);
                sa1 = __builtin_amdgcn_mfma_f32_32x32x16_bf16(a1, qf[ks], sa1, 0, 0, 0);
            }
#pragma unroll
            for (int ks = 0; ks < 6; ++ks) {
                const bf16x8_t a0 = *(const bf16x8_t*)(sKb + (lq) * AT_KLD + ks * 16 + lh * 8), a1 = *(const bf16x8_t*)(sKb + (32 + lq) * AT_KLD + ks * 16 + lh * 8);
                sb0 = __builtin_amdgcn_mfma_f32_32x32x16_bf16(a0, qf[ks], sb0, 0, 0, 0);
                sb1 = __builtin_amdgcn_mfma_f32_32x32x16_bf16(a1, qf[ks], sb1, 0, 0, 0);
            }
            __builtin_amdgcn_sched_barrier(0);
#define MLA_SOFTMAX_PV(s0, s1, sV) do { \
            float mx = -1e30f; \
            _Pragma("unroll") for (int r = 0; r < 16; ++r) mx = fmaxf(mx, fmaxf(s0[r], s1[r])); \
            mx = fmaxf(mx, __shfl_xor(mx, 32)); \
            const float m_new = fmaxf(m_i, mx); \
            const float alpha = __builtin_amdgcn_exp2f(m_i - m_new); \
            float rs = 0.f; \
            _Pragma("unroll") for (int r = 0; r < 16; ++r) { s0[r] = __builtin_amdgcn_exp2f(s0[r] - m_new); s1[r] = __builtin_amdgcn_exp2f(s1[r] - m_new); rs += s0[r] + s1[r]; } \
            rs += __shfl_xor(rs, 32); \
            l_i = l_i * alpha + rs; m_i = m_new; \
            if (__builtin_amdgcn_ballot_w64(alpha != 1.0f) != 0ull) { \
                _Pragma("unroll") for (int r = 0; r < 16; ++r) { o0[r] *= alpha; o1[r] *= alpha; } \
            } \
            Frag8 pf[2][2]; \
            _Pragma("unroll") for (int sp = 0; sp < 2; ++sp) \
                _Pragma("unroll") for (int j = 0; j < 4; ++j) { \
                    pf[0][sp].u[j] = cvt_pk_bf16_h(s0[8 * sp + 2 * j], s0[8 * sp + 2 * j + 1]); \
                    pf[1][sp].u[j] = cvt_pk_bf16_h(s1[8 * sp + 2 * j], s1[8 * sp + 2 * j + 1]); \
                } \
            _Pragma("unroll") for (int kb = 0; kb < 2; ++kb) \
                _Pragma("unroll") for (int sp = 0; sp < 2; ++sp) { \
                    const int kofs = kb * 32 + sp * 16 + lh * 4; \
                    Frag8 va, vb2; \
                    va.d2[0] = *(const uint2*)((sV) + (lq) * AT_VLD + kofs); va.d2[1] = *(const uint2*)((sV) + (lq) * AT_VLD + kofs + 8); \
                    vb2.d2[0] = *(const uint2*)((sV) + (32 + lq) * AT_VLD + kofs); vb2.d2[1] = *(const uint2*)((sV) + (32 + lq) * AT_VLD + kofs + 8); \
                    o0 = __builtin_amdgcn_mfma_f32_32x32x16_bf16(va.v, pf[kb][sp].v, o0, 0, 0, 0); \
                    o1 = __builtin_amdgcn_mfma_f32_32x32x16_bf16(vb2.v, pf[kb][sp].v, o1, 0, 0, 0); \
                } } while (0)
            MLA_SOFTMAX_PV(sa0, sa1, sKa + AT_TK * AT_KLD);
            MLA_SOFTMAX_PV(sb0, sb1, sKb + AT_TK * AT_KLD);
#undef MLA_SOFTMAX_PV
            if (more) MLA_STORE((st + 1) & 1);
            __syncthreads();
        }
#undef MLA_LOAD
#undef MLA_STORE
        const int b = bh / NH, h = bh % NH;
        const size_t rec = ((size_t)(b * LL + q0 + lq) * NH + h) * 2 + kh;
        float* orow = p.mlaO + rec * MLA_V;
#pragma unroll
        for (int g = 0; g < 4; ++g) {
            *(float4*)(orow + 8 * g + 4 * lh) = make_float4(o0[4 * g], o0[4 * g + 1], o0[4 * g + 2], o0[4 * g + 3]);
            *(float4*)(orow + 32 + 8 * g + 4 * lh) = make_float4(o1[4 * g], o1[4 * g + 1], o1[4 * g + 2], o1[4 * g + 3]);
        }
        if (lh == 0) *(float2*)(p.mlaML + rec * 2) = make_float2(m_i, l_i);
    }
}

DEVFN void ph_mla_combine(const Params& p, bool with_ctx, size_t vt, size_t vs) {
    const size_t n = (size_t)TT * NH * (MLA_V / 4);
    for (size_t i = vt; i < n; i += vs) {
        const int d4 = (int)(i % (MLA_V / 4)); const size_t th = i / (MLA_V / 4); const int h = (int)(th % NH); const size_t t = th / NH;
        if (!with_ctx && (int)(t % LL) < CTX) continue;
        const float2 ml0 = *(const float2*)(p.mlaML + (th * 2 + 0) * 2), ml1 = *(const float2*)(p.mlaML + (th * 2 + 1) * 2);
        const float m = fmaxf(ml0.x, ml1.x);
        const float e0 = __builtin_amdgcn_exp2f(ml0.x - m), e1 = __builtin_amdgcn_exp2f(ml1.x - m);
        const float inv = 1.0f / (ml0.y * e0 + ml1.y * e1);
        const float4 a = *(const float4*)(p.mlaO + (th * 2 + 0) * MLA_V + d4 * 4), c = *(const float4*)(p.mlaO + (th * 2 + 1) * MLA_V + d4 * 4);
        uint2 w; w.x = pk2((a.x * e0 + c.x * e1) * inv, (a.y * e0 + c.y * e1) * inv); w.y = pk2((a.z * e0 + c.z * e1) * inv, (a.w * e0 + c.w * e1) * inv);
        *(uint2*)(p.Ymix + t * D_MIX + 2 * GD + h * MLA_V + d4 * 4) = w;
    }
}

constexpr int NA_KLD = 72, NA_VLD = 68;
constexpr int NA_BUF = AT_TK * NA_KLD + HD * NA_VLD;
template <int NTH>
DEVFN void na_unit(const Params& p, int l, bf16_t* smem, const int u) {
    static_assert(HD == 64 && GRID_W == 64 && NA_WR == 8 && NA_WC == 16 && SEQ / GRID_W == 64, "natten tiles are written for a 64x64 grid, 8x16 window");
    constexpr int NWV = NTH / 64, QB = NWV * 32, RPU = NWV / 2, NLR = NA_WR + RPU - 1, NCT = CTX / AT_TK, ROWS = SEQ / GRID_W;
    constexpr int NCHUNK = AT_TK * (HD / 8) + HD * (AT_TK / 8);
    constexpr int NCH = (NCHUNK + NTH - 1) / NTH;
    constexpr int BW = 2 * NA_WC - 1, BH = 2 * NA_WR - 1;
    const float sc2 = 1.4426950408889634f / sqrtf((float)HD);
    const int tid = TIDX(), lane = tid & 63, wave = tid >> 6, lq = lane & 31, lh = lane >> 5;
    float* sbias = (float*)(smem + 2 * NA_BUF);
    const int n_lat = NB * NH * (ROWS / RPU);
    {
        const bool is_lat = u < n_lat;
        int bh, r0 = 0, rstart = 0, sq, ntiles;
        if (is_lat) { bh = u / (ROWS / RPU); r0 = (u % (ROWS / RPU)) * RPU; rstart = r0 - NA_WR / 2; rstart = rstart < 0 ? 0 : (rstart > ROWS - NLR ? ROWS - NLR : rstart);
                      sq = CTX + (r0 + (wave >> 1)) * GRID_W + 32 * (wave & 1) + lq; ntiles = NLR + NCT; }
        else { const int u2 = u - n_lat; bh = u2 / (CTX / QB); sq = (u2 % (CTX / QB)) * QB + wave * 32 + lq; ntiles = NCT; }
        const int b = bh / NH, h = bh % NH;
        const int qr = r0 + (wave >> 1), qc = 32 * (wave & 1) + lq;
        int rs = qr - NA_WR / 2; rs = rs < 0 ? 0 : (rs > ROWS - NA_WR ? ROWS - NA_WR : rs);
        int cs = qc - NA_WC / 2; cs = cs < 0 ? 0 : (cs > GRID_W - NA_WC ? GRID_W - NA_WC : cs);
        const bf16_t* Kg = p.P + (size_t)b * LL * N_IN + OFF_NA + GD + h * HD;
        const bf16_t* Vg = p.naVt + (size_t)bh * HD * LL;
        bf16x8_t qf[4];
#pragma unroll
        for (int ks = 0; ks < 4; ++ks) qf[ks] = *(const bf16x8_t*)(p.P + (size_t)(b * LL + sq) * N_IN + OFF_NA + h * HD + ks * 16 + lh * 8);
        f32x16_t o0, o1;
#pragma unroll
        for (int r = 0; r < 16; ++r) { o0[r] = 0.f; o1[r] = 0.f; }
        float m_i = -1e30f, l_i = 0.f;
        uint4 stg[NCH];
#define NA_KBASE(ti) ((is_lat && (ti) < NLR) ? (CTX + (rstart + (ti)) * GRID_W) : (((ti) - (is_lat ? NLR : 0)) * AT_TK))
#define NA_LOAD(ti) do { const int kb_ = NA_KBASE(ti); _Pragma("unroll") for (int i = 0; i < NCH; ++i) { const int c = tid + i * NTH; \
            if (c < AT_TK * 8) { const int key = c / 8, ch = c % 8; stg[i] = *(const uint4*)(Kg + (size_t)(kb_ + key) * N_IN + ch * 8); } \
            else if (c < NCHUNK) { const int c2 = c - AT_TK * 8; const int d = c2 / 8, ch = c2 % 8; stg[i] = *(const uint4*)(Vg + (size_t)d * LL + kb_ + ch * 8); } } } while (0)
#define NA_STORE(buf) do { bf16_t* dK_ = smem + (buf) * NA_BUF; _Pragma("unroll") for (int i = 0; i < NCH; ++i) { const int c = tid + i * NTH; \
            if (c < AT_TK * 8) { const int key = c / 8, ch = c % 8; *(uint4*)(dK_ + key * NA_KLD + ch * 8) = stg[i]; } \
            else if (c < NCHUNK) { const int c2 = c - AT_TK * 8; const int d = c2 / 8, ch = c2 % 8; uint2* dst = (uint2*)(dK_ + AT_TK * NA_KLD + d * NA_VLD + ch * 8); dst[0] = make_uint2(stg[i].x, stg[i].y); dst[1] = make_uint2(stg[i].z, stg[i].w); } } } while (0)
        NA_LOAD(0);
        __syncthreads();
        NA_STORE(0);
        for (int i = tid; i < BH * BW; i += NTH) sbias[i] = p.na_rpb[((size_t)l * NH + h) * BH * BW + i] * 1.4426950408889634f;
        __syncthreads();
        for (int tile = 0; tile < ntiles; ++tile) {
            const bf16_t* sK = smem + (tile & 1) * NA_BUF; const bf16_t* sV = sK + AT_TK * NA_KLD;
            const bool more = tile + 1 < ntiles;
            if (more) NA_LOAD(tile + 1);
            const bool local = is_lat && tile < NLR;
            const int kr = rstart + tile;
            const bool active = !local || (kr >= rs && kr < rs + NA_WR);
            if (active) {
                f32x16_t s0, s1;
#pragma unroll
                for (int r = 0; r < 16; ++r) { s0[r] = 0.f; s1[r] = 0.f; }
#pragma unroll
                for (int ks = 0; ks < 4; ++ks) {
                    const bf16x8_t a0 = *(const bf16x8_t*)(sK + (lq) * NA_KLD + ks * 16 + lh * 8);
                    const bf16x8_t a1 = *(const bf16x8_t*)(sK + (32 + lq) * NA_KLD + ks * 16 + lh * 8);
                    s0 = __builtin_amdgcn_mfma_f32_32x32x16_bf16(a0, qf[ks], s0, 0, 0, 0);
                    s1 = __builtin_amdgcn_mfma_f32_32x32x16_bf16(a1, qf[ks], s1, 0, 0, 0);
                }
                if (local) {
                    const float* brow = sbias + (kr - qr + NA_WR - 1) * BW;
#pragma unroll
                    for (int r = 0; r < 16; ++r) {
                        const int kc0 = (r & 3) + 8 * (r >> 2) + 4 * lh, kc1 = kc0 + 32;
                        const bool v0 = (unsigned)(kc0 - cs) < (unsigned)NA_WC, v1 = (unsigned)(kc1 - cs) < (unsigned)NA_WC;
                        s0[r] = v0 ? s0[r] * sc2 + brow[kc0 - qc + NA_WC - 1] : -1e30f;
                        s1[r] = v1 ? s1[r] * sc2 + brow[kc1 - qc + NA_WC - 1] : -1e30f;
                    }
                } else {
#pragma unroll
                    for (int r = 0; r < 16; ++r) { s0[r] *= sc2; s1[r] *= sc2; }
                }
                float mx = -1e30f;
#pragma unroll
                for (int r = 0; r < 16; ++r) mx = fmaxf(mx, fmaxf(s0[r], s1[r]));
                mx = fmaxf(mx, __shfl_xor(mx, 32));
                const float m_new = fmaxf(m_i, mx);
                const float alpha = __builtin_amdgcn_exp2f(m_i - m_new);
                float rsum = 0.f;
#pragma unroll
                for (int r = 0; r < 16; ++r) { s0[r] = __builtin_amdgcn_exp2f(s0[r] - m_new); s1[r] = __builtin_amdgcn_exp2f(s1[r] - m_new); rsum += s0[r] + s1[r]; }
                rsum += __shfl_xor(rsum, 32);
                l_i = l_i * alpha + rsum; m_i = m_new;
                if (__builtin_amdgcn_ballot_w64(alpha != 1.0f) != 0ull) {
#pragma unroll
                    for (int r = 0; r < 16; ++r) { o0[r] *= alpha; o1[r] *= alpha; }
                }
                Frag8 pf[2][2];
#pragma unroll
                for (int sp = 0; sp < 2; ++sp)
#pragma unroll
                    for (int j = 0; j < 4; ++j) {
                        pf[0][sp].u[j] = cvt_pk_bf16_h(s0[8 * sp + 2 * j], s0[8 * sp + 2 * j + 1]);
                        pf[1][sp].u[j] = cvt_pk_bf16_h(s1[8 * sp + 2 * j], s1[8 * sp + 2 * j + 1]);
                    }
#pragma unroll
                for (int kb = 0; kb < 2; ++kb)
#pragma unroll
                    for (int sp = 0; sp < 2; ++sp) {
                        const int kofs = kb * 32 + sp * 16 + lh * 4;
                        Frag8 va, vb2;
                        va.d2[0] = *(const uint2*)(sV + (lq) * NA_VLD + kofs); va.d2[1] = *(const uint2*)(sV + (lq) * NA_VLD + kofs + 8);
                        vb2.d2[0] = *(const uint2*)(sV + (32 + lq) * NA_VLD + kofs); vb2.d2[1] = *(const uint2*)(sV + (32 + lq) * NA_VLD + kofs + 8);
                        o0 = __builtin_amdgcn_mfma_f32_32x32x16_bf16(va.v, pf[kb][sp].v, o0, 0, 0, 0);
                        o1 = __builtin_amdgcn_mfma_f32_32x32x16_bf16(vb2.v, pf[kb][sp].v, o1, 0, 0, 0);
                    }
            }
            if (more) NA_STORE((tile + 1) & 1);
            __syncthreads();
        }
#undef NA_KBASE
#undef NA_LOAD
#undef NA_STORE
        const float inv = 1.0f / l_i;
        bf16_t* yrow = p.Ymix + (size_t)(b * LL + sq) * D_MIX + 3 * GD + h * HD;
#pragma unroll
        for (int g = 0; g < 4; ++g) {
            uint2 w0, w1;
            w0.x = cvt_pk_bf16(o0[4 * g] * inv, o0[4 * g + 1] * inv); w0.y = cvt_pk_bf16(o0[4 * g + 2] * inv, o0[4 * g + 3] * inv);
            w1.x = cvt_pk_bf16(o1[4 * g] * inv, o1[4 * g + 1] * inv); w1.y = cvt_pk_bf16(o1[4 * g + 2] * inv, o1[4 * g + 3] * inv);
            *(uint2*)(yrow + 8 * g + 4 * lh) = w0; *(uint2*)(yrow + 32 + 8 * g + 4 * lh) = w1;
        }
    }
}

DEVFN float wave_sum(float v) {
#pragma unroll
    for (int o = 32; o > 0; o >>= 1) v += __shfl_xor(v, o);
    return v;
}
constexpr int LNV = D / 256;

DEVFN void ph_ln1_route(const Params& p, int l, float* lds_f, int* lds_rt, size_t vt, size_t vs) {
    static_assert(NE * D * 4 <= 128 * 1024, "router matrix fits the LDS stage region");
    const float alpha = DN_ALPHA;
    const int lane = (TIDX() & 63);
    const size_t wv = vt >> 6, nwv = vs >> 6;
    __syncthreads();
    if (TIDX() < 2 * NE) lds_rt[TIDX()] = 0;
    for (int i = TIDX(); i < D * NE / 4; i += 512) {
        const float4 w4 = *(const float4*)(p.router_w + (size_t)i * 4); const int d = (i * 4) / NE, e0 = (i * 4) % NE;
        lds_f[(e0 + 0) * D + d] = w4.x; lds_f[(e0 + 1) * D + d] = w4.y; lds_f[(e0 + 2) * D + d] = w4.z; lds_f[(e0 + 3) * D + d] = w4.w;
    }
    __syncthreads();
    for (size_t t = wv; t < (size_t)TT; t += nwv) {
        const int b = (int)(t / LL), s = (int)(t % LL); const int r = s < CTX ? NB : b;
        const float* m = p.mod + ((size_t)l * NMOD + r) * 6 * D;
        float* xr = p.xs + t * D; const bf16_t* yr = p.yo + t * D;
        float4 u[LNV];
        float sum = 0.f;
#pragma unroll
        for (int i = 0; i < LNV; ++i) {
            const int d = i * 256 + lane * 4;
            const float4 xv = *(const float4*)(xr + d); const uint2 yw = *(const uint2*)(yr + d); const float4 gv = *(const float4*)(m + 2 * D + d);
            u[i].x = alpha * xv.x + gv.x * bflo(yw.x); u[i].y = alpha * xv.y + gv.y * bfhi(yw.x); u[i].z = alpha * xv.z + gv.z * bflo(yw.y); u[i].w = alpha * xv.w + gv.w * bfhi(yw.y);
            sum += u[i].x + u[i].y + u[i].z + u[i].w;
        }
        const float mu = wave_sum(sum) * (1.0f / D);
        float sq = 0.f;
#pragma unroll
        for (int i = 0; i < LNV; ++i) { const float a0 = u[i].x - mu, a1 = u[i].y - mu, a2 = u[i].z - mu, a3 = u[i].w - mu; sq += a0 * a0 + a1 * a1 + a2 * a2 + a3 * a3; }
        const float rs = 1.0f / sqrtf(wave_sum(sq) * (1.0f / D) + LN_EPS);
        float lg[NE];
#pragma unroll
        for (int e = 0; e < NE; ++e) lg[e] = 0.f;
#pragma unroll
        for (int i = 0; i < LNV; ++i) {
            const int d = i * 256 + lane * 4;
            const float4 gg = *(const float4*)(p.ln1_g + (size_t)l * D + d), bb = *(const float4*)(p.ln1_b + (size_t)l * D + d);
            const float4 sc = *(const float4*)(m + 4 * D + d), sh = *(const float4*)(m + 3 * D + d);
            float4 xn;
            xn.x = (u[i].x - mu) * rs * gg.x + bb.x; xn.y = (u[i].y - mu) * rs * gg.y + bb.y; xn.z = (u[i].z - mu) * rs * gg.z + bb.z; xn.w = (u[i].w - mu) * rs * gg.w + bb.w;
            *(float4*)(xr + d) = xn;
            float hv[4];
            hv[0] = xn.x * (1.0f + sc.x) + sh.x; hv[1] = xn.y * (1.0f + sc.y) + sh.y; hv[2] = xn.z * (1.0f + sc.z) + sh.z; hv[3] = xn.w * (1.0f + sc.w) + sh.w;
            uint2 pk; pk.x = (unsigned)f2bf(hv[0]) | ((unsigned)f2bf(hv[1]) << 16); pk.y = (unsigned)f2bf(hv[2]) | ((unsigned)f2bf(hv[3]) << 16);
            *(uint2*)(p.hb + t * D + d) = pk;
            asm volatile("" ::: "memory");
#pragma unroll
            for (int e = 0; e < NE; ++e) { const float4 w4 = *(const float4*)(lds_f + e * D + d); lg[e] += hv[0] * w4.x + hv[1] * w4.y + hv[2] * w4.z + hv[3] * w4.w; }
        }
#pragma unroll
        for (int e = 0; e < NE; ++e) lg[e] = wave_sum(lg[e]);
        float gbest = -1e30f; int e1 = 0, e2 = 1; float w1 = 0.f, w2 = 0.f;
#pragma unroll
        for (int g = 0; g < NEG; ++g) {
            float m1 = -1e30f, m2 = -1e30f, s1 = 0.f, s2 = 0.f; int i1 = 0, i2 = 0;
#pragma unroll
            for (int i = 0; i < EPG; ++i) {
                const float scv = sigmoidf_(lg[g * EPG + i]); const float v = scv + p.router_b[g * EPG + i];
                if (v > m1) { m2 = m1; i2 = i1; s2 = s1; m1 = v; i1 = g * EPG + i; s1 = scv; }
                else if (v > m2) { m2 = v; i2 = g * EPG + i; s2 = scv; }
            }
            if (m1 + m2 > gbest) { gbest = m1 + m2; e1 = i1; e2 = i2; w1 = s1; w2 = s2; }
        }
        const float wn = ROUTED_SCALE / (w1 + w2);
        if (lane < 2) {
            const int k = lane;
            const int e = k == 0 ? e1 : e2; const float w = (k == 0 ? w1 : w2) * wn;
            const int pos = atomicAdd(&lds_rt[e], 1);
            ((int*)&p.tok_e[t])[k] = e; ((int*)&p.tok_pos[t])[k] = pos; ((float*)&p.tok_w[t])[k] = w;
        }
    }
    asm volatile("s_waitcnt vmcnt(0)" ::: "memory");
    __syncthreads();
    if (TIDX() < NE) { const int c_ = lds_rt[TIDX()]; lds_rt[NE + TIDX()] = c_ ? atomicAdd(&p.cnt[l * NE + TIDX()], c_) : 0; }
    __syncthreads();
    for (size_t t = wv; t < (size_t)TT; t += nwv) {
        if (lane < 2) { const int e = ((const int*)&p.tok_e[t])[lane]; ((int*)&p.tok_pos[t])[lane] += lds_rt[NE + e]; }
    }
}

DEVFN void ph_moe_perm(const Params& p, int l, size_t vt, size_t vs) {
    const int lane = (TIDX() & 63);
    const size_t wv = vt >> 6, nwv = vs >> 6;
    for (size_t it = wv; it < (size_t)2 * TT; it += nwv) {
        const size_t t = it >> 1; const int k = (int)(it & 1);
        const int e = ((const int*)&p.tok_e[t])[k], pos = ((const int*)&p.tok_pos[t])[k];
        int base = 0;
#pragma unroll
        for (int q = 0; q < NE; ++q) { const int nt = (p.cnt[l * NE + q] + 255) >> 8; base += (q < e) ? nt * 256 : 0; }
        const int row = base + pos;
        const uint4* src = (const uint4*)(p.hb + t * D); uint4* dst = (uint4*)(p.hperm + (size_t)row * D);
#pragma unroll
        for (int q = 0; q < D / 512; ++q) dst[q * 64 + lane] = src[q * 64 + lane];
        if (lane == 0) ((int*)&p.tok_row[t])[k] = row;
    }
}

DEVFN void ph_ln2(const Params& p, int l, size_t vt, size_t vs) {
    const float alpha = DN_ALPHA;
    const int lane = (TIDX() & 63);
    const size_t wv = vt >> 6, nwv = vs >> 6;
    for (size_t t = wv; t < (size_t)TT; t += nwv) {
        const int b = (int)(t / LL), s = (int)(t % LL); const int r = s < CTX ? NB : b;
        const float* m = p.mod + ((size_t)l * NMOD + r) * 6 * D;
        float* xr = p.xs + t * D;
        const int2 rw2 = p.tok_row[t]; const float2 ww = p.tok_w[t];
        const bf16_t* f0 = p.Fperm + (size_t)rw2.x * D; const bf16_t* f1 = p.Fperm + (size_t)rw2.y * D;
        float4 u[LNV];
        float sum = 0.f;
#pragma unroll
        for (int i = 0; i < LNV; ++i) {
            const int d = i * 256 + lane * 4;
            const float4 xv = *(const float4*)(xr + d), gv = *(const float4*)(m + 5 * D + d);
            const uint2 a0 = *(const uint2*)(f0 + d), a1 = *(const uint2*)(f1 + d);
            u[i].x = alpha * xv.x + gv.x * (ww.x * bflo(a0.x) + ww.y * bflo(a1.x)); u[i].y = alpha * xv.y + gv.y * (ww.x * bfhi(a0.x) + ww.y * bfhi(a1.x));
            u[i].z = alpha * xv.z + gv.z * (ww.x * bflo(a0.y) + ww.y * bflo(a1.y)); u[i].w = alpha * xv.w + gv.w * (ww.x * bfhi(a0.y) + ww.y * bfhi(a1.y));
            sum += u[i].x + u[i].y + u[i].z + u[i].w;
        }
        const float mu = wave_sum(sum) * (1.0f / D);
        float sq = 0.f;
#pragma unroll
        for (int i = 0; i < LNV; ++i) { const float a0 = u[i].x - mu, a1 = u[i].y - mu, a2 = u[i].z - mu, a3 = u[i].w - mu; sq += a0 * a0 + a1 * a1 + a2 * a2 + a3 * a3; }
        const float rs = 1.0f / sqrtf(wave_sum(sq) * (1.0f / D) + LN_EPS);
        const float* mn = p.mod + ((size_t)(l + 1 < DEPTH ? l + 1 : l) * NMOD + r) * 6 * D;
#pragma unroll
        for (int i = 0; i < LNV; ++i) {
            const int d = i * 256 + lane * 4;
            const float4 gg = *(const float4*)(p.ln2_g + (size_t)l * D + d), bb = *(const float4*)(p.ln2_b + (size_t)l * D + d);
            float4 xn;
            xn.x = (u[i].x - mu) * rs * gg.x + bb.x; xn.y = (u[i].y - mu) * rs * gg.y + bb.y; xn.z = (u[i].z - mu) * rs * gg.z + bb.z; xn.w = (u[i].w - mu) * rs * gg.w + bb.w;
            if (l < DEPTH - 1) *(float4*)(xr + d) = xn;
            if (l == DEPTH - 1) { if (s >= CTX) *(float4*)(p.out + ((size_t)b * SEQ + (s - CTX)) * D + d) = xn; }
            else {
                const float4 sc = *(const float4*)(mn + D + d), sh = *(const float4*)(mn + d);
                uint2 pk;
                pk.x = (unsigned)f2bf(xn.x * (1.0f + sc.x) + sh.x) | ((unsigned)f2bf(xn.y * (1.0f + sc.y) + sh.y) << 16);
                pk.y = (unsigned)f2bf(xn.z * (1.0f + sc.z) + sh.z) | ((unsigned)f2bf(xn.w * (1.0f + sc.w) + sh.w) << 16);
                *(uint2*)(p.xm + t * D + d) = pk;
            }
        }
    }
}

namespace pg8 {
#define PG8_LAS __attribute__((address_space(3)))
typedef unsigned short bf16_t;
typedef short bf16x8 __attribute__((ext_vector_type(8)));
typedef float f32x4 __attribute__((ext_vector_type(4)));
typedef unsigned u32x4 __attribute__((ext_vector_type(4)));
constexpr int BM = 256, BK = 64, HALF = 128, HTB = HALF * BK * 2  , STAGE_BYTES = 8 * HTB, NXCD = 8, WGM = 8;

__host__ __device__ __forceinline__ int lds_byte(int r, int c) { const int st = (r >> 4) * 2 + (c >> 5), rr = r & 15, cc = c & 31, ob = rr * 64 + cc * 2; return st * 1024 + (ob ^ (((ob >> 9) & 1) << 5)); }
__host__ __device__ __forceinline__ void stage_rc(int b, int& R, int& C) { const int st = b / 1024, sb = b % 1024, swz = sb ^ (((sb >> 9) & 1) << 5); R = (st >> 1) * 16 + swz / 64; C = (st & 1) * 32 + (swz % 64) / 2; }
__host__ __device__ __forceinline__ int perm32(int rho) { const int n = rho >> 4, i = rho & 15; return 8 * (i >> 2) + 4 * n + (i & 3); }

struct Unit { int pm, pn; };
struct Gemm { const bf16_t* A; const bf16_t* Bt; int M, N, K; };

struct StaticOrder {
    int nM, nN, nwg, G, c;
    __host__ __device__ void init(int M, int N, int G_, int c_) { nM = M / BM; nN = N / BM; nwg = nM * nN; G = G_; c = c_; }
    __host__ __device__ bool next(int i, Unit& u) const {
        const long L = (long)i * G + c; if (L >= nwg) return false;
        int wgid = (int)L; { const int q = nwg / NXCD, r = nwg % NXCD, xcd = wgid % NXCD, off = wgid / NXCD; wgid = (xcd < r ? xcd * (q + 1) : r * (q + 1) + (xcd - r) * q) + off; }
        const int nig = WGM * nN, gid = wgid / nig, fm = gid * WGM, gsz = (nM - fm) < WGM ? (nM - fm) : WGM;
        u.pm = fm + ((wgid % nig) % gsz); u.pn = (wgid % nig) / gsz; return true;
    }
    __device__ __forceinline__ void a_ready(const Unit&) const {}
    __device__ __forceinline__ void done(const Unit&) const {}
};
__device__ __forceinline__ unsigned cvt_pk_bf16(float lo, float hi) { return ::cvt_pk_bf16(lo, hi); }
struct EpiF32 {
    static constexpr bool PERM = false, AFTER_DRAIN = false;
    float* C; int ldc; const float* bias;
    __device__ __forceinline__ void operator()(const f32x4 (&acc)[2][2][4][2], const Unit& u, int wr, int wc, int fr, int fq) const {
        const int row0 = u.pm * BM + wr * 64 + fr, col0 = u.pn * BM + wc * 32 + 4 * fq;
        f32x4 bv[2][2];
#pragma unroll
        for (int bj = 0; bj < 2; ++bj)
#pragma unroll
            for (int n = 0; n < 2; ++n) bv[bj][n] = bias ? *(const f32x4*)(bias + col0 + bj * HALF + n * 16) : (f32x4){0.f, 0.f, 0.f, 0.f};
#pragma unroll
        for (int ai = 0; ai < 2; ++ai)
#pragma unroll
            for (int m = 0; m < 4; ++m) { float* rowp = C + (size_t)(row0 + ai * HALF + m * 16) * ldc + col0;
#pragma unroll
                for (int bj = 0; bj < 2; ++bj)
#pragma unroll
                    for (int n = 0; n < 2; ++n) *(f32x4*)(rowp + bj * HALF + n * 16) = acc[ai][bj][m][n] + bv[bj][n]; }
    }
};
template <class Epi, class Sched, bool STAMP = false>
__device__ __forceinline__ void gemm_phase(PG8_LAS unsigned char* lds, const Gemm g, const Sched& S, const Epi& E, unsigned long long* stamps) {
    const int tid = TIDX(), wid = __builtin_amdgcn_readfirstlane(tid >> 6), lane = tid & 63, wr = wid >> 2, wc = wid & 3, fr = lane & 15, fq = lane >> 4;
    const int K = g.K, nt = K / BK;
    int ts_lo = 0, ts_hi = 0, nts = 0; const unsigned long long rt_entry = STAMP ? (unsigned long long)wall_clock64() : 0ull;
#define PG8_STAMP() do { if (STAMP && wid == 0 && nts < 64) { const unsigned long long _c = (unsigned long long)clock64(); \
        ts_lo = (lane == nts) ? (int)(unsigned)_c : ts_lo; ts_hi = (lane == nts) ? (int)(unsigned)(_c >> 32) : ts_hi; ++nts; } } while (0)
    PG8_STAMP();
    unsigned voffA[2], voffB[2];
#pragma unroll
    for (int i = 0; i < 2; ++i) { int R, C; stage_rc(tid * 16 + i * 8192, R, C); const int Rb = Epi::PERM ? ((R & ~31) + perm32(R & 31)) : R;
        voffA[i] = (unsigned)(R * K + C) * 2u; voffB[i] = (unsigned)(Rb * K + C) * 2u; }
    const size_t kstep = (size_t)(BK * 2);
    const size_t hstep = (size_t)HALF * K * 2;
    const size_t tstep = 2 * hstep;
    const unsigned ldsw = (unsigned)wid * 1024u;
    const int aoff = lds_byte(wr * 64 + fr, fq * 8), boff = lds_byte(wc * 32 + fr, fq * 8);
#define PG8_SA(b, h) (((b) * 2 + (h)) * HTB)
#define PG8_SB(b, h) ((4 + (b) * 2 + (h)) * HTB)
#define PG8_STAGE(bufoff, gbase, voff) do { _Pragma("unroll") for (int _i = 0; _i < 2; ++_i) \
        __builtin_amdgcn_global_load_lds((const unsigned*)((const char*)(gbase) + (voff)[_i]), (PG8_LAS unsigned*)(lds + (bufoff) + ldsw + _i * 8192), 16, 0, 0); } while (0)
#define PG8_LDA(dst, b, h) do { _Pragma("unroll") for (int m = 0; m < 4; ++m) _Pragma("unroll") for (int k = 0; k < 2; ++k) dst[m][k] = *(const PG8_LAS bf16x8*)(lds + PG8_SA(b, h) + aoff + m * 2048 + k * 1024); } while (0)
#define PG8_LDB(dst, b, h) do { _Pragma("unroll") for (int n = 0; n < 2; ++n) _Pragma("unroll") for (int k = 0; k < 2; ++k) dst[n][k] = *(const PG8_LAS bf16x8*)(lds + PG8_SB(b, h) + boff + n * 2048 + k * 1024); } while (0)
#define PG8_MMA(ai, bj, At, Bt) do { __builtin_amdgcn_s_setprio(1); _Pragma("unroll") for (int m = 0; m < 4; ++m) _Pragma("unroll") for (int n = 0; n < 2; ++n) _Pragma("unroll") for (int k = 0; k < 2; ++k) \
        acc[ai][bj][m][n] = __builtin_amdgcn_mfma_f32_16x16x32_bf16(Bt[n][k], At[m][k], acc[ai][bj][m][n], 0, 0, 0); __builtin_amdgcn_s_setprio(0); } while (0)
#define PG8_WAIT_V(n) asm volatile("s_waitcnt vmcnt(" #n ")" ::: "memory")
#define PG8_WAIT_L(n) asm volatile("s_waitcnt lgkmcnt(" #n ")" ::: "memory")
#define PG8_BAR __builtin_amdgcn_s_barrier()
#define PG8_SCHED __builtin_amdgcn_sched_barrier(0)
    Unit cur, nxt; int ui = 0;
    if (!S.next(0, cur)) return;
    f32x4 acc[2][2][4][2];
#pragma unroll
    for (int a = 0; a < 2; ++a)
#pragma unroll
        for (int b = 0; b < 2; ++b)
#pragma unroll
            for (int m = 0; m < 4; ++m)
#pragma unroll
                for (int n = 0; n < 2; ++n) acc[a][b][m][n] = (f32x4){0.f, 0.f, 0.f, 0.f};
    bf16x8 At[4][2], B0[2][2], B1[2][2];
    const char* cA = (const char*)g.A + (size_t)cur.pm * tstep; const char* cB = (const char*)g.Bt + (size_t)cur.pn * tstep;
    S.a_ready(cur);
    PG8_STAGE(PG8_SB(0, 0), cB, voffB); PG8_STAGE(PG8_SA(0, 0), cA, voffA); PG8_STAGE(PG8_SB(0, 1), cB + hstep, voffB); PG8_STAGE(PG8_SA(0, 1), cA + hstep, voffA);
    if (wr == 1) PG8_BAR;
    PG8_WAIT_V(4); PG8_BAR;
    PG8_STAGE(PG8_SB(1, 0), cB + kstep, voffB); PG8_STAGE(PG8_SA(1, 0), cA + kstep, voffA); PG8_STAGE(PG8_SB(1, 1), cB + hstep + kstep, voffB);
    PG8_WAIT_V(6); PG8_BAR;
    PG8_STAMP();
    for (;;) {
        const bool has_next = S.next(ui + 1, nxt);
        const char* nA = has_next ? (const char*)g.A + (size_t)nxt.pm * tstep : cA; const char* nB = has_next ? (const char*)g.Bt + (size_t)nxt.pn * tstep : cB;
        for (int t = 0; t < nt; t += 2) {
            const bool last = (t == nt - 2);
            const char* a1 = cA + (size_t)(t + 1) * kstep;
            const char* a2 = last ? nA : cA + (size_t)(t + 2) * kstep; const char* b2 = last ? nB : cB + (size_t)(t + 2) * kstep;
            const char* a3 = a2 + kstep; const char* b3 = b2 + kstep;
            if (last && has_next) S.a_ready(nxt);
            PG8_LDB(B0, 0, 0); PG8_SCHED; PG8_LDA(At, 0, 0); PG8_STAGE(PG8_SA(1, 1), a1 + hstep, voffA);
            PG8_WAIT_L(8); PG8_BAR; PG8_WAIT_L(0); PG8_MMA(0, 0, At, B0); PG8_BAR; PG8_SCHED;
            PG8_LDB(B1, 0, 1); PG8_STAGE(PG8_SB(0, 0), b2, voffB);
            PG8_BAR; PG8_WAIT_L(0); PG8_MMA(0, 1, At, B1); PG8_BAR;
            PG8_LDA(At, 0, 1); PG8_STAGE(PG8_SA(0, 0), a2, voffA);
            PG8_BAR; PG8_WAIT_L(0); PG8_MMA(1, 0, At, B0); PG8_BAR; PG8_SCHED;
            PG8_STAGE(PG8_SB(0, 1), b2 + hstep, voffB);
            PG8_WAIT_V(6); PG8_BAR; PG8_MMA(1, 1, At, B1); PG8_BAR;
            PG8_LDB(B0, 1, 0); PG8_SCHED; PG8_LDA(At, 1, 0); PG8_STAGE(PG8_SA(0, 1), a2 + hstep, voffA);
            PG8_WAIT_L(8); PG8_BAR; PG8_WAIT_L(0); PG8_MMA(0, 0, At, B0); PG8_BAR; PG8_SCHED;
            PG8_LDB(B1, 1, 1); PG8_STAGE(PG8_SB(1, 0), b3, voffB);
            PG8_BAR; PG8_WAIT_L(0); PG8_MMA(0, 1, At, B1); PG8_BAR;
            PG8_LDA(At, 1, 1); PG8_STAGE(PG8_SA(1, 0), a3, voffA);
            PG8_BAR; PG8_WAIT_L(0); PG8_MMA(1, 0, At, B0); PG8_BAR; PG8_SCHED;
            PG8_STAGE(PG8_SB(1, 1), b3 + hstep, voffB);
            PG8_WAIT_V(6); PG8_BAR; PG8_MMA(1, 1, At, B1); PG8_BAR;
        }
        PG8_STAMP();
        if constexpr (!Epi::AFTER_DRAIN) { E(acc, cur, wr, wc, fr, fq); S.done(cur); }
        PG8_STAMP();
        if (!has_next) break;
#pragma unroll
        for (int a = 0; a < 2; ++a)
#pragma unroll
            for (int b = 0; b < 2; ++b)
#pragma unroll
                for (int m = 0; m < 4; ++m)
#pragma unroll
                    for (int n = 0; n < 2; ++n) acc[a][b][m][n] = (f32x4){0.f, 0.f, 0.f, 0.f};
        cur = nxt; cA = nA; cB = nB; ++ui;
    }
    PG8_WAIT_V(0);
    if (wr == 0) PG8_BAR;
    PG8_BAR;
    if constexpr (Epi::AFTER_DRAIN) { E.fused(acc, cur, wr, wc, fr, fq, lds, wid, lane); S.done(cur); }
    PG8_STAMP();
    if (STAMP && wid == 0) { stamps[lane] = lane < nts ? (((unsigned long long)(unsigned)ts_hi << 32) | (unsigned)ts_lo) : 0ull;
        if (lane == 62) stamps[62] = rt_entry; if (lane == 63) stamps[63] = (unsigned long long)wall_clock64(); }
#undef PG8_STAMP
#undef PG8_SA
#undef PG8_SB
#undef PG8_STAGE
#undef PG8_LDA
#undef PG8_LDB
#undef PG8_MMA
#undef PG8_WAIT_V
#undef PG8_WAIT_L
#undef PG8_BAR
#undef PG8_SCHED
}
}

namespace pg8 {
struct EpiBf16N {
    static constexpr bool PERM = true, AFTER_DRAIN = false;
    bf16_t* O; int ldc; int ncols;
    __device__ __forceinline__ void operator()(const f32x4 (&acc)[2][2][4][2], const Unit& u, int wr, int wc, int fr, int fq) const {
        const int row0 = u.pm * BM + wr * 64 + fr; const int col0 = u.pn * BM + wc * 32 + 8 * fq;
#pragma unroll
        for (int ai = 0; ai < 2; ++ai)
#pragma unroll
            for (int m = 0; m < 4; ++m) { bf16_t* rowp = O + (size_t)(row0 + ai * HALF + m * 16) * ldc + col0;
#pragma unroll
                for (int bj = 0; bj < 2; ++bj) { const f32x4 v0 = acc[ai][bj][m][0], v1 = acc[ai][bj][m][1];
                    u32x4 w; w.x = ::cvt_pk_bf16_h(v0[0], v0[1]); w.y = ::cvt_pk_bf16_h(v0[2], v0[3]); w.z = ::cvt_pk_bf16_h(v1[0], v1[1]); w.w = ::cvt_pk_bf16_h(v1[2], v1[3]);
                    if (col0 + bj * HALF < ncols) *(u32x4*)(rowp + bj * HALF) = w; } }
    }
};
struct LatentOrder : StaticOrder {
    __device__ __forceinline__ bool next(int i, Unit& u) const {
        if (!StaticOrder::next(i, u)) return false;
        constexpr int LT = SEQ / 256, CT = CTX / 256;
        u.pm = (u.pm / LT) * (LT + CT) + CT + (u.pm % LT); return true;
    }
};
struct EpiBf16Grp {
    static constexpr bool PERM = true, AFTER_DRAIN = false;
    bf16_t* O; int ldc; int ncu;
    __device__ __forceinline__ void operator()(const f32x4 (&acc)[2][2][4][2], const Unit& u, int wr, int wc, int fr, int fq) const {
        const int row0 = u.pm * BM + wr * 64 + fr; const int col0 = (u.pn % ncu) * BM + wc * 32 + 8 * fq;
#pragma unroll
        for (int ai = 0; ai < 2; ++ai)
#pragma unroll
            for (int m = 0; m < 4; ++m) { bf16_t* rowp = O + (size_t)(row0 + ai * HALF + m * 16) * ldc + col0;
#pragma unroll
                for (int bj = 0; bj < 2; ++bj) { const f32x4 v0 = acc[ai][bj][m][0], v1 = acc[ai][bj][m][1];
                    u32x4 w; w.x = ::cvt_pk_bf16_h(v0[0], v0[1]); w.y = ::cvt_pk_bf16_h(v0[2], v0[3]); w.z = ::cvt_pk_bf16_h(v1[0], v1[1]); w.w = ::cvt_pk_bf16_h(v1[2], v1[3]);
                    *(u32x4*)(rowp + bj * HALF) = w; } }
    }
};
struct MoeOrder {
    const int* cnt; int G, c, ncu;
    __device__ __forceinline__ bool next(int i, Unit& u) const {
        int tot = 0;
#pragma unroll
        for (int k = 0; k < 16; ++k) tot += (cnt[k] + 255) >> 8;
        int rt, cu;
        if ((G & 7) == 0) {
            const int x = c & 7, rank = c >> 3, per = G >> 3;
            const int t0 = (tot * x) >> 3, t1 = (tot * (x + 1)) >> 3;
            const int k = i * per + rank;
            if (k >= (t1 - t0) * ncu) return false;
            rt = t0 + k / ncu; cu = k % ncu;
        } else {
            const long L = (long)i * G + c; rt = (int)(L / ncu); cu = (int)(L % ncu);
            if (rt >= tot) return false;
        }
        int acc = 0, e = -1;
#pragma unroll
        for (int k = 0; k < 16; ++k) { const int nt = (cnt[k] + 255) >> 8; e = (e < 0 && rt < acc + nt) ? k : e; acc += nt; }
        if (e < 0) return false;
        u.pm = rt; u.pn = e * ncu + cu; return true;
    }
    __device__ __forceinline__ void a_ready(const Unit&) const {}
    __device__ __forceinline__ void done(const Unit&) const {}
};
struct EpiSwiGLU {
    static constexpr bool PERM = true, AFTER_DRAIN = false;
    bf16_t* O; int ldc; int ncu;
    __device__ __forceinline__ void operator()(const f32x4 (&acc)[2][2][4][2], const Unit& u, int wr, int wc, int fr, int fq) const {
        const int row0 = u.pm * BM + wr * 64 + fr; const int col0 = (u.pn % ncu) * HALF + wc * 32 + 8 * fq;
#pragma unroll
        for (int ai = 0; ai < 2; ++ai)
#pragma unroll
            for (int m = 0; m < 4; ++m) {
                float hv[8];
#pragma unroll
                for (int n = 0; n < 2; ++n)
#pragma unroll
                    for (int q = 0; q < 4; ++q) { const float g = acc[ai][0][m][n][q], up = acc[ai][1][m][n][q]; hv[4 * n + q] = g / (1.0f + __expf(-g)) * up; }
                u32x4 w; w.x = cvt_pk_bf16(hv[0], hv[1]); w.y = cvt_pk_bf16(hv[2], hv[3]); w.z = cvt_pk_bf16(hv[4], hv[5]); w.w = cvt_pk_bf16(hv[6], hv[7]);
                *(u32x4*)(O + (size_t)(row0 + ai * HALF + m * 16) * ldc + col0) = w;
            }
    }
};
}

#define XB_TMO      128
#define XB_XCNT(j)  (256  + 64 * (j))
#define XB_XSUB(j)  (1280 + 64 * (j))
#define XB_XGEN(j)  (2304 + 64 * (j))
#define XB_TOP      3328
#define XB_TOPGEN   3392
#define XCD_BAR_WORDS 3456
#define XB_SPIN_CAP (1u << 18)
#define LAS __attribute__((address_space(3)))

__device__ __forceinline__ unsigned xb_ld(unsigned* p)              { return __hip_atomic_load(p, __ATOMIC_RELAXED, __HIP_MEMORY_SCOPE_AGENT); }
__device__ __forceinline__ unsigned xb_add(unsigned* p, unsigned v) { return __hip_atomic_fetch_add(p, v, __ATOMIC_RELAXED, __HIP_MEMORY_SCOPE_AGENT); }
__device__ __forceinline__ unsigned xb_xcc_id() { return (unsigned)__builtin_amdgcn_s_getreg((3 << 11) | 20) & 0xFu; }
#define XB_SPIN(cond, bar) do { unsigned _sp = 0; while (cond) { __builtin_amdgcn_s_sleep(1); \
    if ((++_sp & 255u) == 0u) { if (xb_ld(&(bar)[XB_TMO])) break; if (_sp > XB_SPIN_CAP) { atomicAdd(&(bar)[XB_TMO], 1u); break; } } } } while (0)

struct XcdBarrier {
    unsigned* bar; unsigned x;
    volatile LAS unsigned* st;
};

__device__ __forceinline__ XcdBarrier xcd_barrier_post(unsigned* bar, volatile LAS unsigned* st) {
    XcdBarrier b; b.bar = bar; b.x = xb_xcc_id(); b.st = st;
    if (threadIdx.x == 0) (void)xb_add(&bar[XB_XCNT(b.x)], 1u);
    return b;
}
__device__ __forceinline__ void xcd_barrier_complete(unsigned* bar, unsigned x, unsigned& nloc, unsigned& nx) {
    const unsigned G = gridDim.x * gridDim.y * gridDim.z;
    unsigned sum, cnt, mine, sp = 0u;
    for (;;) {
        sum = 0u; cnt = 0u; mine = 0u;
#pragma unroll
        for (unsigned j = 0; j < 16; ++j) { const unsigned c = xb_ld(&bar[XB_XCNT(j)]); sum += c; cnt += (c > 0u) ? 1u : 0u; mine = (j == x) ? c : mine; }
        if (sum == G) break;
        __builtin_amdgcn_s_sleep(1);
        if ((++sp & 255u) == 0u) { if (xb_ld(&bar[XB_TMO])) break; if (sp > XB_SPIN_CAP) { atomicAdd(&bar[XB_TMO], 1u); break; } }
    }
    nloc = mine > 0u ? mine : 1u; nx = cnt > 0u ? cnt : 1u;
}

__device__ __forceinline__ void xcd_barrier(const XcdBarrier& b) {
    asm volatile("s_waitcnt vmcnt(0)" ::: "memory");
    __syncthreads();
    if (threadIdx.x == 0) {
        unsigned* bar = b.bar;
        __builtin_amdgcn_s_waitcnt(0);
        unsigned nloc = b.st[0], nx = b.st[1];
        if (nloc == 0u) { xcd_barrier_complete(bar, b.x, nloc, nx); b.st[0] = nloc; b.st[1] = nx; }
        const unsigned old = xb_add(&bar[XB_XSUB(b.x)], 1u);
        const unsigned gen = old / nloc;
        if (old + 1u == (gen + 1u) * nloc) {
            __builtin_amdgcn_fence(__ATOMIC_RELEASE, "agent");
            asm volatile("s_waitcnt vmcnt(0)" ::: "memory");
            const unsigned og = xb_add(&bar[XB_TOP], 1u);
            const unsigned tg = og / nx;
            if (og + 1u == (tg + 1u) * nx) xb_add(&bar[XB_TOPGEN], 1u);
            else XB_SPIN(xb_ld(&bar[XB_TOPGEN]) == tg, bar);
            __builtin_amdgcn_fence(__ATOMIC_ACQUIRE, "agent");
            xb_add(&bar[XB_XGEN(b.x)], 1u);
            asm volatile("s_waitcnt vmcnt(0)" ::: "memory");
        } else {
            XB_SPIN(xb_ld(&bar[XB_XGEN(b.x)]) == gen, bar);
            __builtin_amdgcn_fence(__ATOMIC_ACQUIRE, "agent");
            asm volatile("s_waitcnt vmcnt(0)" ::: "memory");
        }
    }
    __syncthreads();
}

constexpr int NT = 512;
constexpr int LDS_STAGE = pg8::STAGE_BYTES;
constexpr int LDS_MISC = LDS_STAGE;
constexpr int LDS_RT = LDS_STAGE + 64;
constexpr int LDS_BYTES = LDS_STAGE + 64 + 256;
struct MegaArgs { Params p; unsigned* bar; int reps[16]; };

DEVFN size_t VTF() { return (size_t)blockIdx.x * 512 + (size_t)TIDX(); }
DEVFN int OPQS(int v) { asm volatile("" : "+s"(v)); return v; }
typedef const __attribute__((address_space(4))) MegaArgs* KArgP;
DEVFN int REPS(int k) { KArgP ka = (KArgP)__builtin_amdgcn_kernarg_segment_ptr(); asm volatile("" : "+s"(ka)); return ka->reps[k]; }
DEVFN unsigned* BARP() { KArgP ka = (KArgP)__builtin_amdgcn_kernarg_segment_ptr(); asm volatile("" : "+s"(ka)); return ka->bar; }
DEVFN const Params& PF() { KArgP ka = (KArgP)__builtin_amdgcn_kernarg_segment_ptr(); asm volatile("" : "+s"(ka)); return *(const Params*)&ka->p; }
DEVFN int NBF() { int g = (int)gridDim.x; asm volatile("" : "+s"(g)); return g; }
DEVFN size_t VSF() { return (size_t)NBF() * 512; }
__global__ void __launch_bounds__(NT, 2) k_mega(MegaArgs a) {
    extern __shared__ __attribute__((aligned(16))) unsigned char lds[];
    bf16_t* const smem = (bf16_t*)lds;
    volatile int* const s_unit = (volatile int*)(lds + LDS_MISC + 16);
    static_assert(2 * AT_NSUB * AT_BUF * 2 <= LDS_STAGE && 2 * AT_BUF * 2 + 2048 <= LDS_STAGE && AT_BUF >= NA_BUF && (NT / 64) * RW_STG * 4 <= LDS_STAGE, "LDS carve");
    if (threadIdx.x == 0) *(uint4*)(lds + LDS_MISC) = make_uint4(0u, 0u, 0u, 0u);
    __syncthreads();
    (void)xcd_barrier_post(a.bar, (volatile LAS unsigned*)(lds + LDS_MISC));
#define GRID_BARRIER() do { XcdBarrier b_; b_.bar = BARP(); b_.x = xb_xcc_id(); b_.st = (volatile LAS unsigned*)(lds + LDS_MISC); xcd_barrier(b_); } while (0)
    const Params& p = a.p;
    const int nb = gridDim.x, bx = blockIdx.x;
    const size_t vt = (size_t)bx * NT + threadIdx.x, vs = (size_t)nb * NT;

    ph_init(p, 0, vt, vs);
    for (int r_ = a.reps[12]; r_ > 0; --r_) {
    ph_mod_partial(p, vt, vs);
    ph_transpose_t(p.w_in, p.WinT, D, N_IN, DEPTH, (size_t)N_INP * D, 0, D, 0, smem, bx, nb);
    ph_transpose_t(p.w_out, p.WoutT, D_MIX, D, DEPTH, (size_t)D * D_MIX, 0, D_MIX, 0, smem, bx, nb);
    for (int cu = 0; cu < D_EXP / 128; ++cu) {
        ph_transpose_t(p.exp_w_gate + cu * 128, p.WguT, D, 128, DEPTH * NE, (size_t)2 * D_EXP * D, cu * 256, D, 0, smem, bx, nb, (size_t)D * D_EXP, D_EXP);
        ph_transpose_t(p.exp_w_up + cu * 128, p.WguT, D, 128, DEPTH * NE, (size_t)2 * D_EXP * D, cu * 256 + 128, D, 0, smem, bx, nb, (size_t)D * D_EXP, D_EXP);
    }
    ph_transpose_t(p.exp_w_down, p.WdT, D_EXP, D, DEPTH * NE, (size_t)D * D_EXP, 0, D_EXP, 0, smem, bx, nb);
    }
    ph_zero16((uint4*)p.WupT, (size_t)DEPTH * NUP * KUP * 2 / 16, vt, vs);
    ph_zero16((uint4*)p.WloT, (size_t)DEPTH * NLO * KLO * 2 / 16, vt, vs);
    GRID_BARRIER();
    ph_mod_final(p, vt, vs);
    ph_transpose(p.mla_w_uq, p.WupT, MLA_QL, NUPQ, DEPTH, (size_t)NUP * KUP, 0, KUP, 0, vt, vs);
    ph_transpose(p.mla_w_ukv, p.WupT, MLA_KVL, NUP - NUPQ, DEPTH, (size_t)NUP * KUP, NUPQ, KUP, MLA_QL, vt, vs);
    for (int dir = 0; dir < 2; ++dir) {
        ph_transpose(p.rw_w_up + (size_t)dir * RW_WL * GD, p.WloT, RW_WL, GD, DEPTH, (size_t)NLO * KLO, dir * GD, KLO, dir * RW_WL, vt, vs, (size_t)2 * RW_WL * GD);
        ph_transpose(p.rw_a_up + (size_t)dir * RW_AL * GD, p.WloT, RW_AL, GD, DEPTH, (size_t)NLO * KLO, 2 * GD + dir * GD, KLO, 2 * RW_WL + dir * RW_AL, vt, vs, (size_t)2 * RW_AL * GD);
    }
    ph_transpose(p.rw_g_up, p.WloT, RW_GL, GD, DEPTH, (size_t)NLO * KLO, 4 * GD, KLO, 2 * RW_WL + 2 * RW_AL, vt, vs);
    GRID_BARRIER();
    ph_modulate(p, 0, vt, vs);
    GRID_BARRIER();

    for (int l = 0; l < DEPTH; ++l) {
        for (int r_ = REPS(0); r_ > 0; --r_)
        {
            pg8::Gemm g{PF().xm, PF().WinT + (size_t)l * N_INP * D, TT, N_INP, D}; pg8::StaticOrder S; S.init(TT, N_INP, NBF(), OPQS(bx));
            pg8::EpiBf16N E{PF().P, N_IN, N_IN};
            pg8::gemm_phase<pg8::EpiBf16N, pg8::StaticOrder, false>((PG8_LAS unsigned char*)lds, g, S, E, nullptr);
            GRID_BARRIER();
        }
        for (int r_ = REPS(1); r_ > 0; --r_) {
        ph_rw_mix(PF(), l, VTF(), VSF());
        ph_mb_prep(PF(), l, VTF(), VSF());
        ph_mla_norm(PF(), l, VTF(), VSF());
        ph_vt_tiles(PF(), 0, smem, OPQS(bx), NBF());
        GRID_BARRIER();
        }
        for (int r_ = REPS(8); r_ > 0; --r_) {
        {
            pg8::Gemm g{PF().pmb, PF().WloT + (size_t)l * NLO * KLO, TT, NLO, KLO}; pg8::StaticOrder S; S.init(TT, NLO, NBF(), OPQS(bx));
            pg8::EpiBf16N E{PF().LO, NLO, NLO};
            pg8::gemm_phase<pg8::EpiBf16N, pg8::StaticOrder, false>((PG8_LAS unsigned char*)lds, g, S, E, nullptr);
        }
        {
            pg8::Gemm g{PF().qkvn, PF().WupT + (size_t)l * NUP * KUP, TT, NUP, KUP}; pg8::StaticOrder S; S.init(TT, NUP, NBF(), OPQS(bx));
            pg8::EpiF32 E{PF().QKVraw, NUP, nullptr};
            pg8::gemm_phase<pg8::EpiF32, pg8::StaticOrder, false>((PG8_LAS unsigned char*)lds, g, S, E, nullptr);
        }
        GRID_BARRIER();
        }
        for (int r_ = REPS(9); r_ > 0; --r_) { ph_rw_prep(PF(), l, VTF(), VSF()); ph_mla_rope(PF(), l, VTF(), VSF()); ph_vt_tiles(PF(), 1, smem, OPQS(bx), NBF()); ph_vt_tiles(PF(), 2, smem, OPQS(bx), NBF()); ph_vt_tiles(PF(), 3, smem, OPQS(bx), NBF()); }
        GRID_BARRIER();
        for (int r_ = REPS(10); r_ > 0; --r_) { ph_chunks(PF(), l, (float*)lds, PF().qctr + l * 16 + 8 + (r_ - 1)); GRID_BARRIER(); }
        {
            constexpr int SEQ_BLOCKS = (NU * 2 * 64 + NT - 1) / NT;
            const int wv = __builtin_amdgcn_readfirstlane((int)(VTF() >> 6));
            for (int r_ = REPS(6); r_ > 0; --r_) {
                if (bx < NU) ph_rw_seq(PF(), lds, OPQS(bx), NU);
                else if (bx < NU + 2 * SEQ_BLOCKS) ph_mb_seq(PF(), wv - NU * (NT / 64), 2 * SEQ_BLOCKS * (NT / 64));
            }
            constexpr int QB = (NT / 64) * 32, RPU = NT / 128;
            const bool with_ctx = l < DEPTH - 1;
            const int n_mla = NB * NH * (SEQ / QB) + (with_ctx ? NB * NH * (CTX / QB) : 0);
            const int n_na = NB * NH * ((SEQ / GRID_W) / RPU) + (with_ctx ? NB * NH * (CTX / QB) : 0);
            for (int r_ = REPS(2); r_ > 0; --r_)
            for (;;) {
                __syncthreads();
                if (threadIdx.x == 0) *s_unit = atomicAdd(&PF().qctr[l * 16 + (r_ - 1)], 1);
                __syncthreads();
                const int u = *s_unit;
                if (u >= 2 * n_mla) break;
                mla_unit<NT>(PF(), smem, u);
            }
            for (int r_ = REPS(7); r_ > 0; --r_)
            for (;;) {
                __syncthreads();
                if (threadIdx.x == 0) *s_unit = atomicAdd(&PF().qctr[l * 16 + 4 + (r_ - 1)], 1);
                __syncthreads();
                const int u = *s_unit;
                if (u >= n_na) break;
                na_unit<NT>(PF(), l, smem, u);
            }
            GRID_BARRIER();
        }
        for (int r_ = REPS(3); r_ > 0; --r_) {
        ph_rw_yout(PF(), l, VTF(), VSF());
        ph_mb_yout(PF(), l, VTF(), VSF());
        ph_mla_combine(PF(), l < DEPTH - 1, VTF(), VSF());
        GRID_BARRIER();
        }
        for (int r_ = REPS(4); r_ > 0; --r_)
        {
            pg8::Gemm g{PF().Ymix, PF().WoutT + (size_t)l * D * D_MIX, TT, D, D_MIX};
            pg8::EpiBf16N E{PF().yo, D, D};
            if (l < DEPTH - 1) { pg8::StaticOrder S; S.init(TT, D, NBF(), OPQS(bx)); pg8::gemm_phase<pg8::EpiBf16N, pg8::StaticOrder, false>((PG8_LAS unsigned char*)lds, g, S, E, nullptr); }
            else { pg8::LatentOrder S; S.init(NB * SEQ, D, NBF(), OPQS(bx)); pg8::gemm_phase<pg8::EpiBf16N, pg8::LatentOrder, false>((PG8_LAS unsigned char*)lds, g, S, E, nullptr); }
            GRID_BARRIER();
        }
        ph_ln1_route(PF(), l, (float*)lds, (int*)(lds + LDS_RT), VTF(), VSF());
        GRID_BARRIER();
        for (int r_ = REPS(13); r_ > 0; --r_) {
        ph_moe_perm(PF(), l, VTF(), VSF());
        GRID_BARRIER();
        }
        for (int r_ = REPS(14); r_ > 0; --r_) {
        {
            pg8::Gemm g{PF().hperm, PF().WguT + (size_t)l * NE * 2 * D_EXP * D, MPAD, NE * 2 * D_EXP, D};
            pg8::MoeOrder S{PF().cnt + l * NE, NBF(), OPQS(bx), 2 * D_EXP / 256};
            pg8::EpiSwiGLU E{PF().hidp, D_EXP, 2 * D_EXP / 256};
            pg8::gemm_phase<pg8::EpiSwiGLU, pg8::MoeOrder, false>((PG8_LAS unsigned char*)lds, g, S, E, nullptr);
        }
        GRID_BARRIER();
        }
        for (int r_ = REPS(15); r_ > 0; --r_) {
        {
            pg8::Gemm g{PF().hidp, PF().WdT + (size_t)l * NE * D * D_EXP, MPAD, NE * D, D_EXP};
            pg8::MoeOrder S{PF().cnt + l * NE, NBF(), OPQS(bx), D / 256};
            pg8::EpiBf16Grp E{PF().Fperm, D, D / 256};
            pg8::gemm_phase<pg8::EpiBf16Grp, pg8::MoeOrder, false>((PG8_LAS unsigned char*)lds, g, S, E, nullptr);
        }
        GRID_BARRIER();
        }
        ph_ln2(PF(), l, VTF(), VSF());
        GRID_BARRIER();
    }
}

static size_t carve(size_t& off, size_t bytes) { const size_t o = off; off += (bytes + 255) & ~(size_t)255; return o; }

extern "C" void kernel_launch(void* const* d_in, const int* in_sizes, int n_in, void* d_out, int out_size, void* d_ws, size_t ws_size, hipStream_t stream) {
    (void)in_sizes; (void)n_in; (void)out_size;
    MegaArgs a{};
    Params& p = a.p;
    const float* const* in = (const float* const*)d_in;
    p.x = in[0]; p.c = in[1]; p.ctx = in[2]; p.c_ctx = in[3]; p.ada_w = in[4]; p.ada_b = in[5]; p.w_in = in[6]; p.w_out = in[7];
    p.ln1_g = in[8]; p.ln1_b = in[9]; p.ln2_g = in[10]; p.ln2_b = in[11];
    p.rw_mu = in[12]; p.rw_w0 = in[13]; p.rw_w_up = in[14]; p.rw_a0 = in[15]; p.rw_a_up = in[16]; p.rw_g_up = in[17]; p.rw_k_k = in[18]; p.rw_k_a = in[19];
    p.rw_r_k = in[20]; p.rw_gn_g = in[21]; p.rw_gn_b = in[22];
    p.mb_conv_w = in[23]; p.mb_conv_b = in[24]; p.mb_a_log = in[25]; p.mb_dt_bias = in[26]; p.mb_d = in[27]; p.mb_norm_g = in[28];
    p.mla_q_norm = in[29]; p.mla_w_uq = in[30]; p.mla_kv_norm = in[31]; p.mla_w_ukv = in[32]; p.na_rpb = in[33];
    p.router_w = in[34]; p.router_b = in[35]; p.exp_w_gate = in[36]; p.exp_w_up = in[37]; p.exp_w_down = in[38];
    p.out = (float*)d_out;

    char* ws = (char*)d_ws; size_t off = 0;
    a.bar = (unsigned*)(ws + carve(off, (size_t)XCD_BAR_WORDS * 4));
    p.WinT = (bf16_t*)(ws + carve(off, (size_t)DEPTH * N_INP * D * 2));
    p.WoutT = (bf16_t*)(ws + carve(off, (size_t)DEPTH * D * D_MIX * 2));
    p.WguT = (bf16_t*)(ws + carve(off, (size_t)DEPTH * NE * 2 * D_EXP * D * 2));
    p.WdT = (bf16_t*)(ws + carve(off, (size_t)DEPTH * NE * D * D_EXP * 2));
    p.WupT = (bf16_t*)(ws + carve(off, (size_t)DEPTH * NUP * KUP * 2));
    p.WloT = (bf16_t*)(ws + carve(off, (size_t)DEPTH * NLO * KLO * 2));
    p.xs = (float*)(ws + carve(off, (size_t)TT * D * 4));
    p.xm = (bf16_t*)(ws + carve(off, (size_t)TT * D * 2));
    p.mod = (float*)(ws + carve(off, (size_t)DEPTH * NMOD * 6 * D * 4));
    p.modp = (float*)(ws + carve(off, (size_t)DEPTH * (D / 128) * NMOD * 6 * D * 4));
    p.ropecs = (float2*)(ws + carve(off, (size_t)GRID_W * (MLA_ROPE / 4) * 8));
    p.cnt = (int*)(ws + carve(off, (size_t)DEPTH * NE * 4));
    p.qctr = (int*)(ws + carve(off, (size_t)DEPTH * 16 * 4));
    p.tok_e = (int2*)(ws + carve(off, (size_t)TT * 8));
    p.tok_pos = (int2*)(ws + carve(off, (size_t)TT * 8));
    p.tok_row = (int2*)(ws + carve(off, (size_t)TT * 8));
    p.tok_w = (float2*)(ws + carve(off, (size_t)TT * 8));
    p.Ymix = (bf16_t*)(ws + carve(off, (size_t)TT * D_MIX * 2));
    p.naVt = (bf16_t*)(ws + carve(off, (size_t)NB * NH * HD * LL * 2));
    p.mlaO = (float*)(ws + carve(off, (size_t)TT * NH * 2 * MLA_V * 4));
    p.mlaML = (float*)(ws + carve(off, (size_t)TT * NH * 2 * 2 * 4));
    p.hb = (bf16_t*)(ws + carve(off, (size_t)TT * D * 2));
    const size_t regA = off;
    p.P = (bf16_t*)(ws + carve(off, (size_t)TT * N_IN * 2));
    p.pm = (float*)(ws + carve(off, (size_t)TT * RW_IN * 4));
    p.pmb = (bf16_t*)(ws + carve(off, (size_t)TT * KLO * 2));
    p.rwW = (float*)(ws + carve(off, (size_t)2 * TT * GD * 4));
    p.rwB = (float*)(ws + carve(off, (size_t)2 * TT * GD * 4));
    p.rwKD = (float*)(ws + carve(off, (size_t)2 * TT * GD * 4));
    p.rwKK = (float*)(ws + carve(off, (size_t)TT * GD * 4));
    p.rwG = (float*)(ws + carve(off, (size_t)TT * GD * 4));
    {
        const size_t o0 = off; size_t o1 = off, o2 = off;
        p.rwMsT = (bf16_t*)(ws + carve(o1, (size_t)NU * NCHK * HD * HD * 2));
        p.rwSloc = (float*)(ws + carve(o1, (size_t)NU * NCHK * HD * HD * 4));
        p.rwYI = (bf16_t*)(ws + carve(o1, (size_t)NU * LL * HD * 2));
        p.rwYloc = (float*)(ws + carve(o1, (size_t)NU * LL * HD * 4));
        p.LO = (bf16_t*)(ws + carve(o2, (size_t)TT * NLO * 2));
        p.QKVraw = (float*)(ws + carve(o2, (size_t)TT * NUP * 4));
        off = o1 > o2 ? o1 : o2; (void)o0;
    }
    p.xc = (float*)(ws + carve(off, (size_t)TT * MB_CONV_DIM * 4));
    p.dt = (float*)(ws + carve(off, (size_t)TT * 2 * NH * 4));
    p.mbC = (bf16_t*)(ws + carve(off, (size_t)TT * MB_GROUPS * MB_STATE * 2));
    p.mbB = (bf16_t*)(ws + carve(off, (size_t)TT * MB_GROUPS * MB_STATE * 2));
    p.mbXT = (bf16_t*)(ws + carve(off, (size_t)NB * NH * HD * LL * 2));
    p.mbBT = (bf16_t*)(ws + carve(off, (size_t)NB * MB_GROUPS * MB_STATE * LL * 2));
    p.mbCS = (bf16_t*)(ws + carve(off, (size_t)NU * NCHK * HD * MB_STATE * 2));
    p.mbYloc = (bf16_t*)(ws + carve(off, (size_t)NU * LL * HD * 2));
    p.mbCum = (float*)(ws + carve(off, (size_t)NU * LL * 4));
    p.qkvn = (bf16_t*)(ws + carve(off, (size_t)TT * KUP * 2));
    p.Qm = (bf16_t*)(ws + carve(off, (size_t)TT * NH * MLA_QK * 2));
    p.Km = (bf16_t*)(ws + carve(off, (size_t)TT * NH * MLA_QK * 2));
    p.Vt = (bf16_t*)(ws + carve(off, (size_t)TT * NH * MLA_V * 2));
    const size_t endA = off;
    off = regA;
    p.yo = (bf16_t*)(ws + carve(off, (size_t)TT * D * 2));
    p.hperm = (bf16_t*)(ws + carve(off, (size_t)MPAD * D * 2));
    p.hidp = (bf16_t*)(ws + carve(off, (size_t)MPAD * D_EXP * 2));
    p.Fperm = (bf16_t*)(ws + carve(off, (size_t)MPAD * D * 2));
    const size_t endB = off;
    const size_t need = endA > endB ? endA : endB;
    if (need > ws_size) return;

    static int grid = 0;
    if (!grid) {
        int dev = 0, cus = 0, per_cu = 0;
        if (hipGetDevice(&dev) != hipSuccess || hipDeviceGetAttribute(&cus, hipDeviceAttributeMultiprocessorCount, dev) != hipSuccess) { grid = -1; return; }
        if (hipFuncSetAttribute((const void*)k_mega, hipFuncAttributeMaxDynamicSharedMemorySize, LDS_BYTES) != hipSuccess) { grid = -1; return; }
        if (hipOccupancyMaxActiveBlocksPerMultiprocessor(&per_cu, (const void*)k_mega, NT, LDS_BYTES) != hipSuccess) per_cu = 0;
        grid = cus * (per_cu < 1 ? per_cu : 1);
        if (grid <= 0) grid = -1;
    }
    if (grid <= 0) return;
    for (int k = 0; k < 16; ++k) a.reps[k] = 1;
#ifdef PROBE_GROUP
    a.reps[PROBE_GROUP] = 2;
#endif
    (void)hipMemsetAsync(a.bar, 0, (size_t)XCD_BAR_WORDS * 4, stream);
    hipLaunchKernelGGL(k_mega, dim3(grid), dim3(NT), LDS_BYTES, stream, a);
}
```

```cpp
#include <hip/hip_runtime.h>
#include <stdint.h>
#include <stddef.h>
#include <math.h>

#ifndef CFG_SMALL
constexpr int D = 2048, NB = 2, SEQ = 4096, DEPTH = 4, CTX = 256, GRID_W = 64;
constexpr int HD = 64;
constexpr int RW_WL = 64, RW_AL = 64, RW_GL = 128;
constexpr int MB_STATE = 128, MB_GROUPS = 2, MB_CONV = 5;
constexpr int MLA_NOPE = 64, MLA_ROPE = 32;
constexpr int NA_WR = 8, NA_WC = 16;
constexpr int NE = 16, NEG = 4;
#else
constexpr int D = 256, NB = 2, SEQ = 64, DEPTH = 2, CTX = 16, GRID_W = 8;
constexpr int HD = 16;
constexpr int RW_WL = 8, RW_AL = 8, RW_GL = 16;
constexpr int MB_STATE = 16, MB_GROUPS = 2, MB_CONV = 5;
constexpr int MLA_NOPE = 16, MLA_ROPE = 8;
constexpr int NA_WR = 4, NA_WC = 4;
constexpr int NE = 16, NEG = 4;
#endif
constexpr int GD = D / 4, NH = GD / HD, D_MIX = 4 * GD;
constexpr int MLA_QL = 3 * D / 16, MLA_KVL = D / 16;
constexpr int D_EXP = D / 4, EPG = NE / NEG;
constexpr int RW_IN = 3 * GD + 2 * RW_WL + 2 * RW_AL + RW_GL;
constexpr int MB_CONV_DIM = GD + 2 * MB_GROUPS * MB_STATE;
constexpr int MB_IN = GD + MB_CONV_DIM + 2 * NH;
constexpr int MLA_V = HD, MLA_QK = MLA_NOPE + MLA_ROPE;
constexpr int MLA_IN = MLA_QL + MLA_KVL + MLA_ROPE;
constexpr int NA_IN = 3 * GD;
constexpr int N_IN = RW_IN + MB_IN + MLA_IN + NA_IN;
constexpr int OFF_RW = 0, OFF_MB = RW_IN, OFF_MLA = RW_IN + MB_IN, OFF_NA = OFF_MLA + MLA_IN;
constexpr int LL = CTX + SEQ, TT = NB * LL;
constexpr int NMOD = NB + 1;
constexpr int MPAD = ((2 * TT + 255) / 256 + NE) * 256;
constexpr int N_INP = ((N_IN + 255) / 256) * 256;
constexpr int KLO = 2 * RW_WL + 2 * RW_AL + RW_GL, NLO = 5 * GD;
constexpr int KUP = MLA_QL + MLA_KVL, NUPQ = NH * MLA_QK, NUP = NUPQ + NH * (MLA_NOPE + MLA_V);
constexpr float LN_EPS = 1e-6f, RMS_EPS = 1e-6f, RW_GN_EPS = 64e-5f, RW_DECAY_SCALE = 0.606531f, ROUTED_SCALE = 2.5f;
constexpr float ROPE_BASE = 10000.0f;
#define DN_ALPHA (sqrtf(sqrtf(2.0f * (float)DEPTH)))

typedef unsigned short bf16_t;

#define DEVFN __device__ __forceinline__


DEVFN uint32_t f_as_u(float f) { union { float f; uint32_t u; } c; c.f = f; return c.u; }
DEVFN float u_as_f(uint32_t u) { union { float f; uint32_t u; } c; c.u = u; return c.f; }
DEVFN bf16_t f2bf(float f) { uint32_t u = f_as_u(f); u += 0x7fffu + ((u >> 16) & 1u); return (bf16_t)(u >> 16); }
DEVFN float bf2f(bf16_t h) { return u_as_f(((uint32_t)h) << 16); }
DEVFN int TIDX() { int t = (int)threadIdx.x; asm volatile("" : "+v"(t)); return t; }
DEVFN float bflo(unsigned w) { return u_as_f(w << 16); }
DEVFN float bfhi(unsigned w) { return u_as_f(w & 0xffff0000u); }
DEVFN unsigned pk2(float a, float b) { return (unsigned)f2bf(a) | ((unsigned)f2bf(b) << 16); }
DEVFN float sigmoidf_(float x) { return 1.0f / (1.0f + expf(-x)); }
DEVFN float siluf_(float x) { return x * sigmoidf_(x); }
DEVFN float softplusf_(float x) { return x > 20.0f ? x : log1pf(expf(x)); }

struct Params {
    const float *x, *c, *ctx, *c_ctx, *ada_w, *ada_b, *w_in, *w_out, *ln1_g, *ln1_b, *ln2_g, *ln2_b;
    const float *rw_mu, *rw_w0, *rw_w_up, *rw_a0, *rw_a_up, *rw_g_up, *rw_k_k, *rw_k_a, *rw_r_k, *rw_gn_g, *rw_gn_b;
    const float *mb_conv_w, *mb_conv_b, *mb_a_log, *mb_dt_bias, *mb_d, *mb_norm_g;
    const float *mla_q_norm, *mla_w_uq, *mla_kv_norm, *mla_w_ukv, *na_rpb, *router_w, *router_b, *exp_w_gate, *exp_w_up, *exp_w_down;
    float* out;
    bf16_t *WinT, *WoutT, *WguT, *WdT, *WupT;
    float* xs;
    bf16_t* xm;
    float* mod;
    float* modp;
    float2* ropecs;
    bf16_t* P;
    float* pm;
    bf16_t* pmb;
    bf16_t* LO;
    bf16_t* WloT;
    float *rwW, *rwB, *rwKD;
    float *rwKK, *rwG;
    bf16_t* rwMsT;
    float* rwSloc;
    bf16_t* rwYI;
    float* rwYloc;
    float* xc;
    float* dt;
    bf16_t* mbC;
    bf16_t* mbB;
    bf16_t* mbXT;
    bf16_t* mbBT;
    bf16_t* mbCS;
    bf16_t* mbYloc;
    float* mbCum;
    bf16_t* qkvn;
    float* QKVraw;
    int* qctr;
    bf16_t *Qm, *Km, *Vt;
    bf16_t* naVt;
    float* mlaO;
    float* mlaML;
    bf16_t* Ymix;
    bf16_t* yo;
    bf16_t* hb;
    int* cnt;
    int2 *tok_e, *tok_pos, *tok_row;
    float2* tok_w;
    bf16_t *hperm, *hidp, *Fperm;
};

DEVFN void ph_init(const Params& p, int l, size_t vt, size_t vs) {
    const size_t n = (size_t)TT * D;
    for (size_t i = vt; i < n; i += vs) {
        const int d = (int)(i % D); const int t = (int)(i / D); const int b = t / LL, s = t % LL;
        p.xs[i] = s < CTX ? p.ctx[((size_t)b * CTX + s) * D + d] : p.x[((size_t)b * SEQ + (s - CTX)) * D + d];
    }
    for (size_t i = vt; i < (size_t)GRID_W * (MLA_ROPE / 4); i += vs) {
        const int f = (int)(i % (MLA_ROPE / 4)), pos = (int)(i / (MLA_ROPE / 4));
        const float ang = (float)pos * powf(ROPE_BASE, -(float)f / (float)(MLA_ROPE / 4));
        p.ropecs[i] = make_float2(cosf(ang), sinf(ang));
    }
    for (size_t i = vt; i < (size_t)DEPTH * NE; i += vs) p.cnt[i] = 0;
    for (size_t i = vt; i < (size_t)DEPTH * 16; i += vs) p.qctr[i] = 0;
}

DEVFN void ph_transpose(const float* src, bf16_t* dst, int K, int N, int batch, size_t dst_bstride, int dst_row0, int ldd, int col0, size_t vt, size_t vs, size_t src_bstride = 0, int src_ld = 0) {
    if (src_ld == 0) src_ld = N;
    if (src_bstride == 0) src_bstride = (size_t)K * src_ld;
    const size_t total = (size_t)batch * (K / 8) * N;
    for (size_t idx = vt; idx < total; idx += vs) {
        const int n = (int)(idx % N); const int k8 = (int)((idx / N) % (K / 8)); const int bt = (int)(idx / ((size_t)N * (K / 8)));
        const float* sp = src + (size_t)bt * src_bstride + (size_t)(k8 * 8) * src_ld + n;
        uint4 w;
        const size_t sl_ = (size_t)src_ld;
        w.x = (unsigned)f2bf(sp[0]) | ((unsigned)f2bf(sp[sl_]) << 16); w.y = (unsigned)f2bf(sp[2 * sl_]) | ((unsigned)f2bf(sp[3 * sl_]) << 16);
        w.z = (unsigned)f2bf(sp[4 * sl_]) | ((unsigned)f2bf(sp[5 * sl_]) << 16); w.w = (unsigned)f2bf(sp[6 * sl_]) | ((unsigned)f2bf(sp[7 * sl_]) << 16);
        *(uint4*)(dst + (size_t)bt * dst_bstride + (size_t)(dst_row0 + n) * ldd + col0 + k8 * 8) = w;
    }
}
DEVFN void ph_zero16(uint4* dst, size_t n16, size_t vt, size_t vs) { for (size_t i = vt; i < n16; i += vs) dst[i] = make_uint4(0u, 0u, 0u, 0u); }
DEVFN void ph_transpose_t(const float* src, bf16_t* dst, int K, int N, int batch, size_t dst_bstride, int dst_row0, int ldd, int col0, bf16_t* smem, int vb, int nvb, size_t src_bstride = 0, int src_ld = 0) {
    constexpr int TQ = 8, TLD = 72;
    if (src_ld == 0) src_ld = N;
    if (src_bstride == 0) src_bstride = (size_t)K * src_ld;
    const int tid = TIDX(); const int r = tid >> 3, pc = tid & 7;
    const int kt = K / 64, nt = (N + 63) / 64; const int total = batch * kt * nt;
    for (int t0 = vb * TQ; t0 < total; t0 += nvb * TQ) {
        float4 va[TQ], vb4[TQ];
#pragma unroll
        for (int q = 0; q < TQ; ++q) {
            const int tile = t0 + q; const int tc = tile < total ? tile : total - 1;
            const int nti = tc % nt, kti = (tc / nt) % kt, bt = tc / (nt * kt);
            const int n0 = nti * 64 + pc * 8; const int nc = n0 + 8 <= N ? n0 : 0;
            const float* sp = src + (size_t)bt * src_bstride + (size_t)(kti * 64 + r) * src_ld + nc;
            va[q] = *(const float4*)sp; vb4[q] = *(const float4*)(sp + 4);
        }
        __syncthreads();
#pragma unroll
        for (int q = 0; q < TQ; ++q) {
            bf16_t* sm = smem + q * 64 * TLD + (pc * 8) * TLD + r;
            sm[0] = f2bf(va[q].x); sm[TLD] = f2bf(va[q].y); sm[2 * TLD] = f2bf(va[q].z); sm[3 * TLD] = f2bf(va[q].w);
            sm[4 * TLD] = f2bf(vb4[q].x); sm[5 * TLD] = f2bf(vb4[q].y); sm[6 * TLD] = f2bf(vb4[q].z); sm[7 * TLD] = f2bf(vb4[q].w);
        }
        __syncthreads();
#pragma unroll
        for (int q = 0; q < TQ; ++q) {
            const int tile = t0 + q;
            if (tile < total) {
                const int nti = tile % nt, kti = (tile / nt) % kt, bt = tile / (nt * kt);
                const int n = nti * 64 + r;
                if (n < N) *(uint4*)(dst + (size_t)bt * dst_bstride + (size_t)(dst_row0 + n) * ldd + col0 + kti * 64 + pc * 8) = *(const uint4*)(smem + q * 64 * TLD + r * TLD + pc * 8);
            }
        }
    }
    __syncthreads();
}

constexpr int MOD_IC = 128, MOD_NC = D / MOD_IC;
DEVFN void ph_mod_partial(const Params& p, size_t vt, size_t vs) {
    constexpr int J4 = 6 * D / 4;
    const size_t total = (size_t)DEPTH * MOD_NC * J4;
    for (size_t idx = vt; idx < total; idx += vs) {
        const int j4 = (int)(idx % J4); const int ic = (int)((idx / J4) % MOD_NC); const int l = (int)(idx / ((size_t)J4 * MOD_NC));
        float4 acc[NMOD];
#pragma unroll
        for (int r = 0; r < NMOD; ++r) acc[r] = make_float4(0.f, 0.f, 0.f, 0.f);
        const float* wp = p.ada_w + ((size_t)l * D + (size_t)ic * MOD_IC) * 6 * D + j4 * 4;
#pragma unroll 8
        for (int i = 0; i < MOD_IC; ++i) {
            const float4 w = *(const float4*)(wp + (size_t)i * 6 * D);
#pragma unroll
            for (int r = 0; r < NMOD; ++r) { const float cv = r < NB ? p.c[r * D + ic * MOD_IC + i] : p.c_ctx[ic * MOD_IC + i]; const float sv = siluf_(cv);
                acc[r].x += sv * w.x; acc[r].y += sv * w.y; acc[r].z += sv * w.z; acc[r].w += sv * w.w; }
        }
#pragma unroll
        for (int r = 0; r < NMOD; ++r) *(float4*)(p.modp + ((((size_t)l * MOD_NC + ic) * NMOD + r) * 6 * D) + j4 * 4) = acc[r];
    }
}
DEVFN void ph_mod_final(const Params& p, size_t vt, size_t vs) {
    const size_t total = (size_t)DEPTH * NMOD * 6 * D;
    for (size_t idx = vt; idx < total; idx += vs) {
        const int j = (int)(idx % (6 * D)); const int r = (int)((idx / (6 * D)) % NMOD); const int l = (int)(idx / ((size_t)6 * D * NMOD));
        float acc = p.ada_b[(size_t)l * 6 * D + j];
        for (int ic = 0; ic < MOD_NC; ++ic) acc += p.modp[(((size_t)l * MOD_NC + ic) * NMOD + r) * 6 * D + j];
        p.mod[idx] = acc;
    }
}

DEVFN void ph_modulate(const Params& p, int l, size_t vt, size_t vs) {
    const size_t n = (size_t)TT * D;
    for (size_t i = vt; i < n; i += vs) {
        const int d = (int)(i % D); const int t = (int)(i / D); const int b = t / LL, s = t % LL; const int r = s < CTX ? NB : b;
        const float* m = p.mod + ((size_t)l * NMOD + r) * 6 * D;
        p.xm[i] = f2bf(p.xs[i] * (1.0f + m[D + d]) + m[d]);
    }
}

typedef short bf16x8_t __attribute__((ext_vector_type(8)));
typedef float f32x16_t __attribute__((ext_vector_type(16)));
typedef __bf16 bf16v2_t __attribute__((ext_vector_type(2)));
typedef float f32v2_t __attribute__((ext_vector_type(2)));
DEVFN unsigned cvt_pk_bf16_h(float lo, float hi) { const f32v2_t v = {lo, hi}; const bf16v2_t r = __builtin_convertvector(v, bf16v2_t); return __builtin_bit_cast(unsigned, r); }
DEVFN unsigned cvt_pk_bf16(float lo, float hi) { unsigned r; asm volatile("v_cvt_pk_bf16_f32 %0, %1, %2" : "=v"(r) : "v"(lo), "v"(hi)); return r; }
union Frag8 { bf16x8_t v; unsigned u[4]; uint2 d2[2]; uint4 q; };


DEVFN void ph_rw_mix(const Params& p, int l, size_t vt, size_t vs) {
    static_assert(RW_IN % 8 == 0 && (3 * GD) % 8 == 0 && (2 * RW_WL) % 8 == 0 && (2 * RW_AL) % 8 == 0, "8-column groups");
    constexpr int NG = RW_IN / 8;
    const size_t n = (size_t)TT * NG;
    for (size_t i = vt; i < n; i += vs) {
        const int col = (int)(i % NG) * 8; const int t = (int)(i / NG); const int s_ = t % LL;
        const bool first = (s_ == 0 || s_ == CTX), last = (s_ == CTX - 1 || s_ == LL - 1);
        const bf16_t* pc = p.P + (size_t)t * N_IN + OFF_RW + col;
        const uint4 cv = *(const uint4*)pc;
        const uint4 pv = first ? make_uint4(0, 0, 0, 0) : *(const uint4*)(pc - N_IN);
        const uint4 nv = last ? make_uint4(0, 0, 0, 0) : *(const uint4*)(pc + N_IN);
        const float* m0 = p.rw_mu + ((size_t)l * 2 + 0) * RW_IN + col; const float* m1 = p.rw_mu + ((size_t)l * 2 + 1) * RW_IN + col;
        const float4 a0 = *(const float4*)m0, a1 = *(const float4*)(m0 + 4), b0 = *(const float4*)m1, b1 = *(const float4*)(m1 + 4);
        const float mu0[8] = {a0.x, a0.y, a0.z, a0.w, a1.x, a1.y, a1.z, a1.w}, mu1[8] = {b0.x, b0.y, b0.z, b0.w, b1.x, b1.y, b1.z, b1.w};
        const unsigned cw[4] = {cv.x, cv.y, cv.z, cv.w}, pw[4] = {pv.x, pv.y, pv.z, pv.w}, nw[4] = {nv.x, nv.y, nv.z, nv.w};
        float o[8];
#pragma unroll
        for (int k = 0; k < 4; ++k) {
            const float v0 = bflo(cw[k]), v1 = bfhi(cw[k]);
            o[2 * k] = v0 + mu0[2 * k] * (bflo(pw[k]) - v0) + mu1[2 * k] * (bflo(nw[k]) - v0);
            o[2 * k + 1] = v1 + mu0[2 * k + 1] * (bfhi(pw[k]) - v1) + mu1[2 * k + 1] * (bfhi(nw[k]) - v1);
        }
        if (col >= 3 * GD && col < 3 * GD + 2 * RW_WL) {
#pragma unroll
            for (int k = 0; k < 8; ++k) o[k] = tanhf(o[k]);
        } else if (col >= 3 * GD + 2 * RW_WL + 2 * RW_AL) {
#pragma unroll
            for (int k = 0; k < 8; ++k) o[k] = sigmoidf_(o[k]);
        }
        float* po = p.pm + (size_t)t * RW_IN + col;
        *(float4*)po = make_float4(o[0], o[1], o[2], o[3]); *(float4*)(po + 4) = make_float4(o[4], o[5], o[6], o[7]);
        if (col >= 3 * GD) *(uint4*)(p.pmb + (size_t)t * KLO + (col - 3 * GD)) = make_uint4(pk2(o[0], o[1]), pk2(o[2], o[3]), pk2(o[4], o[5]), pk2(o[6], o[7]));
    }
}

DEVFN void ph_rw_prep(const Params& p, int l, size_t vt, size_t vs) {
    static_assert(HD == 64, "one head = 16 lanes x 4 columns");
    constexpr int NG = GD / 4;
    const size_t n = (size_t)TT * NG;
    for (size_t i = vt; i < n; i += vs) {
        const int c = (int)(i % NG) * 4; const int t = (int)(i / NG);
        const float4 k4 = *(const float4*)(p.pm + (size_t)t * RW_IN + GD + c);
        const float4 kk4 = *(const float4*)(p.rw_k_k + (size_t)l * GD + c), ka4 = *(const float4*)(p.rw_k_a + (size_t)l * GD + c);
        const float k[4] = {k4.x, k4.y, k4.z, k4.w}, kkw[4] = {kk4.x, kk4.y, kk4.z, kk4.w}, ka[4] = {ka4.x, ka4.y, ka4.z, ka4.w};
        float kkr[4], ss = 0.f;
#pragma unroll
        for (int q = 0; q < 4; ++q) { kkr[q] = k[q] * kkw[q]; ss += kkr[q] * kkr[q]; }
#pragma unroll
        for (int o = 8; o > 0; o >>= 1) ss += __shfl_xor(ss, o);
        const float rn = 1.0f / sqrtf(fmaxf(ss, 1e-12f));
        const bf16_t* lo = p.LO + (size_t)t * NLO + c;
        float kkv[4];
#pragma unroll
        for (int q = 0; q < 4; ++q) kkv[q] = kkr[q] * rn;
#pragma unroll
        for (int dir = 0; dir < 2; ++dir) {
            const uint2 wl = *(const uint2*)(lo + dir * GD), al = *(const uint2*)(lo + 2 * GD + dir * GD);
            const float4 w0 = *(const float4*)(p.rw_w0 + ((size_t)l * 2 + dir) * GD + c), a0 = *(const float4*)(p.rw_a0 + ((size_t)l * 2 + dir) * GD + c);
            const float wp[4] = {w0.x + bflo(wl.x), w0.y + bfhi(wl.x), w0.z + bflo(wl.y), w0.w + bfhi(wl.y)};
            const float ap[4] = {a0.x + bflo(al.x), a0.y + bfhi(al.x), a0.z + bflo(al.y), a0.w + bfhi(al.y)};
            float dec[4], bv[4], kd[4];
#pragma unroll
            for (int q = 0; q < 4; ++q) { const float av = sigmoidf_(ap[q]); dec[q] = expf(-RW_DECAY_SCALE * sigmoidf_(wp[q])); bv[q] = kkv[q] * av; kd[q] = k[q] * (1.0f + (av - 1.0f) * ka[q]); }
            const size_t o = ((size_t)dir * TT + t) * GD + c;
            *(float4*)(p.rwW + o) = make_float4(dec[0], dec[1], dec[2], dec[3]); *(float4*)(p.rwB + o) = make_float4(bv[0], bv[1], bv[2], bv[3]); *(float4*)(p.rwKD + o) = make_float4(kd[0], kd[1], kd[2], kd[3]);
        }
        const uint2 gl = *(const uint2*)(lo + 4 * GD);
        *(float4*)(p.rwKK + (size_t)t * GD + c) = make_float4(kkv[0], kkv[1], kkv[2], kkv[3]);
        *(float4*)(p.rwG + (size_t)t * GD + c) = make_float4(bflo(gl.x), bfhi(gl.x), bflo(gl.y), bfhi(gl.y));
    }
}

DEVFN int scan_pos(int dir, int step) {
    if (dir == 0) return step;
    return step < CTX ? (CTX - 1 - step) : (CTX + (SEQ - 1) - (step - CTX));
}

constexpr int CK = 64, NCHK = LL / CK, NU = NB * NH * 2;
constexpr int RWS = 8;
constexpr int RW_ROW = 6 * HD;
constexpr int RW_STG = RWS * RW_ROW;
typedef float f2v __attribute__((ext_vector_type(2)));
template <int MODE>
DEVFN void rw_chunk_item(const Params& p, float* lds_f, const int item) {
    constexpr bool DO_T = MODE != 2, DO_L = MODE != 1;
    static_assert(HD == 64 && CTX % CK == 0 && SEQ % CK == 0 && CK % RWS == 0, "chunking");
    const int lane = (TIDX() & 63);
    float* stg = lds_f + (size_t)__builtin_amdgcn_readfirstlane((TIDX() >> 6)) * RW_STG;
    {
        const int c = item % NCHK, u = item / NCHK;
        const int dir = u % 2, h = (u / 2) % NH, b = u / (2 * NH);
        f2v ST[HD / 2], SL[HD / 2];
#pragma unroll
        for (int j = 0; j < HD / 2; ++j) { ST[j] = (f2v){(2 * j == lane) ? 1.f : 0.f, (2 * j + 1 == lane) ? 1.f : 0.f}; SL[j] = (f2v){0.f, 0.f}; }
        float4 na0, na1, na2, na3, na4, na5, nb0, nb1, nb2, nb3, nb4, nb5;
#define RWC_LOAD1(q_, sub_, X0, X1, X2, X3, X4, X5) do { const int t_ = b * LL + scan_pos(dir, c * CK + (sub_) * RWS + (q_) * 4 + lrow_); \
                X0 = *(const float4*)(p.rwW + ((size_t)dir * TT + t_) * GD + h * HD + lcol_); X1 = *(const float4*)(p.rwB + ((size_t)dir * TT + t_) * GD + h * HD + lcol_); \
                X2 = *(const float4*)(p.rwKD + ((size_t)dir * TT + t_) * GD + h * HD + lcol_); X3 = *(const float4*)(p.rwKK + (size_t)t_ * GD + h * HD + lcol_); \
                X4 = *(const float4*)(p.pm + (size_t)t_ * RW_IN + h * HD + lcol_); X5 = *(const float4*)(p.pm + (size_t)t_ * RW_IN + 2 * GD + h * HD + lcol_); } while (0)
#define RWC_LOAD(sub_) do { int lrow_ = lane >> 4, lcol_ = (lane & 15) * 4; asm volatile("" : "+v"(lrow_), "+v"(lcol_)); \
            RWC_LOAD1(0, sub_, na0, na1, na2, na3, na4, na5); RWC_LOAD1(1, sub_, nb0, nb1, nb2, nb3, nb4, nb5); } while (0)
        RWC_LOAD(0);
#pragma unroll 1
        for (int sub = 0; sub < CK / RWS; ++sub) {
            __builtin_amdgcn_wave_barrier();
            {
                int lrow = lane >> 4, lcol = (lane & 15) * 4;
                asm volatile("" : "+v"(lrow), "+v"(lcol));
                float* d0 = stg + (lrow) * RW_ROW + lcol; float* d1 = stg + (4 + lrow) * RW_ROW + lcol;
                *(float4*)(d0) = na0; *(float4*)(d0 + HD) = na1; *(float4*)(d0 + 2 * HD) = na2; *(float4*)(d0 + 3 * HD) = na3; *(float4*)(d0 + 4 * HD) = na4; *(float4*)(d0 + 5 * HD) = na5;
                *(float4*)(d1) = nb0; *(float4*)(d1 + HD) = nb1; *(float4*)(d1 + 2 * HD) = nb2; *(float4*)(d1 + 3 * HD) = nb3; *(float4*)(d1 + 4 * HD) = nb4; *(float4*)(d1 + 5 * HD) = nb5;
            }
            if (sub + 1 < CK / RWS) RWC_LOAD(sub + 1);
            __builtin_amdgcn_wave_barrier();
#pragma unroll 1
            for (int st = 0; st < RWS; ++st) {
                const float* sv = stg + st * RW_ROW;
                const int gs = c * CK + sub * RWS + st;
                f2v aT = {0.f, 0.f}, aL = {0.f, 0.f};
                float4 kkn = *(const float4*)(sv + 3 * HD);
#pragma unroll
                for (int j = 0; j < HD; j += 4) {
                    const float4 kk = kkn;
                    if (j + 4 < HD) kkn = *(const float4*)(sv + 3 * HD + j + 4);
                    asm volatile("" ::: "memory");
                    const f2v k0 = {kk.x, kk.y}, k1 = {kk.z, kk.w};
                    if (DO_T) { aT += ST[j / 2] * k0; aT += ST[j / 2 + 1] * k1; }
                    if (DO_L) { aL += SL[j / 2] * k0; aL += SL[j / 2 + 1] * k1; }
                }
                const float saT = -(aT.x + aT.y), saL = -(aL.x + aL.y);
                const f2v saT2 = {saT, saT}, saL2 = {saL, saL};
                int ln0 = lane; asm volatile("" : "+v"(ln0));
                const float vi = sv[5 * HD + ln0];
                const f2v vi2 = {vi, vi};
                f2v yT2 = {0.f, 0.f}, yL2 = {0.f, 0.f};
                float4 wn = *(const float4*)(sv), bn = *(const float4*)(sv + HD), kdn = *(const float4*)(sv + 2 * HD), rn = *(const float4*)(sv + 4 * HD);
#pragma unroll
                for (int j = 0; j < HD; j += 4) {
                    const float4 w = wn, bb = bn, kd = kdn, r = rn;
                    if (j + 4 < HD) { wn = *(const float4*)(sv + j + 4); bn = *(const float4*)(sv + HD + j + 4); if (DO_L) kdn = *(const float4*)(sv + 2 * HD + j + 4); rn = *(const float4*)(sv + 4 * HD + j + 4); }
                    asm volatile("" ::: "memory");
                    const f2v w0 = {w.x, w.y}, w1 = {w.z, w.w}, b0 = {bb.x, bb.y}, b1 = {bb.z, bb.w}, r0 = {r.x, r.y}, r1 = {r.z, r.w};
                    if (DO_T) {
                        ST[j / 2] = ST[j / 2] * w0 + saT2 * b0; ST[j / 2 + 1] = ST[j / 2 + 1] * w1 + saT2 * b1;
                        yT2 += ST[j / 2] * r0; yT2 += ST[j / 2 + 1] * r1;
                    }
                    if (DO_L) {
                        const f2v d0 = {kd.x, kd.y}, d1 = {kd.z, kd.w};
                        SL[j / 2] = SL[j / 2] * w0 + saL2 * b0 + vi2 * d0; SL[j / 2 + 1] = SL[j / 2 + 1] * w1 + saL2 * b1 + vi2 * d1;
                        yL2 += SL[j / 2] * r0; yL2 += SL[j / 2 + 1] * r1;
                    }
                }
                int ln = lane; asm volatile("" : "+v"(ln));
                if (DO_T) p.rwYI[((size_t)u * LL + gs) * HD + ln] = f2bf(yT2.x + yT2.y);
                if (DO_L) p.rwYloc[((size_t)u * LL + gs) * HD + ln] = yL2.x + yL2.y;
            }
        }
#undef RWC_LOAD
#undef RWC_LOAD1
        if (DO_T) {
        bf16_t* oT = p.rwMsT + ((size_t)u * NCHK + c) * HD * HD;
#pragma unroll
        for (int j = 0; j < HD; ++j) oT[(size_t)j * HD + lane] = f2bf((j & 1) ? ST[j / 2].y : ST[j / 2].x);
        }
        if (DO_L) {
        float* oL = p.rwSloc + (((size_t)u * NCHK + c) * HD + lane) * HD;
#pragma unroll
        for (int j = 0; j < HD; j += 4) *(float4*)(oL + j) = make_float4(SL[j / 2].x, SL[j / 2].y, SL[j / 2 + 1].x, SL[j / 2 + 1].y);
        }
    }
}

constexpr int RSQ_D = 4;
constexpr int RSQ_SLOT = HD * HD * 2 + HD * HD * 4;
DEVFN void ph_rw_seq(const Params& p, unsigned char* lds_b, int vb, int nvb) {
    static_assert(NCHK % RSQ_D == 0 && RSQ_D == 4 && RSQ_SLOT == 3 * 512 * 16, "chain geometry: 3 x 16 B per thread per chunk");
    const int tid = TIDX(), lane = tid & 63, wave = tid >> 6, li = lane & 31, lh = lane >> 5;
    for (int u = vb; u < NU; u += nvb) {
        const unsigned char* gM = (const unsigned char*)(p.rwMsT + (size_t)u * NCHK * HD * HD);
        const unsigned char* gS = (const unsigned char*)(p.rwSloc + (size_t)u * NCHK * HD * HD);
        uint4 pf[RSQ_D][3];
#define RSQ_LOAD(d, c_) do { pf[d][0] = *(const uint4*)(gM + (size_t)(c_) * (HD * HD * 2) + tid * 16); \
            pf[d][1] = *(const uint4*)(gS + (size_t)(c_) * (HD * HD * 4) + tid * 16); pf[d][2] = *(const uint4*)(gS + (size_t)(c_) * (HD * HD * 4) + 8192 + tid * 16); } while (0)
#pragma unroll
        for (int d = 0; d < RSQ_D; ++d) RSQ_LOAD(d, d);
        f32x16_t X0, X1;
#pragma unroll
        for (int r = 0; r < 16; ++r) { X0[r] = 0.f; X1[r] = 0.f; }
        const int i = wave * 32 + li;
        __syncthreads();
#define RSQ_STEP(d, P0, P1, P2) { \
                const int c = c0 + d; \
                unsigned char* slot = lds_b + (c & 1) * RSQ_SLOT; \
                *(uint4*)(slot + tid * 16) = P0; *(uint4*)(slot + HD * HD * 2 + tid * 16) = P1; *(uint4*)(slot + HD * HD * 2 + 8192 + tid * 16) = P2; \
                if (c + RSQ_D < NCHK) { P0 = *(const uint4*)(gM + (size_t)(c + RSQ_D) * (HD * HD * 2) + tid * 16); P1 = *(const uint4*)(gS + (size_t)(c + RSQ_D) * (HD * HD * 4) + tid * 16); P2 = *(const uint4*)(gS + (size_t)(c + RSQ_D) * (HD * HD * 4) + 8192 + tid * 16); } \
                __syncthreads(); \
                if (wave < 2) { \
                    const bf16_t* ms = (const bf16_t*)slot; const float* sl = (const float*)(slot + HD * HD * 2) + (size_t)i * HD; \
                    Frag8 xb[2][2]; \
_Pragma("unroll") \
                    for (int sp = 0; sp < 2; ++sp) \
_Pragma("unroll") \
                        for (int q = 0; q < 4; ++q) { \
                            xb[0][sp].u[q] = cvt_pk_bf16_h(X0[8 * sp + 2 * q], X0[8 * sp + 2 * q + 1]); \
                            xb[1][sp].u[q] = cvt_pk_bf16_h(X1[8 * sp + 2 * q], X1[8 * sp + 2 * q + 1]); \
                        } \
                    f32x16_t N0, N1; \
_Pragma("unroll") \
                    for (int g = 0; g < 4; ++g) { \
                        const float4 v0 = *(const float4*)(sl + 8 * g + 4 * lh), v1 = *(const float4*)(sl + 32 + 8 * g + 4 * lh); \
                        N0[4 * g] = v0.x; N0[4 * g + 1] = v0.y; N0[4 * g + 2] = v0.z; N0[4 * g + 3] = v0.w; \
                        N1[4 * g] = v1.x; N1[4 * g + 1] = v1.y; N1[4 * g + 2] = v1.z; N1[4 * g + 3] = v1.w; \
                    } \
_Pragma("unroll") \
                    for (int jb = 0; jb < 2; ++jb) \
_Pragma("unroll") \
                        for (int sp = 0; sp < 2; ++sp) { \
                            Frag8 a0, a1; \
                            a0.d2[0] = *(const uint2*)(ms + (li) * HD + 32 * jb + 16 * sp + 4 * lh); a0.d2[1] = *(const uint2*)(ms + (li) * HD + 32 * jb + 16 * sp + 4 * lh + 8); \
                            a1.d2[0] = *(const uint2*)(ms + (32 + li) * HD + 32 * jb + 16 * sp + 4 * lh); a1.d2[1] = *(const uint2*)(ms + (32 + li) * HD + 32 * jb + 16 * sp + 4 * lh + 8); \
                            N0 = __builtin_amdgcn_mfma_f32_32x32x16_bf16(a0.v, xb[jb][sp].v, N0, 0, 0, 0); \
                            N1 = __builtin_amdgcn_mfma_f32_32x32x16_bf16(a1.v, xb[jb][sp].v, N1, 0, 0, 0); \
                        } \
                    float* so = p.rwSloc + (((size_t)u * NCHK + c) * HD + i) * HD; \
_Pragma("unroll") \
                    for (int g = 0; g < 4; ++g) { \
                        *(float4*)(so + 8 * g + 4 * lh) = make_float4(N0[4 * g], N0[4 * g + 1], N0[4 * g + 2], N0[4 * g + 3]); \
                        *(float4*)(so + 32 + 8 * g + 4 * lh) = make_float4(N1[4 * g], N1[4 * g + 1], N1[4 * g + 2], N1[4 * g + 3]); \
                    } \
                    X0 = N0; X1 = N1; \
                } \
 \
            }
        uint4 pa0, pa1, pa2, pb0, pb1, pb2, pc0, pc1, pc2, pd0, pd1, pd2;
        pa0 = pf[0][0]; pa1 = pf[0][1]; pa2 = pf[0][2]; pb0 = pf[1][0]; pb1 = pf[1][1]; pb2 = pf[1][2]; pc0 = pf[2][0]; pc1 = pf[2][1]; pc2 = pf[2][2]; pd0 = pf[3][0]; pd1 = pf[3][1]; pd2 = pf[3][2];
        for (int c0 = 0; c0 < NCHK; c0 += RSQ_D) {
            RSQ_STEP(0, pa0, pa1, pa2) RSQ_STEP(1, pb0, pb1, pb2) RSQ_STEP(2, pc0, pc1, pc2) RSQ_STEP(3, pd0, pd1, pd2)
        }
#undef RSQ_LOAD
#undef RSQ_STEP
        __syncthreads();
    }
}

DEVFN int rev_gs(int s) { return s < CTX ? (CTX - 1 - s) : (CTX + (SEQ - 1) - (s - CTX)); }
DEVFN int rev_chunk(int pbk) { return pbk < CTX / CK ? (CTX / CK - 1 - pbk) : (CTX / CK + (SEQ / CK - 1) - (pbk - CTX / CK)); }

DEVFN void ph_rw_yout(const Params& p, int l, size_t vt, size_t vs) {
    const int lane = (TIDX() & 63), lq = lane & 31, lh = lane >> 5;
    const int wv = __builtin_amdgcn_readfirstlane((int)(vt >> 6)), nwv = (int)(vs >> 6);
    const int wvs = (wv & 7) * (nwv >> 3) + (wv >> 3);
    for (int item = wvs; item < NB * NH * NCHK; item += nwv) {
        const int pbk = item % NCHK, h = (item / NCHK) % NH, b = item / (NCHK * NH);
        f32x16_t acc[2][2];
#pragma unroll
        for (int dir = 0; dir < 2; ++dir) {
            const int u = (b * NH + h) * 2 + dir;
            const int c = dir == 0 ? pbk : rev_chunk(pbk);
            int gs[2];
#pragma unroll
            for (int tb = 0; tb < 2; ++tb) { const int s_ = CK * pbk + 32 * tb + lq; gs[tb] = dir == 0 ? s_ : rev_gs(s_); }
#pragma unroll
            for (int tb = 0; tb < 2; ++tb) {
                const float* yl = p.rwYloc + ((size_t)u * LL + gs[tb]) * HD;
#pragma unroll
                for (int ib = 0; ib < 2; ++ib)
#pragma unroll
                    for (int g = 0; g < 4; ++g) {
                        const float4 v = *(const float4*)(yl + 32 * ib + 8 * g + 4 * lh);
                        if (dir == 0) { acc[ib][tb][4 * g] = v.x; acc[ib][tb][4 * g + 1] = v.y; acc[ib][tb][4 * g + 2] = v.z; acc[ib][tb][4 * g + 3] = v.w; }
                        else { acc[ib][tb][4 * g] += v.x; acc[ib][tb][4 * g + 1] += v.y; acc[ib][tb][4 * g + 2] += v.z; acc[ib][tb][4 * g + 3] += v.w; }
                    }
            }
            if (c > 0) {
                const float* st = p.rwSloc + ((size_t)u * NCHK + (c - 1)) * HD * HD;
#pragma unroll
                for (int ks = 0; ks < 4; ++ks) {
                    Frag8 a[2];
#pragma unroll
                    for (int ib = 0; ib < 2; ++ib) {
                        const float4 lo = *(const float4*)(st + (size_t)(32 * ib + lq) * HD + 16 * ks + 8 * lh), hi = *(const float4*)(st + (size_t)(32 * ib + lq) * HD + 16 * ks + 8 * lh + 4);
                        a[ib].u[0] = cvt_pk_bf16_h(lo.x, lo.y); a[ib].u[1] = cvt_pk_bf16_h(lo.z, lo.w); a[ib].u[2] = cvt_pk_bf16_h(hi.x, hi.y); a[ib].u[3] = cvt_pk_bf16_h(hi.z, hi.w);
                    }
#pragma unroll
                    for (int tb = 0; tb < 2; ++tb) {
                        const bf16x8_t bq = *(const bf16x8_t*)(p.rwYI + ((size_t)u * LL + gs[tb]) * HD + 16 * ks + 8 * lh);
#pragma unroll
                        for (int ib = 0; ib < 2; ++ib) acc[ib][tb] = __builtin_amdgcn_mfma_f32_32x32x16_bf16(a[ib].v, bq, acc[ib][tb], 0, 0, 0);
                    }
                }
            }
        }
#pragma unroll
        for (int tb = 0; tb < 2; ++tb) {
            const int t = b * LL + CK * pbk + 32 * tb + lq;
            float sum = 0.f;
#pragma unroll
            for (int ib = 0; ib < 2; ++ib)
#pragma unroll
                for (int r = 0; r < 16; ++r) sum += acc[ib][tb][r];
            sum += __shfl_xor(sum, 32);
            const float mu = sum * (1.0f / HD);
            float sq = 0.f;
#pragma unroll
            for (int ib = 0; ib < 2; ++ib)
#pragma unroll
                for (int r = 0; r < 16; ++r) { const float d = acc[ib][tb][r] - mu; sq += d * d; }
            sq += __shfl_xor(sq, 32);
            const float rs = 1.0f / sqrtf(sq * (1.0f / HD) + RW_GN_EPS);
            const float* pr = p.pm + (size_t)t * RW_IN + h * HD;
            float bon = 0.f;
#pragma unroll
            for (int ib = 0; ib < 2; ++ib)
#pragma unroll
                for (int g = 0; g < 4; ++g) {
                    const int i0 = 32 * ib + 8 * g + 4 * lh;
                    const float4 r4 = *(const float4*)(pr + i0), k4 = *(const float4*)(pr + GD + i0), rk = *(const float4*)(p.rw_r_k + (size_t)l * GD + h * HD + i0);
                    bon += r4.x * k4.x * rk.x + r4.y * k4.y * rk.y + r4.z * k4.z * rk.z + r4.w * k4.w * rk.w;
                }
            bon += __shfl_xor(bon, 32);
#pragma unroll
            for (int ib = 0; ib < 2; ++ib)
#pragma unroll
                for (int g = 0; g < 4; ++g) {
                    const int i0 = 32 * ib + 8 * g + 4 * lh;
                    const float4 v4 = *(const float4*)(pr + 2 * GD + i0), g4 = *(const float4*)(p.rwG + (size_t)t * GD + h * HD + i0);
                    const float4 gg = *(const float4*)(p.rw_gn_g + (size_t)l * GD + h * HD + i0), gb = *(const float4*)(p.rw_gn_b + (size_t)l * GD + h * HD + i0);
                    const float o0 = ((acc[ib][tb][4 * g] - mu) * rs * gg.x + gb.x + bon * v4.x) * g4.x, o1 = ((acc[ib][tb][4 * g + 1] - mu) * rs * gg.y + gb.y + bon * v4.y) * g4.y;
                    const float o2 = ((acc[ib][tb][4 * g + 2] - mu) * rs * gg.z + gb.z + bon * v4.z) * g4.z, o3 = ((acc[ib][tb][4 * g + 3] - mu) * rs * gg.w + gb.w + bon * v4.w) * g4.w;
                    uint2 w; w.x = cvt_pk_bf16(o0, o1); w.y = cvt_pk_bf16(o2, o3);
                    *(uint2*)(p.Ymix + (size_t)t * D_MIX + 0 * GD + h * HD + i0) = w;
                }
        }
    }
}

DEVFN void ph_mb_prep(const Params& p, int l, size_t vt, size_t vs) {
    static_assert(MB_CONV_DIM % 8 == 0 && MB_CONV == 5 && (GD + MB_GROUPS * MB_STATE) % 8 == 0, "8-channel groups");
    constexpr int NG = MB_CONV_DIM / 8;
    const size_t n = (size_t)TT * NG;
    for (size_t i = vt; i < n; i += vs) {
        const int c = (int)(i % NG) * 8; const int t = (int)(i / NG); const int s_ = t % LL;
        const int lo = s_ < CTX ? 0 : CTX, hi = s_ < CTX ? CTX : LL;
        const float4 b0 = *(const float4*)(p.mb_conv_b + (size_t)l * MB_CONV_DIM + c), b1 = *(const float4*)(p.mb_conv_b + (size_t)l * MB_CONV_DIM + c + 4);
        float acc[8] = {b0.x, b0.y, b0.z, b0.w, b1.x, b1.y, b1.z, b1.w};
#pragma unroll
        for (int j = 0; j < MB_CONV; ++j) {
            const int so = s_ + j - MB_CONV / 2;
            if (so >= lo && so < hi) {
                const uint4 xv = *(const uint4*)(p.P + (size_t)(t + j - MB_CONV / 2) * N_IN + OFF_MB + GD + c);
                const float* wp = p.mb_conv_w + ((size_t)l * MB_CONV + j) * MB_CONV_DIM + c;
                const float4 w0 = *(const float4*)wp, w1 = *(const float4*)(wp + 4);
                acc[0] += w0.x * bflo(xv.x); acc[1] += w0.y * bfhi(xv.x); acc[2] += w0.z * bflo(xv.y); acc[3] += w0.w * bfhi(xv.y);
                acc[4] += w1.x * bflo(xv.z); acc[5] += w1.y * bfhi(xv.z); acc[6] += w1.z * bflo(xv.w); acc[7] += w1.w * bfhi(xv.w);
            }
        }
#pragma unroll
        for (int k = 0; k < 8; ++k) acc[k] = siluf_(acc[k]);
        float* xo = p.xc + (size_t)t * MB_CONV_DIM + c;
        *(float4*)xo = make_float4(acc[0], acc[1], acc[2], acc[3]); *(float4*)(xo + 4) = make_float4(acc[4], acc[5], acc[6], acc[7]);
        if (c >= GD && c < GD + MB_GROUPS * MB_STATE) *(uint4*)(p.mbB + (size_t)t * (MB_GROUPS * MB_STATE) + (c - GD)) = make_uint4(pk2(acc[0], acc[1]), pk2(acc[2], acc[3]), pk2(acc[4], acc[5]), pk2(acc[6], acc[7]));
        if (c >= GD + MB_GROUPS * MB_STATE) *(uint4*)(p.mbC + (size_t)t * (MB_GROUPS * MB_STATE) + (c - GD - MB_GROUPS * MB_STATE)) = make_uint4(pk2(acc[0], acc[1]), pk2(acc[2], acc[3]), pk2(acc[4], acc[5]), pk2(acc[6], acc[7]));
    }
    const size_t n2 = (size_t)TT * 2 * NH;
    for (size_t i = vt; i < n2; i += vs) {
        const int q = (int)(i % (2 * NH)); const int t = (int)(i / (2 * NH));
        p.dt[i] = softplusf_(bf2f(p.P[(size_t)t * N_IN + OFF_MB + GD + MB_CONV_DIM + q]) + p.mb_dt_bias[(size_t)l * 2 * NH + q]);
    }
}

constexpr int MB_STG = 256;
DEVFN void mb_chunk_item(const Params& p, int l, float* lds_f, const int item) {
    static_assert(MB_STATE == 128 && HD == 64 && CK == 64, "mamba chunk geometry");
    const int lane = (TIDX() & 63), lq = lane & 31, lh = lane >> 5;
    (void)lds_f;
    const int pbk = item % NCHK, dir = (item / NCHK) & 1, h = (item / (2 * NCHK)) % NH, b = item / (2 * NCHK * NH);
    const int grp = h / (NH / MB_GROUPS), u = (b * NH + h) * 2 + dir;
    const int c = dir == 0 ? pbk : rev_chunk(pbk);
    const int t0 = b * LL + CK * pbk;
    const float A = -expf(p.mb_a_log[((size_t)l * 2 + dir) * NH + h]);
    const float dtv = p.dt[(size_t)(t0 + lane) * 2 * NH + dir * NH + h];
    float cum = dtv * A;
#pragma unroll
    for (int o = 1; o < 64; o <<= 1) { const float v = __shfl(cum, dir == 0 ? lane - o : lane + o); if (dir == 0 ? lane >= o : lane + o < 64) cum += v; }
    const float ctot = __shfl(cum, dir == 0 ? 63 : 0);
    const int gs = dir == 0 ? CK * pbk + lane : rev_gs(CK * pbk + lane);
    p.mbCum[(size_t)u * LL + gs] = cum;
    const float wsc = expf(ctot - cum) * dtv;
    f32x16_t G[2][2];
#pragma unroll
    for (int st = 0; st < 2; ++st)
#pragma unroll
        for (int tt = 0; tt < 2; ++tt)
#pragma unroll
            for (int r = 0; r < 16; ++r) G[st][tt][r] = 0.f;
    const bf16_t* Bg = p.mbB + (size_t)t0 * (MB_GROUPS * MB_STATE) + grp * MB_STATE; const bf16_t* Cg = p.mbC + (size_t)t0 * (MB_GROUPS * MB_STATE) + grp * MB_STATE;
#pragma unroll
    for (int ks = 0; ks < 8; ++ks) {
        bf16x8_t af[2], bfg[2];
#pragma unroll
        for (int q = 0; q < 2; ++q) { af[q] = *(const bf16x8_t*)(Bg + (size_t)(32 * q + lq) * (MB_GROUPS * MB_STATE) + 16 * ks + 8 * lh); bfg[q] = *(const bf16x8_t*)(Cg + (size_t)(32 * q + lq) * (MB_GROUPS * MB_STATE) + 16 * ks + 8 * lh); }
#pragma unroll
        for (int st = 0; st < 2; ++st)
#pragma unroll
            for (int tt = 0; tt < 2; ++tt) G[st][tt] = __builtin_amdgcn_mfma_f32_32x32x16_bf16(af[st], bfg[tt], G[st][tt], 0, 0, 0);
    }
    Frag8 pf[2][2][2];
#pragma unroll
    for (int tt = 0; tt < 2; ++tt) {
        const int et = 32 * tt + lq; const float cumt = __shfl(cum, et);
#pragma unroll
        for (int st = 0; st < 2; ++st) {
            float mv[16];
#pragma unroll
            for (int g = 0; g < 4; ++g) {
                const int es0 = 32 * st + 8 * g + 4 * lh;
                const float csv[4] = {__shfl(cum, es0), __shfl(cum, es0 + 1), __shfl(cum, es0 + 2), __shfl(cum, es0 + 3)};
                const float dtq[4] = {__shfl(dtv, es0), __shfl(dtv, es0 + 1), __shfl(dtv, es0 + 2), __shfl(dtv, es0 + 3)};
#pragma unroll
                for (int q = 0; q < 4; ++q) { const int es = es0 + q; const bool on = dir == 0 ? es <= et : es >= et; mv[4 * g + q] = on ? G[st][tt][4 * g + q] * expf(fminf(cumt - csv[q], 0.f)) * dtq[q] : 0.f; }
            }
#pragma unroll
            for (int sp = 0; sp < 2; ++sp)
#pragma unroll
                for (int j = 0; j < 4; ++j) pf[st][tt][sp].u[j] = cvt_pk_bf16_h(mv[8 * sp + 2 * j], mv[8 * sp + 2 * j + 1]);
        }
    }
    const bf16_t* Xg = p.mbXT + ((size_t)(b * NH + h) * HD) * LL + (size_t)CK * pbk;
    {
        f32x16_t Y[2][2];
#pragma unroll
        for (int pt = 0; pt < 2; ++pt)
#pragma unroll
            for (int tt = 0; tt < 2; ++tt)
#pragma unroll
                for (int r = 0; r < 16; ++r) Y[pt][tt][r] = 0.f;
#pragma unroll
        for (int st = 0; st < 2; ++st)
#pragma unroll
            for (int sp = 0; sp < 2; ++sp) {
                Frag8 xa[2];
#pragma unroll
                for (int pt = 0; pt < 2; ++pt) { const bf16_t* xr = Xg + (size_t)(32 * pt + lq) * LL + 32 * st + 16 * sp + 4 * lh; xa[pt].d2[0] = *(const uint2*)xr; xa[pt].d2[1] = *(const uint2*)(xr + 8); }
#pragma unroll
                for (int pt = 0; pt < 2; ++pt)
#pragma unroll
                    for (int tt = 0; tt < 2; ++tt) Y[pt][tt] = __builtin_amdgcn_mfma_f32_32x32x16_bf16(xa[pt].v, pf[st][tt][sp].v, Y[pt][tt], 0, 0, 0);
            }
#pragma unroll
        for (int tt = 0; tt < 2; ++tt) {
            const int e = 32 * tt + lq; const int gse = dir == 0 ? CK * pbk + e : rev_gs(CK * pbk + e);
            bf16_t* yo = p.mbYloc + ((size_t)u * LL + gse) * HD;
#pragma unroll
            for (int pt = 0; pt < 2; ++pt)
#pragma unroll
                for (int g = 0; g < 4; ++g) { uint2 w; w.x = cvt_pk_bf16_h(Y[pt][tt][4 * g], Y[pt][tt][4 * g + 1]); w.y = cvt_pk_bf16_h(Y[pt][tt][4 * g + 2], Y[pt][tt][4 * g + 3]); *(uint2*)(yo + 32 * pt + 8 * g + 4 * lh) = w; }
        }
    }
    {
        const bf16_t* BTg = p.mbBT + ((size_t)(b * MB_GROUPS + grp) * MB_STATE) * LL + (size_t)CK * pbk;
        f32x16_t Cs[4][2];
#pragma unroll
        for (int nt = 0; nt < 4; ++nt)
#pragma unroll
            for (int pt = 0; pt < 2; ++pt)
#pragma unroll
                for (int r = 0; r < 16; ++r) Cs[nt][pt][r] = 0.f;
#pragma unroll
        for (int ks = 0; ks < 4; ++ks) {
            const int ew = 16 * ks + 8 * lh;
            const float4 w0 = make_float4(__shfl(wsc, ew), __shfl(wsc, ew + 1), __shfl(wsc, ew + 2), __shfl(wsc, ew + 3)), w1 = make_float4(__shfl(wsc, ew + 4), __shfl(wsc, ew + 5), __shfl(wsc, ew + 6), __shfl(wsc, ew + 7));
            bf16x8_t xb[2];
#pragma unroll
            for (int pt = 0; pt < 2; ++pt) xb[pt] = *(const bf16x8_t*)(Xg + (size_t)(32 * pt + lq) * LL + 16 * ks + 8 * lh);
#pragma unroll
            for (int nt = 0; nt < 4; ++nt) {
                const uint4 bw = *(const uint4*)(BTg + (size_t)(32 * nt + lq) * LL + 16 * ks + 8 * lh);
                Frag8 a; a.u[0] = cvt_pk_bf16_h(bflo(bw.x) * w0.x, bfhi(bw.x) * w0.y); a.u[1] = cvt_pk_bf16_h(bflo(bw.y) * w0.z, bfhi(bw.y) * w0.w);
                a.u[2] = cvt_pk_bf16_h(bflo(bw.z) * w1.x, bfhi(bw.z) * w1.y); a.u[3] = cvt_pk_bf16_h(bflo(bw.w) * w1.z, bfhi(bw.w) * w1.w);
#pragma unroll
                for (int pt = 0; pt < 2; ++pt) Cs[nt][pt] = __builtin_amdgcn_mfma_f32_32x32x16_bf16(a.v, xb[pt], Cs[nt][pt], 0, 0, 0);
            }
        }
#pragma unroll
        for (int pt = 0; pt < 2; ++pt) {
            bf16_t* o = p.mbCS + (((size_t)u * NCHK + c) * HD + 32 * pt + lq) * MB_STATE;
#pragma unroll
            for (int nt = 0; nt < 4; ++nt)
#pragma unroll
                for (int g = 0; g < 4; ++g) { uint2 w; w.x = cvt_pk_bf16_h(Cs[nt][pt][4 * g], Cs[nt][pt][4 * g + 1]); w.y = cvt_pk_bf16_h(Cs[nt][pt][4 * g + 2], Cs[nt][pt][4 * g + 3]); *(uint2*)(o + 32 * nt + 8 * g + 4 * lh) = w; }
        }
    }
}

constexpr int N_RW_PAIRS = NU * NCHK, N_RW_MERGED = 2048 < N_RW_PAIRS ? 2048 : N_RW_PAIRS;
constexpr int N_RW_ITEMS = N_RW_MERGED + 2 * (N_RW_PAIRS - N_RW_MERGED), N_MB_ITEMS = NB * NH * 2 * NCHK;
DEVFN void ph_chunks(const Params& p, int l, float* lds_f, int* ctr) {
    const int lane = (TIDX() & 63);
    for (;;) {
        int it = 0;
        if (lane == 0) it = atomicAdd(ctr, 1);
        it = __builtin_amdgcn_readfirstlane(it);
        if (it >= N_RW_ITEMS + N_MB_ITEMS) break;
        if (it < N_RW_MERGED) rw_chunk_item<0>(p, lds_f, it);
        else if (it < N_RW_ITEMS) { const int h2 = it - N_RW_MERGED; if (h2 & 1) rw_chunk_item<2>(p, lds_f, N_RW_MERGED + (h2 >> 1)); else rw_chunk_item<1>(p, lds_f, N_RW_MERGED + (h2 >> 1)); }
        else mb_chunk_item(p, l, lds_f, it - N_RW_ITEMS);
    }
}

DEVFN void ph_mb_seq(const Params& p, int wv, int nwv) {
    constexpr int DQ = 4;
    static_assert(NCHK % DQ == 0, "ring depth");
    const int lane = (TIDX() & 63);
    for (int item = wv; item < NU * 4; item += nwv) {
        const int q4 = item & 3, u = item >> 2;
        float X[32];
#pragma unroll
        for (int k = 0; k < 32; ++k) X[k] = 0.f;
        const size_t eo = (size_t)q4 * 2048 + (size_t)lane * 32;
        uint4 pf[DQ][4]; float dq[DQ];
#define MSQ_LOAD(d, c_) do { const uint4* src_ = (const uint4*)(p.mbCS + ((size_t)u * NCHK + (c_)) * HD * MB_STATE + eo); \
            _Pragma("unroll") for (int k = 0; k < 4; ++k) pf[d][k] = src_[k]; dq[d] = p.mbCum[(size_t)u * LL + (c_) * CK + CK - 1]; } while (0)
#pragma unroll
        for (int d = 0; d < DQ; ++d) MSQ_LOAD(d, d);
        for (int c0 = 0; c0 < NCHK; c0 += DQ) {
#pragma unroll
            for (int d = 0; d < DQ; ++d) {
                const int c = c0 + d;
                const float dtot = expf(dq[d]);
                uint4 o[4];
#pragma unroll
                for (int k = 0; k < 4; ++k) {
                    const unsigned w[4] = {pf[d][k].x, pf[d][k].y, pf[d][k].z, pf[d][k].w}; unsigned ow[4];
#pragma unroll
                    for (int m = 0; m < 4; ++m) {
                        X[8 * k + 2 * m] = dtot * X[8 * k + 2 * m] + u_as_f(w[m] << 16); X[8 * k + 2 * m + 1] = dtot * X[8 * k + 2 * m + 1] + u_as_f(w[m] & 0xffff0000u);
                        ow[m] = cvt_pk_bf16(X[8 * k + 2 * m], X[8 * k + 2 * m + 1]);
                    }
                    o[k] = make_uint4(ow[0], ow[1], ow[2], ow[3]);
                }
                if (c + DQ < NCHK) MSQ_LOAD(d, c + DQ);
                uint4* dst = (uint4*)(p.mbCS + ((size_t)u * NCHK + c) * HD * MB_STATE + eo);
#pragma unroll
                for (int k = 0; k < 4; ++k) dst[k] = o[k];
            }
        }
#undef MSQ_LOAD
    }
}

DEVFN void ph_mb_yout(const Params& p, int l, size_t vt, size_t vs) {
    constexpr int HPG = NH / MB_GROUPS;
    const int lane = (TIDX() & 63), lq = lane & 31, lh = lane >> 5;
    const int wv = __builtin_amdgcn_readfirstlane((int)(vt >> 6)), nwv = (int)(vs >> 6);
    const int wvs = (wv & 7) * (nwv >> 3) + (wv >> 3);
    for (int item = nwv - 1 - wvs; item < NB * MB_GROUPS * NCHK * 2; item += nwv) {
        const int tb = item & 1, pbk = (item >> 1) % NCHK, grp = ((item >> 1) / NCHK) % MB_GROUPS, b = (item >> 1) / (NCHK * MB_GROUPS);
        const int s_ = CK * pbk + 32 * tb + lq, t = b * LL + s_;
        const int gsd[2] = {s_, rev_gs(s_)};
        const int cd[2] = {pbk, rev_chunk(pbk)};
        const bf16_t* cfp = p.mbC + (size_t)t * (MB_GROUPS * MB_STATE) + grp * MB_STATE + 8 * lh;
        f32x16_t acc[HPG][2];
#pragma unroll
        for (int hh = 0; hh < HPG; ++hh)
#pragma unroll
            for (int pt = 0; pt < 2; ++pt)
#pragma unroll
                for (int r = 0; r < 16; ++r) acc[hh][pt][r] = 0.f;
#pragma unroll
        for (int hh = 0; hh < HPG; ++hh) {
            const int h = grp * HPG + hh;
#pragma unroll
            for (int dir = 0; dir < 2; ++dir) {
                const int u = (b * NH + h) * 2 + dir, c = cd[dir];
                if (c > 0) {
                    const bf16_t* st = p.mbCS + ((size_t)u * NCHK + (c - 1)) * HD * MB_STATE;
                    f32x16_t d0, d1;
#pragma unroll
                    for (int r = 0; r < 16; ++r) { d0[r] = 0.f; d1[r] = 0.f; }
#pragma unroll
                    for (int ks = 0; ks < 8; ++ks) {
                        if ((ks & 1) == 0) asm volatile("" ::: "memory");
                        const bf16x8_t a0 = *(const bf16x8_t*)(st + (size_t)(lq) * MB_STATE + 16 * ks + 8 * lh), a1 = *(const bf16x8_t*)(st + (size_t)(32 + lq) * MB_STATE + 16 * ks + 8 * lh);
                        const bf16x8_t cfk = *(const bf16x8_t*)(cfp + 16 * ks);
                        d0 = __builtin_amdgcn_mfma_f32_32x32x16_bf16(a0, cfk, d0, 0, 0, 0);
                        d1 = __builtin_amdgcn_mfma_f32_32x32x16_bf16(a1, cfk, d1, 0, 0, 0);
                    }
                    const float ec = expf(p.mbCum[(size_t)u * LL + gsd[dir]]);
#pragma unroll
                    for (int r = 0; r < 16; ++r) { acc[hh][0][r] += ec * d0[r]; acc[hh][1][r] += ec * d1[r]; }
                }
            }
        }
        float ss = 0.f;
#pragma unroll
        for (int hh = 0; hh < HPG; ++hh) {
            const int h = grp * HPG + hh;
            const float dsk = p.mb_d[(size_t)l * NH + h];
#pragma unroll
            for (int pt = 0; pt < 2; ++pt)
#pragma unroll
                for (int g = 0; g < 4; ++g) {
                    asm volatile("" ::: "memory");
                    const int p0 = 32 * pt + 8 * g + 4 * lh, ch = h * HD + p0;
                    float yl[4] = {0.f, 0.f, 0.f, 0.f};
#pragma unroll
                    for (int dir = 0; dir < 2; ++dir) {
                            const int u = (b * NH + h) * 2 + dir;
                            const uint2 w = *(const uint2*)(p.mbYloc + ((size_t)u * LL + gsd[dir]) * HD + p0);
                            yl[0] += u_as_f(w.x << 16); yl[1] += u_as_f(w.x & 0xffff0000u); yl[2] += u_as_f(w.y << 16); yl[3] += u_as_f(w.y & 0xffff0000u);
                        }
                    const float4 x4 = *(const float4*)(p.xc + (size_t)t * MB_CONV_DIM + ch);
                    const uint2 zw = *(const uint2*)(p.P + (size_t)t * N_IN + OFF_MB + ch);
                    const float z0 = u_as_f(zw.x << 16), z1 = u_as_f(zw.x & 0xffff0000u), z2 = u_as_f(zw.y << 16), z3 = u_as_f(zw.y & 0xffff0000u);
                    const float v0 = (acc[hh][pt][4 * g] + yl[0] + dsk * x4.x) * siluf_(z0), v1 = (acc[hh][pt][4 * g + 1] + yl[1] + dsk * x4.y) * siluf_(z1);
                    const float v2 = (acc[hh][pt][4 * g + 2] + yl[2] + dsk * x4.z) * siluf_(z2), v3 = (acc[hh][pt][4 * g + 3] + yl[3] + dsk * x4.w) * siluf_(z3);
                    acc[hh][pt][4 * g] = v0; acc[hh][pt][4 * g + 1] = v1; acc[hh][pt][4 * g + 2] = v2; acc[hh][pt][4 * g + 3] = v3;
                    ss += v0 * v0 + v1 * v1 + v2 * v2 + v3 * v3;
                }
        }
        ss += __shfl_xor(ss, 32);
        const float rs = 1.0f / sqrtf(ss * (1.0f / (GD / MB_GROUPS)) + RMS_EPS);
#pragma unroll
        for (int hh = 0; hh < HPG; ++hh)
#pragma unroll
            for (int pt = 0; pt < 2; ++pt)
#pragma unroll
                for (int g = 0; g < 4; ++g) {
                    asm volatile("" ::: "memory");
                    const int ch = (grp * HPG + hh) * HD + 32 * pt + 8 * g + 4 * lh;
                    const float4 ng = *(const float4*)(p.mb_norm_g + (size_t)l * GD + ch);
                    uint2 w; w.x = cvt_pk_bf16(acc[hh][pt][4 * g] * rs * ng.x, acc[hh][pt][4 * g + 1] * rs * ng.y); w.y = cvt_pk_bf16(acc[hh][pt][4 * g + 2] * rs * ng.z, acc[hh][pt][4 * g + 3] * rs * ng.w);
                    *(uint2*)(p.Ymix + (size_t)t * D_MIX + 1 * GD + ch) = w;
                }
    }
}

DEVFN void ph_mla_norm(const Params& p, int l, size_t vt, size_t vs) {
    static_assert(KUP == 512 && MLA_QL % 8 == 0, "one wave = one token: 64 lanes x 8 lora channels (q | kv)");
    const int lane = (TIDX() & 63);
    const size_t wv = vt >> 6, nwv = vs >> 6;
    const bool isq = lane * 8 < MLA_QL;
    for (size_t t = wv; t < (size_t)TT; t += nwv) {
        const uint4 xv = *(const uint4*)(p.P + t * N_IN + OFF_MLA + lane * 8);
        float x[8] = {bflo(xv.x), bfhi(xv.x), bflo(xv.y), bfhi(xv.y), bflo(xv.z), bfhi(xv.z), bflo(xv.w), bfhi(xv.w)};
        float ss = 0.f;
#pragma unroll
        for (int k = 0; k < 8; ++k) ss += x[k] * x[k];
        float sq = isq ? ss : 0.f, sk = isq ? 0.f : ss;
#pragma unroll
        for (int o = 32; o > 0; o >>= 1) { sq += __shfl_xor(sq, o); sk += __shfl_xor(sk, o); }
        const float rs = isq ? 1.0f / sqrtf(sq / MLA_QL + RMS_EPS) : 1.0f / sqrtf(sk / MLA_KVL + RMS_EPS);
        const float* gp = isq ? p.mla_q_norm + (size_t)l * MLA_QL + lane * 8 : p.mla_kv_norm + (size_t)l * MLA_KVL + (lane * 8 - MLA_QL);
        const float4 g0 = *(const float4*)gp, g1 = *(const float4*)(gp + 4);
        *(uint4*)(p.qkvn + t * KUP + lane * 8) = make_uint4(pk2(x[0] * rs * g0.x, x[1] * rs * g0.y), pk2(x[2] * rs * g0.z, x[3] * rs * g0.w), pk2(x[4] * rs * g1.x, x[5] * rs * g1.y), pk2(x[6] * rs * g1.z, x[7] * rs * g1.w));
    }
}

DEVFN void ph_mla_rope(const Params& p, int l, size_t vt, size_t vs) {
    static_assert(MLA_NOPE % 8 == 0 && MLA_ROPE == 32 && MLA_ROPE / 4 == 8, "rope groups: [axis][half][8 freqs]");
    constexpr int NGQ = MLA_QK / 8, NGN = MLA_NOPE / 8;
    const float qscale = 1.4426950408889634f / sqrtf((float)MLA_QK);
    const size_t n = (size_t)TT * NH * NGQ;
    for (size_t id = vt; id < n; id += vs) {
        const int g = (int)(id % NGQ); const int h = (int)((id / NGQ) % NH); const int t = (int)(id / ((size_t)NGQ * NH)); const int b = t / LL, s_ = t % LL; const bool lat = s_ >= CTX; const int tl = s_ - CTX;
        bf16_t* qo = p.Qm + ((size_t)(b * NH + h) * LL + s_) * MLA_QK + g * 8; bf16_t* ko = p.Km + ((size_t)(b * NH + h) * LL + s_) * MLA_QK + g * 8;
        const float* q = p.QKVraw + (size_t)t * NUP + h * MLA_QK;
        if (g < NGN) {
            const float4 q0 = *(const float4*)(q + g * 8), q1 = *(const float4*)(q + g * 8 + 4);
            const float* kv = p.QKVraw + (size_t)t * NUP + NUPQ + h * (MLA_NOPE + MLA_V) + g * 8;
            const float4 k0 = *(const float4*)kv, k1 = *(const float4*)(kv + 4);
            *(uint4*)qo = make_uint4(pk2(q0.x * qscale, q0.y * qscale), pk2(q0.z * qscale, q0.w * qscale), pk2(q1.x * qscale, q1.y * qscale), pk2(q1.z * qscale, q1.w * qscale));
            *(uint4*)ko = make_uint4(pk2(k0.x, k0.y), pk2(k0.z, k0.w), pk2(k1.x, k1.y), pk2(k1.z, k1.w));
        } else {
            const int e0 = (g - NGN) * 8; const int axis = e0 / 16, half = (e0 / 8) & 1;
            const float* qa = q + MLA_NOPE + axis * 16;
            const float4 x10 = *(const float4*)qa, x11 = *(const float4*)(qa + 4), x20 = *(const float4*)(qa + 8), x21 = *(const float4*)(qa + 12);
            const float qx1[8] = {x10.x, x10.y, x10.z, x10.w, x11.x, x11.y, x11.z, x11.w}, qx2[8] = {x20.x, x20.y, x20.z, x20.w, x21.x, x21.y, x21.z, x21.w};
            const bf16_t* kp = p.P + (size_t)t * N_IN + OFF_MLA + MLA_QL + MLA_KVL + axis * 16;
            const uint4 kw1 = *(const uint4*)kp, kw2 = *(const uint4*)(kp + 8);
            const float kx1[8] = {bflo(kw1.x), bfhi(kw1.x), bflo(kw1.y), bfhi(kw1.y), bflo(kw1.z), bfhi(kw1.z), bflo(kw1.w), bfhi(kw1.w)};
            const float kx2[8] = {bflo(kw2.x), bfhi(kw2.x), bflo(kw2.y), bfhi(kw2.y), bflo(kw2.z), bfhi(kw2.z), bflo(kw2.w), bfhi(kw2.w)};
            float qv[8], kvv[8];
            const int pos = lat ? (axis == 0 ? tl / GRID_W : tl % GRID_W) : 0;
#pragma unroll
            for (int f = 0; f < 8; ++f) {
                float cs = 1.f, sn = 0.f;
                if (lat) { const float2 t2 = p.ropecs[pos * 8 + f]; cs = t2.x; sn = t2.y; }
                qv[f] = (half == 0 ? qx1[f] * cs - qx2[f] * sn : qx2[f] * cs + qx1[f] * sn) * qscale;
                kvv[f] = half == 0 ? kx1[f] * cs - kx2[f] * sn : kx2[f] * cs + kx1[f] * sn;
            }
            *(uint4*)qo = make_uint4(pk2(qv[0], qv[1]), pk2(qv[2], qv[3]), pk2(qv[4], qv[5]), pk2(qv[6], qv[7]));
            *(uint4*)ko = make_uint4(pk2(kvv[0], kvv[1]), pk2(kvv[2], kvv[3]), pk2(kvv[4], kvv[5]), pk2(kvv[6], kvv[7]));
        }
    }
}

DEVFN void ph_vt_tiles(const Params& p, int mode, bf16_t* smem, int vb, int nvb) {
    static_assert(HD == 64 && MLA_V == 64 && LL % 64 == 0 && MB_STATE == 128, "64 x 64 tiles");
    const int tid = TIDX(); const int r = tid >> 3, pc = tid & 7;
    const int nrow = mode == 3 ? NB * MB_GROUPS * 2 : NB * NH;
    const int NTL = nrow * (LL / 64);
    constexpr int TLD = 72;
    for (int u = vb; u < NTL; u += nvb) {
        const int tb = u % (LL / 64), bh = u / (LL / 64);
        int b, h;
        if (mode == 3) { b = bh / (MB_GROUPS * 2); h = bh % (MB_GROUPS * 2); } else { b = bh / NH; h = bh % NH; }
        const int t = b * LL + tb * 64 + r;
        unsigned w[4];
        if (mode == 0) { const uint4 v = *(const uint4*)(p.P + (size_t)t * N_IN + OFF_NA + 2 * GD + h * HD + pc * 8); w[0] = v.x; w[1] = v.y; w[2] = v.z; w[3] = v.w; }
        else {
            const float* src = mode == 1 ? p.QKVraw + (size_t)t * NUP + NUPQ + h * (MLA_NOPE + MLA_V) + MLA_NOPE + pc * 8
                             : mode == 2 ? p.xc + (size_t)t * MB_CONV_DIM + h * HD + pc * 8
                                         : p.xc + (size_t)t * MB_CONV_DIM + GD + h * 64 + pc * 8;
            const float4 a = *(const float4*)src, c4 = *(const float4*)(src + 4);
            w[0] = pk2(a.x, a.y); w[1] = pk2(a.z, a.w); w[2] = pk2(c4.x, c4.y); w[3] = pk2(c4.z, c4.w);
        }
        __syncthreads();
#pragma unroll
        for (int k = 0; k < 4; ++k) { smem[(pc * 8 + 2 * k) * TLD + r] = (bf16_t)(w[k] & 0xffffu); smem[(pc * 8 + 2 * k + 1) * TLD + r] = (bf16_t)(w[k] >> 16); }
        __syncthreads();
        const uint4 o = *(const uint4*)(smem + r * TLD + pc * 8);
        bf16_t* base = mode == 0 ? p.naVt : mode == 1 ? p.Vt : mode == 2 ? p.mbXT : p.mbBT;
        *(uint4*)(base + ((size_t)bh * 64 + r) * LL + tb * 64 + pc * 8) = o;
    }
    __syncthreads();
}

constexpr int AT_KLD = 104, AT_VLD = 68, AT_TK = 64;
constexpr int AT_BUF = AT_TK * AT_KLD + MLA_V * AT_VLD;
constexpr int AT_NSUB = 2;
template <int NTH>
DEVFN void mla_unit(const Params& p, bf16_t* smem, const int u2) {
    const int u = u2 >> 1, kh = u2 & 1;
    static_assert(MLA_QK == 96 && MLA_V == 64, "attention tiles are written for d_qk 96 / d_v 64");
    constexpr int NWV = NTH / 64, QB = NWV * 32;
    constexpr int NCHUNK1 = AT_TK * (MLA_QK / 8) + MLA_V * (AT_TK / 8);
    constexpr int NCHUNK = AT_NSUB * NCHUNK1;
    constexpr int NCH = (NCHUNK + NTH - 1) / NTH;
    constexpr int STAGE = AT_NSUB * AT_BUF;
    static_assert((CTX / AT_TK) % AT_NSUB == 0 && (LL / AT_TK) % AT_NSUB == 0, "whole stages");
    const int tid = TIDX(), lane = tid & 63, wave = tid >> 6, lq = lane & 31, lh = lane >> 5;
    const int n_lat = NB * NH * (SEQ / QB);
    {
        int bh, qbase, nkeys;
        if (u < n_lat) { bh = u / (SEQ / QB); qbase = CTX + (u % (SEQ / QB)) * QB; nkeys = LL; }
        else { const int u2 = u - n_lat; bh = u2 / (CTX / QB); qbase = (u2 % (CTX / QB)) * QB; nkeys = CTX; }
        const bf16_t* Kg = p.Km + (size_t)bh * LL * MLA_QK; const bf16_t* Vg = p.Vt + (size_t)bh * MLA_V * LL;
        const int q0 = qbase + wave * 32;
        bf16x8_t qf[6];
#pragma unroll
        for (int ks = 0; ks < 6; ++ks) qf[ks] = *(const bf16x8_t*)(p.Qm + ((size_t)bh * LL + q0 + lq) * MLA_QK + ks * 16 + lh * 8);
        f32x16_t o0, o1;
#pragma unroll
        for (int r = 0; r < 16; ++r) { o0[r] = 0.f; o1[r] = 0.f; }
        float m_i = -1e30f, l_i = 0.f;
        const int nst_all = nkeys / (AT_TK * AT_NSUB); const int nstages = nst_all / 2 + ((nst_all & 1) && kh == 0 ? 1 : 0);
        const int st_base = kh == 0 ? 0 : nst_all - nstages;
        uint4 stg[NCH];
#define MLA_LOAD(st_) do { _Pragma("unroll") for (int i = 0; i < NCH; ++i) { const int c = tid + i * NTH; const int sub = c / NCHUNK1, cc = c % NCHUNK1; const int k1 = ((st_base + (st_)) * AT_NSUB + sub) * AT_TK; \
            if (c < NCHUNK) { if (cc < AT_TK * 12) { const int key = cc / 12, ch = cc % 12; stg[i] = *(const uint4*)(Kg + (size_t)(k1 + key) * MLA_QK + ch * 8); } \
                              else { const int c2 = cc - AT_TK * 12; const int d = c2 / 8, ch = c2 % 8; stg[i] = *(const uint4*)(Vg + (size_t)d * LL + k1 + ch * 8); } } } } while (0)
#define MLA_STORE(buf_) do { _Pragma("unroll") for (int i = 0; i < NCH; ++i) { const int c = tid + i * NTH; const int sub = c / NCHUNK1, cc = c % NCHUNK1; bf16_t* dK = smem + (buf_) * STAGE + sub * AT_BUF; \
            if (c < NCHUNK) { if (cc < AT_TK * 12) { const int key = cc / 12, ch = cc % 12; *(uint4*)(dK + key * AT_KLD + ch * 8) = stg[i]; } \
                              else { const int c2 = cc - AT_TK * 12; const int d = c2 / 8, ch = c2 % 8; uint2* dst = (uint2*)(dK + AT_TK * AT_KLD + d * AT_VLD + ch * 8); dst[0] = make_uint2(stg[i].x, stg[i].y); dst[1] = make_uint2(stg[i].z, stg[i].w); } } } } while (0)
        MLA_LOAD(0);
        __syncthreads();
        MLA_STORE(0);
        __syncthreads();
        for (int st = 0; st < nstages; ++st) {
            const bool more = st + 1 < nstages;
            if (more) MLA_LOAD(st + 1);
            static_assert(AT_NSUB == 2, "two sub-tiles per stage");
            const bf16_t* sKa = smem + (st & 1) * STAGE; const bf16_t* sKb = sKa + AT_BUF;
            f32x16_t sa0, sa1, sb0, sb1;
#pragma unroll
            for (int r = 0; r < 16; ++r) { sa0[r] = 0.f; sa1[r] = 0.f; sb0[r] = 0.f; sb1[r] = 0.f; }
#pragma unroll
            for (int ks = 0; ks < 6; ++ks) {
                const bf16x8_t a0 = *(const bf16x8_t*)(sKa + (lq) * AT_KLD + ks * 16 + lh * 8), a1 = *(const bf16x8_t*)(sKa + (32 + lq) * AT_KLD + ks * 16 + lh * 8);
                sa0 = __builtin_amdgcn_mfma_f32_32x32x16_bf16(a0, qf[ks], sa0, 0, 0, 0);
                sa1 = __builtin_amdgcn_mfma_f32_32x32x16_bf16(a1, qf[ks], sa1, 0, 0, 0);
            }
#pragma unroll
            for (int ks = 0; ks < 6; ++ks) {
                const bf16x8_t a0 = *(const bf16x8_t*)(sKb + (lq) * AT_KLD + ks * 16 + lh * 8), a1 = *(const bf16x8_t*)(sKb + (32 + lq) * AT_KLD + ks * 16 + lh * 8);
                sb0 = __builtin_amdgcn_mfma_f32_32x32x16_bf16(a0, qf[ks], sb0, 0, 0, 0);
                sb1 = __builtin_amdgcn_mfma_f32_32x32x16_bf16(a1, qf[ks], sb1, 0, 0, 0);
            }
            __builtin_amdgcn_sched_barrier(0);
#define MLA_SOFTMAX_PV(s0, s1, sV) do { \
            float mx = -1e30f; \
            _Pragma("unroll") for (int r = 0; r < 16; ++r) mx = fmaxf(mx, fmaxf(s0[r], s1[r])); \
            mx = fmaxf(mx, __shfl_xor(mx, 32)); \
            const float m_new = fmaxf(m_i, mx); \
            const float alpha = __builtin_amdgcn_exp2f(m_i - m_new); \
            float rs = 0.f; \
            _Pragma("unroll") for (int r = 0; r < 16; ++r) { s0[r] = __builtin_amdgcn_exp2f(s0[r] - m_new); s1[r] = __builtin_amdgcn_exp2f(s1[r] - m_new); rs += s0[r] + s1[r]; } \
            rs += __shfl_xor(rs, 32); \
            l_i = l_i * alpha + rs; m_i = m_new; \
            if (__builtin_amdgcn_ballot_w64(alpha != 1.0f) != 0ull) { \
                _Pragma("unroll") for (int r = 0; r < 16; ++r) { o0[r] *= alpha; o1[r] *= alpha; } \
            } \
            Frag8 pf[2][2]; \
            _Pragma("unroll") for (int sp = 0; sp < 2; ++sp) \
                _Pragma("unroll") for (int j = 0; j < 4; ++j) { \
                    pf[0][sp].u[j] = cvt_pk_bf16_h(s0[8 * sp + 2 * j], s0[8 * sp + 2 * j + 1]); \
                    pf[1][sp].u[j] = cvt_pk_bf16_h(s1[8 * sp + 2 * j], s1[8 * sp + 2 * j + 1]); \
                } \
            _Pragma("unroll") for (int kb = 0; kb < 2; ++kb) \
                _Pragma("unroll") for (int sp = 0; sp < 2; ++sp) { \
                    const int kofs = kb * 32 + sp * 16 + lh * 4; \
                    Frag8 va, vb2; \
                    va.d2[0] = *(const uint2*)((sV) + (lq) * AT_VLD + kofs); va.d2[1] = *(const uint2*)((sV) + (lq) * AT_VLD + kofs + 8); \
                    vb2.d2[0] = *(const uint2*)((sV) + (32 + lq) * AT_VLD + kofs); vb2.d2[1] = *(const uint2*)((sV) + (32 + lq) * AT_VLD + kofs + 8); \
                    o0 = __builtin_amdgcn_mfma_f32_32x32x16_bf16(va.v, pf[kb][sp].v, o0, 0, 0, 0); \
                    o1 = __builtin_amdgcn_mfma_f32_32x32x16_bf16(vb2.v, pf[kb][sp].v, o1, 0, 0, 0); \
                } } while (0)
            MLA_SOFTMAX_PV(sa0, sa1, sKa + AT_TK * AT_KLD);
            MLA_SOFTMAX_PV(sb0, sb1, sKb + AT_TK * AT_KLD);
#undef MLA_SOFTMAX_PV
            if (more) MLA_STORE((st + 1) & 1);
            __syncthreads();
        }
#undef MLA_LOAD
#undef MLA_STORE
        const int b = bh / NH, h = bh % NH;
        const size_t rec = ((size_t)(b * LL + q0 + lq) * NH + h) * 2 + kh;
        float* orow = p.mlaO + rec * MLA_V;
#pragma unroll
        for (int g = 0; g < 4; ++g) {
            *(float4*)(orow + 8 * g + 4 * lh) = make_float4(o0[4 * g], o0[4 * g + 1], o0[4 * g + 2], o0[4 * g + 3]);
            *(float4*)(orow + 32 + 8 * g + 4 * lh) = make_float4(o1[4 * g], o1[4 * g + 1], o1[4 * g + 2], o1[4 * g + 3]);
        }
        if (lh == 0) *(float2*)(p.mlaML + rec * 2) = make_float2(m_i, l_i);
    }
}

DEVFN void ph_mla_combine(const Params& p, bool with_ctx, size_t vt, size_t vs) {
    const size_t n = (size_t)TT * NH * (MLA_V / 4);
    for (size_t i = vt; i < n; i += vs) {
        const int d4 = (int)(i % (MLA_V / 4)); const size_t th = i / (MLA_V / 4); const int h = (int)(th % NH); const size_t t = th / NH;
        if (!with_ctx && (int)(t % LL) < CTX) continue;
        const float2 ml0 = *(const float2*)(p.mlaML + (th * 2 + 0) * 2), ml1 = *(const float2*)(p.mlaML + (th * 2 + 1) * 2);
        const float m = fmaxf(ml0.x, ml1.x);
        const float e0 = __builtin_amdgcn_exp2f(ml0.x - m), e1 = __builtin_amdgcn_exp2f(ml1.x - m);
        const float inv = 1.0f / (ml0.y * e0 + ml1.y * e1);
        const float4 a = *(const float4*)(p.mlaO + (th * 2 + 0) * MLA_V + d4 * 4), c = *(const float4*)(p.mlaO + (th * 2 + 1) * MLA_V + d4 * 4);
        uint2 w; w.x = pk2((a.x * e0 + c.x * e1) * inv, (a.y * e0 + c.y * e1) * inv); w.y = pk2((a.z * e0 + c.z * e1) * inv, (a.w * e0 + c.w * e1) * inv);
        *(uint2*)(p.Ymix + t * D_MIX + 2 * GD + h * MLA_V + d4 * 4) = w;
    }
}

constexpr int NA_KLD = 72, NA_VLD = 68;
constexpr int NA_BUF = AT_TK * NA_KLD + HD * NA_VLD;
template <int NTH>
DEVFN void na_unit(const Params& p, int l, bf16_t* smem, const int u) {
    static_assert(HD == 64 && GRID_W == 64 && NA_WR == 8 && NA_WC == 16 && SEQ / GRID_W == 64, "natten tiles are written for a 64x64 grid, 8x16 window");
    constexpr int NWV = NTH / 64, QB = NWV * 32, RPU = NWV / 2, NLR = NA_WR + RPU - 1, NCT = CTX / AT_TK, ROWS = SEQ / GRID_W;
    constexpr int NCHUNK = AT_TK * (HD / 8) + HD * (AT_TK / 8);
    constexpr int NCH = (NCHUNK + NTH - 1) / NTH;
    constexpr int BW = 2 * NA_WC - 1, BH = 2 * NA_WR - 1;
    const float sc2 = 1.4426950408889634f / sqrtf((float)HD);
    const int tid = TIDX(), lane = tid & 63, wave = tid >> 6, lq = lane & 31, lh = lane >> 5;
    float* sbias = (float*)(smem + 2 * NA_BUF);
    const int n_lat = NB * NH * (ROWS / RPU);
    {
        const bool is_lat = u < n_lat;
        int bh, r0 = 0, rstart = 0, sq, ntiles;
        if (is_lat) { bh = u / (ROWS / RPU); r0 = (u % (ROWS / RPU)) * RPU; rstart = r0 - NA_WR / 2; rstart = rstart < 0 ? 0 : (rstart > ROWS - NLR ? ROWS - NLR : rstart);
                      sq = CTX + (r0 + (wave >> 1)) * GRID_W + 32 * (wave & 1) + lq; ntiles = NLR + NCT; }
        else { const int u2 = u - n_lat; bh = u2 / (CTX / QB); sq = (u2 % (CTX / QB)) * QB + wave * 32 + lq; ntiles = NCT; }
        const int b = bh / NH, h = bh % NH;
        const int qr = r0 + (wave >> 1), qc = 32 * (wave & 1) + lq;
        int rs = qr - NA_WR / 2; rs = rs < 0 ? 0 : (rs > ROWS - NA_WR ? ROWS - NA_WR : rs);
        int cs = qc - NA_WC / 2; cs = cs < 0 ? 0 : (cs > GRID_W - NA_WC ? GRID_W - NA_WC : cs);
        const bf16_t* Kg = p.P + (size_t)b * LL * N_IN + OFF_NA + GD + h * HD;
        const bf16_t* Vg = p.naVt + (size_t)bh * HD * LL;
        bf16x8_t qf[4];
#pragma unroll
        for (int ks = 0; ks < 4; ++ks) qf[ks] = *(const bf16x8_t*)(p.P + (size_t)(b * LL + sq) * N_IN + OFF_NA + h * HD + ks * 16 + lh * 8);
        f32x16_t o0, o1;
#pragma unroll
        for (int r = 0; r < 16; ++r) { o0[r] = 0.f; o1[r] = 0.f; }
        float m_i = -1e30f, l_i = 0.f;
        uint4 stg[NCH];
#define NA_KBASE(ti) ((is_lat && (ti) < NLR) ? (CTX + (rstart + (ti)) * GRID_W) : (((ti) - (is_lat ? NLR : 0)) * AT_TK))
#define NA_LOAD(ti) do { const int kb_ = NA_KBASE(ti); _Pragma("unroll") for (int i = 0; i < NCH; ++i) { const int c = tid + i * NTH; \
            if (c < AT_TK * 8) { const int key = c / 8, ch = c % 8; stg[i] = *(const uint4*)(Kg + (size_t)(kb_ + key) * N_IN + ch * 8); } \
            else if (c < NCHUNK) { const int c2 = c - AT_TK * 8; const int d = c2 / 8, ch = c2 % 8; stg[i] = *(const uint4*)(Vg + (size_t)d * LL + kb_ + ch * 8); } } } while (0)
#define NA_STORE(buf) do { bf16_t* dK_ = smem + (buf) * NA_BUF; _Pragma("unroll") for (int i = 0; i < NCH; ++i) { const int c = tid + i * NTH; \
            if (c < AT_TK * 8) { const int key = c / 8, ch = c % 8; *(uint4*)(dK_ + key * NA_KLD + ch * 8) = stg[i]; } \
            else if (c < NCHUNK) { const int c2 = c - AT_TK * 8; const int d = c2 / 8, ch = c2 % 8; uint2* dst = (uint2*)(dK_ + AT_TK * NA_KLD + d * NA_VLD + ch * 8); dst[0] = make_uint2(stg[i].x, stg[i].y); dst[1] = make_uint2(stg[i].z, stg[i].w); } } } while (0)
        NA_LOAD(0);
        __syncthreads();
        NA_STORE(0);
        for (int i = tid; i < BH * BW; i += NTH) sbias[i] = p.na_rpb[((size_t)l * NH + h) * BH * BW + i] * 1.4426950408889634f;
        __syncthreads();
        for (int tile = 0; tile < ntiles; ++tile) {
            const bf16_t* sK = smem + (tile & 1) * NA_BUF; const bf16_t* sV = sK + AT_TK * NA_KLD;
            const bool more = tile + 1 < ntiles;
            if (more) NA_LOAD(tile + 1);
            const bool local = is_lat && tile < NLR;
            const int kr = rstart + tile;
            const bool active = !local || (kr >= rs && kr < rs + NA_WR);
            if (active) {
                f32x16_t s0, s1;
#pragma unroll
                for (int r = 0; r < 16; ++r) { s0[r] = 0.f; s1[r] = 0.f; }
#pragma unroll
                for (int ks = 0; ks < 4; ++ks) {
                    const bf16x8_t a0 = *(const bf16x8_t*)(sK + (lq) * NA_KLD + ks * 16 + lh * 8);
                    const bf16x8_t a1 = *(const bf16x8_t*)(sK + (32 + lq) * NA_KLD + ks * 16 + lh * 8);
                    s0 = __builtin_amdgcn_mfma_f32_32x32x16_bf16(a0, qf[ks], s0, 0, 0, 0);
                    s1 = __builtin_amdgcn_mfma_f32_32x32x16_bf16(a1, qf[ks], s1, 0, 0, 0);
                }
                if (local) {
                    const float* brow = sbias + (kr - qr + NA_WR - 1) * BW;
#pragma unroll
                    for (int r = 0; r < 16; ++r) {
                        const int kc0 = (r & 3) + 8 * (r >> 2) + 4 * lh, kc1 = kc0 + 32;
                        const bool v0 = (unsigned)(kc0 - cs) < (unsigned)NA_WC, v1 = (unsigned)(kc1 - cs) < (unsigned)NA_WC;
                        s0[r] = v0 ? s0[r] * sc2 + brow[kc0 - qc + NA_WC - 1] : -1e30f;
                        s1[r] = v1 ? s1[r] * sc2 + brow[kc1 - qc + NA_WC - 1] : -1e30f;
                    }
                } else {
#pragma unroll
                    for (int r = 0; r < 16; ++r) { s0[r] *= sc2; s1[r] *= sc2; }
                }
                float mx = -1e30f;
#pragma unroll
                for (int r = 0; r < 16; ++r) mx = fmaxf(mx, fmaxf(s0[r], s1[r]));
                mx = fmaxf(mx, __shfl_xor(mx, 32));
                const float m_new = fmaxf(m_i, mx);
                const float alpha = __builtin_amdgcn_exp2f(m_i - m_new);
                float rsum = 0.f;
#pragma unroll
                for (int r = 0; r < 16; ++r) { s0[r] = __builtin_amdgcn_exp2f(s0[r] - m_new); s1[r] = __builtin_amdgcn_exp2f(s1[r] - m_new); rsum += s0[r] + s1[r]; }
                rsum += __shfl_xor(rsum, 32);
                l_i = l_i * alpha + rsum; m_i = m_new;
                if (__builtin_amdgcn_ballot_w64(alpha != 1.0f) != 0ull) {
#pragma unroll
                    for (int r = 0; r < 16; ++r) { o0[r] *= alpha; o1[r] *= alpha; }
                }
                Frag8 pf[2][2];
#pragma unroll
                for (int sp = 0; sp < 2; ++sp)
#pragma unroll
                    for (int j = 0; j < 4; ++j) {
                        pf[0][sp].u[j] = cvt_pk_bf16_h(s0[8 * sp + 2 * j], s0[8 * sp + 2 * j + 1]);
                        pf[1][sp].u[j] = cvt_pk_bf16_h(s1[8 * sp + 2 * j], s1[8 * sp + 2 * j + 1]);
                    }
#pragma unroll
                for (int kb = 0; kb < 2; ++kb)
#pragma unroll
                    for (int sp = 0; sp < 2; ++sp) {
                        const int kofs = kb * 32 + sp * 16 + lh * 4;
                        Frag8 va, vb2;
                        va.d2[0] = *(const uint2*)(sV + (lq) * NA_VLD + kofs); va.d2[1] = *(const uint2*)(sV + (lq) * NA_VLD + kofs + 8);
                        vb2.d2[0] = *(const uint2*)(sV + (32 + lq) * NA_VLD + kofs); vb2.d2[1] = *(const uint2*)(sV + (32 + lq) * NA_VLD + kofs + 8);
                        o0 = __builtin_amdgcn_mfma_f32_32x32x16_bf16(va.v, pf[kb][sp].v, o0, 0, 0, 0);
                        o1 = __builtin_amdgcn_mfma_f32_32x32x16_bf16(vb2.v, pf[kb][sp].v, o1, 0, 0, 0);
                    }
            }
            if (more) NA_STORE((tile + 1) & 1);
            __syncthreads();
        }
#undef NA_KBASE
#undef NA_LOAD
#undef NA_STORE
        const float inv = 1.0f / l_i;
        bf16_t* yrow = p.Ymix + (size_t)(b * LL + sq) * D_MIX + 3 * GD + h * HD;
#pragma unroll
        for (int g = 0; g < 4; ++g) {
            uint2 w0, w1;
            w0.x = cvt_pk_bf16(o0[4 * g] * inv, o0[4 * g + 1] * inv); w0.y = cvt_pk_bf16(o0[4 * g + 2] * inv, o0[4 * g + 3] * inv);
            w1.x = cvt_pk_bf16(o1[4 * g] * inv, o1[4 * g + 1] * inv); w1.y = cvt_pk_bf16(o1[4 * g + 2] * inv, o1[4 * g + 3] * inv);
            *(uint2*)(yrow + 8 * g + 4 * lh) = w0; *(uint2*)(yrow + 32 + 8 * g + 4 * lh) = w1;
        }
    }
}

DEVFN float wave_sum(float v) {
#pragma unroll
    for (int o = 32; o > 0; o >>= 1) v += __shfl_xor(v, o);
    return v;
}
constexpr int LNV = D / 256;

DEVFN void ph_ln1_route(const Params& p, int l, float* lds_f, int* lds_rt, size_t vt, size_t vs, const int t0, const int t1, const bool stage) {
    static_assert(NE * D * 4 <= 128 * 1024, "router matrix fits the LDS stage region");
    const float alpha = DN_ALPHA;
    const int lane = (TIDX() & 63);
    const size_t wv = vt >> 6, nwv = vs >> 6;
    __syncthreads();
    if (TIDX() < 2 * NE) lds_rt[TIDX()] = 0;
    if (stage) for (int i = TIDX(); i < D * NE / 4; i += 512) {
        const float4 w4 = *(const float4*)(p.router_w + (size_t)i * 4); const int d = (i * 4) / NE, e0 = (i * 4) % NE;
        lds_f[(e0 + 0) * D + d] = w4.x; lds_f[(e0 + 1) * D + d] = w4.y; lds_f[(e0 + 2) * D + d] = w4.z; lds_f[(e0 + 3) * D + d] = w4.w;
    }
    __syncthreads();
    for (size_t t = (size_t)t0 + wv; t < (size_t)t1; t += nwv) {
        const int b = (int)(t / LL), s = (int)(t % LL); const int r = s < CTX ? NB : b;
        const float* m = p.mod + ((size_t)l * NMOD + r) * 6 * D;
        float* xr = p.xs + t * D; const bf16_t* yr = p.yo + t * D;
        float4 u[LNV];
        float sum = 0.f;
#pragma unroll
        for (int i = 0; i < LNV; ++i) {
            const int d = i * 256 + lane * 4;
            const float4 xv = *(const float4*)(xr + d); const uint2 yw = *(const uint2*)(yr + d); const float4 gv = *(const float4*)(m + 2 * D + d);
            u[i].x = alpha * xv.x + gv.x * bflo(yw.x); u[i].y = alpha * xv.y + gv.y * bfhi(yw.x); u[i].z = alpha * xv.z + gv.z * bflo(yw.y); u[i].w = alpha * xv.w + gv.w * bfhi(yw.y);
            sum += u[i].x + u[i].y + u[i].z + u[i].w;
        }
        const float mu = wave_sum(sum) * (1.0f / D);
        float sq = 0.f;
#pragma unroll
        for (int i = 0; i < LNV; ++i) { const float a0 = u[i].x - mu, a1 = u[i].y - mu, a2 = u[i].z - mu, a3 = u[i].w - mu; sq += a0 * a0 + a1 * a1 + a2 * a2 + a3 * a3; }
        const float rs = 1.0f / sqrtf(wave_sum(sq) * (1.0f / D) + LN_EPS);
        float lg[NE];
#pragma unroll
        for (int e = 0; e < NE; ++e) lg[e] = 0.f;
#pragma unroll
        for (int i = 0; i < LNV; ++i) {
            const int d = i * 256 + lane * 4;
            const float4 gg = *(const float4*)(p.ln1_g + (size_t)l * D + d), bb = *(const float4*)(p.ln1_b + (size_t)l * D + d);
            const float4 sc = *(const float4*)(m + 4 * D + d), sh = *(const float4*)(m + 3 * D + d);
            float4 xn;
            xn.x = (u[i].x - mu) * rs * gg.x + bb.x; xn.y = (u[i].y - mu) * rs * gg.y + bb.y; xn.z = (u[i].z - mu) * rs * gg.z + bb.z; xn.w = (u[i].w - mu) * rs * gg.w + bb.w;
            *(float4*)(xr + d) = xn;
            float hv[4];
            hv[0] = xn.x * (1.0f + sc.x) + sh.x; hv[1] = xn.y * (1.0f + sc.y) + sh.y; hv[2] = xn.z * (1.0f + sc.z) + sh.z; hv[3] = xn.w * (1.0f + sc.w) + sh.w;
            uint2 pk; pk.x = (unsigned)f2bf(hv[0]) | ((unsigned)f2bf(hv[1]) << 16); pk.y = (unsigned)f2bf(hv[2]) | ((unsigned)f2bf(hv[3]) << 16);
            *(uint2*)(p.hb + t * D + d) = pk;
            asm volatile("" ::: "memory");
#pragma unroll
            for (int e = 0; e < NE; ++e) { const float4 w4 = *(const float4*)(lds_f + e * D + d); lg[e] += hv[0] * w4.x + hv[1] * w4.y + hv[2] * w4.z + hv[3] * w4.w; }
        }
#pragma unroll
        for (int e = 0; e < NE; ++e) lg[e] = wave_sum(lg[e]);
        float gbest = -1e30f; int e1 = 0, e2 = 1; float w1 = 0.f, w2 = 0.f;
#pragma unroll
        for (int g = 0; g < NEG; ++g) {
            float m1 = -1e30f, m2 = -1e30f, s1 = 0.f, s2 = 0.f; int i1 = 0, i2 = 0;
#pragma unroll
            for (int i = 0; i < EPG; ++i) {
                const float scv = sigmoidf_(lg[g * EPG + i]); const float v = scv + p.router_b[g * EPG + i];
                if (v > m1) { m2 = m1; i2 = i1; s2 = s1; m1 = v; i1 = g * EPG + i; s1 = scv; }
                else if (v > m2) { m2 = v; i2 = g * EPG + i; s2 = scv; }
            }
            if (m1 + m2 > gbest) { gbest = m1 + m2; e1 = i1; e2 = i2; w1 = s1; w2 = s2; }
        }
        const float wn = ROUTED_SCALE / (w1 + w2);
        if (lane < 2) {
            const int k = lane;
            const int e = k == 0 ? e1 : e2; const float w = (k == 0 ? w1 : w2) * wn;
            const int pos = atomicAdd(&lds_rt[e], 1);
            ((int*)&p.tok_e[t])[k] = e; ((int*)&p.tok_pos[t])[k] = pos; ((float*)&p.tok_w[t])[k] = w;
        }
    }
    asm volatile("s_waitcnt vmcnt(0)" ::: "memory");
    __syncthreads();
    if (TIDX() < NE) { const int c_ = lds_rt[TIDX()]; lds_rt[NE + TIDX()] = c_ ? atomicAdd(&p.cnt[l * NE + TIDX()], c_) : 0; }
    __syncthreads();
}
DEVFN void ph_ln1_fix(const Params& p, const int* lds_rt, size_t vt, size_t vs, const int t0, const int t1) {
    const int lane = (TIDX() & 63);
    const size_t wv = vt >> 6, nwv = vs >> 6;
    for (size_t t = (size_t)t0 + wv; t < (size_t)t1; t += nwv) {
        if (lane < 2) { const int e = ((const int*)&p.tok_e[t])[lane]; ((int*)&p.tok_pos[t])[lane] += lds_rt[NE + e]; }
    }
}

DEVFN void ph_moe_perm(const Params& p, int l, size_t vt, size_t vs) {
    const int lane = (TIDX() & 63);
    const size_t wv = vt >> 6, nwv = vs >> 6;
    for (size_t it = wv; it < (size_t)2 * TT; it += nwv) {
        const size_t t = it >> 1; const int k = (int)(it & 1);
        const int e = ((const int*)&p.tok_e[t])[k], pos = ((const int*)&p.tok_pos[t])[k];
        int base = 0;
#pragma unroll
        for (int q = 0; q < NE; ++q) { const int nt = (p.cnt[l * NE + q] + 255) >> 8; base += (q < e) ? nt * 256 : 0; }
        const int row = base + pos;
        const uint4* src = (const uint4*)(p.hb + t * D); uint4* dst = (uint4*)(p.hperm + (size_t)row * D);
#pragma unroll
        for (int q = 0; q < D / 512; ++q) dst[q * 64 + lane] = src[q * 64 + lane];
        if (lane == 0) ((int*)&p.tok_row[t])[k] = row;
    }
}

DEVFN void ph_ln2(const Params& p, int l, size_t vt, size_t vs) {
    const float alpha = DN_ALPHA;
    const int lane = (TIDX() & 63);
    const size_t wv = vt >> 6, nwv = vs >> 6;
    for (size_t t = wv; t < (size_t)TT; t += nwv) {
        const int b = (int)(t / LL), s = (int)(t % LL); const int r = s < CTX ? NB : b;
        const float* m = p.mod + ((size_t)l * NMOD + r) * 6 * D;
        float* xr = p.xs + t * D;
        const int2 rw2 = p.tok_row[t]; const float2 ww = p.tok_w[t];
        const bf16_t* f0 = p.Fperm + (size_t)rw2.x * D; const bf16_t* f1 = p.Fperm + (size_t)rw2.y * D;
        float4 u[LNV];
        float sum = 0.f;
#pragma unroll
        for (int i = 0; i < LNV; ++i) {
            const int d = i * 256 + lane * 4;
            const float4 xv = *(const float4*)(xr + d), gv = *(const float4*)(m + 5 * D + d);
            const uint2 a0 = *(const uint2*)(f0 + d), a1 = *(const uint2*)(f1 + d);
            u[i].x = alpha * xv.x + gv.x * (ww.x * bflo(a0.x) + ww.y * bflo(a1.x)); u[i].y = alpha * xv.y + gv.y * (ww.x * bfhi(a0.x) + ww.y * bfhi(a1.x));
            u[i].z = alpha * xv.z + gv.z * (ww.x * bflo(a0.y) + ww.y * bflo(a1.y)); u[i].w = alpha * xv.w + gv.w * (ww.x * bfhi(a0.y) + ww.y * bfhi(a1.y));
            sum += u[i].x + u[i].y + u[i].z + u[i].w;
        }
        const float mu = wave_sum(sum) * (1.0f / D);
        float sq = 0.f;
#pragma unroll
        for (int i = 0; i < LNV; ++i) { const float a0 = u[i].x - mu, a1 = u[i].y - mu, a2 = u[i].z - mu, a3 = u[i].w - mu; sq += a0 * a0 + a1 * a1 + a2 * a2 + a3 * a3; }
        const float rs = 1.0f / sqrtf(wave_sum(sq) * (1.0f / D) + LN_EPS);
        const float* mn = p.mod + ((size_t)(l + 1 < DEPTH ? l + 1 : l) * NMOD + r) * 6 * D;
#pragma unroll
        for (int i = 0; i < LNV; ++i) {
            const int d = i * 256 + lane * 4;
            const float4 gg = *(const float4*)(p.ln2_g + (size_t)l * D + d), bb = *(const float4*)(p.ln2_b + (size_t)l * D + d);
            float4 xn;
            xn.x = (u[i].x - mu) * rs * gg.x + bb.x; xn.y = (u[i].y - mu) * rs * gg.y + bb.y; xn.z = (u[i].z - mu) * rs * gg.z + bb.z; xn.w = (u[i].w - mu) * rs * gg.w + bb.w;
            if (l < DEPTH - 1) *(float4*)(xr + d) = xn;
            if (l == DEPTH - 1) { if (s >= CTX) *(float4*)(p.out + ((size_t)b * SEQ + (s - CTX)) * D + d) = xn; }
            else {
                const float4 sc = *(const float4*)(mn + D + d), sh = *(const float4*)(mn + d);
                uint2 pk;
                pk.x = (unsigned)f2bf(xn.x * (1.0f + sc.x) + sh.x) | ((unsigned)f2bf(xn.y * (1.0f + sc.y) + sh.y) << 16);
                pk.y = (unsigned)f2bf(xn.z * (1.0f + sc.z) + sh.z) | ((unsigned)f2bf(xn.w * (1.0f + sc.w) + sh.w) << 16);
                *(uint2*)(p.xm + t * D + d) = pk;
            }
        }
    }
}

namespace pg8 {
#define PG8_LAS __attribute__((address_space(3)))
typedef unsigned short bf16_t;
typedef short bf16x8 __attribute__((ext_vector_type(8)));
typedef float f32x4 __attribute__((ext_vector_type(4)));
typedef unsigned u32x4 __attribute__((ext_vector_type(4)));
constexpr int BM = 256, BK = 64, HALF = 128, HTB = HALF * BK * 2  , STAGE_BYTES = 8 * HTB, NXCD = 8, WGM = 8;

__host__ __device__ __forceinline__ int lds_byte(int r, int c) { const int st = (r >> 4) * 2 + (c >> 5), rr = r & 15, cc = c & 31, ob = rr * 64 + cc * 2; return st * 1024 + (ob ^ (((ob >> 9) & 1) << 5)); }
__host__ __device__ __forceinline__ void stage_rc(int b, int& R, int& C) { const int st = b / 1024, sb = b % 1024, swz = sb ^ (((sb >> 9) & 1) << 5); R = (st >> 1) * 16 + swz / 64; C = (st & 1) * 32 + (swz % 64) / 2; }
__host__ __device__ __forceinline__ int perm32(int rho) { const int n = rho >> 4, i = rho & 15; return 8 * (i >> 2) + 4 * n + (i & 3); }

struct Unit { int pm, pn; };
struct Gemm { const bf16_t* A; const bf16_t* Bt; int M, N, K; };

struct StaticOrder {
    int nM, nN, nwg, G, c;
    __host__ __device__ void init(int M, int N, int G_, int c_) { nM = M / BM; nN = N / BM; nwg = nM * nN; G = G_; c = c_; }
    __host__ __device__ bool next(int i, Unit& u) const {
        const long L = (long)i * G + c; if (L >= nwg) return false;
        int wgid = (int)L; { const int q = nwg / NXCD, r = nwg % NXCD, xcd = wgid % NXCD, off = wgid / NXCD; wgid = (xcd < r ? xcd * (q + 1) : r * (q + 1) + (xcd - r) * q) + off; }
        const int nig = WGM * nN, gid = wgid / nig, fm = gid * WGM, gsz = (nM - fm) < WGM ? (nM - fm) : WGM;
        u.pm = fm + ((wgid % nig) % gsz); u.pn = (wgid % nig) / gsz; return true;
    }
    __device__ __forceinline__ void a_ready(const Unit&) const {}
    __device__ __forceinline__ void done(const Unit&) const {}
};
__device__ __forceinline__ unsigned cvt_pk_bf16(float lo, float hi) { return ::cvt_pk_bf16(lo, hi); }
struct EpiF32 {
    static constexpr bool PERM = false, AFTER_DRAIN = false;
    float* C; int ldc; const float* bias;
    __device__ __forceinline__ void operator()(const f32x4 (&acc)[2][2][4][2], const Unit& u, int wr, int wc, int fr, int fq) const {
        const int row0 = u.pm * BM + wr * 64 + fr, col0 = u.pn * BM + wc * 32 + 4 * fq;
        f32x4 bv[2][2];
#pragma unroll
        for (int bj = 0; bj < 2; ++bj)
#pragma unroll
            for (int n = 0; n < 2; ++n) bv[bj][n] = bias ? *(const f32x4*)(bias + col0 + bj * HALF + n * 16) : (f32x4){0.f, 0.f, 0.f, 0.f};
#pragma unroll
        for (int ai = 0; ai < 2; ++ai)
#pragma unroll
            for (int m = 0; m < 4; ++m) { float* rowp = C + (size_t)(row0 + ai * HALF + m * 16) * ldc + col0;
#pragma unroll
                for (int bj = 0; bj < 2; ++bj)
#pragma unroll
                    for (int n = 0; n < 2; ++n) *(f32x4*)(rowp + bj * HALF + n * 16) = acc[ai][bj][m][n] + bv[bj][n]; }
    }
};
template <class Epi, class Sched, bool STAMP = false>
__device__ __forceinline__ void gemm_phase(PG8_LAS unsigned char* lds, const Gemm g, const Sched& S, const Epi& E, unsigned long long* stamps) {
    const int tid = TIDX(), wid = __builtin_amdgcn_readfirstlane(tid >> 6), lane = tid & 63, wr = wid >> 2, wc = wid & 3, fr = lane & 15, fq = lane >> 4;
    const int K = g.K, nt = K / BK;
    int ts_lo = 0, ts_hi = 0, nts = 0; const unsigned long long rt_entry = STAMP ? (unsigned long long)wall_clock64() : 0ull;
#define PG8_STAMP() do { if (STAMP && wid == 0 && nts < 64) { const unsigned long long _c = (unsigned long long)clock64(); \
        ts_lo = (lane == nts) ? (int)(unsigned)_c : ts_lo; ts_hi = (lane == nts) ? (int)(unsigned)(_c >> 32) : ts_hi; ++nts; } } while (0)
    PG8_STAMP();
    unsigned voffA[2], voffB[2];
#pragma unroll
    for (int i = 0; i < 2; ++i) { int R, C; stage_rc(tid * 16 + i * 8192, R, C); const int Rb = Epi::PERM ? ((R & ~31) + perm32(R & 31)) : R;
        voffA[i] = (unsigned)(R * K + C) * 2u; voffB[i] = (unsigned)(Rb * K + C) * 2u; }
    const size_t kstep = (size_t)(BK * 2);
    const size_t hstep = (size_t)HALF * K * 2;
    const size_t tstep = 2 * hstep;
    const unsigned ldsw = (unsigned)wid * 1024u;
    const int aoff = lds_byte(wr * 64 + fr, fq * 8), boff = lds_byte(wc * 32 + fr, fq * 8);
#define PG8_SA(b, h) (((b) * 2 + (h)) * HTB)
#define PG8_SB(b, h) ((4 + (b) * 2 + (h)) * HTB)
#define PG8_STAGE(bufoff, gbase, voff) do { _Pragma("unroll") for (int _i = 0; _i < 2; ++_i) \
        __builtin_amdgcn_global_load_lds((const unsigned*)((const char*)(gbase) + (voff)[_i]), (PG8_LAS unsigned*)(lds + (bufoff) + ldsw + _i * 8192), 16, 0, 0); } while (0)
#define PG8_LDA(dst, b, h) do { _Pragma("unroll") for (int m = 0; m < 4; ++m) _Pragma("unroll") for (int k = 0; k < 2; ++k) dst[m][k] = *(const PG8_LAS bf16x8*)(lds + PG8_SA(b, h) + aoff + m * 2048 + k * 1024); } while (0)
#define PG8_LDB(dst, b, h) do { _Pragma("unroll") for (int n = 0; n < 2; ++n) _Pragma("unroll") for (int k = 0; k < 2; ++k) dst[n][k] = *(const PG8_LAS bf16x8*)(lds + PG8_SB(b, h) + boff + n * 2048 + k * 1024); } while (0)
#define PG8_MMA(ai, bj, At, Bt) do { __builtin_amdgcn_s_setprio(1); _Pragma("unroll") for (int m = 0; m < 4; ++m) _Pragma("unroll") for (int n = 0; n < 2; ++n) _Pragma("unroll") for (int k = 0; k < 2; ++k) \
        acc[ai][bj][m][n] = __builtin_amdgcn_mfma_f32_16x16x32_bf16(Bt[n][k], At[m][k], acc[ai][bj][m][n], 0, 0, 0); __builtin_amdgcn_s_setprio(0); } while (0)
#define PG8_WAIT_V(n) asm volatile("s_waitcnt vmcnt(" #n ")" ::: "memory")
#define PG8_WAIT_L(n) asm volatile("s_waitcnt lgkmcnt(" #n ")" ::: "memory")
#define PG8_BAR __builtin_amdgcn_s_barrier()
#define PG8_SCHED __builtin_amdgcn_sched_barrier(0)
    Unit cur, nxt; int ui = 0;
    if (!S.next(0, cur)) return;
    f32x4 acc[2][2][4][2];
#pragma unroll
    for (int a = 0; a < 2; ++a)
#pragma unroll
        for (int b = 0; b < 2; ++b)
#pragma unroll
            for (int m = 0; m < 4; ++m)
#pragma unroll
                for (int n = 0; n < 2; ++n) acc[a][b][m][n] = (f32x4){0.f, 0.f, 0.f, 0.f};
    bf16x8 At[4][2], B0[2][2], B1[2][2];
    const char* cA = (const char*)g.A + (size_t)cur.pm * tstep; const char* cB = (const char*)g.Bt + (size_t)cur.pn * tstep;
    S.a_ready(cur);
    PG8_STAGE(PG8_SB(0, 0), cB, voffB); PG8_STAGE(PG8_SA(0, 0), cA, voffA); PG8_STAGE(PG8_SB(0, 1), cB + hstep, voffB); PG8_STAGE(PG8_SA(0, 1), cA + hstep, voffA);
    if (wr == 1) PG8_BAR;
    PG8_WAIT_V(4); PG8_BAR;
    PG8_STAGE(PG8_SB(1, 0), cB + kstep, voffB); PG8_STAGE(PG8_SA(1, 0), cA + kstep, voffA); PG8_STAGE(PG8_SB(1, 1), cB + hstep + kstep, voffB);
    PG8_WAIT_V(6); PG8_BAR;
    PG8_STAMP();
    for (;;) {
        const bool has_next = S.next(ui + 1, nxt);
        const char* nA = has_next ? (const char*)g.A + (size_t)nxt.pm * tstep : cA; const char* nB = has_next ? (const char*)g.Bt + (size_t)nxt.pn * tstep : cB;
        for (int t = 0; t < nt; t += 2) {
            const bool last = (t == nt - 2);
            const char* a1 = cA + (size_t)(t + 1) * kstep;
            const char* a2 = last ? nA : cA + (size_t)(t + 2) * kstep; const char* b2 = last ? nB : cB + (size_t)(t + 2) * kstep;
            const char* a3 = a2 + kstep; const char* b3 = b2 + kstep;
            if (last && has_next) S.a_ready(nxt);
            PG8_LDB(B0, 0, 0); PG8_SCHED; PG8_LDA(At, 0, 0); PG8_STAGE(PG8_SA(1, 1), a1 + hstep, voffA);
            PG8_WAIT_L(8); PG8_BAR; PG8_WAIT_L(0); PG8_MMA(0, 0, At, B0); PG8_BAR; PG8_SCHED;
            PG8_LDB(B1, 0, 1); PG8_STAGE(PG8_SB(0, 0), b2, voffB);
            PG8_BAR; PG8_WAIT_L(0); PG8_MMA(0, 1, At, B1); PG8_BAR;
            PG8_LDA(At, 0, 1); PG8_STAGE(PG8_SA(0, 0), a2, voffA);
            PG8_BAR; PG8_WAIT_L(0); PG8_MMA(1, 0, At, B0); PG8_BAR; PG8_SCHED;
            PG8_STAGE(PG8_SB(0, 1), b2 + hstep, voffB);
            PG8_WAIT_V(6); PG8_BAR; PG8_MMA(1, 1, At, B1); PG8_BAR;
            PG8_LDB(B0, 1, 0); PG8_SCHED; PG8_LDA(At, 1, 0); PG8_STAGE(PG8_SA(0, 1), a2 + hstep, voffA);
            PG8_WAIT_L(8); PG8_BAR; PG8_WAIT_L(0); PG8_MMA(0, 0, At, B0); PG8_BAR; PG8_SCHED;
            PG8_LDB(B1, 1, 1); PG8_STAGE(PG8_SB(1, 0), b3, voffB);
            PG8_BAR; PG8_WAIT_L(0); PG8_MMA(0, 1, At, B1); PG8_BAR;
            PG8_LDA(At, 1, 1); PG8_STAGE(PG8_SA(1, 0), a3, voffA);
            PG8_BAR; PG8_WAIT_L(0); PG8_MMA(1, 0, At, B0); PG8_BAR; PG8_SCHED;
            PG8_STAGE(PG8_SB(1, 1), b3 + hstep, voffB);
            PG8_WAIT_V(6); PG8_BAR; PG8_MMA(1, 1, At, B1); PG8_BAR;
        }
        PG8_STAMP();
        if constexpr (!Epi::AFTER_DRAIN) { E(acc, cur, wr, wc, fr, fq); S.done(cur); }
        PG8_STAMP();
        if (!has_next) break;
#pragma unroll
        for (int a = 0; a < 2; ++a)
#pragma unroll
            for (int b = 0; b < 2; ++b)
#pragma unroll
                for (int m = 0; m < 4; ++m)
#pragma unroll
                    for (int n = 0; n < 2; ++n) acc[a][b][m][n] = (f32x4){0.f, 0.f, 0.f, 0.f};
        cur = nxt; cA = nA; cB = nB; ++ui;
    }
    PG8_WAIT_V(0);
    if (wr == 0) PG8_BAR;
    PG8_BAR;
    if constexpr (Epi::AFTER_DRAIN) { E.fused(acc, cur, wr, wc, fr, fq, lds, wid, lane); S.done(cur); }
    PG8_STAMP();
    if (STAMP && wid == 0) { stamps[lane] = lane < nts ? (((unsigned long long)(unsigned)ts_hi << 32) | (unsigned)ts_lo) : 0ull;
        if (lane == 62) stamps[62] = rt_entry; if (lane == 63) stamps[63] = (unsigned long long)wall_clock64(); }
#undef PG8_STAMP
#undef PG8_SA
#undef PG8_SB
#undef PG8_STAGE
#undef PG8_LDA
#undef PG8_LDB
#undef PG8_MMA
#undef PG8_WAIT_V
#undef PG8_WAIT_L
#undef PG8_BAR
#undef PG8_SCHED
}
}

namespace pg8 {
struct EpiBf16N {
    static constexpr bool PERM = true, AFTER_DRAIN = false;
    bf16_t* O; int ldc; int ncols;
    __device__ __forceinline__ void operator()(const f32x4 (&acc)[2][2][4][2], const Unit& u, int wr, int wc, int fr, int fq) const {
        const int row0 = u.pm * BM + wr * 64 + fr; const int col0 = u.pn * BM + wc * 32 + 8 * fq;
#pragma unroll
        for (int ai = 0; ai < 2; ++ai)
#pragma unroll
            for (int m = 0; m < 4; ++m) { bf16_t* rowp = O + (size_t)(row0 + ai * HALF + m * 16) * ldc + col0;
#pragma unroll
                for (int bj = 0; bj < 2; ++bj) { const f32x4 v0 = acc[ai][bj][m][0], v1 = acc[ai][bj][m][1];
                    u32x4 w; w.x = ::cvt_pk_bf16_h(v0[0], v0[1]); w.y = ::cvt_pk_bf16_h(v0[2], v0[3]); w.z = ::cvt_pk_bf16_h(v1[0], v1[1]); w.w = ::cvt_pk_bf16_h(v1[2], v1[3]);
                    if (col0 + bj * HALF < ncols) *(u32x4*)(rowp + bj * HALF) = w; } }
    }
};
struct LatentOrder : StaticOrder {
    __device__ __forceinline__ bool next(int i, Unit& u) const {
        if (!StaticOrder::next(i, u)) return false;
        constexpr int LT = SEQ / 256, CT = CTX / 256;
        u.pm = (u.pm / LT) * (LT + CT) + CT + (u.pm % LT); return true;
    }
};
struct TailOrder {
    int pm0, nM, nN, G, c;
    __device__ __forceinline__ bool next(int i, Unit& u) const {
        if (c >= G) return false;
        const int L = i * G + c; if (L >= (nM - pm0) * nN) return false;
        u.pm = pm0 + L / nN; u.pn = L % nN; return true;
    }
    __device__ __forceinline__ void a_ready(const Unit&) const {}
    __device__ __forceinline__ void done(const Unit&) const {}
};
struct EpiBf16Grp {
    static constexpr bool PERM = true, AFTER_DRAIN = false;
    bf16_t* O; int ldc; int ncu;
    __device__ __forceinline__ void operator()(const f32x4 (&acc)[2][2][4][2], const Unit& u, int wr, int wc, int fr, int fq) const {
        const int row0 = u.pm * BM + wr * 64 + fr; const int col0 = (u.pn % ncu) * BM + wc * 32 + 8 * fq;
#pragma unroll
        for (int ai = 0; ai < 2; ++ai)
#pragma unroll
            for (int m = 0; m < 4; ++m) { bf16_t* rowp = O + (size_t)(row0 + ai * HALF + m * 16) * ldc + col0;
#pragma unroll
                for (int bj = 0; bj < 2; ++bj) { const f32x4 v0 = acc[ai][bj][m][0], v1 = acc[ai][bj][m][1];
                    u32x4 w; w.x = ::cvt_pk_bf16_h(v0[0], v0[1]); w.y = ::cvt_pk_bf16_h(v0[2], v0[3]); w.z = ::cvt_pk_bf16_h(v1[0], v1[1]); w.w = ::cvt_pk_bf16_h(v1[2], v1[3]);
                    *(u32x4*)(rowp + bj * HALF) = w; } }
    }
};
struct MoeOrder {
    const int* cnt; int G, c, ncu;
    __device__ __forceinline__ bool next(int i, Unit& u) const {
        int tot = 0;
#pragma unroll
        for (int k = 0; k < 16; ++k) tot += (cnt[k] + 255) >> 8;
        int rt, cu;
        if ((G & 7) == 0) {
            const int x = c & 7, rank = c >> 3, per = G >> 3;
            const int t0 = (tot * x) >> 3, t1 = (tot * (x + 1)) >> 3;
            const int k = i * per + rank;
            if (k >= (t1 - t0) * ncu) return false;
            rt = t0 + k / ncu; cu = k % ncu;
        } else {
            const long L = (long)i * G + c; rt = (int)(L / ncu); cu = (int)(L % ncu);
            if (rt >= tot) return false;
        }
        int acc = 0, e = -1;
#pragma unroll
        for (int k = 0; k < 16; ++k) { const int nt = (cnt[k] + 255) >> 8; e = (e < 0 && rt < acc + nt) ? k : e; acc += nt; }
        if (e < 0) return false;
        u.pm = rt; u.pn = e * ncu + cu; return true;
    }
    __device__ __forceinline__ void a_ready(const Unit&) const {}
    __device__ __forceinline__ void done(const Unit&) const {}
};
struct EpiSwiGLU {
    static constexpr bool PERM = true, AFTER_DRAIN = false;
    bf16_t* O; int ldc; int ncu;
    __device__ __forceinline__ void operator()(const f32x4 (&acc)[2][2][4][2], const Unit& u, int wr, int wc, int fr, int fq) const {
        const int row0 = u.pm * BM + wr * 64 + fr; const int col0 = (u.pn % ncu) * HALF + wc * 32 + 8 * fq;
#pragma unroll
        for (int ai = 0; ai < 2; ++ai)
#pragma unroll
            for (int m = 0; m < 4; ++m) {
                float hv[8];
#pragma unroll
                for (int n = 0; n < 2; ++n)
#pragma unroll
                    for (int q = 0; q < 4; ++q) { const float g = acc[ai][0][m][n][q], up = acc[ai][1][m][n][q]; hv[4 * n + q] = g / (1.0f + __expf(-g)) * up; }
                u32x4 w; w.x = cvt_pk_bf16(hv[0], hv[1]); w.y = cvt_pk_bf16(hv[2], hv[3]); w.z = cvt_pk_bf16(hv[4], hv[5]); w.w = cvt_pk_bf16(hv[6], hv[7]);
                *(u32x4*)(O + (size_t)(row0 + ai * HALF + m * 16) * ldc + col0) = w;
            }
    }
};
}

#define XB_TMO      128
#define XB_XCNT(j)  (256  + 64 * (j))
#define XB_XSUB(j)  (1280 + 64 * (j))
#define XB_XGEN(j)  (2304 + 64 * (j))
#define XB_TOP      3328
#define XB_TOPGEN   3392
#define XCD_BAR_WORDS 3456
#define XB_SPIN_CAP (1u << 18)
#define LAS __attribute__((address_space(3)))

__device__ __forceinline__ unsigned xb_ld(unsigned* p)              { return __hip_atomic_load(p, __ATOMIC_RELAXED, __HIP_MEMORY_SCOPE_AGENT); }
__device__ __forceinline__ unsigned xb_add(unsigned* p, unsigned v) { return __hip_atomic_fetch_add(p, v, __ATOMIC_RELAXED, __HIP_MEMORY_SCOPE_AGENT); }
__device__ __forceinline__ unsigned xb_xcc_id() { return (unsigned)__builtin_amdgcn_s_getreg((3 << 11) | 20) & 0xFu; }
#define XB_SPIN(cond, bar) do { unsigned _sp = 0; while (cond) { __builtin_amdgcn_s_sleep(1); \
    if ((++_sp & 255u) == 0u) { if (xb_ld(&(bar)[XB_TMO])) break; if (_sp > XB_SPIN_CAP) { atomicAdd(&(bar)[XB_TMO], 1u); break; } } } } while (0)

struct XcdBarrier {
    unsigned* bar; unsigned x;
    volatile LAS unsigned* st;
};

__device__ __forceinline__ XcdBarrier xcd_barrier_post(unsigned* bar, volatile LAS unsigned* st) {
    XcdBarrier b; b.bar = bar; b.x = xb_xcc_id(); b.st = st;
    if (threadIdx.x == 0) (void)xb_add(&bar[XB_XCNT(b.x)], 1u);
    return b;
}
__device__ __forceinline__ void xcd_barrier_complete(unsigned* bar, unsigned x, unsigned& nloc, unsigned& nx) {
    const unsigned G = gridDim.x * gridDim.y * gridDim.z;
    unsigned sum, cnt, mine, sp = 0u;
    for (;;) {
        sum = 0u; cnt = 0u; mine = 0u;
#pragma unroll
        for (unsigned j = 0; j < 16; ++j) { const unsigned c = xb_ld(&bar[XB_XCNT(j)]); sum += c; cnt += (c > 0u) ? 1u : 0u; mine = (j == x) ? c : mine; }
        if (sum == G) break;
        __builtin_amdgcn_s_sleep(1);
        if ((++sp & 255u) == 0u) { if (xb_ld(&bar[XB_TMO])) break; if (sp > XB_SPIN_CAP) { atomicAdd(&bar[XB_TMO], 1u); break; } }
    }
    nloc = mine > 0u ? mine : 1u; nx = cnt > 0u ? cnt : 1u;
}

__device__ __forceinline__ void xcd_barrier(const XcdBarrier& b) {
    asm volatile("s_waitcnt vmcnt(0)" ::: "memory");
    __syncthreads();
    if (threadIdx.x == 0) {
        unsigned* bar = b.bar;
        __builtin_amdgcn_s_waitcnt(0);
        unsigned nloc = b.st[0], nx = b.st[1];
        if (nloc == 0u) { xcd_barrier_complete(bar, b.x, nloc, nx); b.st[0] = nloc; b.st[1] = nx; }
        const unsigned old = xb_add(&bar[XB_XSUB(b.x)], 1u);
        const unsigned gen = old / nloc;
        if (old + 1u == (gen + 1u) * nloc) {
            __builtin_amdgcn_fence(__ATOMIC_RELEASE, "agent");
            asm volatile("s_waitcnt vmcnt(0)" ::: "memory");
            const unsigned og = xb_add(&bar[XB_TOP], 1u);
            const unsigned tg = og / nx;
            if (og + 1u == (tg + 1u) * nx) xb_add(&bar[XB_TOPGEN], 1u);
            else XB_SPIN(xb_ld(&bar[XB_TOPGEN]) == tg, bar);
            __builtin_amdgcn_fence(__ATOMIC_ACQUIRE, "agent");
            xb_add(&bar[XB_XGEN(b.x)], 1u);
            asm volatile("s_waitcnt vmcnt(0)" ::: "memory");
        } else {
            XB_SPIN(xb_ld(&bar[XB_XGEN(b.x)]) == gen, bar);
            __builtin_amdgcn_fence(__ATOMIC_ACQUIRE, "agent");
            asm volatile("s_waitcnt vmcnt(0)" ::: "memory");
        }
    }
    __syncthreads();
}

constexpr int NT = 512;
constexpr int LDS_STAGE = pg8::STAGE_BYTES;
constexpr int LDS_MISC = LDS_STAGE;
constexpr int LDS_RT = LDS_STAGE + 64;
constexpr int LDS_BYTES = LDS_STAGE + 64 + 256;
struct MegaArgs { Params p; unsigned* bar; int reps[16]; };

DEVFN size_t VTF() { return (size_t)blockIdx.x * 512 + (size_t)TIDX(); }
DEVFN int OPQS(int v) { asm volatile("" : "+s"(v)); return v; }
typedef const __attribute__((address_space(4))) MegaArgs* KArgP;
DEVFN int REPS(int k) { KArgP ka = (KArgP)__builtin_amdgcn_kernarg_segment_ptr(); asm volatile("" : "+s"(ka)); return ka->reps[k]; }
DEVFN unsigned* BARP() { KArgP ka = (KArgP)__builtin_amdgcn_kernarg_segment_ptr(); asm volatile("" : "+s"(ka)); return ka->bar; }
DEVFN const Params& PF() { KArgP ka = (KArgP)__builtin_amdgcn_kernarg_segment_ptr(); asm volatile("" : "+s"(ka)); return *(const Params*)&ka->p; }
DEVFN int NBF() { int g = (int)gridDim.x; asm volatile("" : "+s"(g)); return g; }
DEVFN size_t VSF() { return (size_t)NBF() * 512; }
__global__ void __launch_bounds__(NT, 2) k_mega(MegaArgs a) {
    extern __shared__ __attribute__((aligned(16))) unsigned char lds[];
    bf16_t* const smem = (bf16_t*)lds;
    volatile int* const s_unit = (volatile int*)(lds + LDS_MISC + 16);
    static_assert(2 * AT_NSUB * AT_BUF * 2 <= LDS_STAGE && 2 * AT_BUF * 2 + 2048 <= LDS_STAGE && AT_BUF >= NA_BUF && (NT / 64) * RW_STG * 4 <= LDS_STAGE, "LDS carve");
    if (threadIdx.x == 0) *(uint4*)(lds + LDS_MISC) = make_uint4(0u, 0u, 0u, 0u);
    __syncthreads();
    (void)xcd_barrier_post(a.bar, (volatile LAS unsigned*)(lds + LDS_MISC));
#define GRID_BARRIER() do { XcdBarrier b_; b_.bar = BARP(); b_.x = xb_xcc_id(); b_.st = (volatile LAS unsigned*)(lds + LDS_MISC); xcd_barrier(b_); } while (0)
    const Params& p = a.p;
    const int nb = gridDim.x, bx = blockIdx.x;
    const size_t vt = (size_t)bx * NT + threadIdx.x, vs = (size_t)nb * NT;

    ph_init(p, 0, vt, vs);
    for (int r_ = a.reps[12]; r_ > 0; --r_) {
    ph_mod_partial(p, vt, vs);
    ph_transpose_t(p.w_in, p.WinT, D, N_IN, DEPTH, (size_t)N_INP * D, 0, D, 0, smem, bx, nb);
    ph_transpose_t(p.w_out, p.WoutT, D_MIX, D, DEPTH, (size_t)D * D_MIX, 0, D_MIX, 0, smem, bx, nb);
    for (int cu = 0; cu < D_EXP / 128; ++cu) {
        ph_transpose_t(p.exp_w_gate + cu * 128, p.WguT, D, 128, DEPTH * NE, (size_t)2 * D_EXP * D, cu * 256, D, 0, smem, bx, nb, (size_t)D * D_EXP, D_EXP);
        ph_transpose_t(p.exp_w_up + cu * 128, p.WguT, D, 128, DEPTH * NE, (size_t)2 * D_EXP * D, cu * 256 + 128, D, 0, smem, bx, nb, (size_t)D * D_EXP, D_EXP);
    }
    ph_transpose_t(p.exp_w_down, p.WdT, D_EXP, D, DEPTH * NE, (size_t)D * D_EXP, 0, D_EXP, 0, smem, bx, nb);
    }
    ph_zero16((uint4*)p.WupT, (size_t)DEPTH * NUP * KUP * 2 / 16, vt, vs);
    ph_zero16((uint4*)p.WloT, (size_t)DEPTH * NLO * KLO * 2 / 16, vt, vs);
    GRID_BARRIER();
    ph_mod_final(p, vt, vs);
    ph_transpose(p.mla_w_uq, p.WupT, MLA_QL, NUPQ, DEPTH, (size_t)NUP * KUP, 0, KUP, 0, vt, vs);
    ph_transpose(p.mla_w_ukv, p.WupT, MLA_KVL, NUP - NUPQ, DEPTH, (size_t)NUP * KUP, NUPQ, KUP, MLA_QL, vt, vs);
    for (int dir = 0; dir < 2; ++dir) {
        ph_transpose(p.rw_w_up + (size_t)dir * RW_WL * GD, p.WloT, RW_WL, GD, DEPTH, (size_t)NLO * KLO, dir * GD, KLO, dir * RW_WL, vt, vs, (size_t)2 * RW_WL * GD);
        ph_transpose(p.rw_a_up + (size_t)dir * RW_AL * GD, p.WloT, RW_AL, GD, DEPTH, (size_t)NLO * KLO, 2 * GD + dir * GD, KLO, 2 * RW_WL + dir * RW_AL, vt, vs, (size_t)2 * RW_AL * GD);
    }
    ph_transpose(p.rw_g_up, p.WloT, RW_GL, GD, DEPTH, (size_t)NLO * KLO, 4 * GD, KLO, 2 * RW_WL + 2 * RW_AL, vt, vs);
    GRID_BARRIER();
    ph_modulate(p, 0, vt, vs);
    GRID_BARRIER();

    for (int l = 0; l < DEPTH; ++l) {
        for (int r_ = REPS(0); r_ > 0; --r_)
        {
            pg8::Gemm g{PF().xm, PF().WinT + (size_t)l * N_INP * D, TT, N_INP, D}; pg8::StaticOrder S; S.init(TT, N_INP, NBF(), OPQS(bx));
            pg8::EpiBf16N E{PF().P, N_IN, N_IN};
            pg8::gemm_phase<pg8::EpiBf16N, pg8::StaticOrder, false>((PG8_LAS unsigned char*)lds, g, S, E, nullptr);
            GRID_BARRIER();
        }
        for (int r_ = REPS(1); r_ > 0; --r_) {
        ph_rw_mix(PF(), l, VTF(), VSF());
        ph_mb_prep(PF(), l, VTF(), VSF());
        ph_mla_norm(PF(), l, VTF(), VSF());
        ph_vt_tiles(PF(), 0, smem, OPQS(bx), NBF());
        GRID_BARRIER();
        }
        for (int r_ = REPS(8); r_ > 0; --r_) {
        {
            pg8::Gemm g{PF().pmb, PF().WloT + (size_t)l * NLO * KLO, TT, NLO, KLO}; pg8::StaticOrder S; S.init(TT, NLO, NBF(), OPQS(bx));
            pg8::EpiBf16N E{PF().LO, NLO, NLO};
            pg8::gemm_phase<pg8::EpiBf16N, pg8::StaticOrder, false>((PG8_LAS unsigned char*)lds, g, S, E, nullptr);
        }
        {
            pg8::Gemm g{PF().qkvn, PF().WupT + (size_t)l * NUP * KUP, TT, NUP, KUP}; pg8::StaticOrder S; S.init(TT, NUP, NBF(), OPQS(bx));
            pg8::EpiF32 E{PF().QKVraw, NUP, nullptr};
            pg8::gemm_phase<pg8::EpiF32, pg8::StaticOrder, false>((PG8_LAS unsigned char*)lds, g, S, E, nullptr);
        }
        GRID_BARRIER();
        }
        for (int r_ = REPS(9); r_ > 0; --r_) { ph_rw_prep(PF(), l, VTF(), VSF()); ph_mla_rope(PF(), l, VTF(), VSF()); ph_vt_tiles(PF(), 1, smem, OPQS(bx), NBF()); ph_vt_tiles(PF(), 2, smem, OPQS(bx), NBF()); ph_vt_tiles(PF(), 3, smem, OPQS(bx), NBF()); }
        GRID_BARRIER();
        for (int r_ = REPS(10); r_ > 0; --r_) { ph_chunks(PF(), l, (float*)lds, PF().qctr + l * 16 + 8 + (r_ - 1)); GRID_BARRIER(); }
        {
            constexpr int SEQ_BLOCKS = (NU * 2 * 64 + NT - 1) / NT;
            const int wv = __builtin_amdgcn_readfirstlane((int)(VTF() >> 6));
            for (int r_ = REPS(6); r_ > 0; --r_) {
                if (bx < NU) ph_rw_seq(PF(), lds, OPQS(bx), NU);
                else if (bx < NU + 2 * SEQ_BLOCKS) ph_mb_seq(PF(), wv - NU * (NT / 64), 2 * SEQ_BLOCKS * (NT / 64));
            }
            constexpr int QB = (NT / 64) * 32, RPU = NT / 128;
            const bool with_ctx = l < DEPTH - 1;
            const int n_mla = NB * NH * (SEQ / QB) + (with_ctx ? NB * NH * (CTX / QB) : 0);
            const int n_na = NB * NH * ((SEQ / GRID_W) / RPU) + (with_ctx ? NB * NH * (CTX / QB) : 0);
            for (int r_ = REPS(2); r_ > 0; --r_)
            for (;;) {
                __syncthreads();
                if (threadIdx.x == 0) *s_unit = atomicAdd(&PF().qctr[l * 16 + (r_ - 1)], 1);
                __syncthreads();
                const int u = *s_unit;
                if (u >= 2 * n_mla) break;
                mla_unit<NT>(PF(), smem, u);
            }
            for (int r_ = REPS(7); r_ > 0; --r_)
            for (;;) {
                __syncthreads();
                if (threadIdx.x == 0) *s_unit = atomicAdd(&PF().qctr[l * 16 + 4 + (r_ - 1)], 1);
                __syncthreads();
                const int u = *s_unit;
                if (u >= n_na) break;
                na_unit<NT>(PF(), l, smem, u);
            }
            GRID_BARRIER();
        }
        for (int r_ = REPS(3); r_ > 0; --r_) {
        ph_rw_yout(PF(), l, VTF(), VSF());
        ph_mb_yout(PF(), l, VTF(), VSF());
        ph_mla_combine(PF(), l < DEPTH - 1, VTF(), VSF());
        GRID_BARRIER();
        }
#define OUT_GEMM(SchedT, S_) do { pg8::Gemm g{PF().Ymix, PF().WoutT + (size_t)l * D * D_MIX, TT, D, D_MIX}; pg8::EpiBf16N E{PF().yo, D, D}; \
            pg8::gemm_phase<pg8::EpiBf16N, SchedT, false>((PG8_LAS unsigned char*)lds, g, S_, E, nullptr); } while (0)
#define OUT_NTL() (NBF() >= 64 ? (TT / 256 - OUT_T0) * (D / 256) : 0)
        if (l < DEPTH - 1) {
            constexpr int OUT_T0 = 32;
            { pg8::StaticOrder S; S.init(OUT_T0 * 256, D, NBF(), OPQS(bx)); OUT_GEMM(pg8::StaticOrder, S); }
            GRID_BARRIER();
            if (OPQS(bx) < OUT_NTL() || OUT_NTL() == 0) { pg8::TailOrder S{OUT_T0, TT / 256, D / 256, OUT_NTL() ? OUT_NTL() : NBF(), OPQS(bx)}; OUT_GEMM(pg8::TailOrder, S); }
            else { ph_ln1_route(PF(), l, (float*)lds, (int*)(lds + LDS_RT), (size_t)(OPQS(bx) - OUT_NTL()) * NT + TIDX(), (size_t)(NBF() - OUT_NTL()) * NT, 0, OUT_T0 * 256, true);
                ph_ln1_fix(PF(), (const int*)(lds + LDS_RT), (size_t)(OPQS(bx) - OUT_NTL()) * NT + TIDX(), (size_t)(NBF() - OUT_NTL()) * NT, 0, OUT_T0 * 256); }
            GRID_BARRIER();
            if (OUT_NTL() == 0) { ph_ln1_route(PF(), l, (float*)lds, (int*)(lds + LDS_RT), VTF(), VSF(), 0, TT, true); ph_ln1_fix(PF(), (const int*)(lds + LDS_RT), VTF(), VSF(), 0, TT); }
            else if (OPQS(bx) >= OUT_NTL()) {
                ph_ln1_route(PF(), l, (float*)lds, (int*)(lds + LDS_RT), ((size_t)(TIDX() >> 6) * (NBF() - OUT_NTL()) + (OPQS(bx) - OUT_NTL())) * 64 + (TIDX() & 63), (size_t)(NBF() - OUT_NTL()) * NT, OUT_T0 * 256, TT, false);
                ph_ln1_fix(PF(), (const int*)(lds + LDS_RT), ((size_t)(TIDX() >> 6) * (NBF() - OUT_NTL()) + (OPQS(bx) - OUT_NTL())) * 64 + (TIDX() & 63), (size_t)(NBF() - OUT_NTL()) * NT, OUT_T0 * 256, TT);
            }
        } else {
            { pg8::LatentOrder S; S.init(NB * SEQ, D, NBF(), OPQS(bx)); OUT_GEMM(pg8::LatentOrder, S); }
            GRID_BARRIER();
            ph_ln1_route(PF(), l, (float*)lds, (int*)(lds + LDS_RT), VTF(), VSF(), 0, TT, true);
            ph_ln1_fix(PF(), (const int*)(lds + LDS_RT), VTF(), VSF(), 0, TT);
        }
#undef OUT_GEMM
#undef OUT_NTL
        GRID_BARRIER();
        for (int r_ = REPS(13); r_ > 0; --r_) {
        ph_moe_perm(PF(), l, VTF(), VSF());
        GRID_BARRIER();
        }
        for (int r_ = REPS(14); r_ > 0; --r_) {
        {
            pg8::Gemm g{PF().hperm, PF().WguT + (size_t)l * NE * 2 * D_EXP * D, MPAD, NE * 2 * D_EXP, D};
            pg8::MoeOrder S{PF().cnt + l * NE, NBF(), OPQS(bx), 2 * D_EXP / 256};
            pg8::EpiSwiGLU E{PF().hidp, D_EXP, 2 * D_EXP / 256};
            pg8::gemm_phase<pg8::EpiSwiGLU, pg8::MoeOrder, false>((PG8_LAS unsigned char*)lds, g, S, E, nullptr);
        }
        GRID_BARRIER();
        }
        for (int r_ = REPS(15); r_ > 0; --r_) {
        {
            pg8::Gemm g{PF().hidp, PF().WdT + (size_t)l * NE * D * D_EXP, MPAD, NE * D, D_EXP};
            pg8::MoeOrder S{PF().cnt + l * NE, NBF(), OPQS(bx), D / 256};
            pg8::EpiBf16Grp E{PF().Fperm, D, D / 256};
            pg8::gemm_phase<pg8::EpiBf16Grp, pg8::MoeOrder, false>((PG8_LAS unsigned char*)lds, g, S, E, nullptr);
        }
        GRID_BARRIER();
        }
        ph_ln2(PF(), l, VTF(), VSF());
        GRID_BARRIER();
    }
}

static size_t carve(size_t& off, size_t bytes) { const size_t o = off; off += (bytes + 255) & ~(size_t)255; return o; }

extern "C" void kernel_launch(void* const* d_in, const int* in_sizes, int n_in, void* d_out, int out_size, void* d_ws, size_t ws_size, hipStream_t stream) {
    (void)in_sizes; (void)n_in; (void)out_size;
    MegaArgs a{};
    Params& p = a.p;
    const float* const* in = (const float* const*)d_in;
    p.x = in[0]; p.c = in[1]; p.ctx = in[2]; p.c_ctx = in[3]; p.ada_w = in[4]; p.ada_b = in[5]; p.w_in = in[6]; p.w_out = in[7];
    p.ln1_g = in[8]; p.ln1_b = in[9]; p.ln2_g = in[10]; p.ln2_b = in[11];
    p.rw_mu = in[12]; p.rw_w0 = in[13]; p.rw_w_up = in[14]; p.rw_a0 = in[15]; p.rw_a_up = in[16]; p.rw_g_up = in[17]; p.rw_k_k = in[18]; p.rw_k_a = in[19];
    p.rw_r_k = in[20]; p.rw_gn_g = in[21]; p.rw_gn_b = in[22];
    p.mb_conv_w = in[23]; p.mb_conv_b = in[24]; p.mb_a_log = in[25]; p.mb_dt_bias = in[26]; p.mb_d = in[27]; p.mb_norm_g = in[28];
    p.mla_q_norm = in[29]; p.mla_w_uq = in[30]; p.mla_kv_norm = in[31]; p.mla_w_ukv = in[32]; p.na_rpb = in[33];
    p.router_w = in[34]; p.router_b = in[35]; p.exp_w_gate = in[36]; p.exp_w_up = in[37]; p.exp_w_down = in[38];
    p.out = (float*)d_out;

    char* ws = (char*)d_ws; size_t off = 0;
    a.bar = (unsigned*)(ws + carve(off, (size_t)XCD_BAR_WORDS * 4));
    p.WinT = (bf16_t*)(ws + carve(off, (size_t)DEPTH * N_INP * D * 2));
    p.WoutT = (bf16_t*)(ws + carve(off, (size_t)DEPTH * D * D_MIX * 2));
    p.WguT = (bf16_t*)(ws + carve(off, (size_t)DEPTH * NE * 2 * D_EXP * D * 2));
    p.WdT = (bf16_t*)(ws + carve(off, (size_t)DEPTH * NE * D * D_EXP * 2));
    p.WupT = (bf16_t*)(ws + carve(off, (size_t)DEPTH * NUP * KUP * 2));
    p.WloT = (bf16_t*)(ws + carve(off, (size_t)DEPTH * NLO * KLO * 2));
    p.xs = (float*)(ws + carve(off, (size_t)TT * D * 4));
    p.xm = (bf16_t*)(ws + carve(off, (size_t)TT * D * 2));
    p.mod = (float*)(ws + carve(off, (size_t)DEPTH * NMOD * 6 * D * 4));
    p.modp = (float*)(ws + carve(off, (size_t)DEPTH * (D / 128) * NMOD * 6 * D * 4));
    p.ropecs = (float2*)(ws + carve(off, (size_t)GRID_W * (MLA_ROPE / 4) * 8));
    p.cnt = (int*)(ws + carve(off, (size_t)DEPTH * NE * 4));
    p.qctr = (int*)(ws + carve(off, (size_t)DEPTH * 16 * 4));
    p.tok_e = (int2*)(ws + carve(off, (size_t)TT * 8));
    p.tok_pos = (int2*)(ws + carve(off, (size_t)TT * 8));
    p.tok_row = (int2*)(ws + carve(off, (size_t)TT * 8));
    p.tok_w = (float2*)(ws + carve(off, (size_t)TT * 8));
    p.Ymix = (bf16_t*)(ws + carve(off, (size_t)TT * D_MIX * 2));
    p.naVt = (bf16_t*)(ws + carve(off, (size_t)NB * NH * HD * LL * 2));
    p.mlaO = (float*)(ws + carve(off, (size_t)TT * NH * 2 * MLA_V * 4));
    p.mlaML = (float*)(ws + carve(off, (size_t)TT * NH * 2 * 2 * 4));
    p.hb = (bf16_t*)(ws + carve(off, (size_t)TT * D * 2));
    const size_t regA = off;
    p.P = (bf16_t*)(ws + carve(off, (size_t)TT * N_IN * 2));
    p.pm = (float*)(ws + carve(off, (size_t)TT * RW_IN * 4));
    p.pmb = (bf16_t*)(ws + carve(off, (size_t)TT * KLO * 2));
    p.rwW = (float*)(ws + carve(off, (size_t)2 * TT * GD * 4));
    p.rwB = (float*)(ws + carve(off, (size_t)2 * TT * GD * 4));
    p.rwKD = (float*)(ws + carve(off, (size_t)2 * TT * GD * 4));
    p.rwKK = (float*)(ws + carve(off, (size_t)TT * GD * 4));
    p.rwG = (float*)(ws + carve(off, (size_t)TT * GD * 4));
    {
        const size_t o0 = off; size_t o1 = off, o2 = off;
        p.rwMsT = (bf16_t*)(ws + carve(o1, (size_t)NU * NCHK * HD * HD * 2));
        p.rwSloc = (float*)(ws + carve(o1, (size_t)NU * NCHK * HD * HD * 4));
        p.rwYI = (bf16_t*)(ws + carve(o1, (size_t)NU * LL * HD * 2));
        p.rwYloc = (float*)(ws + carve(o1, (size_t)NU * LL * HD * 4));
        p.LO = (bf16_t*)(ws + carve(o2, (size_t)TT * NLO * 2));
        p.QKVraw = (float*)(ws + carve(o2, (size_t)TT * NUP * 4));
        off = o1 > o2 ? o1 : o2; (void)o0;
    }
    p.xc = (float*)(ws + carve(off, (size_t)TT * MB_CONV_DIM * 4));
    p.dt = (float*)(ws + carve(off, (size_t)TT * 2 * NH * 4));
    p.mbC = (bf16_t*)(ws + carve(off, (size_t)TT * MB_GROUPS * MB_STATE * 2));
    p.mbB = (bf16_t*)(ws + carve(off, (size_t)TT * MB_GROUPS * MB_STATE * 2));
    p.mbXT = (bf16_t*)(ws + carve(off, (size_t)NB * NH * HD * LL * 2));
    p.mbBT = (bf16_t*)(ws + carve(off, (size_t)NB * MB_GROUPS * MB_STATE * LL * 2));
    p.mbCS = (bf16_t*)(ws + carve(off, (size_t)NU * NCHK * HD * MB_STATE * 2));
    p.mbYloc = (bf16_t*)(ws + carve(off, (size_t)NU * LL * HD * 2));
    p.mbCum = (float*)(ws + carve(off, (size_t)NU * LL * 4));
    p.qkvn = (bf16_t*)(ws + carve(off, (size_t)TT * KUP * 2));
    p.Qm = (bf16_t*)(ws + carve(off, (size_t)TT * NH * MLA_QK * 2));
    p.Km = (bf16_t*)(ws + carve(off, (size_t)TT * NH * MLA_QK * 2));
    p.Vt = (bf16_t*)(ws + carve(off, (size_t)TT * NH * MLA_V * 2));
    const size_t endA = off;
    off = regA;
    p.yo = (bf16_t*)(ws + carve(off, (size_t)TT * D * 2));
    p.hperm = (bf16_t*)(ws + carve(off, (size_t)MPAD * D * 2));
    p.hidp = (bf16_t*)(ws + carve(off, (size_t)MPAD * D_EXP * 2));
    p.Fperm = (bf16_t*)(ws + carve(off, (size_t)MPAD * D * 2));
    const size_t endB = off;
    const size_t need = endA > endB ? endA : endB;
    if (need > ws_size) return;

    static int grid = 0;
    if (!grid) {
        int dev = 0, cus = 0, per_cu = 0;
        if (hipGetDevice(&dev) != hipSuccess || hipDeviceGetAttribute(&cus, hipDeviceAttributeMultiprocessorCount, dev) != hipSuccess) { grid = -1; return; }
        if (hipFuncSetAttribute((const void*)k_mega, hipFuncAttributeMaxDynamicSharedMemorySize, LDS_BYTES) != hipSuccess) { grid = -1; return; }
        if (hipOccupancyMaxActiveBlocksPerMultiprocessor(&per_cu, (const void*)k_mega, NT, LDS_BYTES) != hipSuccess) per_cu = 0;
        grid = cus * (per_cu < 1 ? per_cu : 1);
        if (grid <= 0) grid = -1;
    }
    if (grid <= 0) return;
    for (int k = 0; k < 16; ++k) a.reps[k] = 1;
#ifdef PROBE_GROUP
    a.reps[PROBE_GROUP] = 2;
#endif
    (void)hipMemsetAsync(a.bar, 0, (size_t)XCD_BAR_WORDS * 4, stream);
    hipLaunchKernelGGL(k_mega, dim3(grid), dim3(NT), LDS_BYTES, stream, a);
}
```

```cpp
#include <hip/hip_runtime.h>
#include <stdint.h>
#include <stddef.h>
#include <math.h>

#ifndef CFG_SMALL
constexpr int D = 2048, NB = 2, SEQ = 4096, DEPTH = 4, CTX = 256, GRID_W = 64;
constexpr int HD = 64;
constexpr int RW_WL = 64, RW_AL = 64, RW_GL = 128;
constexpr int MB_STATE = 128, MB_GROUPS = 2, MB_CONV = 5;
constexpr int MLA_NOPE = 64, MLA_ROPE = 32;
constexpr int NA_WR = 8, NA_WC = 16;
constexpr int NE = 16, NEG = 4;
#else
constexpr int D = 256, NB = 2, SEQ = 64, DEPTH = 2, CTX = 16, GRID_W = 8;
constexpr int HD = 16;
constexpr int RW_WL = 8, RW_AL = 8, RW_GL = 16;
constexpr int MB_STATE = 16, MB_GROUPS = 2, MB_CONV = 5;
constexpr int MLA_NOPE = 16, MLA_ROPE = 8;
constexpr int NA_WR = 4, NA_WC = 4;
constexpr int NE = 16, NEG = 4;
#endif
constexpr int GD = D / 4, NH = GD / HD, D_MIX = 4 * GD;
constexpr int MLA_QL = 3 * D / 16, MLA_KVL = D / 16;
constexpr int D_EXP = D / 4, EPG = NE / NEG;
constexpr int RW_IN = 3 * GD + 2 * RW_WL + 2 * RW_AL + RW_GL;
constexpr int MB_CONV_DIM = GD + 2 * MB_GROUPS * MB_STATE;
constexpr int MB_IN = GD + MB_CONV_DIM + 2 * NH;
constexpr int MLA_V = HD, MLA_QK = MLA_NOPE + MLA_ROPE;
constexpr int MLA_IN = MLA_QL + MLA_KVL + MLA_ROPE;
constexpr int NA_IN = 3 * GD;
constexpr int N_IN = RW_IN + MB_IN + MLA_IN + NA_IN;
constexpr int OFF_RW = 0, OFF_MB = RW_IN, OFF_MLA = RW_IN + MB_IN, OFF_NA = OFF_MLA + MLA_IN;
constexpr int LL = CTX + SEQ, TT = NB * LL;
constexpr int NMOD = NB + 1;
constexpr int MPAD = ((2 * TT + 255) / 256 + NE) * 256;
constexpr int N_INP = ((N_IN + 255) / 256) * 256;
constexpr int KLO = 2 * RW_WL + 2 * RW_AL + RW_GL, NLO = 5 * GD;
constexpr int KUP = MLA_QL + MLA_KVL, NUPQ = NH * MLA_QK, NUP = NUPQ + NH * (MLA_NOPE + MLA_V);
constexpr float LN_EPS = 1e-6f, RMS_EPS = 1e-6f, RW_GN_EPS = 64e-5f, RW_DECAY_SCALE = 0.606531f, ROUTED_SCALE = 2.5f;
constexpr float ROPE_BASE = 10000.0f;
#define DN_ALPHA (sqrtf(sqrtf(2.0f * (float)DEPTH)))

typedef unsigned short bf16_t;

#define DEVFN __device__ __forceinline__


DEVFN uint32_t f_as_u(float f) { union { float f; uint32_t u; } c; c.f = f; return c.u; }
DEVFN float u_as_f(uint32_t u) { union { float f; uint32_t u; } c; c.u = u; return c.f; }
DEVFN bf16_t f2bf(float f) { uint32_t u = f_as_u(f); u += 0x7fffu + ((u >> 16) & 1u); return (bf16_t)(u >> 16); }
DEVFN float bf2f(bf16_t h) { return u_as_f(((uint32_t)h) << 16); }
DEVFN int TIDX() { int t = (int)threadIdx.x; asm volatile("" : "+v"(t)); return t; }
DEVFN float bflo(unsigned w) { return u_as_f(w << 16); }
DEVFN float bfhi(unsigned w) { return u_as_f(w & 0xffff0000u); }
DEVFN unsigned pk2(float a, float b) { return (unsigned)f2bf(a) | ((unsigned)f2bf(b) << 16); }
DEVFN float sigmoidf_(float x) { return 1.0f / (1.0f + expf(-x)); }
DEVFN float siluf_(float x) { return x * sigmoidf_(x); }
DEVFN float softplusf_(float x) { return x > 20.0f ? x : log1pf(expf(x)); }

struct Params {
    const float *x, *c, *ctx, *c_ctx, *ada_w, *ada_b, *w_in, *w_out, *ln1_g, *ln1_b, *ln2_g, *ln2_b;
    const float *rw_mu, *rw_w0, *rw_w_up, *rw_a0, *rw_a_up, *rw_g_up, *rw_k_k, *rw_k_a, *rw_r_k, *rw_gn_g, *rw_gn_b;
    const float *mb_conv_w, *mb_conv_b, *mb_a_log, *mb_dt_bias, *mb_d, *mb_norm_g;
    const float *mla_q_norm, *mla_w_uq, *mla_kv_norm, *mla_w_ukv, *na_rpb, *router_w, *router_b, *exp_w_gate, *exp_w_up, *exp_w_down;
    float* out;
    bf16_t *WinT, *WoutT, *WguT, *WdT, *WupT;
    float* xs;
    bf16_t* xm;
    float* mod;
    float* modp;
    float2* ropecs;
    bf16_t* P;
    float* pm;
    bf16_t* pmb;
    bf16_t* LO;
    bf16_t* WloT;
    float *rwW, *rwB, *rwKD;
    float *rwKK, *rwG;
    bf16_t* rwMsT;
    float* rwSloc;
    bf16_t* rwYI;
    float* rwYloc;
    float* xc;
    float* dt;
    bf16_t* mbC;
    bf16_t* mbB;
    bf16_t* mbXT;
    bf16_t* mbBT;
    bf16_t* mbCS;
    bf16_t* mbYloc;
    float* mbCum;
    bf16_t* qkvn;
    float* QKVraw;
    int* qctr;
    bf16_t *Qm, *Km, *Vt;
    bf16_t* naVt;
    float* mlaO;
    float* mlaML;
    bf16_t* Ymix;
    bf16_t* yo;
    bf16_t* hb;
    int* cnt;
    int2 *tok_e, *tok_pos, *tok_row;
    float2* tok_w;
    bf16_t *hperm, *hidp, *Fperm;
};

DEVFN void ph_init(const Params& p, int l, size_t vt, size_t vs) {
    const size_t n = (size_t)TT * D;
    for (size_t i = vt; i < n; i += vs) {
        const int d = (int)(i % D); const int t = (int)(i / D); const int b = t / LL, s = t % LL;
        p.xs[i] = s < CTX ? p.ctx[((size_t)b * CTX + s) * D + d] : p.x[((size_t)b * SEQ + (s - CTX)) * D + d];
    }
    for (size_t i = vt; i < (size_t)GRID_W * (MLA_ROPE / 4); i += vs) {
        const int f = (int)(i % (MLA_ROPE / 4)), pos = (int)(i / (MLA_ROPE / 4));
        const float ang = (float)pos * powf(ROPE_BASE, -(float)f / (float)(MLA_ROPE / 4));
        p.ropecs[i] = make_float2(cosf(ang), sinf(ang));
    }
    for (size_t i = vt; i < (size_t)DEPTH * NE; i += vs) p.cnt[i] = 0;
    for (size_t i = vt; i < (size_t)DEPTH * 16; i += vs) p.qctr[i] = 0;
}

DEVFN void ph_transpose(const float* src, bf16_t* dst, int K, int N, int batch, size_t dst_bstride, int dst_row0, int ldd, int col0, size_t vt, size_t vs, size_t src_bstride = 0, int src_ld = 0) {
    if (src_ld == 0) src_ld = N;
    if (src_bstride == 0) src_bstride = (size_t)K * src_ld;
    const size_t total = (size_t)batch * (K / 8) * N;
    for (size_t idx = vt; idx < total; idx += vs) {
        const int n = (int)(idx % N); const int k8 = (int)((idx / N) % (K / 8)); const int bt = (int)(idx / ((size_t)N * (K / 8)));
        const float* sp = src + (size_t)bt * src_bstride + (size_t)(k8 * 8) * src_ld + n;
        uint4 w;
        const size_t sl_ = (size_t)src_ld;
        w.x = (unsigned)f2bf(sp[0]) | ((unsigned)f2bf(sp[sl_]) << 16); w.y = (unsigned)f2bf(sp[2 * sl_]) | ((unsigned)f2bf(sp[3 * sl_]) << 16);
        w.z = (unsigned)f2bf(sp[4 * sl_]) | ((unsigned)f2bf(sp[5 * sl_]) << 16); w.w = (unsigned)f2bf(sp[6 * sl_]) | ((unsigned)f2bf(sp[7 * sl_]) << 16);
        *(uint4*)(dst + (size_t)bt * dst_bstride + (size_t)(dst_row0 + n) * ldd + col0 + k8 * 8) = w;
    }
}
DEVFN void ph_zero16(uint4* dst, size_t n16, size_t vt, size_t vs) { for (size_t i = vt; i < n16; i += vs) dst[i] = make_uint4(0u, 0u, 0u, 0u); }
typedef float tt_f32v2 __attribute__((ext_vector_type(2)));
typedef __bf16 tt_bf16v2 __attribute__((ext_vector_type(2)));
DEVFN unsigned tt_pk(float lo, float hi) { const tt_f32v2 v = {lo, hi}; const tt_bf16v2 r = __builtin_convertvector(v, tt_bf16v2); return __builtin_bit_cast(unsigned, r); }
DEVFN void ph_transpose_t(const float* src, bf16_t* dst, int K, int N, int batch, size_t dst_bstride, int dst_row0, int ldd, int col0, bf16_t* smem, int vb, int nvb, size_t src_bstride = 0, int src_ld = 0) {
    if (src_ld == 0) src_ld = N;
    if (src_bstride == 0) src_bstride = (size_t)K * src_ld;
    const int tid = TIDX(); const int lane = tid & 63, wid = __builtin_amdgcn_readfirstlane(tid >> 6);
    unsigned* sw = (unsigned*)smem + wid * (64 * 32);
    const int kt = K / 64, nt = (N + 63) / 64; const int total = batch * kt * nt;
    const int pc = lane & 15, r0 = lane >> 4, q = lane & 7, n0 = lane >> 3;
    const int stride = nvb * 8;
    int tile = vb * 8 + wid;
    if (tile >= total) return;
    float4 va[8], vb4[8];
#define TT_LOAD(tile_, A_, B_) do { const int tc = (tile_) < total ? (tile_) : total - 1; const int kti = tc % kt, nti = (tc / kt) % nt, bt = tc / (nt * kt); \
        const int nn = nti * 64 + pc * 4; const int nc = nn + 4 <= N ? nn : 0;            \
        const float* sp = src + (size_t)bt * src_bstride + (size_t)(kti * 64 + 2 * r0) * src_ld + nc; \
        _Pragma("unroll") for (int i = 0; i < 8; ++i) { A_[i] = *(const float4*)(sp + (size_t)(8 * i) * src_ld); B_[i] = *(const float4*)(sp + (size_t)(8 * i + 1) * src_ld); } } while (0)
    TT_LOAD(tile, va, vb4);
    for (; tile < total; tile += stride) {
        float4 na[8], nb4[8];
        TT_LOAD(tile + stride, na, nb4);
        __builtin_amdgcn_wave_barrier();
#pragma unroll
        for (int i = 0; i < 8; ++i) {
            unsigned* w = sw + (4 * pc) * 32 + ((r0 + 4 * i) ^ ((pc & 7) << 2));
            w[0] = tt_pk(va[i].x, vb4[i].x); w[32] = tt_pk(va[i].y, vb4[i].y); w[64] = tt_pk(va[i].z, vb4[i].z); w[96] = tt_pk(va[i].w, vb4[i].w);
        }
        __builtin_amdgcn_wave_barrier();
        {
            const int kti = tile % kt, nti = (tile / kt) % nt, bt = tile / (nt * kt);
#pragma unroll
            for (int i = 0; i < 8; ++i) {
                const int n = n0 + 8 * i; const uint4 v = *(const uint4*)(sw + n * 32 + 4 * (q ^ ((n >> 2) & 7)));
                const int gn = nti * 64 + n;
                if (gn < N) *(uint4*)(dst + (size_t)bt * dst_bstride + (size_t)(dst_row0 + gn) * ldd + col0 + kti * 64 + q * 8) = v;
            }
        }
#pragma unroll
        for (int i = 0; i < 8; ++i) { va[i] = na[i]; vb4[i] = nb4[i]; }
    }
#undef TT_LOAD
}

constexpr int MOD_IC = 128, MOD_NC = D / MOD_IC;
DEVFN void ph_mod_partial(const Params& p, size_t vt, size_t vs) {
    constexpr int J4 = 6 * D / 4;
    const size_t total = (size_t)DEPTH * MOD_NC * J4;
    for (size_t idx = vt; idx < total; idx += vs) {
        const int j4 = (int)(idx % J4); const int ic = (int)((idx / J4) % MOD_NC); const int l = (int)(idx / ((size_t)J4 * MOD_NC));
        float4 acc[NMOD];
#pragma unroll
        for (int r = 0; r < NMOD; ++r) acc[r] = make_float4(0.f, 0.f, 0.f, 0.f);
        const float* wp = p.ada_w + ((size_t)l * D + (size_t)ic * MOD_IC) * 6 * D + j4 * 4;
#pragma unroll 8
        for (int i = 0; i < MOD_IC; ++i) {
            const float4 w = *(const float4*)(wp + (size_t)i * 6 * D);
#pragma unroll
            for (int r = 0; r < NMOD; ++r) { const float cv = r < NB ? p.c[r * D + ic * MOD_IC + i] : p.c_ctx[ic * MOD_IC + i]; const float sv = siluf_(cv);
                acc[r].x += sv * w.x; acc[r].y += sv * w.y; acc[r].z += sv * w.z; acc[r].w += sv * w.w; }
        }
#pragma unroll
        for (int r = 0; r < NMOD; ++r) *(float4*)(p.modp + ((((size_t)l * MOD_NC + ic) * NMOD + r) * 6 * D) + j4 * 4) = acc[r];
    }
}
DEVFN void ph_mod_final(const Params& p, size_t vt, size_t vs) {
    const size_t total = (size_t)DEPTH * NMOD * 6 * D;
    for (size_t idx = vt; idx < total; idx += vs) {
        const int j = (int)(idx % (6 * D)); const int r = (int)((idx / (6 * D)) % NMOD); const int l = (int)(idx / ((size_t)6 * D * NMOD));
        float acc = p.ada_b[(size_t)l * 6 * D + j];
        for (int ic = 0; ic < MOD_NC; ++ic) acc += p.modp[(((size_t)l * MOD_NC + ic) * NMOD + r) * 6 * D + j];
        p.mod[idx] = acc;
    }
}

DEVFN void ph_modulate(const Params& p, int l, size_t vt, size_t vs) {
    const size_t n = (size_t)TT * D;
    for (size_t i = vt; i < n; i += vs) {
        const int d = (int)(i % D); const int t = (int)(i / D); const int b = t / LL, s = t % LL; const int r = s < CTX ? NB : b;
        const float* m = p.mod + ((size_t)l * NMOD + r) * 6 * D;
        p.xm[i] = f2bf(p.xs[i] * (1.0f + m[D + d]) + m[d]);
    }
}

typedef short bf16x8_t __attribute__((ext_vector_type(8)));
typedef float f32x16_t __attribute__((ext_vector_type(16)));
typedef __bf16 bf16v2_t __attribute__((ext_vector_type(2)));
typedef float f32v2_t __attribute__((ext_vector_type(2)));
DEVFN unsigned cvt_pk_bf16_h(float lo, float hi) { const f32v2_t v = {lo, hi}; const bf16v2_t r = __builtin_convertvector(v, bf16v2_t); return __builtin_bit_cast(unsigned, r); }
DEVFN unsigned cvt_pk_bf16(float lo, float hi) { unsigned r; asm volatile("v_cvt_pk_bf16_f32 %0, %1, %2" : "=v"(r) : "v"(lo), "v"(hi)); return r; }
union Frag8 { bf16x8_t v; unsigned u[4]; uint2 d2[2]; uint4 q; };


DEVFN void ph_rw_mix(const Params& p, int l, size_t vt, size_t vs) {
    static_assert(RW_IN % 8 == 0 && (3 * GD) % 8 == 0 && (2 * RW_WL) % 8 == 0 && (2 * RW_AL) % 8 == 0, "8-column groups");
    constexpr int NG = RW_IN / 8;
    const size_t n = (size_t)TT * NG;
    for (size_t i = vt; i < n; i += vs) {
        const int col = (int)(i % NG) * 8; const int t = (int)(i / NG); const int s_ = t % LL;
        const bool first = (s_ == 0 || s_ == CTX), last = (s_ == CTX - 1 || s_ == LL - 1);
        const bf16_t* pc = p.P + (size_t)t * N_IN + OFF_RW + col;
        const uint4 cv = *(const uint4*)pc;
        const uint4 pv = first ? make_uint4(0, 0, 0, 0) : *(const uint4*)(pc - N_IN);
        const uint4 nv = last ? make_uint4(0, 0, 0, 0) : *(const uint4*)(pc + N_IN);
        const float* m0 = p.rw_mu + ((size_t)l * 2 + 0) * RW_IN + col; const float* m1 = p.rw_mu + ((size_t)l * 2 + 1) * RW_IN + col;
        const float4 a0 = *(const float4*)m0, a1 = *(const float4*)(m0 + 4), b0 = *(const float4*)m1, b1 = *(const float4*)(m1 + 4);
        const float mu0[8] = {a0.x, a0.y, a0.z, a0.w, a1.x, a1.y, a1.z, a1.w}, mu1[8] = {b0.x, b0.y, b0.z, b0.w, b1.x, b1.y, b1.z, b1.w};
        const unsigned cw[4] = {cv.x, cv.y, cv.z, cv.w}, pw[4] = {pv.x, pv.y, pv.z, pv.w}, nw[4] = {nv.x, nv.y, nv.z, nv.w};
        float o[8];
#pragma unroll
        for (int k = 0; k < 4; ++k) {
            const float v0 = bflo(cw[k]), v1 = bfhi(cw[k]);
            o[2 * k] = v0 + mu0[2 * k] * (bflo(pw[k]) - v0) + mu1[2 * k] * (bflo(nw[k]) - v0);
            o[2 * k + 1] = v1 + mu0[2 * k + 1] * (bfhi(pw[k]) - v1) + mu1[2 * k + 1] * (bfhi(nw[k]) - v1);
        }
        if (col >= 3 * GD && col < 3 * GD + 2 * RW_WL) {
#pragma unroll
            for (int k = 0; k < 8; ++k) o[k] = tanhf(o[k]);
        } else if (col >= 3 * GD + 2 * RW_WL + 2 * RW_AL) {
#pragma unroll
            for (int k = 0; k < 8; ++k) o[k] = sigmoidf_(o[k]);
        }
        float* po = p.pm + (size_t)t * RW_IN + col;
        *(float4*)po = make_float4(o[0], o[1], o[2], o[3]); *(float4*)(po + 4) = make_float4(o[4], o[5], o[6], o[7]);
        if (col >= 3 * GD) *(uint4*)(p.pmb + (size_t)t * KLO + (col - 3 * GD)) = make_uint4(pk2(o[0], o[1]), pk2(o[2], o[3]), pk2(o[4], o[5]), pk2(o[6], o[7]));
    }
}

DEVFN void ph_rw_prep(const Params& p, int l, size_t vt, size_t vs) {
    static_assert(HD == 64, "one head = 16 lanes x 4 columns");
    constexpr int NG = GD / 4;
    const size_t n = (size_t)TT * NG;
    for (size_t i = vt; i < n; i += vs) {
        const int c = (int)(i % NG) * 4; const int t = (int)(i / NG);
        const float4 k4 = *(const float4*)(p.pm + (size_t)t * RW_IN + GD + c);
        const float4 kk4 = *(const float4*)(p.rw_k_k + (size_t)l * GD + c), ka4 = *(const float4*)(p.rw_k_a + (size_t)l * GD + c);
        const float k[4] = {k4.x, k4.y, k4.z, k4.w}, kkw[4] = {kk4.x, kk4.y, kk4.z, kk4.w}, ka[4] = {ka4.x, ka4.y, ka4.z, ka4.w};
        float kkr[4], ss = 0.f;
#pragma unroll
        for (int q = 0; q < 4; ++q) { kkr[q] = k[q] * kkw[q]; ss += kkr[q] * kkr[q]; }
#pragma unroll
        for (int o = 8; o > 0; o >>= 1) ss += __shfl_xor(ss, o);
        const float rn = 1.0f / sqrtf(fmaxf(ss, 1e-12f));
        const bf16_t* lo = p.LO + (size_t)t * NLO + c;
        float kkv[4];
#pragma unroll
        for (int q = 0; q < 4; ++q) kkv[q] = kkr[q] * rn;
#pragma unroll
        for (int dir = 0; dir < 2; ++dir) {
            const uint2 wl = *(const uint2*)(lo + dir * GD), al = *(const uint2*)(lo + 2 * GD + dir * GD);
            const float4 w0 = *(const float4*)(p.rw_w0 + ((size_t)l * 2 + dir) * GD + c), a0 = *(const float4*)(p.rw_a0 + ((size_t)l * 2 + dir) * GD + c);
            const float wp[4] = {w0.x + bflo(wl.x), w0.y + bfhi(wl.x), w0.z + bflo(wl.y), w0.w + bfhi(wl.y)};
            const float ap[4] = {a0.x + bflo(al.x), a0.y + bfhi(al.x), a0.z + bflo(al.y), a0.w + bfhi(al.y)};
            float dec[4], bv[4], kd[4];
#pragma unroll
            for (int q = 0; q < 4; ++q) { const float av = sigmoidf_(ap[q]); dec[q] = expf(-RW_DECAY_SCALE * sigmoidf_(wp[q])); bv[q] = kkv[q] * av; kd[q] = k[q] * (1.0f + (av - 1.0f) * ka[q]); }
            const size_t o = ((size_t)dir * TT + t) * GD + c;
            *(float4*)(p.rwW + o) = make_float4(dec[0], dec[1], dec[2], dec[3]); *(float4*)(p.rwB + o) = make_float4(bv[0], bv[1], bv[2], bv[3]); *(float4*)(p.rwKD + o) = make_float4(kd[0], kd[1], kd[2], kd[3]);
        }
        const uint2 gl = *(const uint2*)(lo + 4 * GD);
        *(float4*)(p.rwKK + (size_t)t * GD + c) = make_float4(kkv[0], kkv[1], kkv[2], kkv[3]);
        *(float4*)(p.rwG + (size_t)t * GD + c) = make_float4(bflo(gl.x), bfhi(gl.x), bflo(gl.y), bfhi(gl.y));
    }
}

DEVFN int scan_pos(int dir, int step) {
    if (dir == 0) return step;
    return step < CTX ? (CTX - 1 - step) : (CTX + (SEQ - 1) - (step - CTX));
}

constexpr int CK = 64, NCHK = LL / CK, NU = NB * NH * 2;
constexpr int RWS = 8;
constexpr int RW_ROW = 6 * HD;
constexpr int RW_STG = RWS * RW_ROW;
typedef float f2v __attribute__((ext_vector_type(2)));
template <int MODE>
DEVFN void rw_chunk_item(const Params& p, float* lds_f, const int item) {
    constexpr bool DO_T = MODE != 2, DO_L = MODE != 1;
    static_assert(HD == 64 && CTX % CK == 0 && SEQ % CK == 0 && CK % RWS == 0, "chunking");
    const int lane = (TIDX() & 63);
    float* stg = lds_f + (size_t)__builtin_amdgcn_readfirstlane((TIDX() >> 6)) * RW_STG;
    {
        const int c = item % NCHK, u = item / NCHK;
        const int dir = u % 2, h = (u / 2) % NH, b = u / (2 * NH);
        f2v ST[HD / 2], SL[HD / 2];
#pragma unroll
        for (int j = 0; j < HD / 2; ++j) { ST[j] = (f2v){(2 * j == lane) ? 1.f : 0.f, (2 * j + 1 == lane) ? 1.f : 0.f}; SL[j] = (f2v){0.f, 0.f}; }
        float4 na0, na1, na2, na3, na4, na5, nb0, nb1, nb2, nb3, nb4, nb5;
#define RWC_LOAD1(q_, sub_, X0, X1, X2, X3, X4, X5) do { const int t_ = b * LL + scan_pos(dir, c * CK + (sub_) * RWS + (q_) * 4 + lrow_); \
                X0 = *(const float4*)(p.rwW + ((size_t)dir * TT + t_) * GD + h * HD + lcol_); X1 = *(const float4*)(p.rwB + ((size_t)dir * TT + t_) * GD + h * HD + lcol_); \
                X2 = *(const float4*)(p.rwKD + ((size_t)dir * TT + t_) * GD + h * HD + lcol_); X3 = *(const float4*)(p.rwKK + (size_t)t_ * GD + h * HD + lcol_); \
                X4 = *(const float4*)(p.pm + (size_t)t_ * RW_IN + h * HD + lcol_); X5 = *(const float4*)(p.pm + (size_t)t_ * RW_IN + 2 * GD + h * HD + lcol_); } while (0)
#define RWC_LOAD(sub_) do { int lrow_ = lane >> 4, lcol_ = (lane & 15) * 4; asm volatile("" : "+v"(lrow_), "+v"(lcol_)); \
            RWC_LOAD1(0, sub_, na0, na1, na2, na3, na4, na5); RWC_LOAD1(1, sub_, nb0, nb1, nb2, nb3, nb4, nb5); } while (0)
        RWC_LOAD(0);
#pragma unroll 1
        for (int sub = 0; sub < CK / RWS; ++sub) {
            __builtin_amdgcn_wave_barrier();
            {
                int lrow = lane >> 4, lcol = (lane & 15) * 4;
                asm volatile("" : "+v"(lrow), "+v"(lcol));
                float* d0 = stg + (lrow) * RW_ROW + lcol; float* d1 = stg + (4 + lrow) * RW_ROW + lcol;
                *(float4*)(d0) = na0; *(float4*)(d0 + HD) = na1; *(float4*)(d0 + 2 * HD) = na2; *(float4*)(d0 + 3 * HD) = na3; *(float4*)(d0 + 4 * HD) = na4; *(float4*)(d0 + 5 * HD) = na5;
                *(float4*)(d1) = nb0; *(float4*)(d1 + HD) = nb1; *(float4*)(d1 + 2 * HD) = nb2; *(float4*)(d1 + 3 * HD) = nb3; *(float4*)(d1 + 4 * HD) = nb4; *(float4*)(d1 + 5 * HD) = nb5;
            }
            if (sub + 1 < CK / RWS) RWC_LOAD(sub + 1);
            __builtin_amdgcn_wave_barrier();
#pragma unroll 1
            for (int st = 0; st < RWS; ++st) {
                const float* sv = stg + st * RW_ROW;
                const int gs = c * CK + sub * RWS + st;
                f2v aT = {0.f, 0.f}, aL = {0.f, 0.f};
                float4 kkn = *(const float4*)(sv + 3 * HD);
#pragma unroll
                for (int j = 0; j < HD; j += 4) {
                    const float4 kk = kkn;
                    if (j + 4 < HD) kkn = *(const float4*)(sv + 3 * HD + j + 4);
                    asm volatile("" ::: "memory");
                    const f2v k0 = {kk.x, kk.y}, k1 = {kk.z, kk.w};
                    if (DO_T) { aT += ST[j / 2] * k0; aT += ST[j / 2 + 1] * k1; }
                    if (DO_L) { aL += SL[j / 2] * k0; aL += SL[j / 2 + 1] * k1; }
                }
                const float saT = -(aT.x + aT.y), saL = -(aL.x + aL.y);
                const f2v saT2 = {saT, saT}, saL2 = {saL, saL};
                int ln0 = lane; asm volatile("" : "+v"(ln0));
                const float vi = sv[5 * HD + ln0];
                const f2v vi2 = {vi, vi};
                f2v yT2 = {0.f, 0.f}, yL2 = {0.f, 0.f};
                float4 wn = *(const float4*)(sv), bn = *(const float4*)(sv + HD), kdn = *(const float4*)(sv + 2 * HD), rn = *(const float4*)(sv + 4 * HD);
#pragma unroll
                for (int j = 0; j < HD; j += 4) {
                    const float4 w = wn, bb = bn, kd = kdn, r = rn;
                    if (j + 4 < HD) { wn = *(const float4*)(sv + j + 4); bn = *(const float4*)(sv + HD + j + 4); if (DO_L) kdn = *(const float4*)(sv + 2 * HD + j + 4); rn = *(const float4*)(sv + 4 * HD + j + 4); }
                    asm volatile("" ::: "memory");
                    const f2v w0 = {w.x, w.y}, w1 = {w.z, w.w}, b0 = {bb.x, bb.y}, b1 = {bb.z, bb.w}, r0 = {r.x, r.y}, r1 = {r.z, r.w};
                    if (DO_T) {
                        ST[j / 2] = ST[j / 2] * w0 + saT2 * b0; ST[j / 2 + 1] = ST[j / 2 + 1] * w1 + saT2 * b1;
                        yT2 += ST[j / 2] * r0; yT2 += ST[j / 2 + 1] * r1;
                    }
                    if (DO_L) {
                        const f2v d0 = {kd.x, kd.y}, d1 = {kd.z, kd.w};
                        SL[j / 2] = SL[j / 2] * w0 + saL2 * b0 + vi2 * d0; SL[j / 2 + 1] = SL[j / 2 + 1] * w1 + saL2 * b1 + vi2 * d1;
                        yL2 += SL[j / 2] * r0; yL2 += SL[j / 2 + 1] * r1;
                    }
                }
                int ln = lane; asm volatile("" : "+v"(ln));
                if (DO_T) p.rwYI[((size_t)u * LL + gs) * HD + ln] = f2bf(yT2.x + yT2.y);
                if (DO_L) p.rwYloc[((size_t)u * LL + gs) * HD + ln] = yL2.x + yL2.y;
            }
        }
#undef RWC_LOAD
#undef RWC_LOAD1
        if (DO_T) {
        bf16_t* oT = p.rwMsT + ((size_t)u * NCHK + c) * HD * HD;
#pragma unroll
        for (int j = 0; j < HD; ++j) oT[(size_t)j * HD + lane] = f2bf((j & 1) ? ST[j / 2].y : ST[j / 2].x);
        }
        if (DO_L) {
        float* oL = p.rwSloc + (((size_t)u * NCHK + c) * HD + lane) * HD;
#pragma unroll
        for (int j = 0; j < HD; j += 4) *(float4*)(oL + j) = make_float4(SL[j / 2].x, SL[j / 2].y, SL[j / 2 + 1].x, SL[j / 2 + 1].y);
        }
    }
}

template <bool ISL>
DEVFN void rw_chunk_quarter(const Params& p, float* lds_f, const int item, const int rh) {
    const int lane = (TIDX() & 63);
    float* stg = lds_f + (size_t)__builtin_amdgcn_readfirstlane((TIDX() >> 6)) * RW_STG;
    const int c = item % NCHK, u = item / NCHK;
    const int dir = u % 2, h = (u / 2) % NH, b = u / (2 * NH);
    const int row = rh * 32 + (lane & 31), co = 32 * (lane >> 5);
    f2v S[16];
#pragma unroll
    for (int j = 0; j < 16; ++j) S[j] = ISL ? (f2v){0.f, 0.f} : (f2v){(co + 2 * j == row) ? 1.f : 0.f, (co + 2 * j + 1 == row) ? 1.f : 0.f};
    float4 na0, na1, na2, na3, na4, na5, nb0, nb1, nb2, nb3, nb4, nb5;
#define RWC_LOAD1(q_, sub_, X0, X1, X2, X3, X4, X5) do { const int t_ = b * LL + scan_pos(dir, c * CK + (sub_) * RWS + (q_) * 4 + lrow_); \
            X0 = *(const float4*)(p.rwW + ((size_t)dir * TT + t_) * GD + h * HD + lcol_); X1 = *(const float4*)(p.rwB + ((size_t)dir * TT + t_) * GD + h * HD + lcol_); \
            X2 = *(const float4*)(p.rwKD + ((size_t)dir * TT + t_) * GD + h * HD + lcol_); X3 = *(const float4*)(p.rwKK + (size_t)t_ * GD + h * HD + lcol_); \
            X4 = *(const float4*)(p.pm + (size_t)t_ * RW_IN + h * HD + lcol_); X5 = *(const float4*)(p.pm + (size_t)t_ * RW_IN + 2 * GD + h * HD + lcol_); } while (0)
#define RWC_LOAD(sub_) do { int lrow_ = lane >> 4, lcol_ = (lane & 15) * 4; asm volatile("" : "+v"(lrow_), "+v"(lcol_)); \
        RWC_LOAD1(0, sub_, na0, na1, na2, na3, na4, na5); RWC_LOAD1(1, sub_, nb0, nb1, nb2, nb3, nb4, nb5); } while (0)
    RWC_LOAD(0);
#pragma unroll 1
    for (int sub = 0; sub < CK / RWS; ++sub) {
        __builtin_amdgcn_wave_barrier();
        {
            int lrow = lane >> 4, lcol = (lane & 15) * 4;
            asm volatile("" : "+v"(lrow), "+v"(lcol));
            float* d0 = stg + (lrow) * RW_ROW + lcol; float* d1 = stg + (4 + lrow) * RW_ROW + lcol;
            *(float4*)(d0) = na0; *(float4*)(d0 + HD) = na1; *(float4*)(d0 + 2 * HD) = na2; *(float4*)(d0 + 3 * HD) = na3; *(float4*)(d0 + 4 * HD) = na4; *(float4*)(d0 + 5 * HD) = na5;
            *(float4*)(d1) = nb0; *(float4*)(d1 + HD) = nb1; *(float4*)(d1 + 2 * HD) = nb2; *(float4*)(d1 + 3 * HD) = nb3; *(float4*)(d1 + 4 * HD) = nb4; *(float4*)(d1 + 5 * HD) = nb5;
        }
        if (sub + 1 < CK / RWS) RWC_LOAD(sub + 1);
        __builtin_amdgcn_wave_barrier();
#pragma unroll 1
        for (int st = 0; st < RWS; ++st) {
            int co_ = co; asm volatile("" : "+v"(co_));
            const float* sv = stg + st * RW_ROW + co_;
            const int gs = c * CK + sub * RWS + st;
            f2v a2 = {0.f, 0.f};
#pragma unroll
            for (int j = 0; j < 32; j += 4) {
                const float4 kk = *(const float4*)(sv + 3 * HD + j);
                a2 += S[j / 2] * (f2v){kk.x, kk.y}; a2 += S[j / 2 + 1] * (f2v){kk.z, kk.w};
            }
            float sap = a2.x + a2.y; sap += __shfl_xor(sap, 32);
            const f2v sa2 = {-sap, -sap};
            int rw_ = row; asm volatile("" : "+v"(rw_));
            const float vi = ISL ? stg[st * RW_ROW + 5 * HD + rw_] : 0.f;
            const f2v vi2 = {vi, vi};
            f2v y2 = {0.f, 0.f};
#pragma unroll
            for (int j = 0; j < 32; j += 4) {
                asm volatile("" ::: "memory");
                const float4 w = *(const float4*)(sv + j), bb = *(const float4*)(sv + HD + j), r = *(const float4*)(sv + 4 * HD + j);
                const f2v w0 = {w.x, w.y}, w1 = {w.z, w.w}, b0 = {bb.x, bb.y}, b1 = {bb.z, bb.w}, r0 = {r.x, r.y}, r1 = {r.z, r.w};
                if (ISL) { const float4 kd = *(const float4*)(sv + 2 * HD + j); S[j / 2] = S[j / 2] * w0 + sa2 * b0 + vi2 * (f2v){kd.x, kd.y}; S[j / 2 + 1] = S[j / 2 + 1] * w1 + sa2 * b1 + vi2 * (f2v){kd.z, kd.w}; }
                else { S[j / 2] = S[j / 2] * w0 + sa2 * b0; S[j / 2 + 1] = S[j / 2 + 1] * w1 + sa2 * b1; }
                y2 += S[j / 2] * r0; y2 += S[j / 2 + 1] * r1;
            }
            float yp = y2.x + y2.y; yp += __shfl_xor(yp, 32);
            if (lane < 32) { if (ISL) p.rwYloc[((size_t)u * LL + gs) * HD + rw_] = yp; else p.rwYI[((size_t)u * LL + gs) * HD + rw_] = f2bf(yp); }
        }
    }
#undef RWC_LOAD
#undef RWC_LOAD1
    if (!ISL) {
        bf16_t* oT = p.rwMsT + ((size_t)u * NCHK + c) * HD * HD;
#pragma unroll
        for (int j = 0; j < 32; ++j) oT[(size_t)(co + j) * HD + row] = f2bf((j & 1) ? S[j / 2].y : S[j / 2].x);
    } else {
        float* oL = p.rwSloc + (((size_t)u * NCHK + c) * HD + row) * HD + co;
#pragma unroll
        for (int j = 0; j < 32; j += 4) *(float4*)(oL + j) = make_float4(S[j / 2].x, S[j / 2].y, S[j / 2 + 1].x, S[j / 2 + 1].y);
    }
}

constexpr int RSQ_D = 4;
constexpr int RSQ_SLOT = HD * HD * 2 + HD * HD * 4;
DEVFN void ph_rw_seq(const Params& p, unsigned char* lds_b, int vb, int nvb) {
    static_assert(NCHK % RSQ_D == 0 && RSQ_D == 4 && RSQ_SLOT == 3 * 512 * 16, "chain geometry: 3 x 16 B per thread per chunk");
    const int tid = TIDX(), lane = tid & 63, wave = tid >> 6, li = lane & 31, lh = lane >> 5;
    for (int u = vb; u < NU; u += nvb) {
        const unsigned char* gM = (const unsigned char*)(p.rwMsT + (size_t)u * NCHK * HD * HD);
        const unsigned char* gS = (const unsigned char*)(p.rwSloc + (size_t)u * NCHK * HD * HD);
        uint4 pf[RSQ_D][3];
#define RSQ_LOAD(d, c_) do { pf[d][0] = *(const uint4*)(gM + (size_t)(c_) * (HD * HD * 2) + tid * 16); \
            pf[d][1] = *(const uint4*)(gS + (size_t)(c_) * (HD * HD * 4) + tid * 16); pf[d][2] = *(const uint4*)(gS + (size_t)(c_) * (HD * HD * 4) + 8192 + tid * 16); } while (0)
#pragma unroll
        for (int d = 0; d < RSQ_D; ++d) RSQ_LOAD(d, d);
        f32x16_t X0, X1;
#pragma unroll
        for (int r = 0; r < 16; ++r) { X0[r] = 0.f; X1[r] = 0.f; }
        const int i = wave * 32 + li;
        __syncthreads();
#define RSQ_STEP(d, P0, P1, P2) { \
                const int c = c0 + d; \
                unsigned char* slot = lds_b + (c & 1) * RSQ_SLOT; \
                *(uint4*)(slot + tid * 16) = P0; *(uint4*)(slot + HD * HD * 2 + tid * 16) = P1; *(uint4*)(slot + HD * HD * 2 + 8192 + tid * 16) = P2; \
                if (c + RSQ_D < NCHK) { P0 = *(const uint4*)(gM + (size_t)(c + RSQ_D) * (HD * HD * 2) + tid * 16); P1 = *(const uint4*)(gS + (size_t)(c + RSQ_D) * (HD * HD * 4) + tid * 16); P2 = *(const uint4*)(gS + (size_t)(c + RSQ_D) * (HD * HD * 4) + 8192 + tid * 16); } \
                __syncthreads(); \
                if (wave < 2) { \
                    const bf16_t* ms = (const bf16_t*)slot; const float* sl = (const float*)(slot + HD * HD * 2) + (size_t)i * HD; \
                    Frag8 xb[2][2]; \
_Pragma("unroll") \
                    for (int sp = 0; sp < 2; ++sp) \
_Pragma("unroll") \
                        for (int q = 0; q < 4; ++q) { \
                            xb[0][sp].u[q] = cvt_pk_bf16_h(X0[8 * sp + 2 * q], X0[8 * sp + 2 * q + 1]); \
                            xb[1][sp].u[q] = cvt_pk_bf16_h(X1[8 * sp + 2 * q], X1[8 * sp + 2 * q + 1]); \
                        } \
                    f32x16_t N0, N1; \
_Pragma("unroll") \
                    for (int g = 0; g < 4; ++g) { \
                        const float4 v0 = *(const float4*)(sl + 8 * g + 4 * lh), v1 = *(const float4*)(sl + 32 + 8 * g + 4 * lh); \
                        N0[4 * g] = v0.x; N0[4 * g + 1] = v0.y; N0[4 * g + 2] = v0.z; N0[4 * g + 3] = v0.w; \
                        N1[4 * g] = v1.x; N1[4 * g + 1] = v1.y; N1[4 * g + 2] = v1.z; N1[4 * g + 3] = v1.w; \
                    } \
_Pragma("unroll") \
                    for (int jb = 0; jb < 2; ++jb) \
_Pragma("unroll") \
                        for (int sp = 0; sp < 2; ++sp) { \
                            Frag8 a0, a1; \
                            a0.d2[0] = *(const uint2*)(ms + (li) * HD + 32 * jb + 16 * sp + 4 * lh); a0.d2[1] = *(const uint2*)(ms + (li) * HD + 32 * jb + 16 * sp + 4 * lh + 8); \
                            a1.d2[0] = *(const uint2*)(ms + (32 + li) * HD + 32 * jb + 16 * sp + 4 * lh); a1.d2[1] = *(const uint2*)(ms + (32 + li) * HD + 32 * jb + 16 * sp + 4 * lh + 8); \
                            N0 = __builtin_amdgcn_mfma_f32_32x32x16_bf16(a0.v, xb[jb][sp].v, N0, 0, 0, 0); \
                            N1 = __builtin_amdgcn_mfma_f32_32x32x16_bf16(a1.v, xb[jb][sp].v, N1, 0, 0, 0); \
                        } \
                    float* so = p.rwSloc + (((size_t)u * NCHK + c) * HD + i) * HD; \
_Pragma("unroll") \
                    for (int g = 0; g < 4; ++g) { \
                        *(float4*)(so + 8 * g + 4 * lh) = make_float4(N0[4 * g], N0[4 * g + 1], N0[4 * g + 2], N0[4 * g + 3]); \
                        *(float4*)(so + 32 + 8 * g + 4 * lh) = make_float4(N1[4 * g], N1[4 * g + 1], N1[4 * g + 2], N1[4 * g + 3]); \
                    } \
                    X0 = N0; X1 = N1; \
                } \
 \
            }
        uint4 pa0, pa1, pa2, pb0, pb1, pb2, pc0, pc1, pc2, pd0, pd1, pd2;
        pa0 = pf[0][0]; pa1 = pf[0][1]; pa2 = pf[0][2]; pb0 = pf[1][0]; pb1 = pf[1][1]; pb2 = pf[1][2]; pc0 = pf[2][0]; pc1 = pf[2][1]; pc2 = pf[2][2]; pd0 = pf[3][0]; pd1 = pf[3][1]; pd2 = pf[3][2];
        for (int c0 = 0; c0 < NCHK; c0 += RSQ_D) {
            RSQ_STEP(0, pa0, pa1, pa2) RSQ_STEP(1, pb0, pb1, pb2) RSQ_STEP(2, pc0, pc1, pc2) RSQ_STEP(3, pd0, pd1, pd2)
        }
#undef RSQ_LOAD
#undef RSQ_STEP
        __syncthreads();
    }
}

DEVFN int rev_gs(int s) { return s < CTX ? (CTX - 1 - s) : (CTX + (SEQ - 1) - (s - CTX)); }
DEVFN int rev_chunk(int pbk) { return pbk < CTX / CK ? (CTX / CK - 1 - pbk) : (CTX / CK + (SEQ / CK - 1) - (pbk - CTX / CK)); }

DEVFN void ph_rw_yout(const Params& p, int l, size_t vt, size_t vs) {
    const int lane = (TIDX() & 63), lq = lane & 31, lh = lane >> 5;
    const int wv = __builtin_amdgcn_readfirstlane((int)(vt >> 6)), nwv = (int)(vs >> 6);
    const int wvs = (wv & 7) * (nwv >> 3) + (wv >> 3);
    for (int item = wvs; item < NB * NH * NCHK; item += nwv) {
        const int pbk = item % NCHK, h = (item / NCHK) % NH, b = item / (NCHK * NH);
        f32x16_t acc[2][2];
#pragma unroll
        for (int dir = 0; dir < 2; ++dir) {
            const int u = (b * NH + h) * 2 + dir;
            const int c = dir == 0 ? pbk : rev_chunk(pbk);
            int gs[2];
#pragma unroll
            for (int tb = 0; tb < 2; ++tb) { const int s_ = CK * pbk + 32 * tb + lq; gs[tb] = dir == 0 ? s_ : rev_gs(s_); }
#pragma unroll
            for (int tb = 0; tb < 2; ++tb) {
                const float* yl = p.rwYloc + ((size_t)u * LL + gs[tb]) * HD;
#pragma unroll
                for (int ib = 0; ib < 2; ++ib)
#pragma unroll
                    for (int g = 0; g < 4; ++g) {
                        const float4 v = *(const float4*)(yl + 32 * ib + 8 * g + 4 * lh);
                        if (dir == 0) { acc[ib][tb][4 * g] = v.x; acc[ib][tb][4 * g + 1] = v.y; acc[ib][tb][4 * g + 2] = v.z; acc[ib][tb][4 * g + 3] = v.w; }
                        else { acc[ib][tb][4 * g] += v.x; acc[ib][tb][4 * g + 1] += v.y; acc[ib][tb][4 * g + 2] += v.z; acc[ib][tb][4 * g + 3] += v.w; }
                    }
            }
            if (c > 0) {
                const float* st = p.rwSloc + ((size_t)u * NCHK + (c - 1)) * HD * HD;
#pragma unroll
                for (int ks = 0; ks < 4; ++ks) {
                    Frag8 a[2];
#pragma unroll
                    for (int ib = 0; ib < 2; ++ib) {
                        const float4 lo = *(const float4*)(st + (size_t)(32 * ib + lq) * HD + 16 * ks + 8 * lh), hi = *(const float4*)(st + (size_t)(32 * ib + lq) * HD + 16 * ks + 8 * lh + 4);
                        a[ib].u[0] = cvt_pk_bf16_h(lo.x, lo.y); a[ib].u[1] = cvt_pk_bf16_h(lo.z, lo.w); a[ib].u[2] = cvt_pk_bf16_h(hi.x, hi.y); a[ib].u[3] = cvt_pk_bf16_h(hi.z, hi.w);
                    }
#pragma unroll
                    for (int tb = 0; tb < 2; ++tb) {
                        const bf16x8_t bq = *(const bf16x8_t*)(p.rwYI + ((size_t)u * LL + gs[tb]) * HD + 16 * ks + 8 * lh);
#pragma unroll
                        for (int ib = 0; ib < 2; ++ib) acc[ib][tb] = __builtin_amdgcn_mfma_f32_32x32x16_bf16(a[ib].v, bq, acc[ib][tb], 0, 0, 0);
                    }
                }
            }
        }
#pragma unroll
        for (int tb = 0; tb < 2; ++tb) {
            const int t = b * LL + CK * pbk + 32 * tb + lq;
            float sum = 0.f;
#pragma unroll
            for (int ib = 0; ib < 2; ++ib)
#pragma unroll
                for (int r = 0; r < 16; ++r) sum += acc[ib][tb][r];
            sum += __shfl_xor(sum, 32);
            const float mu = sum * (1.0f / HD);
            float sq = 0.f;
#pragma unroll
            for (int ib = 0; ib < 2; ++ib)
#pragma unroll
                for (int r = 0; r < 16; ++r) { const float d = acc[ib][tb][r] - mu; sq += d * d; }
            sq += __shfl_xor(sq, 32);
            const float rs = 1.0f / sqrtf(sq * (1.0f / HD) + RW_GN_EPS);
            const float* pr = p.pm + (size_t)t * RW_IN + h * HD;
            float bon = 0.f;
#pragma unroll
            for (int ib = 0; ib < 2; ++ib)
#pragma unroll
                for (int g = 0; g < 4; ++g) {
                    const int i0 = 32 * ib + 8 * g + 4 * lh;
                    const float4 r4 = *(const float4*)(pr + i0), k4 = *(const float4*)(pr + GD + i0), rk = *(const float4*)(p.rw_r_k + (size_t)l * GD + h * HD + i0);
                    bon += r4.x * k4.x * rk.x + r4.y * k4.y * rk.y + r4.z * k4.z * rk.z + r4.w * k4.w * rk.w;
                }
            bon += __shfl_xor(bon, 32);
#pragma unroll
            for (int ib = 0; ib < 2; ++ib)
#pragma unroll
                for (int g = 0; g < 4; ++g) {
                    const int i0 = 32 * ib + 8 * g + 4 * lh;
                    const float4 v4 = *(const float4*)(pr + 2 * GD + i0), g4 = *(const float4*)(p.rwG + (size_t)t * GD + h * HD + i0);
                    const float4 gg = *(const float4*)(p.rw_gn_g + (size_t)l * GD + h * HD + i0), gb = *(const float4*)(p.rw_gn_b + (size_t)l * GD + h * HD + i0);
                    const float o0 = ((acc[ib][tb][4 * g] - mu) * rs * gg.x + gb.x + bon * v4.x) * g4.x, o1 = ((acc[ib][tb][4 * g + 1] - mu) * rs * gg.y + gb.y + bon * v4.y) * g4.y;
                    const float o2 = ((acc[ib][tb][4 * g + 2] - mu) * rs * gg.z + gb.z + bon * v4.z) * g4.z, o3 = ((acc[ib][tb][4 * g + 3] - mu) * rs * gg.w + gb.w + bon * v4.w) * g4.w;
                    uint2 w; w.x = cvt_pk_bf16(o0, o1); w.y = cvt_pk_bf16(o2, o3);
                    *(uint2*)(p.Ymix + (size_t)t * D_MIX + 0 * GD + h * HD + i0) = w;
                }
        }
    }
}

DEVFN size_t mb_frag_off(int t, int nn) {
    const int grp = nn >> 7, n = nn & 127;
    return ((size_t)((t >> 6) * MB_GROUPS + grp)) * (64 * MB_STATE) + (size_t)((((((t >> 5) & 1) * 8 + (n >> 4)) * 2 + ((n >> 3) & 1)) * 32 + (t & 31)) * 8);
}
DEVFN int tile_frag_off(int r, int pc) { return ((((r >> 5) * 4 + (pc >> 1)) * 2 + (pc & 1)) * 32 + (r & 31)) * 8; }
DEVFN void ph_mb_prep(const Params& p, int l, size_t vt, size_t vs) {
    static_assert(MB_CONV_DIM % 8 == 0 && MB_CONV == 5 && (GD + MB_GROUPS * MB_STATE) % 8 == 0, "8-channel groups");
    constexpr int NG = MB_CONV_DIM / 8;
    const size_t n = (size_t)TT * NG;
    for (size_t i = vt; i < n; i += vs) {
        const int c = (int)(i % NG) * 8; const int t = (int)(i / NG); const int s_ = t % LL;
        const int lo = s_ < CTX ? 0 : CTX, hi = s_ < CTX ? CTX : LL;
        const float4 b0 = *(const float4*)(p.mb_conv_b + (size_t)l * MB_CONV_DIM + c), b1 = *(const float4*)(p.mb_conv_b + (size_t)l * MB_CONV_DIM + c + 4);
        float acc[8] = {b0.x, b0.y, b0.z, b0.w, b1.x, b1.y, b1.z, b1.w};
#pragma unroll
        for (int j = 0; j < MB_CONV; ++j) {
            const int so = s_ + j - MB_CONV / 2;
            if (so >= lo && so < hi) {
                const uint4 xv = *(const uint4*)(p.P + (size_t)(t + j - MB_CONV / 2) * N_IN + OFF_MB + GD + c);
                const float* wp = p.mb_conv_w + ((size_t)l * MB_CONV + j) * MB_CONV_DIM + c;
                const float4 w0 = *(const float4*)wp, w1 = *(const float4*)(wp + 4);
                acc[0] += w0.x * bflo(xv.x); acc[1] += w0.y * bfhi(xv.x); acc[2] += w0.z * bflo(xv.y); acc[3] += w0.w * bfhi(xv.y);
                acc[4] += w1.x * bflo(xv.z); acc[5] += w1.y * bfhi(xv.z); acc[6] += w1.z * bflo(xv.w); acc[7] += w1.w * bfhi(xv.w);
            }
        }
#pragma unroll
        for (int k = 0; k < 8; ++k) acc[k] = siluf_(acc[k]);
        float* xo = p.xc + (size_t)t * MB_CONV_DIM + c;
        *(float4*)xo = make_float4(acc[0], acc[1], acc[2], acc[3]); *(float4*)(xo + 4) = make_float4(acc[4], acc[5], acc[6], acc[7]);
    }
    const size_t n2 = (size_t)TT * 2 * NH;
    for (size_t i = vt; i < n2; i += vs) {
        const int q = (int)(i % (2 * NH)); const int t = (int)(i / (2 * NH));
        p.dt[i] = softplusf_(bf2f(p.P[(size_t)t * N_IN + OFF_MB + GD + MB_CONV_DIM + q]) + p.mb_dt_bias[(size_t)l * 2 * NH + q]);
    }
}

DEVFN void ph_bc_frag(const Params& p, int vb, int nvb) {
    const int tid = TIDX(); const int r = tid >> 3, pc = tid & 7;
    for (int u = vb; u < (TT / 64) * 8; u += nvb) {
        const int nb4 = u & 3, isC = (u >> 2) & 1, tb = u >> 3;
        const int t = tb * 64 + r; const int nn = nb4 * 64 + pc * 8;
        const float* src = p.xc + (size_t)t * MB_CONV_DIM + GD + isC * (MB_GROUPS * MB_STATE) + nn;
        const float4 a = *(const float4*)src, c4 = *(const float4*)(src + 4);
        *(uint4*)((isC ? p.mbC : p.mbB) + mb_frag_off(t, nn)) = make_uint4(pk2(a.x, a.y), pk2(a.z, a.w), pk2(c4.x, c4.y), pk2(c4.z, c4.w));
    }
}

constexpr int MB_STG = 256;
DEVFN void mb_chunk_item(const Params& p, int l, float* lds_f, const int item) {
    static_assert(MB_STATE == 128 && HD == 64 && CK == 64, "mamba chunk geometry");
    const int lane = (TIDX() & 63), lq = lane & 31, lh = lane >> 5;
    (void)lds_f;
    const int pbk = item % NCHK, dir = (item / NCHK) & 1, h = (item / (2 * NCHK)) % NH, b = item / (2 * NCHK * NH);
    const int grp = h / (NH / MB_GROUPS), u = (b * NH + h) * 2 + dir;
    const int c = dir == 0 ? pbk : rev_chunk(pbk);
    const int t0 = b * LL + CK * pbk;
    const float A = -expf(p.mb_a_log[((size_t)l * 2 + dir) * NH + h]);
    const float dtv = p.dt[(size_t)(t0 + lane) * 2 * NH + dir * NH + h];
    float cum = dtv * A;
#pragma unroll
    for (int o = 1; o < 64; o <<= 1) { const float v = __shfl(cum, dir == 0 ? lane - o : lane + o); if (dir == 0 ? lane >= o : lane + o < 64) cum += v; }
    const float ctot = __shfl(cum, dir == 0 ? 63 : 0);
    const int gs = dir == 0 ? CK * pbk + lane : rev_gs(CK * pbk + lane);
    p.mbCum[(size_t)u * LL + gs] = cum;
    const float wsc = expf(ctot - cum) * dtv;
    f32x16_t G[2][2];
#pragma unroll
    for (int st = 0; st < 2; ++st)
#pragma unroll
        for (int tt = 0; tt < 2; ++tt)
#pragma unroll
            for (int r = 0; r < 16; ++r) G[st][tt][r] = 0.f;
    const bf16_t* Bg = p.mbB + (size_t)((t0 >> 6) * MB_GROUPS + grp) * (64 * MB_STATE); const bf16_t* Cg = p.mbC + (size_t)((t0 >> 6) * MB_GROUPS + grp) * (64 * MB_STATE);
#pragma unroll
    for (int ks = 0; ks < 8; ++ks) {
        bf16x8_t af[2], bfg[2];
#pragma unroll
        for (int q = 0; q < 2; ++q) { af[q] = *(const bf16x8_t*)(Bg + (((q * 8 + ks) * 2 + lh) * 32 + lq) * 8); bfg[q] = *(const bf16x8_t*)(Cg + (((q * 8 + ks) * 2 + lh) * 32 + lq) * 8); }
#pragma unroll
        for (int st = 0; st < 2; ++st)
#pragma unroll
            for (int tt = 0; tt < 2; ++tt) G[st][tt] = __builtin_amdgcn_mfma_f32_32x32x16_bf16(af[st], bfg[tt], G[st][tt], 0, 0, 0);
    }
    Frag8 pf[2][2][2];
#pragma unroll
    for (int tt = 0; tt < 2; ++tt) {
        const int et = 32 * tt + lq; const float cumt = __shfl(cum, et);
#pragma unroll
        for (int st = 0; st < 2; ++st) {
            float mv[16];
#pragma unroll
            for (int g = 0; g < 4; ++g) {
                const int es0 = 32 * st + 8 * g + 4 * lh;
                const float csv[4] = {__shfl(cum, es0), __shfl(cum, es0 + 1), __shfl(cum, es0 + 2), __shfl(cum, es0 + 3)};
                const float dtq[4] = {__shfl(dtv, es0), __shfl(dtv, es0 + 1), __shfl(dtv, es0 + 2), __shfl(dtv, es0 + 3)};
#pragma unroll
                for (int q = 0; q < 4; ++q) { const int es = es0 + q; const bool on = dir == 0 ? es <= et : es >= et; mv[4 * g + q] = on ? G[st][tt][4 * g + q] * expf(fminf(cumt - csv[q], 0.f)) * dtq[q] : 0.f; }
            }
#pragma unroll
            for (int sp = 0; sp < 2; ++sp)
#pragma unroll
                for (int j = 0; j < 4; ++j) pf[st][tt][sp].u[j] = cvt_pk_bf16_h(mv[8 * sp + 2 * j], mv[8 * sp + 2 * j + 1]);
        }
    }
    const bf16_t* Xg = p.mbXT + ((size_t)(b * NH + h) * NCHK + pbk) * 4096;
    {
        f32x16_t Y[2][2];
#pragma unroll
        for (int pt = 0; pt < 2; ++pt)
#pragma unroll
            for (int tt = 0; tt < 2; ++tt)
#pragma unroll
                for (int r = 0; r < 16; ++r) Y[pt][tt][r] = 0.f;
#pragma unroll
        for (int st = 0; st < 2; ++st)
#pragma unroll
            for (int sp = 0; sp < 2; ++sp) {
                Frag8 xa[2];
#pragma unroll
                for (int pt = 0; pt < 2; ++pt) { const bf16_t* xr = Xg + (((pt * 4 + 2 * st + sp) * 2) * 32 + lq) * 8 + 4 * lh; xa[pt].d2[0] = *(const uint2*)xr; xa[pt].d2[1] = *(const uint2*)(xr + 32 * 8); }
#pragma unroll
                for (int pt = 0; pt < 2; ++pt)
#pragma unroll
                    for (int tt = 0; tt < 2; ++tt) Y[pt][tt] = __builtin_amdgcn_mfma_f32_32x32x16_bf16(xa[pt].v, pf[st][tt][sp].v, Y[pt][tt], 0, 0, 0);
            }
#pragma unroll
        for (int tt = 0; tt < 2; ++tt) {
            bf16_t* yo = p.mbYloc + ((size_t)u * NCHK + pbk) * 4096 + tt * 2048;
#pragma unroll
            for (int pt = 0; pt < 2; ++pt)
#pragma unroll
                for (int g = 0; g < 4; ++g) { uint2 w; w.x = cvt_pk_bf16_h(Y[pt][tt][4 * g], Y[pt][tt][4 * g + 1]); w.y = cvt_pk_bf16_h(Y[pt][tt][4 * g + 2], Y[pt][tt][4 * g + 3]); *(uint2*)(yo + (((pt * 4 + g) * 32 + lq) * 2 + lh) * 4) = w; }
        }
    }
    {
        const bf16_t* BTg = p.mbBT + ((size_t)((b * MB_GROUPS + grp) * 2) * NCHK + pbk) * 4096;
        f32x16_t Cs[4][2];
#pragma unroll
        for (int nt = 0; nt < 4; ++nt)
#pragma unroll
            for (int pt = 0; pt < 2; ++pt)
#pragma unroll
                for (int r = 0; r < 16; ++r) Cs[nt][pt][r] = 0.f;
#pragma unroll
        for (int ks = 0; ks < 4; ++ks) {
            const int ew = 16 * ks + 8 * lh;
            const float4 w0 = make_float4(__shfl(wsc, ew), __shfl(wsc, ew + 1), __shfl(wsc, ew + 2), __shfl(wsc, ew + 3)), w1 = make_float4(__shfl(wsc, ew + 4), __shfl(wsc, ew + 5), __shfl(wsc, ew + 6), __shfl(wsc, ew + 7));
            bf16x8_t xb[2];
#pragma unroll
            for (int pt = 0; pt < 2; ++pt) xb[pt] = *(const bf16x8_t*)(Xg + (((pt * 4 + ks) * 2 + lh) * 32 + lq) * 8);
#pragma unroll
            for (int nt = 0; nt < 4; ++nt) {
                const uint4 bw = *(const uint4*)(BTg + (size_t)(nt >> 1) * NCHK * 4096 + ((((nt & 1) * 4 + ks) * 2 + lh) * 32 + lq) * 8);
                Frag8 a; a.u[0] = cvt_pk_bf16_h(bflo(bw.x) * w0.x, bfhi(bw.x) * w0.y); a.u[1] = cvt_pk_bf16_h(bflo(bw.y) * w0.z, bfhi(bw.y) * w0.w);
                a.u[2] = cvt_pk_bf16_h(bflo(bw.z) * w1.x, bfhi(bw.z) * w1.y); a.u[3] = cvt_pk_bf16_h(bflo(bw.w) * w1.z, bfhi(bw.w) * w1.w);
#pragma unroll
                for (int pt = 0; pt < 2; ++pt) Cs[nt][pt] = __builtin_amdgcn_mfma_f32_32x32x16_bf16(a.v, xb[pt], Cs[nt][pt], 0, 0, 0);
            }
        }
#pragma unroll
        for (int pt = 0; pt < 2; ++pt) {
            bf16_t* o = p.mbCS + ((size_t)u * NCHK + c) * HD * MB_STATE + pt * 4096;
#pragma unroll
            for (int nt = 0; nt < 4; ++nt)
#pragma unroll
                for (int g = 0; g < 4; ++g) { uint2 w; w.x = cvt_pk_bf16_h(Cs[nt][pt][4 * g], Cs[nt][pt][4 * g + 1]); w.y = cvt_pk_bf16_h(Cs[nt][pt][4 * g + 2], Cs[nt][pt][4 * g + 3]); *(uint2*)(o + (((nt * 4 + g) * 32 + lq) * 2 + lh) * 4) = w; }
        }
    }
}

constexpr int N_RW_PAIRS = NU * NCHK, N_RW_MERGED = 2048 < N_RW_PAIRS ? 2048 : N_RW_PAIRS;
constexpr int N_RW_ITEMS = N_RW_MERGED + 4 * (N_RW_PAIRS - N_RW_MERGED), N_MB_ITEMS = NB * NH * 2 * NCHK;
DEVFN void ph_chunks(const Params& p, int l, float* lds_f, int* ctr) {
    const int lane = (TIDX() & 63);
    for (;;) {
        int it = 0;
        if (lane == 0) it = atomicAdd(ctr, 1);
        it = __builtin_amdgcn_readfirstlane(it);
        if (it >= N_RW_ITEMS + N_MB_ITEMS) break;
        if (it < N_RW_MERGED) rw_chunk_item<0>(p, lds_f, it);
        else if (it < N_RW_ITEMS) { const int h4 = it - N_RW_MERGED; if (h4 & 2) rw_chunk_quarter<true>(p, lds_f, N_RW_MERGED + (h4 >> 2), h4 & 1); else rw_chunk_quarter<false>(p, lds_f, N_RW_MERGED + (h4 >> 2), h4 & 1); }
        else mb_chunk_item(p, l, lds_f, it - N_RW_ITEMS);
    }
}

DEVFN void ph_mb_seq(const Params& p, int wv, int nwv) {
    constexpr int DQ = 4;
    static_assert(NCHK % DQ == 0, "ring depth");
    const int lane = (TIDX() & 63);
    for (int item = wv; item < NU * 4; item += nwv) {
        const int q4 = item & 3, u = item >> 2;
        float X[32];
#pragma unroll
        for (int k = 0; k < 32; ++k) X[k] = 0.f;
        const size_t eo = (size_t)q4 * 2048 + (size_t)lane * 32;
        uint4 pf[DQ][4]; float dq[DQ];
#define MSQ_LOAD(d, c_) do { const uint4* src_ = (const uint4*)(p.mbCS + ((size_t)u * NCHK + (c_)) * HD * MB_STATE + eo); \
            _Pragma("unroll") for (int k = 0; k < 4; ++k) pf[d][k] = src_[k]; dq[d] = p.mbCum[(size_t)u * LL + (c_) * CK + CK - 1]; } while (0)
#pragma unroll
        for (int d = 0; d < DQ; ++d) MSQ_LOAD(d, d);
        for (int c0 = 0; c0 < NCHK; c0 += DQ) {
#pragma unroll
            for (int d = 0; d < DQ; ++d) {
                const int c = c0 + d;
                const float dtot = expf(dq[d]);
                uint4 o[4];
#pragma unroll
                for (int k = 0; k < 4; ++k) {
                    const unsigned w[4] = {pf[d][k].x, pf[d][k].y, pf[d][k].z, pf[d][k].w}; unsigned ow[4];
#pragma unroll
                    for (int m = 0; m < 4; ++m) {
                        X[8 * k + 2 * m] = dtot * X[8 * k + 2 * m] + u_as_f(w[m] << 16); X[8 * k + 2 * m + 1] = dtot * X[8 * k + 2 * m + 1] + u_as_f(w[m] & 0xffff0000u);
                        ow[m] = cvt_pk_bf16(X[8 * k + 2 * m], X[8 * k + 2 * m + 1]);
                    }
                    o[k] = make_uint4(ow[0], ow[1], ow[2], ow[3]);
                }
                if (c + DQ < NCHK) MSQ_LOAD(d, c + DQ);
                uint4* dst = (uint4*)(p.mbCS + ((size_t)u * NCHK + c) * HD * MB_STATE + eo);
#pragma unroll
                for (int k = 0; k < 4; ++k) dst[k] = o[k];
            }
        }
#undef MSQ_LOAD
    }
}

DEVFN void ph_mb_yout(const Params& p, int l, size_t vt, size_t vs) {
    constexpr int HPG = NH / MB_GROUPS;
    const int lane = (TIDX() & 63), lq = lane & 31, lh = lane >> 5;
    const int wv = __builtin_amdgcn_readfirstlane((int)(vt >> 6)), nwv = (int)(vs >> 6);
    const int wvs = (wv & 7) * (nwv >> 3) + (wv >> 3);
    for (int item = nwv - 1 - wvs; item < NB * MB_GROUPS * NCHK * 2; item += nwv) {
        const int tb = item & 1, pbk = (item >> 1) % NCHK, grp = ((item >> 1) / NCHK) % MB_GROUPS, b = (item >> 1) / (NCHK * MB_GROUPS);
        const int s_ = CK * pbk + 32 * tb + lq, t = b * LL + s_;
        const int gsd[2] = {s_, rev_gs(s_)};
        const int cd[2] = {pbk, rev_chunk(pbk)};
        const bf16_t* cfp = p.mbC + mb_frag_off(t, grp * MB_STATE + 8 * lh);
        f32x16_t acc[HPG][2];
#pragma unroll
        for (int hh = 0; hh < HPG; ++hh)
#pragma unroll
            for (int pt = 0; pt < 2; ++pt)
#pragma unroll
                for (int r = 0; r < 16; ++r) acc[hh][pt][r] = 0.f;
#pragma unroll
        for (int hh = 0; hh < HPG; ++hh) {
            const int h = grp * HPG + hh;
#pragma unroll
            for (int dir = 0; dir < 2; ++dir) {
                const int u = (b * NH + h) * 2 + dir, c = cd[dir];
                if (c > 0) {
                    const bf16_t* st = p.mbCS + ((size_t)u * NCHK + (c - 1)) * HD * MB_STATE;
                    f32x16_t d0, d1;
#pragma unroll
                    for (int r = 0; r < 16; ++r) { d0[r] = 0.f; d1[r] = 0.f; }
#pragma unroll
                    for (int ks = 0; ks < 8; ++ks) {
                        if ((ks & 1) == 0) asm volatile("" ::: "memory");
                        const bf16x8_t a0 = *(const bf16x8_t*)(st + ((((ks >> 1) * 4 + 2 * (ks & 1) + lh) * 32 + lq) * 2) * 4), a1 = *(const bf16x8_t*)(st + 4096 + ((((ks >> 1) * 4 + 2 * (ks & 1) + lh) * 32 + lq) * 2) * 4);
                        const bf16x8_t cfk = *(const bf16x8_t*)(cfp + ks * 512);
                        d0 = __builtin_amdgcn_mfma_f32_32x32x16_bf16(a0, cfk, d0, 0, 0, 0);
                        d1 = __builtin_amdgcn_mfma_f32_32x32x16_bf16(a1, cfk, d1, 0, 0, 0);
                    }
                    const float ec = expf(p.mbCum[(size_t)u * LL + gsd[dir]]);
#pragma unroll
                    for (int r = 0; r < 16; ++r) { acc[hh][0][r] += ec * d0[r]; acc[hh][1][r] += ec * d1[r]; }
                }
            }
        }
        float ss = 0.f;
#pragma unroll
        for (int hh = 0; hh < HPG; ++hh) {
            const int h = grp * HPG + hh;
            const float dsk = p.mb_d[(size_t)l * NH + h];
#pragma unroll
            for (int pt = 0; pt < 2; ++pt)
#pragma unroll
                for (int g = 0; g < 4; ++g) {
                    asm volatile("" ::: "memory");
                    const int p0 = 32 * pt + 8 * g + 4 * lh, ch = h * HD + p0;
                    float yl[4] = {0.f, 0.f, 0.f, 0.f};
#pragma unroll
                    for (int dir = 0; dir < 2; ++dir) {
                            const int u = (b * NH + h) * 2 + dir;
                            const uint2 w = *(const uint2*)(p.mbYloc + ((size_t)u * NCHK + pbk) * 4096 + tb * 2048 + (((pt * 4 + g) * 32 + lq) * 2 + lh) * 4);
                            yl[0] += u_as_f(w.x << 16); yl[1] += u_as_f(w.x & 0xffff0000u); yl[2] += u_as_f(w.y << 16); yl[3] += u_as_f(w.y & 0xffff0000u);
                        }
                    const float4 x4 = *(const float4*)(p.xc + (size_t)t * MB_CONV_DIM + ch);
                    const uint2 zw = *(const uint2*)(p.P + (size_t)t * N_IN + OFF_MB + ch);
                    const float z0 = u_as_f(zw.x << 16), z1 = u_as_f(zw.x & 0xffff0000u), z2 = u_as_f(zw.y << 16), z3 = u_as_f(zw.y & 0xffff0000u);
                    const float v0 = (acc[hh][pt][4 * g] + yl[0] + dsk * x4.x) * siluf_(z0), v1 = (acc[hh][pt][4 * g + 1] + yl[1] + dsk * x4.y) * siluf_(z1);
                    const float v2 = (acc[hh][pt][4 * g + 2] + yl[2] + dsk * x4.z) * siluf_(z2), v3 = (acc[hh][pt][4 * g + 3] + yl[3] + dsk * x4.w) * siluf_(z3);
                    acc[hh][pt][4 * g] = v0; acc[hh][pt][4 * g + 1] = v1; acc[hh][pt][4 * g + 2] = v2; acc[hh][pt][4 * g + 3] = v3;
                    ss += v0 * v0 + v1 * v1 + v2 * v2 + v3 * v3;
                }
        }
        ss += __shfl_xor(ss, 32);
        const float rs = 1.0f / sqrtf(ss * (1.0f / (GD / MB_GROUPS)) + RMS_EPS);
#pragma unroll
        for (int hh = 0; hh < HPG; ++hh)
#pragma unroll
            for (int pt = 0; pt < 2; ++pt)
#pragma unroll
                for (int g = 0; g < 4; ++g) {
                    asm volatile("" ::: "memory");
                    const int ch = (grp * HPG + hh) * HD + 32 * pt + 8 * g + 4 * lh;
                    const float4 ng = *(const float4*)(p.mb_norm_g + (size_t)l * GD + ch);
                    uint2 w; w.x = cvt_pk_bf16(acc[hh][pt][4 * g] * rs * ng.x, acc[hh][pt][4 * g + 1] * rs * ng.y); w.y = cvt_pk_bf16(acc[hh][pt][4 * g + 2] * rs * ng.z, acc[hh][pt][4 * g + 3] * rs * ng.w);
                    *(uint2*)(p.Ymix + (size_t)t * D_MIX + 1 * GD + ch) = w;
                }
    }
}

DEVFN void ph_mla_norm(const Params& p, int l, size_t vt, size_t vs) {
    static_assert(KUP == 512 && MLA_QL % 8 == 0, "one wave = one token: 64 lanes x 8 lora channels (q | kv)");
    const int lane = (TIDX() & 63);
    const size_t wv = vt >> 6, nwv = vs >> 6;
    const bool isq = lane * 8 < MLA_QL;
    for (size_t t = wv; t < (size_t)TT; t += nwv) {
        const uint4 xv = *(const uint4*)(p.P + t * N_IN + OFF_MLA + lane * 8);
        float x[8] = {bflo(xv.x), bfhi(xv.x), bflo(xv.y), bfhi(xv.y), bflo(xv.z), bfhi(xv.z), bflo(xv.w), bfhi(xv.w)};
        float ss = 0.f;
#pragma unroll
        for (int k = 0; k < 8; ++k) ss += x[k] * x[k];
        float sq = isq ? ss : 0.f, sk = isq ? 0.f : ss;
#pragma unroll
        for (int o = 32; o > 0; o >>= 1) { sq += __shfl_xor(sq, o); sk += __shfl_xor(sk, o); }
        const float rs = isq ? 1.0f / sqrtf(sq / MLA_QL + RMS_EPS) : 1.0f / sqrtf(sk / MLA_KVL + RMS_EPS);
        const float* gp = isq ? p.mla_q_norm + (size_t)l * MLA_QL + lane * 8 : p.mla_kv_norm + (size_t)l * MLA_KVL + (lane * 8 - MLA_QL);
        const float4 g0 = *(const float4*)gp, g1 = *(const float4*)(gp + 4);
        *(uint4*)(p.qkvn + t * KUP + lane * 8) = make_uint4(pk2(x[0] * rs * g0.x, x[1] * rs * g0.y), pk2(x[2] * rs * g0.z, x[3] * rs * g0.w), pk2(x[4] * rs * g1.x, x[5] * rs * g1.y), pk2(x[6] * rs * g1.z, x[7] * rs * g1.w));
    }
}

DEVFN void ph_mla_rope(const Params& p, int l, size_t vt, size_t vs) {
    static_assert(MLA_NOPE % 8 == 0 && MLA_ROPE == 32 && MLA_ROPE / 4 == 8, "rope groups: [axis][half][8 freqs]");
    constexpr int NGQ = MLA_QK / 8, NGN = MLA_NOPE / 8;
    const float qscale = 1.4426950408889634f / sqrtf((float)MLA_QK);
    const size_t n = (size_t)TT * NH * NGQ;
    for (size_t id = vt; id < n; id += vs) {
        const int g = (int)(id % NGQ); const int h = (int)((id / NGQ) % NH); const int t = (int)(id / ((size_t)NGQ * NH)); const int b = t / LL, s_ = t % LL; const bool lat = s_ >= CTX; const int tl = s_ - CTX;
        bf16_t* qo = p.Qm + ((size_t)(b * NH + h) * LL + s_) * MLA_QK + g * 8; bf16_t* ko = p.Km + ((size_t)(b * NH + h) * LL + s_) * MLA_QK + g * 8;
        const float* q = p.QKVraw + (size_t)t * NUP + h * MLA_QK;
        if (g < NGN) {
            const float4 q0 = *(const float4*)(q + g * 8), q1 = *(const float4*)(q + g * 8 + 4);
            const float* kv = p.QKVraw + (size_t)t * NUP + NUPQ + h * (MLA_NOPE + MLA_V) + g * 8;
            const float4 k0 = *(const float4*)kv, k1 = *(const float4*)(kv + 4);
            *(uint4*)qo = make_uint4(pk2(q0.x * qscale, q0.y * qscale), pk2(q0.z * qscale, q0.w * qscale), pk2(q1.x * qscale, q1.y * qscale), pk2(q1.z * qscale, q1.w * qscale));
            *(uint4*)ko = make_uint4(pk2(k0.x, k0.y), pk2(k0.z, k0.w), pk2(k1.x, k1.y), pk2(k1.z, k1.w));
        } else {
            const int e0 = (g - NGN) * 8; const int axis = e0 / 16, half = (e0 / 8) & 1;
            const float* qa = q + MLA_NOPE + axis * 16;
            const float4 x10 = *(const float4*)qa, x11 = *(const float4*)(qa + 4), x20 = *(const float4*)(qa + 8), x21 = *(const float4*)(qa + 12);
            const float qx1[8] = {x10.x, x10.y, x10.z, x10.w, x11.x, x11.y, x11.z, x11.w}, qx2[8] = {x20.x, x20.y, x20.z, x20.w, x21.x, x21.y, x21.z, x21.w};
            const bf16_t* kp = p.P + (size_t)t * N_IN + OFF_MLA + MLA_QL + MLA_KVL + axis * 16;
            const uint4 kw1 = *(const uint4*)kp, kw2 = *(const uint4*)(kp + 8);
            const float kx1[8] = {bflo(kw1.x), bfhi(kw1.x), bflo(kw1.y), bfhi(kw1.y), bflo(kw1.z), bfhi(kw1.z), bflo(kw1.w), bfhi(kw1.w)};
            const float kx2[8] = {bflo(kw2.x), bfhi(kw2.x), bflo(kw2.y), bfhi(kw2.y), bflo(kw2.z), bfhi(kw2.z), bflo(kw2.w), bfhi(kw2.w)};
            float qv[8], kvv[8];
            const int pos = lat ? (axis == 0 ? tl / GRID_W : tl % GRID_W) : 0;
#pragma unroll
            for (int f = 0; f < 8; ++f) {
                float cs = 1.f, sn = 0.f;
                if (lat) { const float2 t2 = p.ropecs[pos * 8 + f]; cs = t2.x; sn = t2.y; }
                qv[f] = (half == 0 ? qx1[f] * cs - qx2[f] * sn : qx2[f] * cs + qx1[f] * sn) * qscale;
                kvv[f] = half == 0 ? kx1[f] * cs - kx2[f] * sn : kx2[f] * cs + kx1[f] * sn;
            }
            *(uint4*)qo = make_uint4(pk2(qv[0], qv[1]), pk2(qv[2], qv[3]), pk2(qv[4], qv[5]), pk2(qv[6], qv[7]));
            *(uint4*)ko = make_uint4(pk2(kvv[0], kvv[1]), pk2(kvv[2], kvv[3]), pk2(kvv[4], kvv[5]), pk2(kvv[6], kvv[7]));
        }
    }
}

DEVFN void ph_vt_tiles(const Params& p, int mode, bf16_t* smem, int vb, int nvb) {
    static_assert(HD == 64 && MLA_V == 64 && LL % 64 == 0 && MB_STATE == 128, "64 x 64 tiles");
    const int tid = TIDX(); const int r = tid >> 3, pc = tid & 7;
    const int nrow = mode == 3 ? NB * MB_GROUPS * 2 : NB * NH;
    const int NTL = nrow * (LL / 64);
    constexpr int TLD = 72;
    for (int u = vb; u < NTL; u += nvb) {
        const int tb = u % (LL / 64), bh = u / (LL / 64);
        int b, h;
        if (mode == 3) { b = bh / (MB_GROUPS * 2); h = bh % (MB_GROUPS * 2); } else { b = bh / NH; h = bh % NH; }
        const int t = b * LL + tb * 64 + r;
        unsigned w[4];
        if (mode == 0) { const uint4 v = *(const uint4*)(p.P + (size_t)t * N_IN + OFF_NA + 2 * GD + h * HD + pc * 8); w[0] = v.x; w[1] = v.y; w[2] = v.z; w[3] = v.w; }
        else {
            const float* src = mode == 1 ? p.QKVraw + (size_t)t * NUP + NUPQ + h * (MLA_NOPE + MLA_V) + MLA_NOPE + pc * 8
                             : mode == 2 ? p.xc + (size_t)t * MB_CONV_DIM + h * HD + pc * 8
                                         : p.xc + (size_t)t * MB_CONV_DIM + GD + h * 64 + pc * 8;
            const float4 a = *(const float4*)src, c4 = *(const float4*)(src + 4);
            w[0] = pk2(a.x, a.y); w[1] = pk2(a.z, a.w); w[2] = pk2(c4.x, c4.y); w[3] = pk2(c4.z, c4.w);
        }
        __syncthreads();
#pragma unroll
        for (int k = 0; k < 4; ++k) { smem[(pc * 8 + 2 * k) * TLD + r] = (bf16_t)(w[k] & 0xffffu); smem[(pc * 8 + 2 * k + 1) * TLD + r] = (bf16_t)(w[k] >> 16); }
        __syncthreads();
        const uint4 o = *(const uint4*)(smem + r * TLD + pc * 8);
        bf16_t* base = mode == 0 ? p.naVt : mode == 1 ? p.Vt : mode == 2 ? p.mbXT : p.mbBT;
        if (mode >= 2) *(uint4*)(base + ((size_t)bh * (LL / 64) + tb) * 4096 + tile_frag_off(r, pc)) = o;
        else *(uint4*)(base + ((size_t)bh * 64 + r) * LL + tb * 64 + pc * 8) = o;
    }
    __syncthreads();
}

constexpr int AT_KLD = 104, AT_VLD = 68, AT_TK = 64;
constexpr int AT_BUF = AT_TK * AT_KLD + MLA_V * AT_VLD;
constexpr int AT_NSUB = 2;
template <int NTH>
DEVFN void mla_unit(const Params& p, bf16_t* smem, const int u2) {
    const int u = u2 >> 1, kh = u2 & 1;
    static_assert(MLA_QK == 96 && MLA_V == 64, "attention tiles are written for d_qk 96 / d_v 64");
    constexpr int NWV = NTH / 64, QB = NWV * 32;
    constexpr int NCHUNK1 = AT_TK * (MLA_QK / 8) + MLA_V * (AT_TK / 8);
    constexpr int NCHUNK = AT_NSUB * NCHUNK1;
    constexpr int NCH = (NCHUNK + NTH - 1) / NTH;
    constexpr int STAGE = AT_NSUB * AT_BUF;
    static_assert((CTX / AT_TK) % AT_NSUB == 0 && (LL / AT_TK) % AT_NSUB == 0, "whole stages");
    const int tid = TIDX(), lane = tid & 63, wave = tid >> 6, lq = lane & 31, lh = lane >> 5;
    const int n_lat = NB * NH * (SEQ / QB);
    {
        int bh, qbase, nkeys;
        if (u < n_lat) { bh = u / (SEQ / QB); qbase = CTX + (u % (SEQ / QB)) * QB; nkeys = LL; }
        else { const int u2 = u - n_lat; bh = u2 / (CTX / QB); qbase = (u2 % (CTX / QB)) * QB; nkeys = CTX; }
        const bf16_t* Kg = p.Km + (size_t)bh * LL * MLA_QK; const bf16_t* Vg = p.Vt + (size_t)bh * MLA_V * LL;
        const int q0 = qbase + wave * 32;
        bf16x8_t qf[6];
#pragma unroll
        for (int ks = 0; ks < 6; ++ks) qf[ks] = *(const bf16x8_t*)(p.Qm + ((size_t)bh * LL + q0 + lq) * MLA_QK + ks * 16 + lh * 8);
        f32x16_t o0, o1;
#pragma unroll
        for (int r = 0; r < 16; ++r) { o0[r] = 0.f; o1[r] = 0.f; }
        float m_i = -1e30f, l_i = 0.f;
        const int nst_all = nkeys / (AT_TK * AT_NSUB); const int nstages = nst_all / 2 + ((nst_all & 1) && kh == 0 ? 1 : 0);
        const int st_base = kh == 0 ? 0 : nst_all - nstages;
        uint4 stg[NCH];
#define MLA_LOAD(st_) do { _Pragma("unroll") for (int i = 0; i < NCH; ++i) { const int c = tid + i * NTH; const int sub = c / NCHUNK1, cc = c % NCHUNK1; const int k1 = ((st_base + (st_)) * AT_NSUB + sub) * AT_TK; \
            if (c < NCHUNK) { if (cc < AT_TK * 12) { const int key = cc / 12, ch = cc % 12; stg[i] = *(const uint4*)(Kg + (size_t)(k1 + key) * MLA_QK + ch * 8); } \
                              else { const int c2 = cc - AT_TK * 12; const int d = c2 / 8, ch = c2 % 8; stg[i] = *(const uint4*)(Vg + (size_t)d * LL + k1 + ch * 8); } } } } while (0)
#define MLA_STORE(buf_) do { _Pragma("unroll") for (int i = 0; i < NCH; ++i) { const int c = tid + i * NTH; const int sub = c / NCHUNK1, cc = c % NCHUNK1; bf16_t* dK = smem + (buf_) * STAGE + sub * AT_BUF; \
            if (c < NCHUNK) { if (cc < AT_TK * 12) { const int key = cc / 12, ch = cc % 12; *(uint4*)(dK + key * AT_KLD + ch * 8) = stg[i]; } \
                              else { const int c2 = cc - AT_TK * 12; const int d = c2 / 8, ch = c2 % 8; uint2* dst = (uint2*)(dK + AT_TK * AT_KLD + d * AT_VLD + ch * 8); dst[0] = make_uint2(stg[i].x, stg[i].y); dst[1] = make_uint2(stg[i].z, stg[i].w); } } } } while (0)
        MLA_LOAD(0);
        __syncthreads();
        MLA_STORE(0);
        __syncthreads();
        for (int st = 0; st < nstages; ++st) {
            const bool more = st + 1 < nstages;
            if (more) MLA_LOAD(st + 1);
            static_assert(AT_NSUB == 2, "two sub-tiles per stage");
            const bf16_t* sKa = smem + (st & 1) * STAGE; const bf16_t* sKb = sKa + AT_BUF;
            f32x16_t sa0, sa1, sb0, sb1;
#pragma unroll
            for (int r = 0; r < 16; ++r) { sa0[r] = 0.f; sa1[r] = 0.f; sb0[r] = 0.f; sb1[r] = 0.f; }
#pragma unroll
            for (int ks = 0; ks < 6; ++ks) {
                const bf16x8_t a0 = *(const bf16x8_t*)(sKa + (lq) * AT_KLD + ks * 16 + lh * 8), a1 = *(const bf16x8_t*)(sKa + (32 + lq) * AT_KLD + ks * 16 + lh * 8);
                sa0 = __builtin_amdgcn_mfma_f32_32x32x16_bf16(a0, qf[ks], sa0, 0, 0, 0);
                sa1 = __builtin_amdgcn_mfma_f32_32x32x16_bf16(a1, qf[ks], sa1, 0, 0, 0);
            }
#pragma unroll
            for (int ks = 0; ks < 6; ++ks) {
                const bf16x8_t a0 = *(const bf16x8_t*)(sKb + (lq) * AT_KLD + ks * 16 + lh * 8), a1 = *(const bf16x8_t*)(sKb + (32 + lq) * AT_KLD + ks * 16 + lh * 8);
                sb0 = __builtin_amdgcn_mfma_f32_32x32x16_bf16(a0, qf[ks], sb0, 0, 0, 0);
                sb1 = __builtin_amdgcn_mfma_f32_32x32x16_bf16(a1, qf[ks], sb1, 0, 0, 0);
            }
            __builtin_amdgcn_sched_barrier(0);
#define MLA_SOFTMAX_PV(s0, s1, sV) do { \
            float mx = -1e30f; \
            _Pragma("unroll") for (int r = 0; r < 16; ++r) mx = fmaxf(mx, fmaxf(s0[r], s1[r])); \
            mx = fmaxf(mx, __shfl_xor(mx, 32)); \
            const float m_new = fmaxf(m_i, mx); \
            const float alpha = __builtin_amdgcn_exp2f(m_i - m_new); \
            float rs = 0.f; \
            _Pragma("unroll") for (int r = 0; r < 16; ++r) { s0[r] = __builtin_amdgcn_exp2f(s0[r] - m_new); s1[r] = __builtin_amdgcn_exp2f(s1[r] - m_new); rs += s0[r] + s1[r]; } \
            rs += __shfl_xor(rs, 32); \
            l_i = l_i * alpha + rs; m_i = m_new; \
            if (__builtin_amdgcn_ballot_w64(alpha != 1.0f) != 0ull) { \
                _Pragma("unroll") for (int r = 0; r < 16; ++r) { o0[r] *= alpha; o1[r] *= alpha; } \
            } \
            Frag8 pf[2][2]; \
            _Pragma("unroll") for (int sp = 0; sp < 2; ++sp) \
                _Pragma("unroll") for (int j = 0; j < 4; ++j) { \
                    pf[0][sp].u[j] = cvt_pk_bf16_h(s0[8 * sp + 2 * j], s0[8 * sp + 2 * j + 1]); \
                    pf[1][sp].u[j] = cvt_pk_bf16_h(s1[8 * sp + 2 * j], s1[8 * sp + 2 * j + 1]); \
                } \
            _Pragma("unroll") for (int kb = 0; kb < 2; ++kb) \
                _Pragma("unroll") for (int sp = 0; sp < 2; ++sp) { \
                    const int kofs = kb * 32 + sp * 16 + lh * 4; \
                    Frag8 va, vb2; \
                    va.d2[0] = *(const uint2*)((sV) + (lq) * AT_VLD + kofs); va.d2[1] = *(const uint2*)((sV) + (lq) * AT_VLD + kofs + 8); \
                    vb2.d2[0] = *(const uint2*)((sV) + (32 + lq) * AT_VLD + kofs); vb2.d2[1] = *(const uint2*)((sV) + (32 + lq) * AT_VLD + kofs + 8); \
                    o0 = __builtin_amdgcn_mfma_f32_32x32x16_bf16(va.v, pf[kb][sp].v, o0, 0, 0, 0); \
                    o1 = __builtin_amdgcn_mfma_f32_32x32x16_bf16(vb2.v, pf[kb][sp].v, o1, 0, 0, 0); \
                } } while (0)
            MLA_SOFTMAX_PV(sa0, sa1, sKa + AT_TK * AT_KLD);
            MLA_SOFTMAX_PV(sb0, sb1, sKb + AT_TK * AT_KLD);
#undef MLA_SOFTMAX_PV
            if (more) MLA_STORE((st + 1) & 1);
            __syncthreads();
        }
#undef MLA_LOAD
#undef MLA_STORE
        const int b = bh / NH, h = bh % NH;
        const size_t rec = ((size_t)(b * LL + q0 + lq) * NH + h) * 2 + kh;
        float* orow = p.mlaO + rec * MLA_V;
#pragma unroll
        for (int g = 0; g < 4; ++g) {
            *(float4*)(orow + 8 * g + 4 * lh) = make_float4(o0[4 * g], o0[4 * g + 1], o0[4 * g + 2], o0[4 * g + 3]);
            *(float4*)(orow + 32 + 8 * g + 4 * lh) = make_float4(o1[4 * g], o1[4 * g + 1], o1[4 * g + 2], o1[4 * g + 3]);
        }
        if (lh == 0) *(float2*)(p.mlaML + rec * 2) = make_float2(m_i, l_i);
    }
}

DEVFN void ph_mla_combine(const Params& p, bool with_ctx, size_t vt, size_t vs) {
    const size_t n = (size_t)TT * NH * (MLA_V / 4);
    for (size_t i = vt; i < n; i += vs) {
        const int d4 = (int)(i % (MLA_V / 4)); const size_t th = i / (MLA_V / 4); const int h = (int)(th % NH); const size_t t = th / NH;
        if (!with_ctx && (int)(t % LL) < CTX) continue;
        const float2 ml0 = *(const float2*)(p.mlaML + (th * 2 + 0) * 2), ml1 = *(const float2*)(p.mlaML + (th * 2 + 1) * 2);
        const float m = fmaxf(ml0.x, ml1.x);
        const float e0 = __builtin_amdgcn_exp2f(ml0.x - m), e1 = __builtin_amdgcn_exp2f(ml1.x - m);
        const float inv = 1.0f / (ml0.y * e0 + ml1.y * e1);
        const float4 a = *(const float4*)(p.mlaO + (th * 2 + 0) * MLA_V + d4 * 4), c = *(const float4*)(p.mlaO + (th * 2 + 1) * MLA_V + d4 * 4);
        uint2 w; w.x = pk2((a.x * e0 + c.x * e1) * inv, (a.y * e0 + c.y * e1) * inv); w.y = pk2((a.z * e0 + c.z * e1) * inv, (a.w * e0 + c.w * e1) * inv);
        *(uint2*)(p.Ymix + t * D_MIX + 2 * GD + h * MLA_V + d4 * 4) = w;
    }
}

constexpr int NA_KLD = 72, NA_VLD = 68;
constexpr int NA_BUF = AT_TK * NA_KLD + HD * NA_VLD;
template <int NTH>
DEVFN void na_unit(const Params& p, int l, bf16_t* smem, const int u) {
    static_assert(HD == 64 && GRID_W == 64 && NA_WR == 8 && NA_WC == 16 && SEQ / GRID_W == 64, "natten tiles are written for a 64x64 grid, 8x16 window");
    constexpr int NWV = NTH / 64, QB = NWV * 32, RPU = NWV / 2, NLR = NA_WR + RPU - 1, NCT = CTX / AT_TK, ROWS = SEQ / GRID_W;
    constexpr int NCHUNK = AT_TK * (HD / 8) + HD * (AT_TK / 8);
    constexpr int NCH = (NCHUNK + NTH - 1) / NTH;
    constexpr int BW = 2 * NA_WC - 1, BH = 2 * NA_WR - 1;
    const float sc2 = 1.4426950408889634f / sqrtf((float)HD);
    const int tid = TIDX(), lane = tid & 63, wave = tid >> 6, lq = lane & 31, lh = lane >> 5;
    float* sbias = (float*)(smem + 2 * NA_BUF);
    const int n_lat = NB * NH * (ROWS / RPU);
    {
        const bool is_lat = u < n_lat;
        int bh, r0 = 0, rstart = 0, sq, ntiles;
        if (is_lat) { bh = u / (ROWS / RPU); r0 = (u % (ROWS / RPU)) * RPU; rstart = r0 - NA_WR / 2; rstart = rstart < 0 ? 0 : (rstart > ROWS - NLR ? ROWS - NLR : rstart);
                      sq = CTX + (r0 + (wave >> 1)) * GRID_W + 32 * (wave & 1) + lq; ntiles = NLR + NCT; }
        else { const int u2 = u - n_lat; bh = u2 / (CTX / QB); sq = (u2 % (CTX / QB)) * QB + wave * 32 + lq; ntiles = NCT; }
        const int b = bh / NH, h = bh % NH;
        const int qr = r0 + (wave >> 1), qc = 32 * (wave & 1) + lq;
        int rs = qr - NA_WR / 2; rs = rs < 0 ? 0 : (rs > ROWS - NA_WR ? ROWS - NA_WR : rs);
        int cs = qc - NA_WC / 2; cs = cs < 0 ? 0 : (cs > GRID_W - NA_WC ? GRID_W - NA_WC : cs);
        const bf16_t* Kg = p.P + (size_t)b * LL * N_IN + OFF_NA + GD + h * HD;
        const bf16_t* Vg = p.naVt + (size_t)bh * HD * LL;
        bf16x8_t qf[4];
#pragma unroll
        for (int ks = 0; ks < 4; ++ks) qf[ks] = *(const bf16x8_t*)(p.P + (size_t)(b * LL + sq) * N_IN + OFF_NA + h * HD + ks * 16 + lh * 8);
        f32x16_t o0, o1;
#pragma unroll
        for (int r = 0; r < 16; ++r) { o0[r] = 0.f; o1[r] = 0.f; }
        float m_i = -1e30f, l_i = 0.f;
        uint4 stg[NCH];
#define NA_KBASE(ti) ((is_lat && (ti) < NLR) ? (CTX + (rstart + (ti)) * GRID_W) : (((ti) - (is_lat ? NLR : 0)) * AT_TK))
#define NA_LOAD(ti) do { const int kb_ = NA_KBASE(ti); _Pragma("unroll") for (int i = 0; i < NCH; ++i) { const int c = tid + i * NTH; \
            if (c < AT_TK * 8) { const int key = c / 8, ch = c % 8; stg[i] = *(const uint4*)(Kg + (size_t)(kb_ + key) * N_IN + ch * 8); } \
            else if (c < NCHUNK) { const int c2 = c - AT_TK * 8; const int d = c2 / 8, ch = c2 % 8; stg[i] = *(const uint4*)(Vg + (size_t)d * LL + kb_ + ch * 8); } } } while (0)
#define NA_STORE(buf) do { bf16_t* dK_ = smem + (buf) * NA_BUF; _Pragma("unroll") for (int i = 0; i < NCH; ++i) { const int c = tid + i * NTH; \
            if (c < AT_TK * 8) { const int key = c / 8, ch = c % 8; *(uint4*)(dK_ + key * NA_KLD + ch * 8) = stg[i]; } \
            else if (c < NCHUNK) { const int c2 = c - AT_TK * 8; const int d = c2 / 8, ch = c2 % 8; uint2* dst = (uint2*)(dK_ + AT_TK * NA_KLD + d * NA_VLD + ch * 8); dst[0] = make_uint2(stg[i].x, stg[i].y); dst[1] = make_uint2(stg[i].z, stg[i].w); } } } while (0)
        NA_LOAD(0);
        __syncthreads();
        NA_STORE(0);
        for (int i = tid; i < BH * BW; i += NTH) sbias[i] = p.na_rpb[((size_t)l * NH + h) * BH * BW + i] * 1.4426950408889634f;
        __syncthreads();
        for (int tile = 0; tile < ntiles; ++tile) {
            const bf16_t* sK = smem + (tile & 1) * NA_BUF; const bf16_t* sV = sK + AT_TK * NA_KLD;
            const bool more = tile + 1 < ntiles;
            if (more) NA_LOAD(tile + 1);
            const bool local = is_lat && tile < NLR;
            const int kr = rstart + tile;
            const bool active = !local || (kr >= rs && kr < rs + NA_WR);
            if (active) {
                f32x16_t s0, s1;
#pragma unroll
                for (int r = 0; r < 16; ++r) { s0[r] = 0.f; s1[r] = 0.f; }
#pragma unroll
                for (int ks = 0; ks < 4; ++ks) {
                    const bf16x8_t a0 = *(const bf16x8_t*)(sK + (lq) * NA_KLD + ks * 16 + lh * 8);
                    const bf16x8_t a1 = *(const bf16x8_t*)(sK + (32 + lq) * NA_KLD + ks * 16 + lh * 8);
                    s0 = __builtin_amdgcn_mfma_f32_32x32x16_bf16(a0, qf[ks], s0, 0, 0, 0);
                    s1 = __builtin_amdgcn_mfma_f32_32x32x16_bf16(a1, qf[ks], s1, 0, 0, 0);
                }
                if (local) {
                    const float* brow = sbias + (kr - qr + NA_WR - 1) * BW;
#pragma unroll
                    for (int r = 0; r < 16; ++r) {
                        const int kc0 = (r & 3) + 8 * (r >> 2) + 4 * lh, kc1 = kc0 + 32;
                        const bool v0 = (unsigned)(kc0 - cs) < (unsigned)NA_WC, v1 = (unsigned)(kc1 - cs) < (unsigned)NA_WC;
                        s0[r] = v0 ? s0[r] * sc2 + brow[kc0 - qc + NA_WC - 1] : -1e30f;
                        s1[r] = v1 ? s1[r] * sc2 + brow[kc1 - qc + NA_WC - 1] : -1e30f;
                    }
                } else {
#pragma unroll
                    for (int r = 0; r < 16; ++r) { s0[r] *= sc2; s1[r] *= sc2; }
                }
                float mx = -1e30f;
#pragma unroll
                for (int r = 0; r < 16; ++r) mx = fmaxf(mx, fmaxf(s0[r], s1[r]));
                mx = fmaxf(mx, __shfl_xor(mx, 32));
                const float m_new = fmaxf(m_i, mx);
                const float alpha = __builtin_amdgcn_exp2f(m_i - m_new);
                float rsum = 0.f;
#pragma unroll
                for (int r = 0; r < 16; ++r) { s0[r] = __builtin_amdgcn_exp2f(s0[r] - m_new); s1[r] = __builtin_amdgcn_exp2f(s1[r] - m_new); rsum += s0[r] + s1[r]; }
                rsum += __shfl_xor(rsum, 32);
                l_i = l_i * alpha + rsum; m_i = m_new;
                if (__builtin_amdgcn_ballot_w64(alpha != 1.0f) != 0ull) {
#pragma unroll
                    for (int r = 0; r < 16; ++r) { o0[r] *= alpha; o1[r] *= alpha; }
                }
                Frag8 pf[2][2];
#pragma unroll
                for (int sp = 0; sp < 2; ++sp)
#pragma unroll
                    for (int j = 0; j < 4; ++j) {
                        pf[0][sp].u[j] = cvt_pk_bf16_h(s0[8 * sp + 2 * j], s0[8 * sp + 2 * j + 1]);
                        pf[1][sp].u[j] = cvt_pk_bf16_h(s1[8 * sp + 2 * j], s1[8 * sp + 2 * j + 1]);
                    }
#pragma unroll
                for (int kb = 0; kb < 2; ++kb)
#pragma unroll
                    for (int sp = 0; sp < 2; ++sp) {
                        const int kofs = kb * 32 + sp * 16 + lh * 4;
                        Frag8 va, vb2;
                        va.d2[0] = *(const uint2*)(sV + (lq) * NA_VLD + kofs); va.d2[1] = *(const uint2*)(sV + (lq) * NA_VLD + kofs + 8);
                        vb2.d2[0] = *(const uint2*)(sV + (32 + lq) * NA_VLD + kofs); vb2.d2[1] = *(const uint2*)(sV + (32 + lq) * NA_VLD + kofs + 8);
                        o0 = __builtin_amdgcn_mfma_f32_32x32x16_bf16(va.v, pf[kb][sp].v, o0, 0, 0, 0);
                        o1 = __builtin_amdgcn_mfma_f32_32x32x16_bf16(vb2.v, pf[kb][sp].v, o1, 0, 0, 0);
                    }
            }
            if (more) NA_STORE((tile + 1) & 1);
            __syncthreads();
        }
#undef NA_KBASE
#undef NA_LOAD
#undef NA_STORE
        const float inv = 1.0f / l_i;
        bf16_t* yrow = p.Ymix + (size_t)(b * LL + sq) * D_MIX + 3 * GD + h * HD;
#pragma unroll
        for (int g = 0; g < 4; ++g) {
            uint2 w0, w1;
            w0.x = cvt_pk_bf16(o0[4 * g] * inv, o0[4 * g + 1] * inv); w0.y = cvt_pk_bf16(o0[4 * g + 2] * inv, o0[4 * g + 3] * inv);
            w1.x = cvt_pk_bf16(o1[4 * g] * inv, o1[4 * g + 1] * inv); w1.y = cvt_pk_bf16(o1[4 * g + 2] * inv, o1[4 * g + 3] * inv);
            *(uint2*)(yrow + 8 * g + 4 * lh) = w0; *(uint2*)(yrow + 32 + 8 * g + 4 * lh) = w1;
        }
    }
}

DEVFN float wave_sum(float v) {
#pragma unroll
    for (int o = 32; o > 0; o >>= 1) v += __shfl_xor(v, o);
    return v;
}
constexpr int LNV = D / 256;

DEVFN void ph_ln1_route(const Params& p, int l, float* lds_f, int* lds_rt, size_t vt, size_t vs, const int t0, const int t1, const bool stage) {
    static_assert(NE * D * 4 <= 128 * 1024, "router matrix fits the LDS stage region");
    const float alpha = DN_ALPHA;
    const int lane = (TIDX() & 63);
    const size_t wv = vt >> 6, nwv = vs >> 6;
    __syncthreads();
    if (TIDX() < 2 * NE) lds_rt[TIDX()] = 0;
    if (stage) for (int i = TIDX(); i < D * NE / 4; i += 512) {
        const float4 w4 = *(const float4*)(p.router_w + (size_t)i * 4); const int d = (i * 4) / NE, e0 = (i * 4) % NE;
        lds_f[(e0 + 0) * D + d] = w4.x; lds_f[(e0 + 1) * D + d] = w4.y; lds_f[(e0 + 2) * D + d] = w4.z; lds_f[(e0 + 3) * D + d] = w4.w;
    }
    __syncthreads();
    for (size_t t = (size_t)t0 + wv; t < (size_t)t1; t += nwv) {
        const int b = (int)(t / LL), s = (int)(t % LL); const int r = s < CTX ? NB : b;
        const float* m = p.mod + ((size_t)l * NMOD + r) * 6 * D;
        float* xr = p.xs + t * D; const bf16_t* yr = p.yo + t * D;
        float4 u[LNV];
        float sum = 0.f;
#pragma unroll
        for (int i = 0; i < LNV; ++i) {
            const int d = i * 256 + lane * 4;
            const float4 xv = *(const float4*)(xr + d); const uint2 yw = *(const uint2*)(yr + d); const float4 gv = *(const float4*)(m + 2 * D + d);
            u[i].x = alpha * xv.x + gv.x * bflo(yw.x); u[i].y = alpha * xv.y + gv.y * bfhi(yw.x); u[i].z = alpha * xv.z + gv.z * bflo(yw.y); u[i].w = alpha * xv.w + gv.w * bfhi(yw.y);
            sum += u[i].x + u[i].y + u[i].z + u[i].w;
        }
        const float mu = wave_sum(sum) * (1.0f / D);
        float sq = 0.f;
#pragma unroll
        for (int i = 0; i < LNV; ++i) { const float a0 = u[i].x - mu, a1 = u[i].y - mu, a2 = u[i].z - mu, a3 = u[i].w - mu; sq += a0 * a0 + a1 * a1 + a2 * a2 + a3 * a3; }
        const float rs = 1.0f / sqrtf(wave_sum(sq) * (1.0f / D) + LN_EPS);
        float lg[NE];
#pragma unroll
        for (int e = 0; e < NE; ++e) lg[e] = 0.f;
#pragma unroll
        for (int i = 0; i < LNV; ++i) {
            const int d = i * 256 + lane * 4;
            const float4 gg = *(const float4*)(p.ln1_g + (size_t)l * D + d), bb = *(const float4*)(p.ln1_b + (size_t)l * D + d);
            const float4 sc = *(const float4*)(m + 4 * D + d), sh = *(const float4*)(m + 3 * D + d);
            float4 xn;
            xn.x = (u[i].x - mu) * rs * gg.x + bb.x; xn.y = (u[i].y - mu) * rs * gg.y + bb.y; xn.z = (u[i].z - mu) * rs * gg.z + bb.z; xn.w = (u[i].w - mu) * rs * gg.w + bb.w;
            *(float4*)(xr + d) = xn;
            float hv[4];
            hv[0] = xn.x * (1.0f + sc.x) + sh.x; hv[1] = xn.y * (1.0f + sc.y) + sh.y; hv[2] = xn.z * (1.0f + sc.z) + sh.z; hv[3] = xn.w * (1.0f + sc.w) + sh.w;
            uint2 pk; pk.x = (unsigned)f2bf(hv[0]) | ((unsigned)f2bf(hv[1]) << 16); pk.y = (unsigned)f2bf(hv[2]) | ((unsigned)f2bf(hv[3]) << 16);
            *(uint2*)(p.hb + t * D + d) = pk;
            asm volatile("" ::: "memory");
#pragma unroll
            for (int e = 0; e < NE; ++e) { const float4 w4 = *(const float4*)(lds_f + e * D + d); lg[e] += hv[0] * w4.x + hv[1] * w4.y + hv[2] * w4.z + hv[3] * w4.w; }
        }
#pragma unroll
        for (int e = 0; e < NE; ++e) lg[e] = wave_sum(lg[e]);
        float gbest = -1e30f; int e1 = 0, e2 = 1; float w1 = 0.f, w2 = 0.f;
#pragma unroll
        for (int g = 0; g < NEG; ++g) {
            float m1 = -1e30f, m2 = -1e30f, s1 = 0.f, s2 = 0.f; int i1 = 0, i2 = 0;
#pragma unroll
            for (int i = 0; i < EPG; ++i) {
                const float scv = sigmoidf_(lg[g * EPG + i]); const float v = scv + p.router_b[g * EPG + i];
                if (v > m1) { m2 = m1; i2 = i1; s2 = s1; m1 = v; i1 = g * EPG + i; s1 = scv; }
                else if (v > m2) { m2 = v; i2 = g * EPG + i; s2 = scv; }
            }
            if (m1 + m2 > gbest) { gbest = m1 + m2; e1 = i1; e2 = i2; w1 = s1; w2 = s2; }
        }
        const float wn = ROUTED_SCALE / (w1 + w2);
        if (lane < 2) {
            const int k = lane;
            const int e = k == 0 ? e1 : e2; const float w = (k == 0 ? w1 : w2) * wn;
            const int pos = atomicAdd(&lds_rt[e], 1);
            ((int*)&p.tok_e[t])[k] = e; ((int*)&p.tok_pos[t])[k] = pos; ((float*)&p.tok_w[t])[k] = w;
        }
    }
    asm volatile("s_waitcnt vmcnt(0)" ::: "memory");
    __syncthreads();
    if (TIDX() < NE) { const int c_ = lds_rt[TIDX()]; lds_rt[NE + TIDX()] = c_ ? atomicAdd(&p.cnt[l * NE + TIDX()], c_) : 0; }
    __syncthreads();
}
DEVFN void ph_ln1_fix(const Params& p, const int* lds_rt, size_t vt, size_t vs, const int t0, const int t1) {
    const int lane = (TIDX() & 63);
    const size_t wv = vt >> 6, nwv = vs >> 6;
    for (size_t t = (size_t)t0 + wv; t < (size_t)t1; t += nwv) {
        if (lane < 2) { const int e = ((const int*)&p.tok_e[t])[lane]; ((int*)&p.tok_pos[t])[lane] += lds_rt[NE + e]; }
    }
}

DEVFN void ph_moe_perm(const Params& p, int l, size_t vt, size_t vs) {
    const int lane = (TIDX() & 63);
    const size_t wv = vt >> 6, nwv = vs >> 6;
    for (size_t it = wv; it < (size_t)2 * TT; it += nwv) {
        const size_t t = it >> 1; const int k = (int)(it & 1);
        const int e = ((const int*)&p.tok_e[t])[k], pos = ((const int*)&p.tok_pos[t])[k];
        int base = 0;
#pragma unroll
        for (int q = 0; q < NE; ++q) { const int nt = (p.cnt[l * NE + q] + 255) >> 8; base += (q < e) ? nt * 256 : 0; }
        const int row = base + pos;
        const uint4* src = (const uint4*)(p.hb + t * D); uint4* dst = (uint4*)(p.hperm + (size_t)row * D);
#pragma unroll
        for (int q = 0; q < D / 512; ++q) dst[q * 64 + lane] = src[q * 64 + lane];
        if (lane == 0) ((int*)&p.tok_row[t])[k] = row;
    }
}

DEVFN void ph_ln2(const Params& p, int l, size_t vt, size_t vs) {
    const float alpha = DN_ALPHA;
    const int lane = (TIDX() & 63);
    const size_t wv = vt >> 6, nwv = vs >> 6;
    for (size_t t = wv; t < (size_t)TT; t += nwv) {
        const int b = (int)(t / LL), s = (int)(t % LL); const int r = s < CTX ? NB : b;
        const float* m = p.mod + ((size_t)l * NMOD + r) * 6 * D;
        float* xr = p.xs + t * D;
        const int2 rw2 = p.tok_row[t]; const float2 ww = p.tok_w[t];
        const bf16_t* f0 = p.Fperm + (size_t)rw2.x * D; const bf16_t* f1 = p.Fperm + (size_t)rw2.y * D;
        float4 u[LNV];
        float sum = 0.f;
#pragma unroll
        for (int i = 0; i < LNV; ++i) {
            const int d = i * 256 + lane * 4;
            const float4 xv = *(const float4*)(xr + d), gv = *(const float4*)(m + 5 * D + d);
            const uint2 a0 = *(const uint2*)(f0 + d), a1 = *(const uint2*)(f1 + d);
            u[i].x = alpha * xv.x + gv.x * (ww.x * bflo(a0.x) + ww.y * bflo(a1.x)); u[i].y = alpha * xv.y + gv.y * (ww.x * bfhi(a0.x) + ww.y * bfhi(a1.x));
            u[i].z = alpha * xv.z + gv.z * (ww.x * bflo(a0.y) + ww.y * bflo(a1.y)); u[i].w = alpha * xv.w + gv.w * (ww.x * bfhi(a0.y) + ww.y * bfhi(a1.y));
            sum += u[i].x + u[i].y + u[i].z + u[i].w;
        }
        const float mu = wave_sum(sum) * (1.0f / D);
        float sq = 0.f;
#pragma unroll
        for (int i = 0; i < LNV; ++i) { const float a0 = u[i].x - mu, a1 = u[i].y - mu, a2 = u[i].z - mu, a3 = u[i].w - mu; sq += a0 * a0 + a1 * a1 + a2 * a2 + a3 * a3; }
        const float rs = 1.0f / sqrtf(wave_sum(sq) * (1.0f / D) + LN_EPS);
        const float* mn = p.mod + ((size_t)(l + 1 < DEPTH ? l + 1 : l) * NMOD + r) * 6 * D;
#pragma unroll
        for (int i = 0; i < LNV; ++i) {
            const int d = i * 256 + lane * 4;
            const float4 gg = *(const float4*)(p.ln2_g + (size_t)l * D + d), bb = *(const float4*)(p.ln2_b + (size_t)l * D + d);
            float4 xn;
            xn.x = (u[i].x - mu) * rs * gg.x + bb.x; xn.y = (u[i].y - mu) * rs * gg.y + bb.y; xn.z = (u[i].z - mu) * rs * gg.z + bb.z; xn.w = (u[i].w - mu) * rs * gg.w + bb.w;
            if (l < DEPTH - 1) *(float4*)(xr + d) = xn;
            if (l == DEPTH - 1) { if (s >= CTX) *(float4*)(p.out + ((size_t)b * SEQ + (s - CTX)) * D + d) = xn; }
            else {
                const float4 sc = *(const float4*)(mn + D + d), sh = *(const float4*)(mn + d);
                uint2 pk;
                pk.x = (unsigned)f2bf(xn.x * (1.0f + sc.x) + sh.x) | ((unsigned)f2bf(xn.y * (1.0f + sc.y) + sh.y) << 16);
                pk.y = (unsigned)f2bf(xn.z * (1.0f + sc.z) + sh.z) | ((unsigned)f2bf(xn.w * (1.0f + sc.w) + sh.w) << 16);
                *(uint2*)(p.xm + t * D + d) = pk;
            }
        }
    }
}

namespace pg8 {
#define PG8_LAS __attribute__((address_space(3)))
typedef unsigned short bf16_t;
typedef short bf16x8 __attribute__((ext_vector_type(8)));
typedef float f32x4 __attribute__((ext_vector_type(4)));
typedef unsigned u32x4 __attribute__((ext_vector_type(4)));
constexpr int BM = 256, BK = 64, HALF = 128, HTB = HALF * BK * 2  , STAGE_BYTES = 8 * HTB, NXCD = 8, WGM = 8;

__host__ __device__ __forceinline__ int lds_byte(int r, int c) { const int st = (r >> 4) * 2 + (c >> 5), rr = r & 15, cc = c & 31, ob = rr * 64 + cc * 2; return st * 1024 + (ob ^ (((ob >> 9) & 1) << 5)); }
__host__ __device__ __forceinline__ void stage_rc(int b, int& R, int& C) { const int st = b / 1024, sb = b % 1024, swz = sb ^ (((sb >> 9) & 1) << 5); R = (st >> 1) * 16 + swz / 64; C = (st & 1) * 32 + (swz % 64) / 2; }
__host__ __device__ __forceinline__ int perm32(int rho) { const int n = rho >> 4, i = rho & 15; return 8 * (i >> 2) + 4 * n + (i & 3); }

struct Unit { int pm, pn; };
struct Gemm { const bf16_t* A; const bf16_t* Bt; int M, N, K; };

struct StaticOrder {
    int nM, nN, nwg, G, c;
    __host__ __device__ void init(int M, int N, int G_, int c_) { nM = M / BM; nN = N / BM; nwg = nM * nN; G = G_; c = c_; }
    __host__ __device__ bool next(int i, Unit& u) const {
        const long L = (long)i * G + c; if (L >= nwg) return false;
        int wgid = (int)L; { const int q = nwg / NXCD, r = nwg % NXCD, xcd = wgid % NXCD, off = wgid / NXCD; wgid = (xcd < r ? xcd * (q + 1) : r * (q + 1) + (xcd - r) * q) + off; }
        const int nig = WGM * nN, gid = wgid / nig, fm = gid * WGM, gsz = (nM - fm) < WGM ? (nM - fm) : WGM;
        u.pm = fm + ((wgid % nig) % gsz); u.pn = (wgid % nig) / gsz; return true;
    }
    __device__ __forceinline__ void a_ready(const Unit&) const {}
    __device__ __forceinline__ void done(const Unit&) const {}
};
__device__ __forceinline__ unsigned cvt_pk_bf16(float lo, float hi) { return ::cvt_pk_bf16(lo, hi); }
struct EpiF32 {
    static constexpr bool PERM = false, AFTER_DRAIN = false;
    float* C; int ldc; const float* bias;
    __device__ __forceinline__ void operator()(const f32x4 (&acc)[2][2][4][2], const Unit& u, int wr, int wc, int fr, int fq) const {
        const int row0 = u.pm * BM + wr * 64 + fr, col0 = u.pn * BM + wc * 32 + 4 * fq;
        f32x4 bv[2][2];
#pragma unroll
        for (int bj = 0; bj < 2; ++bj)
#pragma unroll
            for (int n = 0; n < 2; ++n) bv[bj][n] = bias ? *(const f32x4*)(bias + col0 + bj * HALF + n * 16) : (f32x4){0.f, 0.f, 0.f, 0.f};
#pragma unroll
        for (int ai = 0; ai < 2; ++ai)
#pragma unroll
            for (int m = 0; m < 4; ++m) { float* rowp = C + (size_t)(row0 + ai * HALF + m * 16) * ldc + col0;
#pragma unroll
                for (int bj = 0; bj < 2; ++bj)
#pragma unroll
                    for (int n = 0; n < 2; ++n) *(f32x4*)(rowp + bj * HALF + n * 16) = acc[ai][bj][m][n] + bv[bj][n]; }
    }
};
template <class Epi, class Sched, bool STAMP = false>
__device__ __forceinline__ void gemm_phase(PG8_LAS unsigned char* lds, const Gemm g, const Sched& S, const Epi& E, unsigned long long* stamps) {
    const int tid = TIDX(), wid = __builtin_amdgcn_readfirstlane(tid >> 6), lane = tid & 63, wr = wid >> 2, wc = wid & 3, fr = lane & 15, fq = lane >> 4;
    const int K = g.K, nt = K / BK;
    int ts_lo = 0, ts_hi = 0, nts = 0; const unsigned long long rt_entry = STAMP ? (unsigned long long)wall_clock64() : 0ull;
#define PG8_STAMP() do { if (STAMP && wid == 0 && nts < 64) { const unsigned long long _c = (unsigned long long)clock64(); \
        ts_lo = (lane == nts) ? (int)(unsigned)_c : ts_lo; ts_hi = (lane == nts) ? (int)(unsigned)(_c >> 32) : ts_hi; ++nts; } } while (0)
    PG8_STAMP();
    unsigned voffA[2], voffB[2];
#pragma unroll
    for (int i = 0; i < 2; ++i) { int R, C; stage_rc(tid * 16 + i * 8192, R, C); const int Rb = Epi::PERM ? ((R & ~31) + perm32(R & 31)) : R;
        voffA[i] = (unsigned)(R * K + C) * 2u; voffB[i] = (unsigned)(Rb * K + C) * 2u; }
    const size_t kstep = (size_t)(BK * 2);
    const size_t hstep = (size_t)HALF * K * 2;
    const size_t tstep = 2 * hstep;
    const unsigned ldsw = (unsigned)wid * 1024u;
    const int aoff = lds_byte(wr * 64 + fr, fq * 8), boff = lds_byte(wc * 32 + fr, fq * 8);
#define PG8_SA(b, h) (((b) * 2 + (h)) * HTB)
#define PG8_SB(b, h) ((4 + (b) * 2 + (h)) * HTB)
#define PG8_STAGE(bufoff, gbase, voff) do { _Pragma("unroll") for (int _i = 0; _i < 2; ++_i) \
        __builtin_amdgcn_global_load_lds((const unsigned*)((const char*)(gbase) + (voff)[_i]), (PG8_LAS unsigned*)(lds + (bufoff) + ldsw + _i * 8192), 16, 0, 0); } while (0)
#define PG8_LDA(dst, b, h) do { _Pragma("unroll") for (int m = 0; m < 4; ++m) _Pragma("unroll") for (int k = 0; k < 2; ++k) dst[m][k] = *(const PG8_LAS bf16x8*)(lds + PG8_SA(b, h) + aoff + m * 2048 + k * 1024); } while (0)
#define PG8_LDB(dst, b, h) do { _Pragma("unroll") for (int n = 0; n < 2; ++n) _Pragma("unroll") for (int k = 0; k < 2; ++k) dst[n][k] = *(const PG8_LAS bf16x8*)(lds + PG8_SB(b, h) + boff + n * 2048 + k * 1024); } while (0)
#define PG8_MMA(ai, bj, At, Bt) do { __builtin_amdgcn_s_setprio(1); _Pragma("unroll") for (int m = 0; m < 4; ++m) _Pragma("unroll") for (int n = 0; n < 2; ++n) _Pragma("unroll") for (int k = 0; k < 2; ++k) \
        acc[ai][bj][m][n] = __builtin_amdgcn_mfma_f32_16x16x32_bf16(Bt[n][k], At[m][k], acc[ai][bj][m][n], 0, 0, 0); __builtin_amdgcn_s_setprio(0); } while (0)
#define PG8_WAIT_V(n) asm volatile("s_waitcnt vmcnt(" #n ")" ::: "memory")
#define PG8_WAIT_L(n) asm volatile("s_waitcnt lgkmcnt(" #n ")" ::: "memory")
#define PG8_BAR __builtin_amdgcn_s_barrier()
#define PG8_SCHED __builtin_amdgcn_sched_barrier(0)
    Unit cur, nxt; int ui = 0;
    if (!S.next(0, cur)) return;
    f32x4 acc[2][2][4][2];
#pragma unroll
    for (int a = 0; a < 2; ++a)
#pragma unroll
        for (int b = 0; b < 2; ++b)
#pragma unroll
            for (int m = 0; m < 4; ++m)
#pragma unroll
                for (int n = 0; n < 2; ++n) acc[a][b][m][n] = (f32x4){0.f, 0.f, 0.f, 0.f};
    bf16x8 At[4][2], B0[2][2], B1[2][2];
    const char* cA = (const char*)g.A + (size_t)cur.pm * tstep; const char* cB = (const char*)g.Bt + (size_t)cur.pn * tstep;
    S.a_ready(cur);
    PG8_STAGE(PG8_SB(0, 0), cB, voffB); PG8_STAGE(PG8_SA(0, 0), cA, voffA); PG8_STAGE(PG8_SB(0, 1), cB + hstep, voffB); PG8_STAGE(PG8_SA(0, 1), cA + hstep, voffA);
    if (wr == 1) PG8_BAR;
    PG8_WAIT_V(4); PG8_BAR;
    PG8_STAGE(PG8_SB(1, 0), cB + kstep, voffB); PG8_STAGE(PG8_SA(1, 0), cA + kstep, voffA); PG8_STAGE(PG8_SB(1, 1), cB + hstep + kstep, voffB);
    PG8_WAIT_V(6); PG8_BAR;
    PG8_STAMP();
    for (;;) {
        const bool has_next = S.next(ui + 1, nxt);
        const char* nA = has_next ? (const char*)g.A + (size_t)nxt.pm * tstep : cA; const char* nB = has_next ? (const char*)g.Bt + (size_t)nxt.pn * tstep : cB;
        for (int t = 0; t < nt; t += 2) {
            const bool last = (t == nt - 2);
            const char* a1 = cA + (size_t)(t + 1) * kstep;
            const char* a2 = last ? nA : cA + (size_t)(t + 2) * kstep; const char* b2 = last ? nB : cB + (size_t)(t + 2) * kstep;
            const char* a3 = a2 + kstep; const char* b3 = b2 + kstep;
            if (last && has_next) S.a_ready(nxt);
            PG8_LDB(B0, 0, 0); PG8_SCHED; PG8_LDA(At, 0, 0); PG8_STAGE(PG8_SA(1, 1), a1 + hstep, voffA);
            PG8_WAIT_L(8); PG8_BAR; PG8_WAIT_L(0); PG8_MMA(0, 0, At, B0); PG8_BAR; PG8_SCHED;
            PG8_LDB(B1, 0, 1); PG8_STAGE(PG8_SB(0, 0), b2, voffB);
            PG8_BAR; PG8_WAIT_L(0); PG8_MMA(0, 1, At, B1); PG8_BAR;
            PG8_LDA(At, 0, 1); PG8_STAGE(PG8_SA(0, 0), a2, voffA);
            PG8_BAR; PG8_WAIT_L(0); PG8_MMA(1, 0, At, B0); PG8_BAR; PG8_SCHED;
            PG8_STAGE(PG8_SB(0, 1), b2 + hstep, voffB);
            PG8_WAIT_V(6); PG8_BAR; PG8_MMA(1, 1, At, B1); PG8_BAR;
            PG8_LDB(B0, 1, 0); PG8_SCHED; PG8_LDA(At, 1, 0); PG8_STAGE(PG8_SA(0, 1), a2 + hstep, voffA);
            PG8_WAIT_L(8); PG8_BAR; PG8_WAIT_L(0); PG8_MMA(0, 0, At, B0); PG8_BAR; PG8_SCHED;
            PG8_LDB(B1, 1, 1); PG8_STAGE(PG8_SB(1, 0), b3, voffB);
            PG8_BAR; PG8_WAIT_L(0); PG8_MMA(0, 1, At, B1); PG8_BAR;
            PG8_LDA(At, 1, 1); PG8_STAGE(PG8_SA(1, 0), a3, voffA);
            PG8_BAR; PG8_WAIT_L(0); PG8_MMA(1, 0, At, B0); PG8_BAR; PG8_SCHED;
            PG8_STAGE(PG8_SB(1, 1), b3 + hstep, voffB);
            PG8_WAIT_V(6); PG8_BAR; PG8_MMA(1, 1, At, B1); PG8_BAR;
        }
        PG8_STAMP();
        if constexpr (!Epi::AFTER_DRAIN) { E(acc, cur, wr, wc, fr, fq); S.done(cur); }
        PG8_STAMP();
        if (!has_next) break;
#pragma unroll
        for (int a = 0; a < 2; ++a)
#pragma unroll
            for (int b = 0; b < 2; ++b)
#pragma unroll
                for (int m = 0; m < 4; ++m)
#pragma unroll
                    for (int n = 0; n < 2; ++n) acc[a][b][m][n] = (f32x4){0.f, 0.f, 0.f, 0.f};
        cur = nxt; cA = nA; cB = nB; ++ui;
    }
    PG8_WAIT_V(0);
    if (wr == 0) PG8_BAR;
    PG8_BAR;
    if constexpr (Epi::AFTER_DRAIN) { E.fused(acc, cur, wr, wc, fr, fq, lds, wid, lane); S.done(cur); }
    PG8_STAMP();
    if (STAMP && wid == 0) { stamps[lane] = lane < nts ? (((unsigned long long)(unsigned)ts_hi << 32) | (unsigned)ts_lo) : 0ull;
        if (lane == 62) stamps[62] = rt_entry; if (lane == 63) stamps[63] = (unsigned long long)wall_clock64(); }
#undef PG8_STAMP
#undef PG8_SA
#undef PG8_SB
#undef PG8_STAGE
#undef PG8_LDA
#undef PG8_LDB
#undef PG8_MMA
#undef PG8_WAIT_V
#undef PG8_WAIT_L
#undef PG8_BAR
#undef PG8_SCHED
}
}

namespace pg8 {
struct EpiBf16N {
    static constexpr bool PERM = true, AFTER_DRAIN = false;
    bf16_t* O; int ldc; int ncols;
    __device__ __forceinline__ void operator()(const f32x4 (&acc)[2][2][4][2], const Unit& u, int wr, int wc, int fr, int fq) const {
        const int row0 = u.pm * BM + wr * 64 + fr; const int col0 = u.pn * BM + wc * 32 + 8 * fq;
#pragma unroll
        for (int ai = 0; ai < 2; ++ai)
#pragma unroll
            for (int m = 0; m < 4; ++m) { bf16_t* rowp = O + (size_t)(row0 + ai * HALF + m * 16) * ldc + col0;
#pragma unroll
                for (int bj = 0; bj < 2; ++bj) { const f32x4 v0 = acc[ai][bj][m][0], v1 = acc[ai][bj][m][1];
                    u32x4 w; w.x = ::cvt_pk_bf16_h(v0[0], v0[1]); w.y = ::cvt_pk_bf16_h(v0[2], v0[3]); w.z = ::cvt_pk_bf16_h(v1[0], v1[1]); w.w = ::cvt_pk_bf16_h(v1[2], v1[3]);
                    if (col0 + bj * HALF < ncols) *(u32x4*)(rowp + bj * HALF) = w; } }
    }
};
struct LatentOrder : StaticOrder {
    __device__ __forceinline__ bool next(int i, Unit& u) const {
        if (!StaticOrder::next(i, u)) return false;
        constexpr int LT = SEQ / 256, CT = CTX / 256;
        u.pm = (u.pm / LT) * (LT + CT) + CT + (u.pm % LT); return true;
    }
};
struct TailOrder {
    int pm0, nM, nN, G, c;
    __device__ __forceinline__ bool next(int i, Unit& u) const {
        if (c >= G) return false;
        const int L = i * G + c; if (L >= (nM - pm0) * nN) return false;
        u.pm = pm0 + L / nN; u.pn = L % nN; return true;
    }
    __device__ __forceinline__ void a_ready(const Unit&) const {}
    __device__ __forceinline__ void done(const Unit&) const {}
};
struct EpiBf16Grp {
    static constexpr bool PERM = true, AFTER_DRAIN = false;
    bf16_t* O; int ldc; int ncu;
    __device__ __forceinline__ void operator()(const f32x4 (&acc)[2][2][4][2], const Unit& u, int wr, int wc, int fr, int fq) const {
        const int row0 = u.pm * BM + wr * 64 + fr; const int col0 = (u.pn % ncu) * BM + wc * 32 + 8 * fq;
#pragma unroll
        for (int ai = 0; ai < 2; ++ai)
#pragma unroll
            for (int m = 0; m < 4; ++m) { bf16_t* rowp = O + (size_t)(row0 + ai * HALF + m * 16) * ldc + col0;
#pragma unroll
                for (int bj = 0; bj < 2; ++bj) { const f32x4 v0 = acc[ai][bj][m][0], v1 = acc[ai][bj][m][1];
                    u32x4 w; w.x = ::cvt_pk_bf16_h(v0[0], v0[1]); w.y = ::cvt_pk_bf16_h(v0[2], v0[3]); w.z = ::cvt_pk_bf16_h(v1[0], v1[1]); w.w = ::cvt_pk_bf16_h(v1[2], v1[3]);
                    *(u32x4*)(rowp + bj * HALF) = w; } }
    }
};
struct MoeOrder {
    const int* cnt; int G, c, ncu;
    __device__ __forceinline__ bool next(int i, Unit& u) const {
        int tot = 0;
#pragma unroll
        for (int k = 0; k < 16; ++k) tot += (cnt[k] + 255) >> 8;
        int rt, cu;
        if ((G & 7) == 0) {
            const int x = c & 7, rank = c >> 3, per = G >> 3;
            const int t0 = (tot * x) >> 3, t1 = (tot * (x + 1)) >> 3;
            const int k = i * per + rank;
            if (k >= (t1 - t0) * ncu) return false;
            rt = t0 + k / ncu; cu = k % ncu;
        } else {
            const long L = (long)i * G + c; rt = (int)(L / ncu); cu = (int)(L % ncu);
            if (rt >= tot) return false;
        }
        int acc = 0, e = -1;
#pragma unroll
        for (int k = 0; k < 16; ++k) { const int nt = (cnt[k] + 255) >> 8; e = (e < 0 && rt < acc + nt) ? k : e; acc += nt; }
        if (e < 0) return false;
        u.pm = rt; u.pn = e * ncu + cu; return true;
    }
    __device__ __forceinline__ void a_ready(const Unit&) const {}
    __device__ __forceinline__ void done(const Unit&) const {}
};
struct EpiSwiGLU {
    static constexpr bool PERM = true, AFTER_DRAIN = false;
    bf16_t* O; int ldc; int ncu;
    __device__ __forceinline__ void operator()(const f32x4 (&acc)[2][2][4][2], const Unit& u, int wr, int wc, int fr, int fq) const {
        const int row0 = u.pm * BM + wr * 64 + fr; const int col0 = (u.pn % ncu) * HALF + wc * 32 + 8 * fq;
#pragma unroll
        for (int ai = 0; ai < 2; ++ai)
#pragma unroll
            for (int m = 0; m < 4; ++m) {
                float hv[8];
#pragma unroll
                for (int n = 0; n < 2; ++n)
#pragma unroll
                    for (int q = 0; q < 4; ++q) { const float g = acc[ai][0][m][n][q], up = acc[ai][1][m][n][q]; hv[4 * n + q] = g / (1.0f + __expf(-g)) * up; }
                u32x4 w; w.x = cvt_pk_bf16(hv[0], hv[1]); w.y = cvt_pk_bf16(hv[2], hv[3]); w.z = cvt_pk_bf16(hv[4], hv[5]); w.w = cvt_pk_bf16(hv[6], hv[7]);
                *(u32x4*)(O + (size_t)(row0 + ai * HALF + m * 16) * ldc + col0) = w;
            }
    }
};
}

#define XB_TMO      128
#define XB_XCNT(j)  (256  + 64 * (j))
#define XB_XSUB(j)  (1280 + 64 * (j))
#define XB_XGEN(j)  (2304 + 64 * (j))
#define XB_TOP      3328
#define XB_TOPGEN   3392
#define XCD_BAR_WORDS 3456
#define XB_SPIN_CAP (1u << 18)
#define LAS __attribute__((address_space(3)))

__device__ __forceinline__ unsigned xb_ld(unsigned* p)              { return __hip_atomic_load(p, __ATOMIC_RELAXED, __HIP_MEMORY_SCOPE_AGENT); }
__device__ __forceinline__ unsigned xb_add(unsigned* p, unsigned v) { return __hip_atomic_fetch_add(p, v, __ATOMIC_RELAXED, __HIP_MEMORY_SCOPE_AGENT); }
__device__ __forceinline__ unsigned xb_xcc_id() { return (unsigned)__builtin_amdgcn_s_getreg((3 << 11) | 20) & 0xFu; }
#define XB_SPIN(cond, bar) do { unsigned _sp = 0; while (cond) { __builtin_amdgcn_s_sleep(1); \
    if ((++_sp & 255u) == 0u) { if (xb_ld(&(bar)[XB_TMO])) break; if (_sp > XB_SPIN_CAP) { atomicAdd(&(bar)[XB_TMO], 1u); break; } } } } while (0)

struct XcdBarrier {
    unsigned* bar; unsigned x;
    volatile LAS unsigned* st;
};

__device__ __forceinline__ XcdBarrier xcd_barrier_post(unsigned* bar, volatile LAS unsigned* st) {
    XcdBarrier b; b.bar = bar; b.x = xb_xcc_id(); b.st = st;
    if (threadIdx.x == 0) (void)xb_add(&bar[XB_XCNT(b.x)], 1u);
    return b;
}
__device__ __forceinline__ void xcd_barrier_complete(unsigned* bar, unsigned x, unsigned& nloc, unsigned& nx) {
    const unsigned G = gridDim.x * gridDim.y * gridDim.z;
    unsigned sum, cnt, mine, sp = 0u;
    for (;;) {
        sum = 0u; cnt = 0u; mine = 0u;
#pragma unroll
        for (unsigned j = 0; j < 16; ++j) { const unsigned c = xb_ld(&bar[XB_XCNT(j)]); sum += c; cnt += (c > 0u) ? 1u : 0u; mine = (j == x) ? c : mine; }
        if (sum == G) break;
        __builtin_amdgcn_s_sleep(1);
        if ((++sp & 255u) == 0u) { if (xb_ld(&bar[XB_TMO])) break; if (sp > XB_SPIN_CAP) { atomicAdd(&bar[XB_TMO], 1u); break; } }
    }
    nloc = mine > 0u ? mine : 1u; nx = cnt > 0u ? cnt : 1u;
}

__device__ __forceinline__ void xcd_barrier(const XcdBarrier& b) {
    asm volatile("s_waitcnt vmcnt(0)" ::: "memory");
    __syncthreads();
    if (threadIdx.x == 0) {
        unsigned* bar = b.bar;
        __builtin_amdgcn_s_waitcnt(0);
        unsigned nloc = b.st[0], nx = b.st[1];
        if (nloc == 0u) { xcd_barrier_complete(bar, b.x, nloc, nx); b.st[0] = nloc; b.st[1] = nx; }
        const unsigned old = xb_add(&bar[XB_XSUB(b.x)], 1u);
        const unsigned gen = old / nloc;
        if (old + 1u == (gen + 1u) * nloc) {
            __builtin_amdgcn_fence(__ATOMIC_RELEASE, "agent");
            asm volatile("s_waitcnt vmcnt(0)" ::: "memory");
            const unsigned og = xb_add(&bar[XB_TOP], 1u);
            const unsigned tg = og / nx;
            if (og + 1u == (tg + 1u) * nx) xb_add(&bar[XB_TOPGEN], 1u);
            else XB_SPIN(xb_ld(&bar[XB_TOPGEN]) == tg, bar);
            __builtin_amdgcn_fence(__ATOMIC_ACQUIRE, "agent");
            xb_add(&bar[XB_XGEN(b.x)], 1u);
            asm volatile("s_waitcnt vmcnt(0)" ::: "memory");
        } else {
            XB_SPIN(xb_ld(&bar[XB_XGEN(b.x)]) == gen, bar);
            __builtin_amdgcn_fence(__ATOMIC_ACQUIRE, "agent");
            asm volatile("s_waitcnt vmcnt(0)" ::: "memory");
        }
    }
    __syncthreads();
}

constexpr int NT = 512;
constexpr int LDS_STAGE = pg8::STAGE_BYTES;
constexpr int LDS_MISC = LDS_STAGE;
constexpr int LDS_RT = LDS_STAGE + 64;
constexpr int LDS_BYTES = LDS_STAGE + 64 + 256;
struct MegaArgs { Params p; unsigned* bar; int reps[16]; };

DEVFN size_t VTF() { return (size_t)blockIdx.x * 512 + (size_t)TIDX(); }
DEVFN int OPQS(int v) { asm volatile("" : "+s"(v)); return v; }
typedef const __attribute__((address_space(4))) MegaArgs* KArgP;
DEVFN int REPS(int k) { KArgP ka = (KArgP)__builtin_amdgcn_kernarg_segment_ptr(); asm volatile("" : "+s"(ka)); return ka->reps[k]; }
DEVFN unsigned* BARP() { KArgP ka = (KArgP)__builtin_amdgcn_kernarg_segment_ptr(); asm volatile("" : "+s"(ka)); return ka->bar; }
DEVFN const Params& PF() { KArgP ka = (KArgP)__builtin_amdgcn_kernarg_segment_ptr(); asm volatile("" : "+s"(ka)); return *(const Params*)&ka->p; }
DEVFN int NBF() { int g = (int)gridDim.x; asm volatile("" : "+s"(g)); return g; }
DEVFN size_t VSF() { return (size_t)NBF() * 512; }
__global__ void __launch_bounds__(NT, 2) k_mega(MegaArgs a) {
    extern __shared__ __attribute__((aligned(16))) unsigned char lds[];
    bf16_t* const smem = (bf16_t*)lds;
    volatile int* const s_unit = (volatile int*)(lds + LDS_MISC + 16);
    static_assert(2 * AT_NSUB * AT_BUF * 2 <= LDS_STAGE && 2 * AT_BUF * 2 + 2048 <= LDS_STAGE && AT_BUF >= NA_BUF && (NT / 64) * RW_STG * 4 <= LDS_STAGE, "LDS carve");
    if (threadIdx.x == 0) *(uint4*)(lds + LDS_MISC) = make_uint4(0u, 0u, 0u, 0u);
    __syncthreads();
    (void)xcd_barrier_post(a.bar, (volatile LAS unsigned*)(lds + LDS_MISC));
#define GRID_BARRIER() do { XcdBarrier b_; b_.bar = BARP(); b_.x = xb_xcc_id(); b_.st = (volatile LAS unsigned*)(lds + LDS_MISC); xcd_barrier(b_); } while (0)
    const Params& p = a.p;
    const int nb = gridDim.x, bx = blockIdx.x;
    const size_t vt = (size_t)bx * NT + threadIdx.x, vs = (size_t)nb * NT;

    ph_init(p, 0, vt, vs);
    for (int r_ = a.reps[12]; r_ > 0; --r_) {
    ph_mod_partial(p, vt, vs);
    ph_transpose_t(p.w_in, p.WinT, D, N_IN, DEPTH, (size_t)N_INP * D, 0, D, 0, smem, bx, nb);
    ph_transpose_t(p.w_out, p.WoutT, D_MIX, D, DEPTH, (size_t)D * D_MIX, 0, D_MIX, 0, smem, bx, nb);
    for (int cu = 0; cu < D_EXP / 128; ++cu) {
        ph_transpose_t(p.exp_w_gate + cu * 128, p.WguT, D, 128, DEPTH * NE, (size_t)2 * D_EXP * D, cu * 256, D, 0, smem, bx, nb, (size_t)D * D_EXP, D_EXP);
        ph_transpose_t(p.exp_w_up + cu * 128, p.WguT, D, 128, DEPTH * NE, (size_t)2 * D_EXP * D, cu * 256 + 128, D, 0, smem, bx, nb, (size_t)D * D_EXP, D_EXP);
    }
    ph_transpose_t(p.exp_w_down, p.WdT, D_EXP, D, DEPTH * NE, (size_t)D * D_EXP, 0, D_EXP, 0, smem, bx, nb);
    }
    ph_zero16((uint4*)p.WupT, (size_t)DEPTH * NUP * KUP * 2 / 16, vt, vs);
    ph_zero16((uint4*)p.WloT, (size_t)DEPTH * NLO * KLO * 2 / 16, vt, vs);
    GRID_BARRIER();
    ph_mod_final(p, vt, vs);
    ph_transpose(p.mla_w_uq, p.WupT, MLA_QL, NUPQ, DEPTH, (size_t)NUP * KUP, 0, KUP, 0, vt, vs);
    ph_transpose(p.mla_w_ukv, p.WupT, MLA_KVL, NUP - NUPQ, DEPTH, (size_t)NUP * KUP, NUPQ, KUP, MLA_QL, vt, vs);
    for (int dir = 0; dir < 2; ++dir) {
        ph_transpose(p.rw_w_up + (size_t)dir * RW_WL * GD, p.WloT, RW_WL, GD, DEPTH, (size_t)NLO * KLO, dir * GD, KLO, dir * RW_WL, vt, vs, (size_t)2 * RW_WL * GD);
        ph_transpose(p.rw_a_up + (size_t)dir * RW_AL * GD, p.WloT, RW_AL, GD, DEPTH, (size_t)NLO * KLO, 2 * GD + dir * GD, KLO, 2 * RW_WL + dir * RW_AL, vt, vs, (size_t)2 * RW_AL * GD);
    }
    ph_transpose(p.rw_g_up, p.WloT, RW_GL, GD, DEPTH, (size_t)NLO * KLO, 4 * GD, KLO, 2 * RW_WL + 2 * RW_AL, vt, vs);
    GRID_BARRIER();
    ph_modulate(p, 0, vt, vs);
    GRID_BARRIER();

    for (int l = 0; l < DEPTH; ++l) {
        for (int r_ = REPS(0); r_ > 0; --r_)
        {
            pg8::Gemm g{PF().xm, PF().WinT + (size_t)l * N_INP * D, TT, N_INP, D}; pg8::StaticOrder S; S.init(TT, N_INP, NBF(), OPQS(bx));
            pg8::EpiBf16N E{PF().P, N_IN, N_IN};
            pg8::gemm_phase<pg8::EpiBf16N, pg8::StaticOrder, false>((PG8_LAS unsigned char*)lds, g, S, E, nullptr);
            GRID_BARRIER();
        }
        for (int r_ = REPS(1); r_ > 0; --r_) {
        ph_rw_mix(PF(), l, VTF(), VSF());
        ph_mb_prep(PF(), l, VTF(), VSF());
        ph_mla_norm(PF(), l, VTF(), VSF());
        ph_vt_tiles(PF(), 0, smem, OPQS(bx), NBF());
        GRID_BARRIER();
        }
        for (int r_ = REPS(8); r_ > 0; --r_) {
        {
            pg8::Gemm g{PF().pmb, PF().WloT + (size_t)l * NLO * KLO, TT, NLO, KLO}; pg8::StaticOrder S; S.init(TT, NLO, NBF(), OPQS(bx));
            pg8::EpiBf16N E{PF().LO, NLO, NLO};
            pg8::gemm_phase<pg8::EpiBf16N, pg8::StaticOrder, false>((PG8_LAS unsigned char*)lds, g, S, E, nullptr);
        }
        {
            pg8::Gemm g{PF().qkvn, PF().WupT + (size_t)l * NUP * KUP, TT, NUP, KUP}; pg8::StaticOrder S; S.init(TT, NUP, NBF(), OPQS(bx));
            pg8::EpiF32 E{PF().QKVraw, NUP, nullptr};
            pg8::gemm_phase<pg8::EpiF32, pg8::StaticOrder, false>((PG8_LAS unsigned char*)lds, g, S, E, nullptr);
        }
        GRID_BARRIER();
        }
        for (int r_ = REPS(9); r_ > 0; --r_) { ph_rw_prep(PF(), l, VTF(), VSF()); ph_mla_rope(PF(), l, VTF(), VSF()); ph_vt_tiles(PF(), 1, smem, OPQS(bx), NBF()); ph_vt_tiles(PF(), 2, smem, OPQS(bx), NBF()); ph_vt_tiles(PF(), 3, smem, OPQS(bx), NBF()); ph_bc_frag(PF(), OPQS(bx), NBF()); }
        GRID_BARRIER();
        for (int r_ = REPS(10); r_ > 0; --r_) { ph_chunks(PF(), l, (float*)lds, PF().qctr + l * 16 + 8 + (r_ - 1)); GRID_BARRIER(); }
        {
            constexpr int SEQ_BLOCKS = (NU * 2 * 64 + NT - 1) / NT;
            const int wv = __builtin_amdgcn_readfirstlane((int)(VTF() >> 6));
            for (int r_ = REPS(6); r_ > 0; --r_) {
                if (bx < NU) ph_rw_seq(PF(), lds, OPQS(bx), NU);
                else if (bx < NU + 2 * SEQ_BLOCKS) ph_mb_seq(PF(), wv - NU * (NT / 64), 2 * SEQ_BLOCKS * (NT / 64));
            }
            constexpr int QB = (NT / 64) * 32, RPU = NT / 128;
            const bool with_ctx = l < DEPTH - 1;
            const int n_mla = NB * NH * (SEQ / QB) + (with_ctx ? NB * NH * (CTX / QB) : 0);
            const int n_na = NB * NH * ((SEQ / GRID_W) / RPU) + (with_ctx ? NB * NH * (CTX / QB) : 0);
            for (int r_ = REPS(2); r_ > 0; --r_)
            for (;;) {
                __syncthreads();
                if (threadIdx.x == 0) *s_unit = atomicAdd(&PF().qctr[l * 16 + (r_ - 1)], 1);
                __syncthreads();
                const int u = *s_unit;
                if (u >= 2 * n_mla) break;
                mla_unit<NT>(PF(), smem, u);
            }
            for (int r_ = REPS(7); r_ > 0; --r_)
            for (;;) {
                __syncthreads();
                if (threadIdx.x == 0) *s_unit = atomicAdd(&PF().qctr[l * 16 + 4 + (r_ - 1)], 1);
                __syncthreads();
                const int u = *s_unit;
                if (u >= n_na) break;
                na_unit<NT>(PF(), l, smem, u);
            }
            GRID_BARRIER();
        }
        for (int r_ = REPS(3); r_ > 0; --r_) {
        ph_rw_yout(PF(), l, VTF(), VSF());
        ph_mb_yout(PF(), l, VTF(), VSF());
        ph_mla_combine(PF(), l < DEPTH - 1, VTF(), VSF());
        GRID_BARRIER();
        }
#define OUT_GEMM(SchedT, S_) do { pg8::Gemm g{PF().Ymix, PF().WoutT + (size_t)l * D * D_MIX, TT, D, D_MIX}; pg8::EpiBf16N E{PF().yo, D, D}; \
            pg8::gemm_phase<pg8::EpiBf16N, SchedT, false>((PG8_LAS unsigned char*)lds, g, S_, E, nullptr); } while (0)
#define OUT_NTL() (NBF() >= 64 ? (TT / 256 - OUT_T0) * (D / 256) : 0)
        if (l < DEPTH - 1) {
            constexpr int OUT_T0 = 32;
            for (int r_ = REPS(4); r_ > 0; --r_) {
            { pg8::StaticOrder S; S.init(OUT_T0 * 256, D, NBF(), OPQS(bx)); OUT_GEMM(pg8::StaticOrder, S); }
            GRID_BARRIER();
            }
            if (OPQS(bx) < OUT_NTL() || OUT_NTL() == 0) { pg8::TailOrder S{OUT_T0, TT / 256, D / 256, OUT_NTL() ? OUT_NTL() : NBF(), OPQS(bx)}; OUT_GEMM(pg8::TailOrder, S); }
            else { ph_ln1_route(PF(), l, (float*)lds, (int*)(lds + LDS_RT), (size_t)(OPQS(bx) - OUT_NTL()) * NT + TIDX(), (size_t)(NBF() - OUT_NTL()) * NT, 0, OUT_T0 * 256, true);
                ph_ln1_fix(PF(), (const int*)(lds + LDS_RT), (size_t)(OPQS(bx) - OUT_NTL()) * NT + TIDX(), (size_t)(NBF() - OUT_NTL()) * NT, 0, OUT_T0 * 256); }
            GRID_BARRIER();
            if (OUT_NTL() == 0) { ph_ln1_route(PF(), l, (float*)lds, (int*)(lds + LDS_RT), VTF(), VSF(), 0, TT, true); ph_ln1_fix(PF(), (const int*)(lds + LDS_RT), VTF(), VSF(), 0, TT); }
            else if (OPQS(bx) >= OUT_NTL()) {
                ph_ln1_route(PF(), l, (float*)lds, (int*)(lds + LDS_RT), ((size_t)(TIDX() >> 6) * (NBF() - OUT_NTL()) + (OPQS(bx) - OUT_NTL())) * 64 + (TIDX() & 63), (size_t)(NBF() - OUT_NTL()) * NT, OUT_T0 * 256, TT, false);
                ph_ln1_fix(PF(), (const int*)(lds + LDS_RT), ((size_t)(TIDX() >> 6) * (NBF() - OUT_NTL()) + (OPQS(bx) - OUT_NTL())) * 64 + (TIDX() & 63), (size_t)(NBF() - OUT_NTL()) * NT, OUT_T0 * 256, TT);
            }
        } else {
            for (int r_ = REPS(5); r_ > 0; --r_) {
            { pg8::LatentOrder S; S.init(NB * SEQ, D, NBF(), OPQS(bx)); OUT_GEMM(pg8::LatentOrder, S); }
            GRID_BARRIER();
            }
            ph_ln1_route(PF(), l, (float*)lds, (int*)(lds + LDS_RT), VTF(), VSF(), 0, TT, true);
            ph_ln1_fix(PF(), (const int*)(lds + LDS_RT), VTF(), VSF(), 0, TT);
        }
#undef OUT_GEMM
#undef OUT_NTL
        GRID_BARRIER();
        for (int r_ = REPS(13); r_ > 0; --r_) {
        ph_moe_perm(PF(), l, VTF(), VSF());
        GRID_BARRIER();
        }
        for (int r_ = REPS(14); r_ > 0; --r_) {
        {
            pg8::Gemm g{PF().hperm, PF().WguT + (size_t)l * NE * 2 * D_EXP * D, MPAD, NE * 2 * D_EXP, D};
            pg8::MoeOrder S{PF().cnt + l * NE, NBF(), OPQS(bx), 2 * D_EXP / 256};
            pg8::EpiSwiGLU E{PF().hidp, D_EXP, 2 * D_EXP / 256};
            pg8::gemm_phase<pg8::EpiSwiGLU, pg8::MoeOrder, false>((PG8_LAS unsigned char*)lds, g, S, E, nullptr);
        }
        GRID_BARRIER();
        }
        for (int r_ = REPS(15); r_ > 0; --r_) {
        {
            pg8::Gemm g{PF().hidp, PF().WdT + (size_t)l * NE * D * D_EXP, MPAD, NE * D, D_EXP};
            pg8::MoeOrder S{PF().cnt + l * NE, NBF(), OPQS(bx), D / 256};
            pg8::EpiBf16Grp E{PF().Fperm, D, D / 256};
            pg8::gemm_phase<pg8::EpiBf16Grp, pg8::MoeOrder, false>((PG8_LAS unsigned char*)lds, g, S, E, nullptr);
        }
        GRID_BARRIER();
        }
        ph_ln2(PF(), l, VTF(), VSF());
        GRID_BARRIER();
    }
}

static size_t carve(size_t& off, size_t bytes) { const size_t o = off; off += (bytes + 255) & ~(size_t)255; return o; }

extern "C" void kernel_launch(void* const* d_in, const int* in_sizes, int n_in, void* d_out, int out_size, void* d_ws, size_t ws_size, hipStream_t stream) {
    (void)in_sizes; (void)n_in; (void)out_size;
    MegaArgs a{};
    Params& p = a.p;
    const float* const* in = (const float* const*)d_in;
    p.x = in[0]; p.c = in[1]; p.ctx = in[2]; p.c_ctx = in[3]; p.ada_w = in[4]; p.ada_b = in[5]; p.w_in = in[6]; p.w_out = in[7];
    p.ln1_g = in[8]; p.ln1_b = in[9]; p.ln2_g = in[10]; p.ln2_b = in[11];
    p.rw_mu = in[12]; p.rw_w0 = in[13]; p.rw_w_up = in[14]; p.rw_a0 = in[15]; p.rw_a_up = in[16]; p.rw_g_up = in[17]; p.rw_k_k = in[18]; p.rw_k_a = in[19];
    p.rw_r_k = in[20]; p.rw_gn_g = in[21]; p.rw_gn_b = in[22];
    p.mb_conv_w = in[23]; p.mb_conv_b = in[24]; p.mb_a_log = in[25]; p.mb_dt_bias = in[26]; p.mb_d = in[27]; p.mb_norm_g = in[28];
    p.mla_q_norm = in[29]; p.mla_w_uq = in[30]; p.mla_kv_norm = in[31]; p.mla_w_ukv = in[32]; p.na_rpb = in[33];
    p.router_w = in[34]; p.router_b = in[35]; p.exp_w_gate = in[36]; p.exp_w_up = in[37]; p.exp_w_down = in[38];
    p.out = (float*)d_out;

    char* ws = (char*)d_ws; size_t off = 0;
    a.bar = (unsigned*)(ws + carve(off, (size_t)XCD_BAR_WORDS * 4));
    p.WinT = (bf16_t*)(ws + carve(off, (size_t)DEPTH * N_INP * D * 2));
    p.WoutT = (bf16_t*)(ws + carve(off, (size_t)DEPTH * D * D_MIX * 2));
    p.WguT = (bf16_t*)(ws + carve(off, (size_t)DEPTH * NE * 2 * D_EXP * D * 2));
    p.WdT = (bf16_t*)(ws + carve(off, (size_t)DEPTH * NE * D * D_EXP * 2));
    p.WupT = (bf16_t*)(ws + carve(off, (size_t)DEPTH * NUP * KUP * 2));
    p.WloT = (bf16_t*)(ws + carve(off, (size_t)DEPTH * NLO * KLO * 2));
    p.xs = (float*)(ws + carve(off, (size_t)TT * D * 4));
    p.xm = (bf16_t*)(ws + carve(off, (size_t)TT * D * 2));
    p.mod = (float*)(ws + carve(off, (size_t)DEPTH * NMOD * 6 * D * 4));
    p.modp = (float*)(ws + carve(off, (size_t)DEPTH * (D / 128) * NMOD * 6 * D * 4));
    p.ropecs = (float2*)(ws + carve(off, (size_t)GRID_W * (MLA_ROPE / 4) * 8));
    p.cnt = (int*)(ws + carve(off, (size_t)DEPTH * NE * 4));
    p.qctr = (int*)(ws + carve(off, (size_t)DEPTH * 16 * 4));
    p.tok_e = (int2*)(ws + carve(off, (size_t)TT * 8));
    p.tok_pos = (int2*)(ws + carve(off, (size_t)TT * 8));
    p.tok_row = (int2*)(ws + carve(off, (size_t)TT * 8));
    p.tok_w = (float2*)(ws + carve(off, (size_t)TT * 8));
    p.Ymix = (bf16_t*)(ws + carve(off, (size_t)TT * D_MIX * 2));
    p.naVt = (bf16_t*)(ws + carve(off, (size_t)NB * NH * HD * LL * 2));
    p.mlaO = (float*)(ws + carve(off, (size_t)TT * NH * 2 * MLA_V * 4));
    p.mlaML = (float*)(ws + carve(off, (size_t)TT * NH * 2 * 2 * 4));
    p.hb = (bf16_t*)(ws + carve(off, (size_t)TT * D * 2));
    const size_t regA = off;
    p.P = (bf16_t*)(ws + carve(off, (size_t)TT * N_IN * 2));
    p.pm = (float*)(ws + carve(off, (size_t)TT * RW_IN * 4));
    p.pmb = (bf16_t*)(ws + carve(off, (size_t)TT * KLO * 2));
    p.rwW = (float*)(ws + carve(off, (size_t)2 * TT * GD * 4));
    p.rwB = (float*)(ws + carve(off, (size_t)2 * TT * GD * 4));
    p.rwKD = (float*)(ws + carve(off, (size_t)2 * TT * GD * 4));
    p.rwKK = (float*)(ws + carve(off, (size_t)TT * GD * 4));
    p.rwG = (float*)(ws + carve(off, (size_t)TT * GD * 4));
    {
        const size_t o0 = off; size_t o1 = off, o2 = off;
        p.rwMsT = (bf16_t*)(ws + carve(o1, (size_t)NU * NCHK * HD * HD * 2));
        p.rwSloc = (float*)(ws + carve(o1, (size_t)NU * NCHK * HD * HD * 4));
        p.rwYI = (bf16_t*)(ws + carve(o1, (size_t)NU * LL * HD * 2));
        p.rwYloc = (float*)(ws + carve(o1, (size_t)NU * LL * HD * 4));
        p.LO = (bf16_t*)(ws + carve(o2, (size_t)TT * NLO * 2));
        p.QKVraw = (float*)(ws + carve(o2, (size_t)TT * NUP * 4));
        off = o1 > o2 ? o1 : o2; (void)o0;
    }
    p.xc = (float*)(ws + carve(off, (size_t)TT * MB_CONV_DIM * 4));
    p.dt = (float*)(ws + carve(off, (size_t)TT * 2 * NH * 4));
    p.mbC = (bf16_t*)(ws + carve(off, (size_t)TT * MB_GROUPS * MB_STATE * 2));
    p.mbB = (bf16_t*)(ws + carve(off, (size_t)TT * MB_GROUPS * MB_STATE * 2));
    p.mbXT = (bf16_t*)(ws + carve(off, (size_t)NB * NH * HD * LL * 2));
    p.mbBT = (bf16_t*)(ws + carve(off, (size_t)NB * MB_GROUPS * MB_STATE * LL * 2));
    p.mbCS = (bf16_t*)(ws + carve(off, (size_t)NU * NCHK * HD * MB_STATE * 2));
    p.mbYloc = (bf16_t*)(ws + carve(off, (size_t)NU * LL * HD * 2));
    p.mbCum = (float*)(ws + carve(off, (size_t)NU * LL * 4));
    p.qkvn = (bf16_t*)(ws + carve(off, (size_t)TT * KUP * 2));
    p.Qm = (bf16_t*)(ws + carve(off, (size_t)TT * NH * MLA_QK * 2));
    p.Km = (bf16_t*)(ws + carve(off, (size_t)TT * NH * MLA_QK * 2));
    p.Vt = (bf16_t*)(ws + carve(off, (size_t)TT * NH * MLA_V * 2));
    const size_t endA = off;
    off = regA;
    p.yo = (bf16_t*)(ws + carve(off, (size_t)TT * D * 2));
    p.hperm = (bf16_t*)(ws + carve(off, (size_t)MPAD * D * 2));
    p.hidp = (bf16_t*)(ws + carve(off, (size_t)MPAD * D_EXP * 2));
    p.Fperm = (bf16_t*)(ws + carve(off, (size_t)MPAD * D * 2));
    const size_t endB = off;
    const size_t need = endA > endB ? endA : endB;
    if (need > ws_size) return;

    static int grid = 0;
    if (!grid) {
        int dev = 0, cus = 0, per_cu = 0;
        if (hipGetDevice(&dev) != hipSuccess || hipDeviceGetAttribute(&cus, hipDeviceAttributeMultiprocessorCount, dev) != hipSuccess) { grid = -1; return; }
        if (hipFuncSetAttribute((const void*)k_mega, hipFuncAttributeMaxDynamicSharedMemorySize, LDS_BYTES) != hipSuccess) { grid = -1; return; }
        if (hipOccupancyMaxActiveBlocksPerMultiprocessor(&per_cu, (const void*)k_mega, NT, LDS_BYTES) != hipSuccess) per_cu = 0;
        grid = cus * (per_cu < 1 ? per_cu : 1);
        if (grid <= 0) grid = -1;
    }
    if (grid <= 0) return;
    for (int k = 0; k < 16; ++k) a.reps[k] = 1;
#ifdef PROBE_GROUP
    a.reps[PROBE_GROUP] = 2;
#endif
    (void)hipMemsetAsync(a.bar, 0, (size_t)XCD_BAR_WORDS * 4, stream);
    hipLaunchKernelGGL(k_mega, dim3(grid), dim3(NT), LDS_BYTES, stream, a);
}
```

```cpp
#include <hip/hip_runtime.h>
#include <stdint.h>
#include <stddef.h>
#include <math.h>

#ifndef CFG_SMALL
constexpr int D = 2048, NB = 2, SEQ = 4096, DEPTH = 4, CTX = 256, GRID_W = 64;
constexpr int HD = 64;
constexpr int RW_WL = 64, RW_AL = 64, RW_GL = 128;
constexpr int MB_STATE = 128, MB_GROUPS = 2, MB_CONV = 5;
constexpr int MLA_NOPE = 64, MLA_ROPE = 32;
constexpr int NA_WR = 8, NA_WC = 16;
constexpr int NE = 16, NEG = 4;
#else
constexpr int D = 256, NB = 2, SEQ = 64, DEPTH = 2, CTX = 16, GRID_W = 8;
constexpr int HD = 16;
constexpr int RW_WL = 8, RW_AL = 8, RW_GL = 16;
constexpr int MB_STATE = 16, MB_GROUPS = 2, MB_CONV = 5;
constexpr int MLA_NOPE = 16, MLA_ROPE = 8;
constexpr int NA_WR = 4, NA_WC = 4;
constexpr int NE = 16, NEG = 4;
#endif
constexpr int GD = D / 4, NH = GD / HD, D_MIX = 4 * GD;
constexpr int MLA_QL = 3 * D / 16, MLA_KVL = D / 16;
constexpr int D_EXP = D / 4, EPG = NE / NEG;
constexpr int RW_IN = 3 * GD + 2 * RW_WL + 2 * RW_AL + RW_GL;
constexpr int MB_CONV_DIM = GD + 2 * MB_GROUPS * MB_STATE;
constexpr int MB_IN = GD + MB_CONV_DIM + 2 * NH;
constexpr int MLA_V = HD, MLA_QK = MLA_NOPE + MLA_ROPE;
constexpr int MLA_IN = MLA_QL + MLA_KVL + MLA_ROPE;
constexpr int NA_IN = 3 * GD;
constexpr int N_IN = RW_IN + MB_IN + MLA_IN + NA_IN;
constexpr int OFF_RW = 0, OFF_MB = RW_IN, OFF_MLA = RW_IN + MB_IN, OFF_NA = OFF_MLA + MLA_IN;
constexpr int LL = CTX + SEQ, TT = NB * LL;
constexpr int NMOD = NB + 1;
constexpr int MPAD = ((2 * TT + 255) / 256 + NE) * 256;
constexpr int N_INP = ((N_IN + 255) / 256) * 256;
constexpr int KLO = 2 * RW_WL + 2 * RW_AL + RW_GL, NLO = 5 * GD;
constexpr int KUP = MLA_QL + MLA_KVL, NUPQ = NH * MLA_QK, NUP = NUPQ + NH * (MLA_NOPE + MLA_V);
constexpr float LN_EPS = 1e-6f, RMS_EPS = 1e-6f, RW_GN_EPS = 64e-5f, RW_DECAY_SCALE = 0.606531f, ROUTED_SCALE = 2.5f;
constexpr float ROPE_BASE = 10000.0f;
#define DN_ALPHA (sqrtf(sqrtf(2.0f * (float)DEPTH)))

typedef unsigned short bf16_t;

#define DEVFN __device__ __forceinline__


DEVFN uint32_t f_as_u(float f) { union { float f; uint32_t u; } c; c.f = f; return c.u; }
DEVFN float u_as_f(uint32_t u) { union { float f; uint32_t u; } c; c.u = u; return c.f; }
DEVFN bf16_t f2bf(float f) { uint32_t u = f_as_u(f); u += 0x7fffu + ((u >> 16) & 1u); return (bf16_t)(u >> 16); }
DEVFN float bf2f(bf16_t h) { return u_as_f(((uint32_t)h) << 16); }
DEVFN int TIDX() { int t = (int)threadIdx.x; asm volatile("" : "+v"(t)); return t; }
DEVFN float bflo(unsigned w) { return u_as_f(w << 16); }
DEVFN float bfhi(unsigned w) { return u_as_f(w & 0xffff0000u); }
DEVFN unsigned pk2(float a, float b) { return (unsigned)f2bf(a) | ((unsigned)f2bf(b) << 16); }
DEVFN float sigmoidf_(float x) { return 1.0f / (1.0f + expf(-x)); }
DEVFN float siluf_(float x) { return x * sigmoidf_(x); }
DEVFN float softplusf_(float x) { return x > 20.0f ? x : log1pf(expf(x)); }

struct Params {
    const float *x, *c, *ctx, *c_ctx, *ada_w, *ada_b, *w_in, *w_out, *ln1_g, *ln1_b, *ln2_g, *ln2_b;
    const float *rw_mu, *rw_w0, *rw_w_up, *rw_a0, *rw_a_up, *rw_g_up, *rw_k_k, *rw_k_a, *rw_r_k, *rw_gn_g, *rw_gn_b;
    const float *mb_conv_w, *mb_conv_b, *mb_a_log, *mb_dt_bias, *mb_d, *mb_norm_g;
    const float *mla_q_norm, *mla_w_uq, *mla_kv_norm, *mla_w_ukv, *na_rpb, *router_w, *router_b, *exp_w_gate, *exp_w_up, *exp_w_down;
    float* out;
    bf16_t *WinT, *WoutT, *WguT, *WdT, *WupT;
    float* xs;
    bf16_t* xm;
    float* mod;
    float* modp;
    float2* ropecs;
    bf16_t* P;
    float* pm;
    bf16_t* pmb;
    bf16_t* LO;
    bf16_t* WloT;
    float *rwW, *rwB, *rwKD;
    float *rwKK, *rwG;
    bf16_t* rwMsT;
    float* rwSloc;
    bf16_t* rwYI;
    float* rwYloc;
    float* xc;
    float* dt;
    bf16_t* mbC;
    bf16_t* mbB;
    bf16_t* mbXT;
    bf16_t* mbBT;
    bf16_t* mbCS;
    bf16_t* mbYloc;
    float* mbCum;
    bf16_t* qkvn;
    float* QKVraw;
    int* qctr;
    bf16_t *Qm, *Km, *Vt;
    bf16_t* naVt;
    float* mlaO;
    float* mlaML;
    bf16_t* Ymix;
    bf16_t* yo;
    bf16_t* hb;
    int* cnt;
    int2 *tok_e, *tok_pos, *tok_row;
    float2* tok_w;
    bf16_t *hperm, *hidp, *Fperm;
};

DEVFN void ph_init(const Params& p, int l, size_t vt, size_t vs) {
    const size_t n = (size_t)TT * D;
    for (size_t i = vt; i < n; i += vs) {
        const int d = (int)(i % D); const int t = (int)(i / D); const int b = t / LL, s = t % LL;
        p.xs[i] = s < CTX ? p.ctx[((size_t)b * CTX + s) * D + d] : p.x[((size_t)b * SEQ + (s - CTX)) * D + d];
    }
    for (size_t i = vt; i < (size_t)GRID_W * (MLA_ROPE / 4); i += vs) {
        const int f = (int)(i % (MLA_ROPE / 4)), pos = (int)(i / (MLA_ROPE / 4));
        const float ang = (float)pos * powf(ROPE_BASE, -(float)f / (float)(MLA_ROPE / 4));
        p.ropecs[i] = make_float2(cosf(ang), sinf(ang));
    }
    for (size_t i = vt; i < (size_t)DEPTH * NE; i += vs) p.cnt[i] = 0;
    for (size_t i = vt; i < (size_t)DEPTH * 16; i += vs) p.qctr[i] = 0;
}

DEVFN void ph_transpose(const float* src, bf16_t* dst, int K, int N, int batch, size_t dst_bstride, int dst_row0, int ldd, int col0, size_t vt, size_t vs, size_t src_bstride = 0, int src_ld = 0) {
    if (src_ld == 0) src_ld = N;
    if (src_bstride == 0) src_bstride = (size_t)K * src_ld;
    const size_t total = (size_t)batch * (K / 8) * N;
    for (size_t idx = vt; idx < total; idx += vs) {
        const int n = (int)(idx % N); const int k8 = (int)((idx / N) % (K / 8)); const int bt = (int)(idx / ((size_t)N * (K / 8)));
        const float* sp = src + (size_t)bt * src_bstride + (size_t)(k8 * 8) * src_ld + n;
        uint4 w;
        const size_t sl_ = (size_t)src_ld;
        w.x = (unsigned)f2bf(sp[0]) | ((unsigned)f2bf(sp[sl_]) << 16); w.y = (unsigned)f2bf(sp[2 * sl_]) | ((unsigned)f2bf(sp[3 * sl_]) << 16);
        w.z = (unsigned)f2bf(sp[4 * sl_]) | ((unsigned)f2bf(sp[5 * sl_]) << 16); w.w = (unsigned)f2bf(sp[6 * sl_]) | ((unsigned)f2bf(sp[7 * sl_]) << 16);
        *(uint4*)(dst + (size_t)bt * dst_bstride + (size_t)(dst_row0 + n) * ldd + col0 + k8 * 8) = w;
    }
}
DEVFN void ph_zero16(uint4* dst, size_t n16, size_t vt, size_t vs) { for (size_t i = vt; i < n16; i += vs) dst[i] = make_uint4(0u, 0u, 0u, 0u); }
typedef float tt_f32v2 __attribute__((ext_vector_type(2)));
typedef __bf16 tt_bf16v2 __attribute__((ext_vector_type(2)));
DEVFN unsigned tt_pk(float lo, float hi) { const tt_f32v2 v = {lo, hi}; const tt_bf16v2 r = __builtin_convertvector(v, tt_bf16v2); return __builtin_bit_cast(unsigned, r); }
DEVFN void tr_tiles(const float* src, bf16_t* dst, int K, int N, int batch, size_t dst_bstride, int dst_row0, int ldd, int col0, unsigned* sw, int tile0, int tile_end, int stride, size_t src_bstride = 0, int src_ld = 0) {
    if (src_ld == 0) src_ld = N;
    if (src_bstride == 0) src_bstride = (size_t)K * src_ld;
    const int lane = TIDX() & 63;
    const int kt = K / 64, nt = (N + 63) / 64; const int total = batch * kt * nt < tile_end ? batch * kt * nt : tile_end;
    const int pc = lane & 15, r0 = lane >> 4, q = lane & 7, n0 = lane >> 3;
    int tile = tile0;
    if (tile >= total) return;
    float4 va[8], vb4[8];
#define TT_LOAD(tile_, A_, B_) do { const int tc = (tile_) < total ? (tile_) : total - 1; const int kti = tc % kt, nti = (tc / kt) % nt, bt = tc / (nt * kt); \
        const int nn = nti * 64 + pc * 4; const int nc = nn + 4 <= N ? nn : 0;            \
        const float* sp = src + (size_t)bt * src_bstride + (size_t)(kti * 64 + 2 * r0) * src_ld + nc; \
        _Pragma("unroll") for (int i = 0; i < 8; ++i) { A_[i] = *(const float4*)(sp + (size_t)(8 * i) * src_ld); B_[i] = *(const float4*)(sp + (size_t)(8 * i + 1) * src_ld); } } while (0)
    TT_LOAD(tile, va, vb4);
    for (; tile < total; tile += stride) {
        float4 na[8], nb4[8];
        TT_LOAD(tile + stride, na, nb4);
        __builtin_amdgcn_wave_barrier();
#pragma unroll
        for (int i = 0; i < 8; ++i) {
            unsigned* w = sw + (4 * pc) * 32 + ((r0 + 4 * i) ^ ((pc & 7) << 2));
            w[0] = tt_pk(va[i].x, vb4[i].x); w[32] = tt_pk(va[i].y, vb4[i].y); w[64] = tt_pk(va[i].z, vb4[i].z); w[96] = tt_pk(va[i].w, vb4[i].w);
        }
        __builtin_amdgcn_wave_barrier();
        {
            const int kti = tile % kt, nti = (tile / kt) % nt, bt = tile / (nt * kt);
#pragma unroll
            for (int i = 0; i < 8; ++i) {
                const int n = n0 + 8 * i; const uint4 v = *(const uint4*)(sw + n * 32 + 4 * (q ^ ((n >> 2) & 7)));
                const int gn = nti * 64 + n;
                if (gn < N) *(uint4*)(dst + (size_t)bt * dst_bstride + (size_t)(dst_row0 + gn) * ldd + col0 + kti * 64 + q * 8) = v;
            }
        }
#pragma unroll
        for (int i = 0; i < 8; ++i) { va[i] = na[i]; vb4[i] = nb4[i]; }
    }
#undef TT_LOAD
}
DEVFN void ph_transpose_t(const float* src, bf16_t* dst, int K, int N, int batch, size_t dst_bstride, int dst_row0, int ldd, int col0, bf16_t* smem, int vb, int nvb, size_t src_bstride = 0, int src_ld = 0) {
    const int wid = __builtin_amdgcn_readfirstlane(TIDX() >> 6);
    tr_tiles(src, dst, K, N, batch, dst_bstride, dst_row0, ldd, col0, (unsigned*)smem + wid * (64 * 32), vb * 8 + wid, 0x7fffffff, nvb * 8, src_bstride, src_ld);
}
constexpr int CONV_TB = 8;
constexpr int CV_IN = (D / 64) * ((N_IN + 63) / 64), CV_OUT = (D_MIX / 64) * (D / 64), CV_GU = NE * (D / 64) * 2, CV_DN = NE * (D_EXP / 64) * (D / 64);
static_assert(CV_IN % CONV_TB == 0 && CV_OUT % CONV_TB == 0 && CV_GU % CONV_TB == 0 && CV_DN % CONV_TB == 0, "whole batches");
constexpr int NCONV = (CV_IN + CV_OUT + 8 * CV_GU + CV_DN) / CONV_TB;
DEVFN void conv_mat(const Params& p, int l, int mat, unsigned* sw, int tile0, int tile_end, int stride) {
    const float* src; bf16_t* dst; int K, N, batch, row0, ldd, src_ld; size_t dbs, sbs;
    if (mat == 0) { src = p.w_in + (size_t)l * D * N_IN; dst = p.WinT + (size_t)l * N_INP * D; K = D; N = N_IN; batch = 1; dbs = 0; row0 = 0; ldd = D; sbs = (size_t)D * N_IN; src_ld = N_IN; }
    else if (mat == 1) { src = p.w_out + (size_t)l * D_MIX * D; dst = p.WoutT + (size_t)l * D * D_MIX; K = D_MIX; N = D; batch = 1; dbs = 0; row0 = 0; ldd = D_MIX; sbs = (size_t)D_MIX * D; src_ld = D; }
    else if (mat < 10) { const int cu = (mat - 2) & 3, up = (mat - 2) >> 2; src = (up ? p.exp_w_up : p.exp_w_gate) + (size_t)l * NE * D * D_EXP + cu * 128; dst = p.WguT + (size_t)l * NE * 2 * D_EXP * D;
        K = D; N = 128; batch = NE; dbs = (size_t)2 * D_EXP * D; row0 = cu * 256 + up * 128; ldd = D; sbs = (size_t)D * D_EXP; src_ld = D_EXP; }
    else { src = p.exp_w_down + (size_t)l * NE * D_EXP * D; dst = p.WdT + (size_t)l * NE * D * D_EXP; K = D_EXP; N = D; batch = NE; dbs = (size_t)D * D_EXP; row0 = 0; ldd = D_EXP; sbs = (size_t)D_EXP * D; src_ld = D; }
    tr_tiles(src, dst, K, N, batch, dbs, row0, ldd, 0, sw, tile0, tile_end, stride, sbs, src_ld);
}
DEVFN void conv_item(const Params& p, int l, int bi, unsigned* sw) {
    int mat, b0;
    if (bi < CV_IN / CONV_TB) { mat = 0; b0 = bi; }
    else if (bi < (CV_IN + CV_OUT) / CONV_TB) { mat = 1; b0 = bi - CV_IN / CONV_TB; }
    else if (bi < (CV_IN + CV_OUT + 8 * CV_GU) / CONV_TB) { const int r = bi - (CV_IN + CV_OUT) / CONV_TB; mat = 2 + r / (CV_GU / CONV_TB); b0 = r % (CV_GU / CONV_TB); }
    else { mat = 10; b0 = bi - (CV_IN + CV_OUT + 8 * CV_GU) / CONV_TB; }
    conv_mat(p, l, mat, sw, b0 * CONV_TB, b0 * CONV_TB + CONV_TB, 1);
}

constexpr int MOD_IC = 128, MOD_NC = D / MOD_IC;
DEVFN void ph_mod_partial(const Params& p, size_t vt, size_t vs) {
    constexpr int J4 = 6 * D / 4;
    const size_t total = (size_t)DEPTH * MOD_NC * J4;
    for (size_t idx = vt; idx < total; idx += vs) {
        const int j4 = (int)(idx % J4); const int ic = (int)((idx / J4) % MOD_NC); const int l = (int)(idx / ((size_t)J4 * MOD_NC));
        float4 acc[NMOD];
#pragma unroll
        for (int r = 0; r < NMOD; ++r) acc[r] = make_float4(0.f, 0.f, 0.f, 0.f);
        const float* wp = p.ada_w + ((size_t)l * D + (size_t)ic * MOD_IC) * 6 * D + j4 * 4;
#pragma unroll 8
        for (int i = 0; i < MOD_IC; ++i) {
            const float4 w = *(const float4*)(wp + (size_t)i * 6 * D);
#pragma unroll
            for (int r = 0; r < NMOD; ++r) { const float cv = r < NB ? p.c[r * D + ic * MOD_IC + i] : p.c_ctx[ic * MOD_IC + i]; const float sv = siluf_(cv);
                acc[r].x += sv * w.x; acc[r].y += sv * w.y; acc[r].z += sv * w.z; acc[r].w += sv * w.w; }
        }
#pragma unroll
        for (int r = 0; r < NMOD; ++r) *(float4*)(p.modp + ((((size_t)l * MOD_NC + ic) * NMOD + r) * 6 * D) + j4 * 4) = acc[r];
    }
}
DEVFN void ph_mod_final(const Params& p, size_t vt, size_t vs) {
    const size_t total = (size_t)DEPTH * NMOD * 6 * D;
    for (size_t idx = vt; idx < total; idx += vs) {
        const int j = (int)(idx % (6 * D)); const int r = (int)((idx / (6 * D)) % NMOD); const int l = (int)(idx / ((size_t)6 * D * NMOD));
        float acc = p.ada_b[(size_t)l * 6 * D + j];
        for (int ic = 0; ic < MOD_NC; ++ic) acc += p.modp[(((size_t)l * MOD_NC + ic) * NMOD + r) * 6 * D + j];
        p.mod[idx] = acc;
    }
}

DEVFN void ph_modulate(const Params& p, int l, size_t vt, size_t vs) {
    const size_t n = (size_t)TT * D;
    for (size_t i = vt; i < n; i += vs) {
        const int d = (int)(i % D); const int t = (int)(i / D); const int b = t / LL, s = t % LL; const int r = s < CTX ? NB : b;
        const float* m = p.mod + ((size_t)l * NMOD + r) * 6 * D;
        p.xm[i] = f2bf(p.xs[i] * (1.0f + m[D + d]) + m[d]);
    }
}

typedef short bf16x8_t __attribute__((ext_vector_type(8)));
typedef float f32x16_t __attribute__((ext_vector_type(16)));
typedef __bf16 bf16v2_t __attribute__((ext_vector_type(2)));
typedef float f32v2_t __attribute__((ext_vector_type(2)));
DEVFN unsigned cvt_pk_bf16_h(float lo, float hi) { const f32v2_t v = {lo, hi}; const bf16v2_t r = __builtin_convertvector(v, bf16v2_t); return __builtin_bit_cast(unsigned, r); }
DEVFN unsigned cvt_pk_bf16(float lo, float hi) { unsigned r; asm volatile("v_cvt_pk_bf16_f32 %0, %1, %2" : "=v"(r) : "v"(lo), "v"(hi)); return r; }
union Frag8 { bf16x8_t v; unsigned u[4]; uint2 d2[2]; uint4 q; };


DEVFN void ph_rw_mix(const Params& p, int l, size_t vt, size_t vs) {
    static_assert(RW_IN % 8 == 0 && (3 * GD) % 8 == 0 && (2 * RW_WL) % 8 == 0 && (2 * RW_AL) % 8 == 0, "8-column groups");
    constexpr int NG = RW_IN / 8;
    const size_t n = (size_t)TT * NG;
    for (size_t i = vt; i < n; i += vs) {
        const int col = (int)(i % NG) * 8; const int t = (int)(i / NG); const int s_ = t % LL;
        const bool first = (s_ == 0 || s_ == CTX), last = (s_ == CTX - 1 || s_ == LL - 1);
        const bf16_t* pc = p.P + (size_t)t * N_IN + OFF_RW + col;
        const uint4 cv = *(const uint4*)pc;
        const uint4 pv = first ? make_uint4(0, 0, 0, 0) : *(const uint4*)(pc - N_IN);
        const uint4 nv = last ? make_uint4(0, 0, 0, 0) : *(const uint4*)(pc + N_IN);
        const float* m0 = p.rw_mu + ((size_t)l * 2 + 0) * RW_IN + col; const float* m1 = p.rw_mu + ((size_t)l * 2 + 1) * RW_IN + col;
        const float4 a0 = *(const float4*)m0, a1 = *(const float4*)(m0 + 4), b0 = *(const float4*)m1, b1 = *(const float4*)(m1 + 4);
        const float mu0[8] = {a0.x, a0.y, a0.z, a0.w, a1.x, a1.y, a1.z, a1.w}, mu1[8] = {b0.x, b0.y, b0.z, b0.w, b1.x, b1.y, b1.z, b1.w};
        const unsigned cw[4] = {cv.x, cv.y, cv.z, cv.w}, pw[4] = {pv.x, pv.y, pv.z, pv.w}, nw[4] = {nv.x, nv.y, nv.z, nv.w};
        float o[8];
#pragma unroll
        for (int k = 0; k < 4; ++k) {
            const float v0 = bflo(cw[k]), v1 = bfhi(cw[k]);
            o[2 * k] = v0 + mu0[2 * k] * (bflo(pw[k]) - v0) + mu1[2 * k] * (bflo(nw[k]) - v0);
            o[2 * k + 1] = v1 + mu0[2 * k + 1] * (bfhi(pw[k]) - v1) + mu1[2 * k + 1] * (bfhi(nw[k]) - v1);
        }
        if (col >= 3 * GD && col < 3 * GD + 2 * RW_WL) {
#pragma unroll
            for (int k = 0; k < 8; ++k) o[k] = tanhf(o[k]);
        } else if (col >= 3 * GD + 2 * RW_WL + 2 * RW_AL) {
#pragma unroll
            for (int k = 0; k < 8; ++k) o[k] = sigmoidf_(o[k]);
        }
        float* po = p.pm + (size_t)t * RW_IN + col;
        *(float4*)po = make_float4(o[0], o[1], o[2], o[3]); *(float4*)(po + 4) = make_float4(o[4], o[5], o[6], o[7]);
        if (col >= 3 * GD) *(uint4*)(p.pmb + (size_t)t * KLO + (col - 3 * GD)) = make_uint4(pk2(o[0], o[1]), pk2(o[2], o[3]), pk2(o[4], o[5]), pk2(o[6], o[7]));
    }
}

DEVFN void ph_rw_prep(const Params& p, int l, size_t vt, size_t vs) {
    static_assert(HD == 64, "one head = 16 lanes x 4 columns");
    constexpr int NG = GD / 4;
    const size_t n = (size_t)TT * NG;
    for (size_t i = vt; i < n; i += vs) {
        const int c = (int)(i % NG) * 4; const int t = (int)(i / NG);
        const float4 k4 = *(const float4*)(p.pm + (size_t)t * RW_IN + GD + c);
        const float4 kk4 = *(const float4*)(p.rw_k_k + (size_t)l * GD + c), ka4 = *(const float4*)(p.rw_k_a + (size_t)l * GD + c);
        const float k[4] = {k4.x, k4.y, k4.z, k4.w}, kkw[4] = {kk4.x, kk4.y, kk4.z, kk4.w}, ka[4] = {ka4.x, ka4.y, ka4.z, ka4.w};
        float kkr[4], ss = 0.f;
#pragma unroll
        for (int q = 0; q < 4; ++q) { kkr[q] = k[q] * kkw[q]; ss += kkr[q] * kkr[q]; }
#pragma unroll
        for (int o = 8; o > 0; o >>= 1) ss += __shfl_xor(ss, o);
        const float rn = 1.0f / sqrtf(fmaxf(ss, 1e-12f));
        const bf16_t* lo = p.LO + (size_t)t * NLO + c;
        float kkv[4];
#pragma unroll
        for (int q = 0; q < 4; ++q) kkv[q] = kkr[q] * rn;
#pragma unroll
        for (int dir = 0; dir < 2; ++dir) {
            const uint2 wl = *(const uint2*)(lo + dir * GD), al = *(const uint2*)(lo + 2 * GD + dir * GD);
            const float4 w0 = *(const float4*)(p.rw_w0 + ((size_t)l * 2 + dir) * GD + c), a0 = *(const float4*)(p.rw_a0 + ((size_t)l * 2 + dir) * GD + c);
            const float wp[4] = {w0.x + bflo(wl.x), w0.y + bfhi(wl.x), w0.z + bflo(wl.y), w0.w + bfhi(wl.y)};
            const float ap[4] = {a0.x + bflo(al.x), a0.y + bfhi(al.x), a0.z + bflo(al.y), a0.w + bfhi(al.y)};
            float dec[4], bv[4], kd[4];
#pragma unroll
            for (int q = 0; q < 4; ++q) { const float av = sigmoidf_(ap[q]); dec[q] = expf(-RW_DECAY_SCALE * sigmoidf_(wp[q])); bv[q] = kkv[q] * av; kd[q] = k[q] * (1.0f + (av - 1.0f) * ka[q]); }
            const size_t o = ((size_t)dir * TT + t) * GD + c;
            *(float4*)(p.rwW + o) = make_float4(dec[0], dec[1], dec[2], dec[3]); *(float4*)(p.rwB + o) = make_float4(bv[0], bv[1], bv[2], bv[3]); *(float4*)(p.rwKD + o) = make_float4(kd[0], kd[1], kd[2], kd[3]);
        }
        const uint2 gl = *(const uint2*)(lo + 4 * GD);
        *(float4*)(p.rwKK + (size_t)t * GD + c) = make_float4(kkv[0], kkv[1], kkv[2], kkv[3]);
        *(float4*)(p.rwG + (size_t)t * GD + c) = make_float4(bflo(gl.x), bfhi(gl.x), bflo(gl.y), bfhi(gl.y));
    }
}

DEVFN int scan_pos(int dir, int step) {
    if (dir == 0) return step;
    return step < CTX ? (CTX - 1 - step) : (CTX + (SEQ - 1) - (step - CTX));
}

constexpr int CK = 64, NCHK = LL / CK, NU = NB * NH * 2;
constexpr int RWS = 8;
constexpr int RW_ROW = 6 * HD;
constexpr int RW_STG = RWS * RW_ROW;
typedef float f2v __attribute__((ext_vector_type(2)));
template <int MODE>
DEVFN void rw_chunk_item(const Params& p, float* lds_f, const int item) {
    constexpr bool DO_T = MODE != 2, DO_L = MODE != 1;
    static_assert(HD == 64 && CTX % CK == 0 && SEQ % CK == 0 && CK % RWS == 0, "chunking");
    const int lane = (TIDX() & 63);
    float* stg = lds_f + (size_t)__builtin_amdgcn_readfirstlane((TIDX() >> 6)) * RW_STG;
    {
        const int c = item % NCHK, u = item / NCHK;
        const int dir = u % 2, h = (u / 2) % NH, b = u / (2 * NH);
        f2v ST[HD / 2], SL[HD / 2];
#pragma unroll
        for (int j = 0; j < HD / 2; ++j) { ST[j] = (f2v){(2 * j == lane) ? 1.f : 0.f, (2 * j + 1 == lane) ? 1.f : 0.f}; SL[j] = (f2v){0.f, 0.f}; }
        float4 na0, na1, na2, na3, na4, na5, nb0, nb1, nb2, nb3, nb4, nb5;
#define RWC_LOAD1(q_, sub_, X0, X1, X2, X3, X4, X5) do { const int t_ = b * LL + scan_pos(dir, c * CK + (sub_) * RWS + (q_) * 4 + lrow_); \
                X0 = *(const float4*)(p.rwW + ((size_t)dir * TT + t_) * GD + h * HD + lcol_); X1 = *(const float4*)(p.rwB + ((size_t)dir * TT + t_) * GD + h * HD + lcol_); \
                X2 = *(const float4*)(p.rwKD + ((size_t)dir * TT + t_) * GD + h * HD + lcol_); X3 = *(const float4*)(p.rwKK + (size_t)t_ * GD + h * HD + lcol_); \
                X4 = *(const float4*)(p.pm + (size_t)t_ * RW_IN + h * HD + lcol_); X5 = *(const float4*)(p.pm + (size_t)t_ * RW_IN + 2 * GD + h * HD + lcol_); } while (0)
#define RWC_LOAD(sub_) do { int lrow_ = lane >> 4, lcol_ = (lane & 15) * 4; asm volatile("" : "+v"(lrow_), "+v"(lcol_)); \
            RWC_LOAD1(0, sub_, na0, na1, na2, na3, na4, na5); RWC_LOAD1(1, sub_, nb0, nb1, nb2, nb3, nb4, nb5); } while (0)
        RWC_LOAD(0);
#pragma unroll 1
        for (int sub = 0; sub < CK / RWS; ++sub) {
            __builtin_amdgcn_wave_barrier();
            {
                int lrow = lane >> 4, lcol = (lane & 15) * 4;
                asm volatile("" : "+v"(lrow), "+v"(lcol));
                float* d0 = stg + (lrow) * RW_ROW + lcol; float* d1 = stg + (4 + lrow) * RW_ROW + lcol;
                *(float4*)(d0) = na0; *(float4*)(d0 + HD) = na1; *(float4*)(d0 + 2 * HD) = na2; *(float4*)(d0 + 3 * HD) = na3; *(float4*)(d0 + 4 * HD) = na4; *(float4*)(d0 + 5 * HD) = na5;
                *(float4*)(d1) = nb0; *(float4*)(d1 + HD) = nb1; *(float4*)(d1 + 2 * HD) = nb2; *(float4*)(d1 + 3 * HD) = nb3; *(float4*)(d1 + 4 * HD) = nb4; *(float4*)(d1 + 5 * HD) = nb5;
            }
            if (sub + 1 < CK / RWS) RWC_LOAD(sub + 1);
            __builtin_amdgcn_wave_barrier();
#pragma unroll 1
            for (int st = 0; st < RWS; ++st) {
                const float* sv = stg + st * RW_ROW;
                const int gs = c * CK + sub * RWS + st;
                f2v aT = {0.f, 0.f}, aL = {0.f, 0.f};
                float4 kkn = *(const float4*)(sv + 3 * HD);
#pragma unroll
                for (int j = 0; j < HD; j += 4) {
                    const float4 kk = kkn;
                    if (j + 4 < HD) kkn = *(const float4*)(sv + 3 * HD + j + 4);
                    asm volatile("" ::: "memory");
                    const f2v k0 = {kk.x, kk.y}, k1 = {kk.z, kk.w};
                    if (DO_T) { aT += ST[j / 2] * k0; aT += ST[j / 2 + 1] * k1; }
                    if (DO_L) { aL += SL[j / 2] * k0; aL += SL[j / 2 + 1] * k1; }
                }
                const float saT = -(aT.x + aT.y), saL = -(aL.x + aL.y);
                const f2v saT2 = {saT, saT}, saL2 = {saL, saL};
                int ln0 = lane; asm volatile("" : "+v"(ln0));
                const float vi = sv[5 * HD + ln0];
                const f2v vi2 = {vi, vi};
                f2v yT2 = {0.f, 0.f}, yL2 = {0.f, 0.f};
                float4 wn = *(const float4*)(sv), bn = *(const float4*)(sv + HD), kdn = *(const float4*)(sv + 2 * HD), rn = *(const float4*)(sv + 4 * HD);
#pragma unroll
                for (int j = 0; j < HD; j += 4) {
                    const float4 w = wn, bb = bn, kd = kdn, r = rn;
                    if (j + 4 < HD) { wn = *(const float4*)(sv + j + 4); bn = *(const float4*)(sv + HD + j + 4); if (DO_L) kdn = *(const float4*)(sv + 2 * HD + j + 4); rn = *(const float4*)(sv + 4 * HD + j + 4); }
                    asm volatile("" ::: "memory");
                    const f2v w0 = {w.x, w.y}, w1 = {w.z, w.w}, b0 = {bb.x, bb.y}, b1 = {bb.z, bb.w}, r0 = {r.x, r.y}, r1 = {r.z, r.w};
                    if (DO_T) {
                        ST[j / 2] = ST[j / 2] * w0 + saT2 * b0; ST[j / 2 + 1] = ST[j / 2 + 1] * w1 + saT2 * b1;
                        yT2 += ST[j / 2] * r0; yT2 += ST[j / 2 + 1] * r1;
                    }
                    if (DO_L) {
                        const f2v d0 = {kd.x, kd.y}, d1 = {kd.z, kd.w};
                        SL[j / 2] = SL[j / 2] * w0 + saL2 * b0 + vi2 * d0; SL[j / 2 + 1] = SL[j / 2 + 1] * w1 + saL2 * b1 + vi2 * d1;
                        yL2 += SL[j / 2] * r0; yL2 += SL[j / 2 + 1] * r1;
                    }
                }
                int ln = lane; asm volatile("" : "+v"(ln));
                if (DO_T) p.rwYI[((size_t)u * LL + gs) * HD + ln] = f2bf(yT2.x + yT2.y);
                if (DO_L) p.rwYloc[((size_t)u * LL + gs) * HD + ln] = yL2.x + yL2.y;
            }
        }
#undef RWC_LOAD
#undef RWC_LOAD1
        if (DO_T) {
        bf16_t* oT = p.rwMsT + ((size_t)u * NCHK + c) * HD * HD;
#pragma unroll
        for (int j = 0; j < HD; ++j) oT[(size_t)j * HD + lane] = f2bf((j & 1) ? ST[j / 2].y : ST[j / 2].x);
        }
        if (DO_L) {
        float* oL = p.rwSloc + (((size_t)u * NCHK + c) * HD + lane) * HD;
#pragma unroll
        for (int j = 0; j < HD; j += 4) *(float4*)(oL + j) = make_float4(SL[j / 2].x, SL[j / 2].y, SL[j / 2 + 1].x, SL[j / 2 + 1].y);
        }
    }
}

template <bool ISL>
DEVFN void rw_chunk_quarter(const Params& p, float* lds_f, const int item, const int rh) {
    const int lane = (TIDX() & 63);
    float* stg = lds_f + (size_t)__builtin_amdgcn_readfirstlane((TIDX() >> 6)) * RW_STG;
    const int c = item % NCHK, u = item / NCHK;
    const int dir = u % 2, h = (u / 2) % NH, b = u / (2 * NH);
    const int row = rh * 32 + (lane & 31), co = 32 * (lane >> 5);
    f2v S[16];
#pragma unroll
    for (int j = 0; j < 16; ++j) S[j] = ISL ? (f2v){0.f, 0.f} : (f2v){(co + 2 * j == row) ? 1.f : 0.f, (co + 2 * j + 1 == row) ? 1.f : 0.f};
    float4 na0, na1, na2, na3, na4, na5, nb0, nb1, nb2, nb3, nb4, nb5;
#define RWC_LOAD1(q_, sub_, X0, X1, X2, X3, X4, X5) do { const int t_ = b * LL + scan_pos(dir, c * CK + (sub_) * RWS + (q_) * 4 + lrow_); \
            X0 = *(const float4*)(p.rwW + ((size_t)dir * TT + t_) * GD + h * HD + lcol_); X1 = *(const float4*)(p.rwB + ((size_t)dir * TT + t_) * GD + h * HD + lcol_); \
            X2 = *(const float4*)(p.rwKD + ((size_t)dir * TT + t_) * GD + h * HD + lcol_); X3 = *(const float4*)(p.rwKK + (size_t)t_ * GD + h * HD + lcol_); \
            X4 = *(const float4*)(p.pm + (size_t)t_ * RW_IN + h * HD + lcol_); X5 = *(const float4*)(p.pm + (size_t)t_ * RW_IN + 2 * GD + h * HD + lcol_); } while (0)
#define RWC_LOAD(sub_) do { int lrow_ = lane >> 4, lcol_ = (lane & 15) * 4; asm volatile("" : "+v"(lrow_), "+v"(lcol_)); \
        RWC_LOAD1(0, sub_, na0, na1, na2, na3, na4, na5); RWC_LOAD1(1, sub_, nb0, nb1, nb2, nb3, nb4, nb5); } while (0)
    RWC_LOAD(0);
#pragma unroll 1
    for (int sub = 0; sub < CK / RWS; ++sub) {
        __builtin_amdgcn_wave_barrier();
        {
            int lrow = lane >> 4, lcol = (lane & 15) * 4;
            asm volatile("" : "+v"(lrow), "+v"(lcol));
            float* d0 = stg + (lrow) * RW_ROW + lcol; float* d1 = stg + (4 + lrow) * RW_ROW + lcol;
            *(float4*)(d0) = na0; *(float4*)(d0 + HD) = na1; *(float4*)(d0 + 2 * HD) = na2; *(float4*)(d0 + 3 * HD) = na3; *(float4*)(d0 + 4 * HD) = na4; *(float4*)(d0 + 5 * HD) = na5;
            *(float4*)(d1) = nb0; *(float4*)(d1 + HD) = nb1; *(float4*)(d1 + 2 * HD) = nb2; *(float4*)(d1 + 3 * HD) = nb3; *(float4*)(d1 + 4 * HD) = nb4; *(float4*)(d1 + 5 * HD) = nb5;
        }
        if (sub + 1 < CK / RWS) RWC_LOAD(sub + 1);
        __builtin_amdgcn_wave_barrier();
#pragma unroll 1
        for (int st = 0; st < RWS; ++st) {
            int co_ = co; asm volatile("" : "+v"(co_));
            const float* sv = stg + st * RW_ROW + co_;
            const int gs = c * CK + sub * RWS + st;
            f2v a2 = {0.f, 0.f};
#pragma unroll
            for (int j = 0; j < 32; j += 4) {
                const float4 kk = *(const float4*)(sv + 3 * HD + j);
                a2 += S[j / 2] * (f2v){kk.x, kk.y}; a2 += S[j / 2 + 1] * (f2v){kk.z, kk.w};
            }
            float sap = a2.x + a2.y; sap += __shfl_xor(sap, 32);
            const f2v sa2 = {-sap, -sap};
            int rw_ = row; asm volatile("" : "+v"(rw_));
            const float vi = ISL ? stg[st * RW_ROW + 5 * HD + rw_] : 0.f;
            const f2v vi2 = {vi, vi};
            f2v y2 = {0.f, 0.f};
#pragma unroll
            for (int j = 0; j < 32; j += 4) {
                asm volatile("" ::: "memory");
                const float4 w = *(const float4*)(sv + j), bb = *(const float4*)(sv + HD + j), r = *(const float4*)(sv + 4 * HD + j);
                const f2v w0 = {w.x, w.y}, w1 = {w.z, w.w}, b0 = {bb.x, bb.y}, b1 = {bb.z, bb.w}, r0 = {r.x, r.y}, r1 = {r.z, r.w};
                if (ISL) { const float4 kd = *(const float4*)(sv + 2 * HD + j); S[j / 2] = S[j / 2] * w0 + sa2 * b0 + vi2 * (f2v){kd.x, kd.y}; S[j / 2 + 1] = S[j / 2 + 1] * w1 + sa2 * b1 + vi2 * (f2v){kd.z, kd.w}; }
                else { S[j / 2] = S[j / 2] * w0 + sa2 * b0; S[j / 2 + 1] = S[j / 2 + 1] * w1 + sa2 * b1; }
                y2 += S[j / 2] * r0; y2 += S[j / 2 + 1] * r1;
            }
            float yp = y2.x + y2.y; yp += __shfl_xor(yp, 32);
            if (lane < 32) { if (ISL) p.rwYloc[((size_t)u * LL + gs) * HD + rw_] = yp; else p.rwYI[((size_t)u * LL + gs) * HD + rw_] = f2bf(yp); }
        }
    }
#undef RWC_LOAD
#undef RWC_LOAD1
    if (!ISL) {
        bf16_t* oT = p.rwMsT + ((size_t)u * NCHK + c) * HD * HD;
#pragma unroll
        for (int j = 0; j < 32; ++j) oT[(size_t)(co + j) * HD + row] = f2bf((j & 1) ? S[j / 2].y : S[j / 2].x);
    } else {
        float* oL = p.rwSloc + (((size_t)u * NCHK + c) * HD + row) * HD + co;
#pragma unroll
        for (int j = 0; j < 32; j += 4) *(float4*)(oL + j) = make_float4(S[j / 2].x, S[j / 2].y, S[j / 2 + 1].x, S[j / 2 + 1].y);
    }
}

constexpr int RSQ_D = 4;
constexpr int RSQ_SLOT = HD * HD * 2 + HD * HD * 4;
DEVFN void ph_rw_seq(const Params& p, unsigned char* lds_b, int vb, int nvb) {
    static_assert(NCHK % RSQ_D == 0 && RSQ_D == 4 && RSQ_SLOT == 3 * 512 * 16, "chain geometry: 3 x 16 B per thread per chunk");
    const int tid = TIDX(), lane = tid & 63, wave = tid >> 6, li = lane & 31, lh = lane >> 5;
    for (int u = vb; u < NU; u += nvb) {
        const unsigned char* gM = (const unsigned char*)(p.rwMsT + (size_t)u * NCHK * HD * HD);
        const unsigned char* gS = (const unsigned char*)(p.rwSloc + (size_t)u * NCHK * HD * HD);
        uint4 pf[RSQ_D][3];
#define RSQ_LOAD(d, c_) do { pf[d][0] = *(const uint4*)(gM + (size_t)(c_) * (HD * HD * 2) + tid * 16); \
            pf[d][1] = *(const uint4*)(gS + (size_t)(c_) * (HD * HD * 4) + tid * 16); pf[d][2] = *(const uint4*)(gS + (size_t)(c_) * (HD * HD * 4) + 8192 + tid * 16); } while (0)
#pragma unroll
        for (int d = 0; d < RSQ_D; ++d) RSQ_LOAD(d, d);
        f32x16_t X0, X1;
#pragma unroll
        for (int r = 0; r < 16; ++r) { X0[r] = 0.f; X1[r] = 0.f; }
        const int i = wave * 32 + li;
        __syncthreads();
#define RSQ_STEP(d, P0, P1, P2) { \
                const int c = c0 + d; \
                unsigned char* slot = lds_b + (c & 1) * RSQ_SLOT; \
                *(uint4*)(slot + tid * 16) = P0; *(uint4*)(slot + HD * HD * 2 + tid * 16) = P1; *(uint4*)(slot + HD * HD * 2 + 8192 + tid * 16) = P2; \
                if (c + RSQ_D < NCHK) { P0 = *(const uint4*)(gM + (size_t)(c + RSQ_D) * (HD * HD * 2) + tid * 16); P1 = *(const uint4*)(gS + (size_t)(c + RSQ_D) * (HD * HD * 4) + tid * 16); P2 = *(const uint4*)(gS + (size_t)(c + RSQ_D) * (HD * HD * 4) + 8192 + tid * 16); } \
                __syncthreads(); \
                if (wave < 2) { \
                    const bf16_t* ms = (const bf16_t*)slot; const float* sl = (const float*)(slot + HD * HD * 2) + (size_t)i * HD; \
                    Frag8 xb[2][2]; \
_Pragma("unroll") \
                    for (int sp = 0; sp < 2; ++sp) \
_Pragma("unroll") \
                        for (int q = 0; q < 4; ++q) { \
                            xb[0][sp].u[q] = cvt_pk_bf16_h(X0[8 * sp + 2 * q], X0[8 * sp + 2 * q + 1]); \
                            xb[1][sp].u[q] = cvt_pk_bf16_h(X1[8 * sp + 2 * q], X1[8 * sp + 2 * q + 1]); \
                        } \
                    f32x16_t N0, N1; \
_Pragma("unroll") \
                    for (int g = 0; g < 4; ++g) { \
                        const float4 v0 = *(const float4*)(sl + 8 * g + 4 * lh), v1 = *(const float4*)(sl + 32 + 8 * g + 4 * lh); \
                        N0[4 * g] = v0.x; N0[4 * g + 1] = v0.y; N0[4 * g + 2] = v0.z; N0[4 * g + 3] = v0.w; \
                        N1[4 * g] = v1.x; N1[4 * g + 1] = v1.y; N1[4 * g + 2] = v1.z; N1[4 * g + 3] = v1.w; \
                    } \
_Pragma("unroll") \
                    for (int jb = 0; jb < 2; ++jb) \
_Pragma("unroll") \
                        for (int sp = 0; sp < 2; ++sp) { \
                            Frag8 a0, a1; \
                            a0.d2[0] = *(const uint2*)(ms + (li) * HD + 32 * jb + 16 * sp + 4 * lh); a0.d2[1] = *(const uint2*)(ms + (li) * HD + 32 * jb + 16 * sp + 4 * lh + 8); \
                            a1.d2[0] = *(const uint2*)(ms + (32 + li) * HD + 32 * jb + 16 * sp + 4 * lh); a1.d2[1] = *(const uint2*)(ms + (32 + li) * HD + 32 * jb + 16 * sp + 4 * lh + 8); \
                            N0 = __builtin_amdgcn_mfma_f32_32x32x16_bf16(a0.v, xb[jb][sp].v, N0, 0, 0, 0); \
                            N1 = __builtin_amdgcn_mfma_f32_32x32x16_bf16(a1.v, xb[jb][sp].v, N1, 0, 0, 0); \
                        } \
                    float* so = p.rwSloc + (((size_t)u * NCHK + c) * HD + i) * HD; \
_Pragma("unroll") \
                    for (int g = 0; g < 4; ++g) { \
                        *(float4*)(so + 8 * g + 4 * lh) = make_float4(N0[4 * g], N0[4 * g + 1], N0[4 * g + 2], N0[4 * g + 3]); \
                        *(float4*)(so + 32 + 8 * g + 4 * lh) = make_float4(N1[4 * g], N1[4 * g + 1], N1[4 * g + 2], N1[4 * g + 3]); \
                    } \
                    X0 = N0; X1 = N1; \
                } \
 \
            }
        uint4 pa0, pa1, pa2, pb0, pb1, pb2, pc0, pc1, pc2, pd0, pd1, pd2;
        pa0 = pf[0][0]; pa1 = pf[0][1]; pa2 = pf[0][2]; pb0 = pf[1][0]; pb1 = pf[1][1]; pb2 = pf[1][2]; pc0 = pf[2][0]; pc1 = pf[2][1]; pc2 = pf[2][2]; pd0 = pf[3][0]; pd1 = pf[3][1]; pd2 = pf[3][2];
        for (int c0 = 0; c0 < NCHK; c0 += RSQ_D) {
            RSQ_STEP(0, pa0, pa1, pa2) RSQ_STEP(1, pb0, pb1, pb2) RSQ_STEP(2, pc0, pc1, pc2) RSQ_STEP(3, pd0, pd1, pd2)
        }
#undef RSQ_LOAD
#undef RSQ_STEP
        __syncthreads();
    }
}

DEVFN int rev_gs(int s) { return s < CTX ? (CTX - 1 - s) : (CTX + (SEQ - 1) - (s - CTX)); }
DEVFN int rev_chunk(int pbk) { return pbk < CTX / CK ? (CTX / CK - 1 - pbk) : (CTX / CK + (SEQ / CK - 1) - (pbk - CTX / CK)); }

DEVFN void ph_rw_yout(const Params& p, int l, size_t vt, size_t vs) {
    const int lane = (TIDX() & 63), lq = lane & 31, lh = lane >> 5;
    const int wv = __builtin_amdgcn_readfirstlane((int)(vt >> 6)), nwv = (int)(vs >> 6);
    const int wvs = (wv & 7) * (nwv >> 3) + (wv >> 3);
    for (int item = wvs; item < NB * NH * NCHK; item += nwv) {
        const int pbk = item % NCHK, h = (item / NCHK) % NH, b = item / (NCHK * NH);
        f32x16_t acc[2][2];
#pragma unroll
        for (int dir = 0; dir < 2; ++dir) {
            const int u = (b * NH + h) * 2 + dir;
            const int c = dir == 0 ? pbk : rev_chunk(pbk);
            int gs[2];
#pragma unroll
            for (int tb = 0; tb < 2; ++tb) { const int s_ = CK * pbk + 32 * tb + lq; gs[tb] = dir == 0 ? s_ : rev_gs(s_); }
#pragma unroll
            for (int tb = 0; tb < 2; ++tb) {
                const float* yl = p.rwYloc + ((size_t)u * LL + gs[tb]) * HD;
#pragma unroll
                for (int ib = 0; ib < 2; ++ib)
#pragma unroll
                    for (int g = 0; g < 4; ++g) {
                        const float4 v = *(const float4*)(yl + 32 * ib + 8 * g + 4 * lh);
                        if (dir == 0) { acc[ib][tb][4 * g] = v.x; acc[ib][tb][4 * g + 1] = v.y; acc[ib][tb][4 * g + 2] = v.z; acc[ib][tb][4 * g + 3] = v.w; }
                        else { acc[ib][tb][4 * g] += v.x; acc[ib][tb][4 * g + 1] += v.y; acc[ib][tb][4 * g + 2] += v.z; acc[ib][tb][4 * g + 3] += v.w; }
                    }
            }
            if (c > 0) {
                const float* st = p.rwSloc + ((size_t)u * NCHK + (c - 1)) * HD * HD;
#pragma unroll
                for (int ks = 0; ks < 4; ++ks) {
                    Frag8 a[2];
#pragma unroll
                    for (int ib = 0; ib < 2; ++ib) {
                        const float4 lo = *(const float4*)(st + (size_t)(32 * ib + lq) * HD + 16 * ks + 8 * lh), hi = *(const float4*)(st + (size_t)(32 * ib + lq) * HD + 16 * ks + 8 * lh + 4);
                        a[ib].u[0] = cvt_pk_bf16_h(lo.x, lo.y); a[ib].u[1] = cvt_pk_bf16_h(lo.z, lo.w); a[ib].u[2] = cvt_pk_bf16_h(hi.x, hi.y); a[ib].u[3] = cvt_pk_bf16_h(hi.z, hi.w);
                    }
#pragma unroll
                    for (int tb = 0; tb < 2; ++tb) {
                        const bf16x8_t bq = *(const bf16x8_t*)(p.rwYI + ((size_t)u * LL + gs[tb]) * HD + 16 * ks + 8 * lh);
#pragma unroll
                        for (int ib = 0; ib < 2; ++ib) acc[ib][tb] = __builtin_amdgcn_mfma_f32_32x32x16_bf16(a[ib].v, bq, acc[ib][tb], 0, 0, 0);
                    }
                }
            }
        }
#pragma unroll
        for (int tb = 0; tb < 2; ++tb) {
            const int t = b * LL + CK * pbk + 32 * tb + lq;
            float sum = 0.f;
#pragma unroll
            for (int ib = 0; ib < 2; ++ib)
#pragma unroll
                for (int r = 0; r < 16; ++r) sum += acc[ib][tb][r];
            sum += __shfl_xor(sum, 32);
            const float mu = sum * (1.0f / HD);
            float sq = 0.f;
#pragma unroll
            for (int ib = 0; ib < 2; ++ib)
#pragma unroll
                for (int r = 0; r < 16; ++r) { const float d = acc[ib][tb][r] - mu; sq += d * d; }
            sq += __shfl_xor(sq, 32);
            const float rs = 1.0f / sqrtf(sq * (1.0f / HD) + RW_GN_EPS);
            const float* pr = p.pm + (size_t)t * RW_IN + h * HD;
            float bon = 0.f;
#pragma unroll
            for (int ib = 0; ib < 2; ++ib)
#pragma unroll
                for (int g = 0; g < 4; ++g) {
                    const int i0 = 32 * ib + 8 * g + 4 * lh;
                    const float4 r4 = *(const float4*)(pr + i0), k4 = *(const float4*)(pr + GD + i0), rk = *(const float4*)(p.rw_r_k + (size_t)l * GD + h * HD + i0);
                    bon += r4.x * k4.x * rk.x + r4.y * k4.y * rk.y + r4.z * k4.z * rk.z + r4.w * k4.w * rk.w;
                }
            bon += __shfl_xor(bon, 32);
#pragma unroll
            for (int ib = 0; ib < 2; ++ib)
#pragma unroll
                for (int g = 0; g < 4; ++g) {
                    const int i0 = 32 * ib + 8 * g + 4 * lh;
                    const float4 v4 = *(const float4*)(pr + 2 * GD + i0), g4 = *(const float4*)(p.rwG + (size_t)t * GD + h * HD + i0);
                    const float4 gg = *(const float4*)(p.rw_gn_g + (size_t)l * GD + h * HD + i0), gb = *(const float4*)(p.rw_gn_b + (size_t)l * GD + h * HD + i0);
                    const float o0 = ((acc[ib][tb][4 * g] - mu) * rs * gg.x + gb.x + bon * v4.x) * g4.x, o1 = ((acc[ib][tb][4 * g + 1] - mu) * rs * gg.y + gb.y + bon * v4.y) * g4.y;
                    const float o2 = ((acc[ib][tb][4 * g + 2] - mu) * rs * gg.z + gb.z + bon * v4.z) * g4.z, o3 = ((acc[ib][tb][4 * g + 3] - mu) * rs * gg.w + gb.w + bon * v4.w) * g4.w;
                    uint2 w; w.x = cvt_pk_bf16(o0, o1); w.y = cvt_pk_bf16(o2, o3);
                    *(uint2*)(p.Ymix + (size_t)t * D_MIX + 0 * GD + h * HD + i0) = w;
                }
        }
    }
}

DEVFN size_t mb_frag_off(int t, int nn) {
    const int grp = nn >> 7, n = nn & 127;
    return ((size_t)((t >> 6) * MB_GROUPS + grp)) * (64 * MB_STATE) + (size_t)((((((t >> 5) & 1) * 8 + (n >> 4)) * 2 + ((n >> 3) & 1)) * 32 + (t & 31)) * 8);
}
DEVFN int tile_frag_off(int r, int pc) { return ((((r >> 5) * 4 + (pc >> 1)) * 2 + (pc & 1)) * 32 + (r & 31)) * 8; }
DEVFN void ph_mb_prep(const Params& p, int l, size_t vt, size_t vs) {
    static_assert(MB_CONV_DIM % 8 == 0 && MB_CONV == 5 && (GD + MB_GROUPS * MB_STATE) % 8 == 0, "8-channel groups");
    constexpr int NG = MB_CONV_DIM / 8;
    const size_t n = (size_t)TT * NG;
    for (size_t i = vt; i < n; i += vs) {
        const int c = (int)(i % NG) * 8; const int t = (int)(i / NG); const int s_ = t % LL;
        const int lo = s_ < CTX ? 0 : CTX, hi = s_ < CTX ? CTX : LL;
        const float4 b0 = *(const float4*)(p.mb_conv_b + (size_t)l * MB_CONV_DIM + c), b1 = *(const float4*)(p.mb_conv_b + (size_t)l * MB_CONV_DIM + c + 4);
        float acc[8] = {b0.x, b0.y, b0.z, b0.w, b1.x, b1.y, b1.z, b1.w};
#pragma unroll
        for (int j = 0; j < MB_CONV; ++j) {
            const int so = s_ + j - MB_CONV / 2;
            if (so >= lo && so < hi) {
                const uint4 xv = *(const uint4*)(p.P + (size_t)(t + j - MB_CONV / 2) * N_IN + OFF_MB + GD + c);
                const float* wp = p.mb_conv_w + ((size_t)l * MB_CONV + j) * MB_CONV_DIM + c;
                const float4 w0 = *(const float4*)wp, w1 = *(const float4*)(wp + 4);
                acc[0] += w0.x * bflo(xv.x); acc[1] += w0.y * bfhi(xv.x); acc[2] += w0.z * bflo(xv.y); acc[3] += w0.w * bfhi(xv.y);
                acc[4] += w1.x * bflo(xv.z); acc[5] += w1.y * bfhi(xv.z); acc[6] += w1.z * bflo(xv.w); acc[7] += w1.w * bfhi(xv.w);
            }
        }
#pragma unroll
        for (int k = 0; k < 8; ++k) acc[k] = siluf_(acc[k]);
        float* xo = p.xc + (size_t)t * MB_CONV_DIM + c;
        *(float4*)xo = make_float4(acc[0], acc[1], acc[2], acc[3]); *(float4*)(xo + 4) = make_float4(acc[4], acc[5], acc[6], acc[7]);
    }
    const size_t n2 = (size_t)TT * 2 * NH;
    for (size_t i = vt; i < n2; i += vs) {
        const int q = (int)(i % (2 * NH)); const int t = (int)(i / (2 * NH));
        p.dt[i] = softplusf_(bf2f(p.P[(size_t)t * N_IN + OFF_MB + GD + MB_CONV_DIM + q]) + p.mb_dt_bias[(size_t)l * 2 * NH + q]);
    }
}

DEVFN void ph_bc_frag(const Params& p, int vb, int nvb) {
    const int tid = TIDX(); const int r = tid >> 3, pc = tid & 7;
    for (int u = vb; u < (TT / 64) * 8; u += nvb) {
        const int nb4 = u & 3, isC = (u >> 2) & 1, tb = u >> 3;
        const int t = tb * 64 + r; const int nn = nb4 * 64 + pc * 8;
        const float* src = p.xc + (size_t)t * MB_CONV_DIM + GD + isC * (MB_GROUPS * MB_STATE) + nn;
        const float4 a = *(const float4*)src, c4 = *(const float4*)(src + 4);
        *(uint4*)((isC ? p.mbC : p.mbB) + mb_frag_off(t, nn)) = make_uint4(pk2(a.x, a.y), pk2(a.z, a.w), pk2(c4.x, c4.y), pk2(c4.z, c4.w));
    }
}

constexpr int MB_STG = 256;
DEVFN void mb_chunk_item(const Params& p, int l, float* lds_f, const int item) {
    static_assert(MB_STATE == 128 && HD == 64 && CK == 64, "mamba chunk geometry");
    const int lane = (TIDX() & 63), lq = lane & 31, lh = lane >> 5;
    (void)lds_f;
    const int pbk = item % NCHK, dir = (item / NCHK) & 1, h = (item / (2 * NCHK)) % NH, b = item / (2 * NCHK * NH);
    const int grp = h / (NH / MB_GROUPS), u = (b * NH + h) * 2 + dir;
    const int c = dir == 0 ? pbk : rev_chunk(pbk);
    const int t0 = b * LL + CK * pbk;
    const float A = -expf(p.mb_a_log[((size_t)l * 2 + dir) * NH + h]);
    const float dtv = p.dt[(size_t)(t0 + lane) * 2 * NH + dir * NH + h];
    float cum = dtv * A;
#pragma unroll
    for (int o = 1; o < 64; o <<= 1) { const float v = __shfl(cum, dir == 0 ? lane - o : lane + o); if (dir == 0 ? lane >= o : lane + o < 64) cum += v; }
    const float ctot = __shfl(cum, dir == 0 ? 63 : 0);
    const int gs = dir == 0 ? CK * pbk + lane : rev_gs(CK * pbk + lane);
    p.mbCum[(size_t)u * LL + gs] = cum;
    const float wsc = expf(ctot - cum) * dtv;
    f32x16_t G[2][2];
#pragma unroll
    for (int st = 0; st < 2; ++st)
#pragma unroll
        for (int tt = 0; tt < 2; ++tt)
#pragma unroll
            for (int r = 0; r < 16; ++r) G[st][tt][r] = 0.f;
    const bf16_t* Bg = p.mbB + (size_t)((t0 >> 6) * MB_GROUPS + grp) * (64 * MB_STATE); const bf16_t* Cg = p.mbC + (size_t)((t0 >> 6) * MB_GROUPS + grp) * (64 * MB_STATE);
#pragma unroll
    for (int ks = 0; ks < 8; ++ks) {
        bf16x8_t af[2], bfg[2];
#pragma unroll
        for (int q = 0; q < 2; ++q) { af[q] = *(const bf16x8_t*)(Bg + (((q * 8 + ks) * 2 + lh) * 32 + lq) * 8); bfg[q] = *(const bf16x8_t*)(Cg + (((q * 8 + ks) * 2 + lh) * 32 + lq) * 8); }
#pragma unroll
        for (int st = 0; st < 2; ++st)
#pragma unroll
            for (int tt = 0; tt < 2; ++tt) G[st][tt] = __builtin_amdgcn_mfma_f32_32x32x16_bf16(af[st], bfg[tt], G[st][tt], 0, 0, 0);
    }
    Frag8 pf[2][2][2];
#pragma unroll
    for (int tt = 0; tt < 2; ++tt) {
        const int et = 32 * tt + lq; const float cumt = __shfl(cum, et);
#pragma unroll
        for (int st = 0; st < 2; ++st) {
            float mv[16];
#pragma unroll
            for (int g = 0; g < 4; ++g) {
                const int es0 = 32 * st + 8 * g + 4 * lh;
                const float csv[4] = {__shfl(cum, es0), __shfl(cum, es0 + 1), __shfl(cum, es0 + 2), __shfl(cum, es0 + 3)};
                const float dtq[4] = {__shfl(dtv, es0), __shfl(dtv, es0 + 1), __shfl(dtv, es0 + 2), __shfl(dtv, es0 + 3)};
#pragma unroll
                for (int q = 0; q < 4; ++q) { const int es = es0 + q; const bool on = dir == 0 ? es <= et : es >= et; mv[4 * g + q] = on ? G[st][tt][4 * g + q] * expf(fminf(cumt - csv[q], 0.f)) * dtq[q] : 0.f; }
            }
#pragma unroll
            for (int sp = 0; sp < 2; ++sp)
#pragma unroll
                for (int j = 0; j < 4; ++j) pf[st][tt][sp].u[j] = cvt_pk_bf16_h(mv[8 * sp + 2 * j], mv[8 * sp + 2 * j + 1]);
        }
    }
    const bf16_t* Xg = p.mbXT + ((size_t)(b * NH + h) * NCHK + pbk) * 4096;
    {
        f32x16_t Y[2][2];
#pragma unroll
        for (int pt = 0; pt < 2; ++pt)
#pragma unroll
            for (int tt = 0; tt < 2; ++tt)
#pragma unroll
                for (int r = 0; r < 16; ++r) Y[pt][tt][r] = 0.f;
#pragma unroll
        for (int st = 0; st < 2; ++st)
#pragma unroll
            for (int sp = 0; sp < 2; ++sp) {
                Frag8 xa[2];
#pragma unroll
                for (int pt = 0; pt < 2; ++pt) { const bf16_t* xr = Xg + (((pt * 4 + 2 * st + sp) * 2) * 32 + lq) * 8 + 4 * lh; xa[pt].d2[0] = *(const uint2*)xr; xa[pt].d2[1] = *(const uint2*)(xr + 32 * 8); }
#pragma unroll
                for (int pt = 0; pt < 2; ++pt)
#pragma unroll
                    for (int tt = 0; tt < 2; ++tt) Y[pt][tt] = __builtin_amdgcn_mfma_f32_32x32x16_bf16(xa[pt].v, pf[st][tt][sp].v, Y[pt][tt], 0, 0, 0);
            }
#pragma unroll
        for (int tt = 0; tt < 2; ++tt) {
            bf16_t* yo = p.mbYloc + ((size_t)u * NCHK + pbk) * 4096 + tt * 2048;
#pragma unroll
            for (int pt = 0; pt < 2; ++pt)
#pragma unroll
                for (int g = 0; g < 4; ++g) { uint2 w; w.x = cvt_pk_bf16_h(Y[pt][tt][4 * g], Y[pt][tt][4 * g + 1]); w.y = cvt_pk_bf16_h(Y[pt][tt][4 * g + 2], Y[pt][tt][4 * g + 3]); *(uint2*)(yo + (((pt * 4 + g) * 32 + lq) * 2 + lh) * 4) = w; }
        }
    }
    {
        const bf16_t* BTg = p.mbBT + ((size_t)((b * MB_GROUPS + grp) * 2) * NCHK + pbk) * 4096;
        f32x16_t Cs[4][2];
#pragma unroll
        for (int nt = 0; nt < 4; ++nt)
#pragma unroll
            for (int pt = 0; pt < 2; ++pt)
#pragma unroll
                for (int r = 0; r < 16; ++r) Cs[nt][pt][r] = 0.f;
#pragma unroll
        for (int ks = 0; ks < 4; ++ks) {
            const int ew = 16 * ks + 8 * lh;
            const float4 w0 = make_float4(__shfl(wsc, ew), __shfl(wsc, ew + 1), __shfl(wsc, ew + 2), __shfl(wsc, ew + 3)), w1 = make_float4(__shfl(wsc, ew + 4), __shfl(wsc, ew + 5), __shfl(wsc, ew + 6), __shfl(wsc, ew + 7));
            bf16x8_t xb[2];
#pragma unroll
            for (int pt = 0; pt < 2; ++pt) xb[pt] = *(const bf16x8_t*)(Xg + (((pt * 4 + ks) * 2 + lh) * 32 + lq) * 8);
#pragma unroll
            for (int nt = 0; nt < 4; ++nt) {
                const uint4 bw = *(const uint4*)(BTg + (size_t)(nt >> 1) * NCHK * 4096 + ((((nt & 1) * 4 + ks) * 2 + lh) * 32 + lq) * 8);
                Frag8 a; a.u[0] = cvt_pk_bf16_h(bflo(bw.x) * w0.x, bfhi(bw.x) * w0.y); a.u[1] = cvt_pk_bf16_h(bflo(bw.y) * w0.z, bfhi(bw.y) * w0.w);
                a.u[2] = cvt_pk_bf16_h(bflo(bw.z) * w1.x, bfhi(bw.z) * w1.y); a.u[3] = cvt_pk_bf16_h(bflo(bw.w) * w1.z, bfhi(bw.w) * w1.w);
#pragma unroll
                for (int pt = 0; pt < 2; ++pt) Cs[nt][pt] = __builtin_amdgcn_mfma_f32_32x32x16_bf16(a.v, xb[pt], Cs[nt][pt], 0, 0, 0);
            }
        }
#pragma unroll
        for (int pt = 0; pt < 2; ++pt) {
            bf16_t* o = p.mbCS + ((size_t)u * NCHK + c) * HD * MB_STATE + pt * 4096;
#pragma unroll
            for (int nt = 0; nt < 4; ++nt)
#pragma unroll
                for (int g = 0; g < 4; ++g) { uint2 w; w.x = cvt_pk_bf16_h(Cs[nt][pt][4 * g], Cs[nt][pt][4 * g + 1]); w.y = cvt_pk_bf16_h(Cs[nt][pt][4 * g + 2], Cs[nt][pt][4 * g + 3]); *(uint2*)(o + (((nt * 4 + g) * 32 + lq) * 2 + lh) * 4) = w; }
        }
    }
}

constexpr int N_RW_PAIRS = NU * NCHK, N_RW_MERGED = 2048 < N_RW_PAIRS ? 2048 : N_RW_PAIRS;
constexpr int N_RW_ITEMS = N_RW_MERGED + 4 * (N_RW_PAIRS - N_RW_MERGED), N_MB_ITEMS = NB * NH * 2 * NCHK;
DEVFN void ph_chunks(const Params& p, int l, float* lds_f, int* ctr, int* cctr) {
    const int lane = (TIDX() & 63);
    const int wid = __builtin_amdgcn_readfirstlane(TIDX() >> 6);
    const bool conv = l < DEPTH - 1;
#define CONV_DRAIN() do { for (;;) { int it = 0; if (lane == 0) it = atomicAdd(cctr, 1); it = __builtin_amdgcn_readfirstlane(it); if (it >= NCONV) break; \
        conv_item(p, l + 1, it, (unsigned*)(lds_f + (size_t)wid * RW_STG)); } } while (0)
    if (conv && wid == 7) CONV_DRAIN();
    for (;;) {
        int it = 0;
        if (lane == 0) it = atomicAdd(ctr, 1);
        it = __builtin_amdgcn_readfirstlane(it);
        if (it >= N_RW_ITEMS + N_MB_ITEMS) break;
        if (it < N_RW_MERGED) rw_chunk_item<0>(p, lds_f, it);
        else if (it < N_RW_ITEMS) { const int h4 = it - N_RW_MERGED; if (h4 & 2) rw_chunk_quarter<true>(p, lds_f, N_RW_MERGED + (h4 >> 2), h4 & 1); else rw_chunk_quarter<false>(p, lds_f, N_RW_MERGED + (h4 >> 2), h4 & 1); }
        else mb_chunk_item(p, l, lds_f, it - N_RW_ITEMS);
    }
    if (conv) CONV_DRAIN();
#undef CONV_DRAIN
}

DEVFN void ph_mb_seq(const Params& p, int wv, int nwv) {
    constexpr int DQ = 4;
    static_assert(NCHK % DQ == 0, "ring depth");
    const int lane = (TIDX() & 63);
    for (int item = wv; item < NU * 4; item += nwv) {
        const int q4 = item & 3, u = item >> 2;
        float X[32];
#pragma unroll
        for (int k = 0; k < 32; ++k) X[k] = 0.f;
        const size_t eo = (size_t)q4 * 2048 + (size_t)lane * 32;
        uint4 pf[DQ][4]; float dq[DQ];
#define MSQ_LOAD(d, c_) do { const uint4* src_ = (const uint4*)(p.mbCS + ((size_t)u * NCHK + (c_)) * HD * MB_STATE + eo); \
            _Pragma("unroll") for (int k = 0; k < 4; ++k) pf[d][k] = src_[k]; dq[d] = p.mbCum[(size_t)u * LL + (c_) * CK + CK - 1]; } while (0)
#pragma unroll
        for (int d = 0; d < DQ; ++d) MSQ_LOAD(d, d);
        for (int c0 = 0; c0 < NCHK; c0 += DQ) {
#pragma unroll
            for (int d = 0; d < DQ; ++d) {
                const int c = c0 + d;
                const float dtot = expf(dq[d]);
                uint4 o[4];
#pragma unroll
                for (int k = 0; k < 4; ++k) {
                    const unsigned w[4] = {pf[d][k].x, pf[d][k].y, pf[d][k].z, pf[d][k].w}; unsigned ow[4];
#pragma unroll
                    for (int m = 0; m < 4; ++m) {
                        X[8 * k + 2 * m] = dtot * X[8 * k + 2 * m] + u_as_f(w[m] << 16); X[8 * k + 2 * m + 1] = dtot * X[8 * k + 2 * m + 1] + u_as_f(w[m] & 0xffff0000u);
                        ow[m] = cvt_pk_bf16(X[8 * k + 2 * m], X[8 * k + 2 * m + 1]);
                    }
                    o[k] = make_uint4(ow[0], ow[1], ow[2], ow[3]);
                }
                if (c + DQ < NCHK) MSQ_LOAD(d, c + DQ);
                uint4* dst = (uint4*)(p.mbCS + ((size_t)u * NCHK + c) * HD * MB_STATE + eo);
#pragma unroll
                for (int k = 0; k < 4; ++k) dst[k] = o[k];
            }
        }
#undef MSQ_LOAD
    }
}

DEVFN void ph_mb_yout(const Params& p, int l, size_t vt, size_t vs) {
    constexpr int HPG = NH / MB_GROUPS;
    const int lane = (TIDX() & 63), lq = lane & 31, lh = lane >> 5;
    const int wv = __builtin_amdgcn_readfirstlane((int)(vt >> 6)), nwv = (int)(vs >> 6);
    const int wvs = (wv & 7) * (nwv >> 3) + (wv >> 3);
    for (int item = nwv - 1 - wvs; item < NB * MB_GROUPS * NCHK * 2; item += nwv) {
        const int tb = item & 1, pbk = (item >> 1) % NCHK, grp = ((item >> 1) / NCHK) % MB_GROUPS, b = (item >> 1) / (NCHK * MB_GROUPS);
        const int s_ = CK * pbk + 32 * tb + lq, t = b * LL + s_;
        const int gsd[2] = {s_, rev_gs(s_)};
        const int cd[2] = {pbk, rev_chunk(pbk)};
        const bf16_t* cfp = p.mbC + mb_frag_off(t, grp * MB_STATE + 8 * lh);
        f32x16_t acc[HPG][2];
#pragma unroll
        for (int hh = 0; hh < HPG; ++hh)
#pragma unroll
            for (int pt = 0; pt < 2; ++pt)
#pragma unroll
                for (int r = 0; r < 16; ++r) acc[hh][pt][r] = 0.f;
#pragma unroll
        for (int hh = 0; hh < HPG; ++hh) {
            const int h = grp * HPG + hh;
#pragma unroll
            for (int dir = 0; dir < 2; ++dir) {
                const int u = (b * NH + h) * 2 + dir, c = cd[dir];
                if (c > 0) {
                    const bf16_t* st = p.mbCS + ((size_t)u * NCHK + (c - 1)) * HD * MB_STATE;
                    f32x16_t d0, d1;
#pragma unroll
                    for (int r = 0; r < 16; ++r) { d0[r] = 0.f; d1[r] = 0.f; }
#pragma unroll
                    for (int ks = 0; ks < 8; ++ks) {
                        if ((ks & 1) == 0) asm volatile("" ::: "memory");
                        const bf16x8_t a0 = *(const bf16x8_t*)(st + ((((ks >> 1) * 4 + 2 * (ks & 1) + lh) * 32 + lq) * 2) * 4), a1 = *(const bf16x8_t*)(st + 4096 + ((((ks >> 1) * 4 + 2 * (ks & 1) + lh) * 32 + lq) * 2) * 4);
                        const bf16x8_t cfk = *(const bf16x8_t*)(cfp + ks * 512);
                        d0 = __builtin_amdgcn_mfma_f32_32x32x16_bf16(a0, cfk, d0, 0, 0, 0);
                        d1 = __builtin_amdgcn_mfma_f32_32x32x16_bf16(a1, cfk, d1, 0, 0, 0);
                    }
                    const float ec = expf(p.mbCum[(size_t)u * LL + gsd[dir]]);
#pragma unroll
                    for (int r = 0; r < 16; ++r) { acc[hh][0][r] += ec * d0[r]; acc[hh][1][r] += ec * d1[r]; }
                }
            }
        }
        float ss = 0.f;
#pragma unroll
        for (int hh = 0; hh < HPG; ++hh) {
            const int h = grp * HPG + hh;
            const float dsk = p.mb_d[(size_t)l * NH + h];
#pragma unroll
            for (int pt = 0; pt < 2; ++pt)
#pragma unroll
                for (int g = 0; g < 4; ++g) {
                    asm volatile("" ::: "memory");
                    const int p0 = 32 * pt + 8 * g + 4 * lh, ch = h * HD + p0;
                    float yl[4] = {0.f, 0.f, 0.f, 0.f};
#pragma unroll
                    for (int dir = 0; dir < 2; ++dir) {
                            const int u = (b * NH + h) * 2 + dir;
                            const uint2 w = *(const uint2*)(p.mbYloc + ((size_t)u * NCHK + pbk) * 4096 + tb * 2048 + (((pt * 4 + g) * 32 + lq) * 2 + lh) * 4);
                            yl[0] += u_as_f(w.x << 16); yl[1] += u_as_f(w.x & 0xffff0000u); yl[2] += u_as_f(w.y << 16); yl[3] += u_as_f(w.y & 0xffff0000u);
                        }
                    const float4 x4 = *(const float4*)(p.xc + (size_t)t * MB_CONV_DIM + ch);
                    const uint2 zw = *(const uint2*)(p.P + (size_t)t * N_IN + OFF_MB + ch);
                    const float z0 = u_as_f(zw.x << 16), z1 = u_as_f(zw.x & 0xffff0000u), z2 = u_as_f(zw.y << 16), z3 = u_as_f(zw.y & 0xffff0000u);
                    const float v0 = (acc[hh][pt][4 * g] + yl[0] + dsk * x4.x) * siluf_(z0), v1 = (acc[hh][pt][4 * g + 1] + yl[1] + dsk * x4.y) * siluf_(z1);
                    const float v2 = (acc[hh][pt][4 * g + 2] + yl[2] + dsk * x4.z) * siluf_(z2), v3 = (acc[hh][pt][4 * g + 3] + yl[3] + dsk * x4.w) * siluf_(z3);
                    acc[hh][pt][4 * g] = v0; acc[hh][pt][4 * g + 1] = v1; acc[hh][pt][4 * g + 2] = v2; acc[hh][pt][4 * g + 3] = v3;
                    ss += v0 * v0 + v1 * v1 + v2 * v2 + v3 * v3;
                }
        }
        ss += __shfl_xor(ss, 32);
        const float rs = 1.0f / sqrtf(ss * (1.0f / (GD / MB_GROUPS)) + RMS_EPS);
#pragma unroll
        for (int hh = 0; hh < HPG; ++hh)
#pragma unroll
            for (int pt = 0; pt < 2; ++pt)
#pragma unroll
                for (int g = 0; g < 4; ++g) {
                    asm volatile("" ::: "memory");
                    const int ch = (grp * HPG + hh) * HD + 32 * pt + 8 * g + 4 * lh;
                    const float4 ng = *(const float4*)(p.mb_norm_g + (size_t)l * GD + ch);
                    uint2 w; w.x = cvt_pk_bf16(acc[hh][pt][4 * g] * rs * ng.x, acc[hh][pt][4 * g + 1] * rs * ng.y); w.y = cvt_pk_bf16(acc[hh][pt][4 * g + 2] * rs * ng.z, acc[hh][pt][4 * g + 3] * rs * ng.w);
                    *(uint2*)(p.Ymix + (size_t)t * D_MIX + 1 * GD + ch) = w;
                }
    }
}

DEVFN void ph_mla_norm(const Params& p, int l, size_t vt, size_t vs) {
    static_assert(KUP == 512 && MLA_QL % 8 == 0, "one wave = one token: 64 lanes x 8 lora channels (q | kv)");
    const int lane = (TIDX() & 63);
    const size_t wv = vt >> 6, nwv = vs >> 6;
    const bool isq = lane * 8 < MLA_QL;
    for (size_t t = wv; t < (size_t)TT; t += nwv) {
        const uint4 xv = *(const uint4*)(p.P + t * N_IN + OFF_MLA + lane * 8);
        float x[8] = {bflo(xv.x), bfhi(xv.x), bflo(xv.y), bfhi(xv.y), bflo(xv.z), bfhi(xv.z), bflo(xv.w), bfhi(xv.w)};
        float ss = 0.f;
#pragma unroll
        for (int k = 0; k < 8; ++k) ss += x[k] * x[k];
        float sq = isq ? ss : 0.f, sk = isq ? 0.f : ss;
#pragma unroll
        for (int o = 32; o > 0; o >>= 1) { sq += __shfl_xor(sq, o); sk += __shfl_xor(sk, o); }
        const float rs = isq ? 1.0f / sqrtf(sq / MLA_QL + RMS_EPS) : 1.0f / sqrtf(sk / MLA_KVL + RMS_EPS);
        const float* gp = isq ? p.mla_q_norm + (size_t)l * MLA_QL + lane * 8 : p.mla_kv_norm + (size_t)l * MLA_KVL + (lane * 8 - MLA_QL);
        const float4 g0 = *(const float4*)gp, g1 = *(const float4*)(gp + 4);
        *(uint4*)(p.qkvn + t * KUP + lane * 8) = make_uint4(pk2(x[0] * rs * g0.x, x[1] * rs * g0.y), pk2(x[2] * rs * g0.z, x[3] * rs * g0.w), pk2(x[4] * rs * g1.x, x[5] * rs * g1.y), pk2(x[6] * rs * g1.z, x[7] * rs * g1.w));
    }
}

DEVFN void ph_mla_rope(const Params& p, int l, size_t vt, size_t vs) {
    static_assert(MLA_NOPE % 8 == 0 && MLA_ROPE == 32 && MLA_ROPE / 4 == 8, "rope groups: [axis][half][8 freqs]");
    constexpr int NGQ = MLA_QK / 8, NGN = MLA_NOPE / 8;
    const float qscale = 1.4426950408889634f / sqrtf((float)MLA_QK);
    const size_t n = (size_t)TT * NH * NGQ;
    for (size_t id = vt; id < n; id += vs) {
        const int g = (int)(id % NGQ); const int h = (int)((id / NGQ) % NH); const int t = (int)(id / ((size_t)NGQ * NH)); const int b = t / LL, s_ = t % LL; const bool lat = s_ >= CTX; const int tl = s_ - CTX;
        bf16_t* qo = p.Qm + ((size_t)(b * NH + h) * LL + s_) * MLA_QK + g * 8; bf16_t* ko = p.Km + ((size_t)(b * NH + h) * LL + s_) * MLA_QK + g * 8;
        const float* q = p.QKVraw + (size_t)t * NUP + h * MLA_QK;
        if (g < NGN) {
            const float4 q0 = *(const float4*)(q + g * 8), q1 = *(const float4*)(q + g * 8 + 4);
            const float* kv = p.QKVraw + (size_t)t * NUP + NUPQ + h * (MLA_NOPE + MLA_V) + g * 8;
            const float4 k0 = *(const float4*)kv, k1 = *(const float4*)(kv + 4);
            *(uint4*)qo = make_uint4(pk2(q0.x * qscale, q0.y * qscale), pk2(q0.z * qscale, q0.w * qscale), pk2(q1.x * qscale, q1.y * qscale), pk2(q1.z * qscale, q1.w * qscale));
            *(uint4*)ko = make_uint4(pk2(k0.x, k0.y), pk2(k0.z, k0.w), pk2(k1.x, k1.y), pk2(k1.z, k1.w));
        } else {
            const int e0 = (g - NGN) * 8; const int axis = e0 / 16, half = (e0 / 8) & 1;
            const float* qa = q + MLA_NOPE + axis * 16;
            const float4 x10 = *(const float4*)qa, x11 = *(const float4*)(qa + 4), x20 = *(const float4*)(qa + 8), x21 = *(const float4*)(qa + 12);
            const float qx1[8] = {x10.x, x10.y, x10.z, x10.w, x11.x, x11.y, x11.z, x11.w}, qx2[8] = {x20.x, x20.y, x20.z, x20.w, x21.x, x21.y, x21.z, x21.w};
            const bf16_t* kp = p.P + (size_t)t * N_IN + OFF_MLA + MLA_QL + MLA_KVL + axis * 16;
            const uint4 kw1 = *(const uint4*)kp, kw2 = *(const uint4*)(kp + 8);
            const float kx1[8] = {bflo(kw1.x), bfhi(kw1.x), bflo(kw1.y), bfhi(kw1.y), bflo(kw1.z), bfhi(kw1.z), bflo(kw1.w), bfhi(kw1.w)};
            const float kx2[8] = {bflo(kw2.x), bfhi(kw2.x), bflo(kw2.y), bfhi(kw2.y), bflo(kw2.z), bfhi(kw2.z), bflo(kw2.w), bfhi(kw2.w)};
            float qv[8], kvv[8];
            const int pos = lat ? (axis == 0 ? tl / GRID_W : tl % GRID_W) : 0;
#pragma unroll
            for (int f = 0; f < 8; ++f) {
                float cs = 1.f, sn = 0.f;
                if (lat) { const float2 t2 = p.ropecs[pos * 8 + f]; cs = t2.x; sn = t2.y; }
                qv[f] = (half == 0 ? qx1[f] * cs - qx2[f] * sn : qx2[f] * cs + qx1[f] * sn) * qscale;
                kvv[f] = half == 0 ? kx1[f] * cs - kx2[f] * sn : kx2[f] * cs + kx1[f] * sn;
            }
            *(uint4*)qo = make_uint4(pk2(qv[0], qv[1]), pk2(qv[2], qv[3]), pk2(qv[4], qv[5]), pk2(qv[6], qv[7]));
            *(uint4*)ko = make_uint4(pk2(kvv[0], kvv[1]), pk2(kvv[2], kvv[3]), pk2(kvv[4], kvv[5]), pk2(kvv[6], kvv[7]));
        }
    }
}

DEVFN void ph_vt_tiles(const Params& p, int mode, bf16_t* smem, int vb, int nvb) {
    static_assert(HD == 64 && MLA_V == 64 && LL % 64 == 0 && MB_STATE == 128, "64 x 64 tiles");
    const int tid = TIDX(); const int r = tid >> 3, pc = tid & 7;
    const int nrow = mode == 3 ? NB * MB_GROUPS * 2 : NB * NH;
    const int NTL = nrow * (LL / 64);
    constexpr int TLD = 72;
    for (int u = vb; u < NTL; u += nvb) {
        const int tb = u % (LL / 64), bh = u / (LL / 64);
        int b, h;
        if (mode == 3) { b = bh / (MB_GROUPS * 2); h = bh % (MB_GROUPS * 2); } else { b = bh / NH; h = bh % NH; }
        const int t = b * LL + tb * 64 + r;
        unsigned w[4];
        if (mode == 0) { const uint4 v = *(const uint4*)(p.P + (size_t)t * N_IN + OFF_NA + 2 * GD + h * HD + pc * 8); w[0] = v.x; w[1] = v.y; w[2] = v.z; w[3] = v.w; }
        else {
            const float* src = mode == 1 ? p.QKVraw + (size_t)t * NUP + NUPQ + h * (MLA_NOPE + MLA_V) + MLA_NOPE + pc * 8
                             : mode == 2 ? p.xc + (size_t)t * MB_CONV_DIM + h * HD + pc * 8
                                         : p.xc + (size_t)t * MB_CONV_DIM + GD + h * 64 + pc * 8;
            const float4 a = *(const float4*)src, c4 = *(const float4*)(src + 4);
            w[0] = pk2(a.x, a.y); w[1] = pk2(a.z, a.w); w[2] = pk2(c4.x, c4.y); w[3] = pk2(c4.z, c4.w);
        }
        __syncthreads();
#pragma unroll
        for (int k = 0; k < 4; ++k) { smem[(pc * 8 + 2 * k) * TLD + r] = (bf16_t)(w[k] & 0xffffu); smem[(pc * 8 + 2 * k + 1) * TLD + r] = (bf16_t)(w[k] >> 16); }
        __syncthreads();
        const uint4 o = *(const uint4*)(smem + r * TLD + pc * 8);
        bf16_t* base = mode == 0 ? p.naVt : mode == 1 ? p.Vt : mode == 2 ? p.mbXT : p.mbBT;
        if (mode >= 2) *(uint4*)(base + ((size_t)bh * (LL / 64) + tb) * 4096 + tile_frag_off(r, pc)) = o;
        else *(uint4*)(base + ((size_t)bh * 64 + r) * LL + tb * 64 + pc * 8) = o;
    }
    __syncthreads();
}

constexpr int AT_KLD = 104, AT_VLD = 68, AT_TK = 64;
constexpr int AT_BUF = AT_TK * AT_KLD + MLA_V * AT_VLD;
constexpr int AT_NSUB = 2;
template <int NTH>
DEVFN void mla_unit(const Params& p, bf16_t* smem, const int u2) {
    const int u = u2 >> 1, kh = u2 & 1;
    static_assert(MLA_QK == 96 && MLA_V == 64, "attention tiles are written for d_qk 96 / d_v 64");
    constexpr int NWV = NTH / 64, QB = NWV * 32;
    constexpr int NCHUNK1 = AT_TK * (MLA_QK / 8) + MLA_V * (AT_TK / 8);
    constexpr int NCHUNK = AT_NSUB * NCHUNK1;
    constexpr int NCH = (NCHUNK + NTH - 1) / NTH;
    constexpr int STAGE = AT_NSUB * AT_BUF;
    static_assert((CTX / AT_TK) % AT_NSUB == 0 && (LL / AT_TK) % AT_NSUB == 0, "whole stages");
    const int tid = TIDX(), lane = tid & 63, wave = tid >> 6, lq = lane & 31, lh = lane >> 5;
    const int n_lat = NB * NH * (SEQ / QB);
    {
        int bh, qbase, nkeys;
        if (u < n_lat) { bh = u / (SEQ / QB); qbase = CTX + (u % (SEQ / QB)) * QB; nkeys = LL; }
        else { const int u2 = u - n_lat; bh = u2 / (CTX / QB); qbase = (u2 % (CTX / QB)) * QB; nkeys = CTX; }
        const bf16_t* Kg = p.Km + (size_t)bh * LL * MLA_QK; const bf16_t* Vg = p.Vt + (size_t)bh * MLA_V * LL;
        const int q0 = qbase + wave * 32;
        bf16x8_t qf[6];
#pragma unroll
        for (int ks = 0; ks < 6; ++ks) qf[ks] = *(const bf16x8_t*)(p.Qm + ((size_t)bh * LL + q0 + lq) * MLA_QK + ks * 16 + lh * 8);
        f32x16_t o0, o1;
#pragma unroll
        for (int r = 0; r < 16; ++r) { o0[r] = 0.f; o1[r] = 0.f; }
        float m_i = -1e30f, l_i = 0.f;
        const int nst_all = nkeys / (AT_TK * AT_NSUB); const int nstages = nst_all / 2 + ((nst_all & 1) && kh == 0 ? 1 : 0);
        const int st_base = kh == 0 ? 0 : nst_all - nstages;
        uint4 stg[NCH];
#define MLA_LOAD(st_) do { _Pragma("unroll") for (int i = 0; i < NCH; ++i) { const int c = tid + i * NTH; const int sub = c / NCHUNK1, cc = c % NCHUNK1; const int k1 = ((st_base + (st_)) * AT_NSUB + sub) * AT_TK; \
            if (c < NCHUNK) { if (cc < AT_TK * 12) { const int key = cc / 12, ch = cc % 12; stg[i] = *(const uint4*)(Kg + (size_t)(k1 + key) * MLA_QK + ch * 8); } \
                              else { const int c2 = cc - AT_TK * 12; const int d = c2 / 8, ch = c2 % 8; stg[i] = *(const uint4*)(Vg + (size_t)d * LL + k1 + ch * 8); } } } } while (0)
#define MLA_STORE(buf_) do { _Pragma("unroll") for (int i = 0; i < NCH; ++i) { const int c = tid + i * NTH; const int sub = c / NCHUNK1, cc = c % NCHUNK1; bf16_t* dK = smem + (buf_) * STAGE + sub * AT_BUF; \
            if (c < NCHUNK) { if (cc < AT_TK * 12) { const int key = cc / 12, ch = cc % 12; *(uint4*)(dK + key * AT_KLD + ch * 8) = stg[i]; } \
                              else { const int c2 = cc - AT_TK * 12; const int d = c2 / 8, ch = c2 % 8; uint2* dst = (uint2*)(dK + AT_TK * AT_KLD + d * AT_VLD + ch * 8); dst[0] = make_uint2(stg[i].x, stg[i].y); dst[1] = make_uint2(stg[i].z, stg[i].w); } } } } while (0)
        MLA_LOAD(0);
        __syncthreads();
        MLA_STORE(0);
        __syncthreads();
        for (int st = 0; st < nstages; ++st) {
            const bool more = st + 1 < nstages;
            if (more) MLA_LOAD(st + 1);
            static_assert(AT_NSUB == 2, "two sub-tiles per stage");
            const bf16_t* sKa = smem + (st & 1) * STAGE; const bf16_t* sKb = sKa + AT_BUF;
            f32x16_t sa0, sa1, sb0, sb1;
#pragma unroll
            for (int r = 0; r < 16; ++r) { sa0[r] = 0.f; sa1[r] = 0.f; sb0[r] = 0.f; sb1[r] = 0.f; }
#pragma unroll
            for (int ks = 0; ks < 6; ++ks) {
                const bf16x8_t a0 = *(const bf16x8_t*)(sKa + (lq) * AT_KLD + ks * 16 + lh * 8), a1 = *(const bf16x8_t*)(sKa + (32 + lq) * AT_KLD + ks * 16 + lh * 8);
                sa0 = __builtin_amdgcn_mfma_f32_32x32x16_bf16(a0, qf[ks], sa0, 0, 0, 0);
                sa1 = __builtin_amdgcn_mfma_f32_32x32x16_bf16(a1, qf[ks], sa1, 0, 0, 0);
            }
#pragma unroll
            for (int ks = 0; ks < 6; ++ks) {
                const bf16x8_t a0 = *(const bf16x8_t*)(sKb + (lq) * AT_KLD + ks * 16 + lh * 8), a1 = *(const bf16x8_t*)(sKb + (32 + lq) * AT_KLD + ks * 16 + lh * 8);
                sb0 = __builtin_amdgcn_mfma_f32_32x32x16_bf16(a0, qf[ks], sb0, 0, 0, 0);
                sb1 = __builtin_amdgcn_mfma_f32_32x32x16_bf16(a1, qf[ks], sb1, 0, 0, 0);
            }
            __builtin_amdgcn_sched_barrier(0);
#define MLA_SOFTMAX_PV(s0, s1, sV) do { \
            float mx = -1e30f; \
            _Pragma("unroll") for (int r = 0; r < 16; ++r) mx = fmaxf(mx, fmaxf(s0[r], s1[r])); \
            mx = fmaxf(mx, __shfl_xor(mx, 32)); \
            const float m_new = fmaxf(m_i, mx); \
            const float alpha = __builtin_amdgcn_exp2f(m_i - m_new); \
            float rs = 0.f; \
            _Pragma("unroll") for (int r = 0; r < 16; ++r) { s0[r] = __builtin_amdgcn_exp2f(s0[r] - m_new); s1[r] = __builtin_amdgcn_exp2f(s1[r] - m_new); rs += s0[r] + s1[r]; } \
            rs += __shfl_xor(rs, 32); \
            l_i = l_i * alpha + rs; m_i = m_new; \
            if (__builtin_amdgcn_ballot_w64(alpha != 1.0f) != 0ull) { \
                _Pragma("unroll") for (int r = 0; r < 16; ++r) { o0[r] *= alpha; o1[r] *= alpha; } \
            } \
            Frag8 pf[2][2]; \
            _Pragma("unroll") for (int sp = 0; sp < 2; ++sp) \
                _Pragma("unroll") for (int j = 0; j < 4; ++j) { \
                    pf[0][sp].u[j] = cvt_pk_bf16_h(s0[8 * sp + 2 * j], s0[8 * sp + 2 * j + 1]); \
                    pf[1][sp].u[j] = cvt_pk_bf16_h(s1[8 * sp + 2 * j], s1[8 * sp + 2 * j + 1]); \
                } \
            _Pragma("unroll") for (int kb = 0; kb < 2; ++kb) \
                _Pragma("unroll") for (int sp = 0; sp < 2; ++sp) { \
                    const int kofs = kb * 32 + sp * 16 + lh * 4; \
                    Frag8 va, vb2; \
                    va.d2[0] = *(const uint2*)((sV) + (lq) * AT_VLD + kofs); va.d2[1] = *(const uint2*)((sV) + (lq) * AT_VLD + kofs + 8); \
                    vb2.d2[0] = *(const uint2*)((sV) + (32 + lq) * AT_VLD + kofs); vb2.d2[1] = *(const uint2*)((sV) + (32 + lq) * AT_VLD + kofs + 8); \
                    o0 = __builtin_amdgcn_mfma_f32_32x32x16_bf16(va.v, pf[kb][sp].v, o0, 0, 0, 0); \
                    o1 = __builtin_amdgcn_mfma_f32_32x32x16_bf16(vb2.v, pf[kb][sp].v, o1, 0, 0, 0); \
                } } while (0)
            MLA_SOFTMAX_PV(sa0, sa1, sKa + AT_TK * AT_KLD);
            MLA_SOFTMAX_PV(sb0, sb1, sKb + AT_TK * AT_KLD);
#undef MLA_SOFTMAX_PV
            if (more) MLA_STORE((st + 1) & 1);
            __syncthreads();
        }
#undef MLA_LOAD
#undef MLA_STORE
        const int b = bh / NH, h = bh % NH;
        const size_t rec = ((size_t)(b * LL + q0 + lq) * NH + h) * 2 + kh;
        float* orow = p.mlaO + rec * MLA_V;
#pragma unroll
        for (int g = 0; g < 4; ++g) {
            *(float4*)(orow + 8 * g + 4 * lh) = make_float4(o0[4 * g], o0[4 * g + 1], o0[4 * g + 2], o0[4 * g + 3]);
            *(float4*)(orow + 32 + 8 * g + 4 * lh) = make_float4(o1[4 * g], o1[4 * g + 1], o1[4 * g + 2], o1[4 * g + 3]);
        }
        if (lh == 0) *(float2*)(p.mlaML + rec * 2) = make_float2(m_i, l_i);
    }
}

DEVFN void ph_mla_combine(const Params& p, bool with_ctx, size_t vt, size_t vs) {
    const size_t n = (size_t)TT * NH * (MLA_V / 4);
    for (size_t i = vt; i < n; i += vs) {
        const int d4 = (int)(i % (MLA_V / 4)); const size_t th = i / (MLA_V / 4); const int h = (int)(th % NH); const size_t t = th / NH;
        if (!with_ctx && (int)(t % LL) < CTX) continue;
        const float2 ml0 = *(const float2*)(p.mlaML + (th * 2 + 0) * 2), ml1 = *(const float2*)(p.mlaML + (th * 2 + 1) * 2);
        const float m = fmaxf(ml0.x, ml1.x);
        const float e0 = __builtin_amdgcn_exp2f(ml0.x - m), e1 = __builtin_amdgcn_exp2f(ml1.x - m);
        const float inv = 1.0f / (ml0.y * e0 + ml1.y * e1);
        const float4 a = *(const float4*)(p.mlaO + (th * 2 + 0) * MLA_V + d4 * 4), c = *(const float4*)(p.mlaO + (th * 2 + 1) * MLA_V + d4 * 4);
        uint2 w; w.x = pk2((a.x * e0 + c.x * e1) * inv, (a.y * e0 + c.y * e1) * inv); w.y = pk2((a.z * e0 + c.z * e1) * inv, (a.w * e0 + c.w * e1) * inv);
        *(uint2*)(p.Ymix + t * D_MIX + 2 * GD + h * MLA_V + d4 * 4) = w;
    }
}

constexpr int NA_KLD = 72, NA_VLD = 68;
constexpr int NA_BUF = AT_TK * NA_KLD + HD * NA_VLD;
template <int NTH>
DEVFN void na_unit(const Params& p, int l, bf16_t* smem, const int u) {
    static_assert(HD == 64 && GRID_W == 64 && NA_WR == 8 && NA_WC == 16 && SEQ / GRID_W == 64, "natten tiles are written for a 64x64 grid, 8x16 window");
    constexpr int NWV = NTH / 64, QB = NWV * 32, RPU = NWV / 2, NLR = NA_WR + RPU - 1, NCT = CTX / AT_TK, ROWS = SEQ / GRID_W;
    constexpr int NCHUNK = AT_TK * (HD / 8) + HD * (AT_TK / 8);
    constexpr int NCH = (NCHUNK + NTH - 1) / NTH;
    constexpr int BW = 2 * NA_WC - 1, BH = 2 * NA_WR - 1;
    const float sc2 = 1.4426950408889634f / sqrtf((float)HD);
    const int tid = TIDX(), lane = tid & 63, wave = tid >> 6, lq = lane & 31, lh = lane >> 5;
    float* sbias = (float*)(smem + 2 * NA_BUF);
    const int n_lat = NB * NH * (ROWS / RPU);
    {
        const bool is_lat = u < n_lat;
        int bh, r0 = 0, rstart = 0, sq, ntiles;
        if (is_lat) { bh = u / (ROWS / RPU); r0 = (u % (ROWS / RPU)) * RPU; rstart = r0 - NA_WR / 2; rstart = rstart < 0 ? 0 : (rstart > ROWS - NLR ? ROWS - NLR : rstart);
                      sq = CTX + (r0 + (wave >> 1)) * GRID_W + 32 * (wave & 1) + lq; ntiles = NLR + NCT; }
        else { const int u2 = u - n_lat; bh = u2 / (CTX / QB); sq = (u2 % (CTX / QB)) * QB + wave * 32 + lq; ntiles = NCT; }
        const int b = bh / NH, h = bh % NH;
        const int qr = r0 + (wave >> 1), qc = 32 * (wave & 1) + lq;
        int rs = qr - NA_WR / 2; rs = rs < 0 ? 0 : (rs > ROWS - NA_WR ? ROWS - NA_WR : rs);
        int cs = qc - NA_WC / 2; cs = cs < 0 ? 0 : (cs > GRID_W - NA_WC ? GRID_W - NA_WC : cs);
        const bf16_t* Kg = p.P + (size_t)b * LL * N_IN + OFF_NA + GD + h * HD;
        const bf16_t* Vg = p.naVt + (size_t)bh * HD * LL;
        bf16x8_t qf[4];
#pragma unroll
        for (int ks = 0; ks < 4; ++ks) qf[ks] = *(const bf16x8_t*)(p.P + (size_t)(b * LL + sq) * N_IN + OFF_NA + h * HD + ks * 16 + lh * 8);
        f32x16_t o0, o1;
#pragma unroll
        for (int r = 0; r < 16; ++r) { o0[r] = 0.f; o1[r] = 0.f; }
        float m_i = -1e30f, l_i = 0.f;
        uint4 stg[NCH];
#define NA_KBASE(ti) ((is_lat && (ti) < NLR) ? (CTX + (rstart + (ti)) * GRID_W) : (((ti) - (is_lat ? NLR : 0)) * AT_TK))
#define NA_LOAD(ti) do { const int kb_ = NA_KBASE(ti); _Pragma("unroll") for (int i = 0; i < NCH; ++i) { const int c = tid + i * NTH; \
            if (c < AT_TK * 8) { const int key = c / 8, ch = c % 8; stg[i] = *(const uint4*)(Kg + (size_t)(kb_ + key) * N_IN + ch * 8); } \
            else if (c < NCHUNK) { const int c2 = c - AT_TK * 8; const int d = c2 / 8, ch = c2 % 8; stg[i] = *(const uint4*)(Vg + (size_t)d * LL + kb_ + ch * 8); } } } while (0)
#define NA_STORE(buf) do { bf16_t* dK_ = smem + (buf) * NA_BUF; _Pragma("unroll") for (int i = 0; i < NCH; ++i) { const int c = tid + i * NTH; \
            if (c < AT_TK * 8) { const int key = c / 8, ch = c % 8; *(uint4*)(dK_ + key * NA_KLD + ch * 8) = stg[i]; } \
            else if (c < NCHUNK) { const int c2 = c - AT_TK * 8; const int d = c2 / 8, ch = c2 % 8; uint2* dst = (uint2*)(dK_ + AT_TK * NA_KLD + d * NA_VLD + ch * 8); dst[0] = make_uint2(stg[i].x, stg[i].y); dst[1] = make_uint2(stg[i].z, stg[i].w); } } } while (0)
        NA_LOAD(0);
        __syncthreads();
        NA_STORE(0);
        for (int i = tid; i < BH * BW; i += NTH) sbias[i] = p.na_rpb[((size_t)l * NH + h) * BH * BW + i] * 1.4426950408889634f;
        __syncthreads();
        for (int tile = 0; tile < ntiles; ++tile) {
            const bf16_t* sK = smem + (tile & 1) * NA_BUF; const bf16_t* sV = sK + AT_TK * NA_KLD;
            const bool more = tile + 1 < ntiles;
            if (more) NA_LOAD(tile + 1);
            const bool local = is_lat && tile < NLR;
            const int kr = rstart + tile;
            const bool active = !local || (kr >= rs && kr < rs + NA_WR);
            if (active) {
                f32x16_t s0, s1;
#pragma unroll
                for (int r = 0; r < 16; ++r) { s0[r] = 0.f; s1[r] = 0.f; }
#pragma unroll
                for (int ks = 0; ks < 4; ++ks) {
                    const bf16x8_t a0 = *(const bf16x8_t*)(sK + (lq) * NA_KLD + ks * 16 + lh * 8);
                    const bf16x8_t a1 = *(const bf16x8_t*)(sK + (32 + lq) * NA_KLD + ks * 16 + lh * 8);
                    s0 = __builtin_amdgcn_mfma_f32_32x32x16_bf16(a0, qf[ks], s0, 0, 0, 0);
                    s1 = __builtin_amdgcn_mfma_f32_32x32x16_bf16(a1, qf[ks], s1, 0, 0, 0);
                }
                if (local) {
                    const float* brow = sbias + (kr - qr + NA_WR - 1) * BW;
#pragma unroll
                    for (int r = 0; r < 16; ++r) {
                        const int kc0 = (r & 3) + 8 * (r >> 2) + 4 * lh, kc1 = kc0 + 32;
                        const bool v0 = (unsigned)(kc0 - cs) < (unsigned)NA_WC, v1 = (unsigned)(kc1 - cs) < (unsigned)NA_WC;
                        s0[r] = v0 ? s0[r] * sc2 + brow[kc0 - qc + NA_WC - 1] : -1e30f;
                        s1[r] = v1 ? s1[r] * sc2 + brow[kc1 - qc + NA_WC - 1] : -1e30f;
                    }
                } else {
#pragma unroll
                    for (int r = 0; r < 16; ++r) { s0[r] *= sc2; s1[r] *= sc2; }
                }
                float mx = -1e30f;
#pragma unroll
                for (int r = 0; r < 16; ++r) mx = fmaxf(mx, fmaxf(s0[r], s1[r]));
                mx = fmaxf(mx, __shfl_xor(mx, 32));
                const float m_new = fmaxf(m_i, mx);
                const float alpha = __builtin_amdgcn_exp2f(m_i - m_new);
                float rsum = 0.f;
#pragma unroll
                for (int r = 0; r < 16; ++r) { s0[r] = __builtin_amdgcn_exp2f(s0[r] - m_new); s1[r] = __builtin_amdgcn_exp2f(s1[r] - m_new); rsum += s0[r] + s1[r]; }
                rsum += __shfl_xor(rsum, 32);
                l_i = l_i * alpha + rsum; m_i = m_new;
                if (__builtin_amdgcn_ballot_w64(alpha != 1.0f) != 0ull) {
#pragma unroll
                    for (int r = 0; r < 16; ++r) { o0[r] *= alpha; o1[r] *= alpha; }
                }
                Frag8 pf[2][2];
#pragma unroll
                for (int sp = 0; sp < 2; ++sp)
#pragma unroll
                    for (int j = 0; j < 4; ++j) {
                        pf[0][sp].u[j] = cvt_pk_bf16_h(s0[8 * sp + 2 * j], s0[8 * sp + 2 * j + 1]);
                        pf[1][sp].u[j] = cvt_pk_bf16_h(s1[8 * sp + 2 * j], s1[8 * sp + 2 * j + 1]);
                    }
#pragma unroll
                for (int kb = 0; kb < 2; ++kb)
#pragma unroll
                    for (int sp = 0; sp < 2; ++sp) {
                        const int kofs = kb * 32 + sp * 16 + lh * 4;
                        Frag8 va, vb2;
                        va.d2[0] = *(const uint2*)(sV + (lq) * NA_VLD + kofs); va.d2[1] = *(const uint2*)(sV + (lq) * NA_VLD + kofs + 8);
                        vb2.d2[0] = *(const uint2*)(sV + (32 + lq) * NA_VLD + kofs); vb2.d2[1] = *(const uint2*)(sV + (32 + lq) * NA_VLD + kofs + 8);
                        o0 = __builtin_amdgcn_mfma_f32_32x32x16_bf16(va.v, pf[kb][sp].v, o0, 0, 0, 0);
                        o1 = __builtin_amdgcn_mfma_f32_32x32x16_bf16(vb2.v, pf[kb][sp].v, o1, 0, 0, 0);
                    }
            }
            if (more) NA_STORE((tile + 1) & 1);
            __syncthreads();
        }
#undef NA_KBASE
#undef NA_LOAD
#undef NA_STORE
        const float inv = 1.0f / l_i;
        bf16_t* yrow = p.Ymix + (size_t)(b * LL + sq) * D_MIX + 3 * GD + h * HD;
#pragma unroll
        for (int g = 0; g < 4; ++g) {
            uint2 w0, w1;
            w0.x = cvt_pk_bf16(o0[4 * g] * inv, o0[4 * g + 1] * inv); w0.y = cvt_pk_bf16(o0[4 * g + 2] * inv, o0[4 * g + 3] * inv);
            w1.x = cvt_pk_bf16(o1[4 * g] * inv, o1[4 * g + 1] * inv); w1.y = cvt_pk_bf16(o1[4 * g + 2] * inv, o1[4 * g + 3] * inv);
            *(uint2*)(yrow + 8 * g + 4 * lh) = w0; *(uint2*)(yrow + 32 + 8 * g + 4 * lh) = w1;
        }
    }
}

DEVFN float wave_sum(float v) {
#pragma unroll
    for (int o = 32; o > 0; o >>= 1) v += __shfl_xor(v, o);
    return v;
}
constexpr int LNV = D / 256;

DEVFN void ph_ln1_route(const Params& p, int l, float* lds_f, int* lds_rt, size_t vt, size_t vs, const int t0, const int t1, const bool stage) {
    static_assert(NE * D * 4 <= 128 * 1024, "router matrix fits the LDS stage region");
    const float alpha = DN_ALPHA;
    const int lane = (TIDX() & 63);
    const size_t wv = vt >> 6, nwv = vs >> 6;
    __syncthreads();
    if (TIDX() < 2 * NE) lds_rt[TIDX()] = 0;
    if (stage) for (int i = TIDX(); i < D * NE / 4; i += 512) {
        const float4 w4 = *(const float4*)(p.router_w + (size_t)i * 4); const int d = (i * 4) / NE, e0 = (i * 4) % NE;
        lds_f[(e0 + 0) * D + d] = w4.x; lds_f[(e0 + 1) * D + d] = w4.y; lds_f[(e0 + 2) * D + d] = w4.z; lds_f[(e0 + 3) * D + d] = w4.w;
    }
    __syncthreads();
    for (size_t t = (size_t)t0 + wv; t < (size_t)t1; t += nwv) {
        const int b = (int)(t / LL), s = (int)(t % LL); const int r = s < CTX ? NB : b;
        const float* m = p.mod + ((size_t)l * NMOD + r) * 6 * D;
        float* xr = p.xs + t * D; const bf16_t* yr = p.yo + t * D;
        float4 u[LNV];
        float sum = 0.f;
#pragma unroll
        for (int i = 0; i < LNV; ++i) {
            const int d = i * 256 + lane * 4;
            const float4 xv = *(const float4*)(xr + d); const uint2 yw = *(const uint2*)(yr + d); const float4 gv = *(const float4*)(m + 2 * D + d);
            u[i].x = alpha * xv.x + gv.x * bflo(yw.x); u[i].y = alpha * xv.y + gv.y * bfhi(yw.x); u[i].z = alpha * xv.z + gv.z * bflo(yw.y); u[i].w = alpha * xv.w + gv.w * bfhi(yw.y);
            sum += u[i].x + u[i].y + u[i].z + u[i].w;
        }
        const float mu = wave_sum(sum) * (1.0f / D);
        float sq = 0.f;
#pragma unroll
        for (int i = 0; i < LNV; ++i) { const float a0 = u[i].x - mu, a1 = u[i].y - mu, a2 = u[i].z - mu, a3 = u[i].w - mu; sq += a0 * a0 + a1 * a1 + a2 * a2 + a3 * a3; }
        const float rs = 1.0f / sqrtf(wave_sum(sq) * (1.0f / D) + LN_EPS);
        float lg[NE];
#pragma unroll
        for (int e = 0; e < NE; ++e) lg[e] = 0.f;
#pragma unroll
        for (int i = 0; i < LNV; ++i) {
            const int d = i * 256 + lane * 4;
            const float4 gg = *(const float4*)(p.ln1_g + (size_t)l * D + d), bb = *(const float4*)(p.ln1_b + (size_t)l * D + d);
            const float4 sc = *(const float4*)(m + 4 * D + d), sh = *(const float4*)(m + 3 * D + d);
            float4 xn;
            xn.x = (u[i].x - mu) * rs * gg.x + bb.x; xn.y = (u[i].y - mu) * rs * gg.y + bb.y; xn.z = (u[i].z - mu) * rs * gg.z + bb.z; xn.w = (u[i].w - mu) * rs * gg.w + bb.w;
            *(float4*)(xr + d) = xn;
            float hv[4];
            hv[0] = xn.x * (1.0f + sc.x) + sh.x; hv[1] = xn.y * (1.0f + sc.y) + sh.y; hv[2] = xn.z * (1.0f + sc.z) + sh.z; hv[3] = xn.w * (1.0f + sc.w) + sh.w;
            uint2 pk; pk.x = (unsigned)f2bf(hv[0]) | ((unsigned)f2bf(hv[1]) << 16); pk.y = (unsigned)f2bf(hv[2]) | ((unsigned)f2bf(hv[3]) << 16);
            *(uint2*)(p.hb + t * D + d) = pk;
            asm volatile("" ::: "memory");
#pragma unroll
            for (int e = 0; e < NE; ++e) { const float4 w4 = *(const float4*)(lds_f + e * D + d); lg[e] += hv[0] * w4.x + hv[1] * w4.y + hv[2] * w4.z + hv[3] * w4.w; }
        }
#pragma unroll
        for (int e = 0; e < NE; ++e) lg[e] = wave_sum(lg[e]);
        float gbest = -1e30f; int e1 = 0, e2 = 1; float w1 = 0.f, w2 = 0.f;
#pragma unroll
        for (int g = 0; g < NEG; ++g) {
            float m1 = -1e30f, m2 = -1e30f, s1 = 0.f, s2 = 0.f; int i1 = 0, i2 = 0;
#pragma unroll
            for (int i = 0; i < EPG; ++i) {
                const float scv = sigmoidf_(lg[g * EPG + i]); const float v = scv + p.router_b[g * EPG + i];
                if (v > m1) { m2 = m1; i2 = i1; s2 = s1; m1 = v; i1 = g * EPG + i; s1 = scv; }
                else if (v > m2) { m2 = v; i2 = g * EPG + i; s2 = scv; }
            }
            if (m1 + m2 > gbest) { gbest = m1 + m2; e1 = i1; e2 = i2; w1 = s1; w2 = s2; }
        }
        const float wn = ROUTED_SCALE / (w1 + w2);
        if (lane < 2) {
            const int k = lane;
            const int e = k == 0 ? e1 : e2; const float w = (k == 0 ? w1 : w2) * wn;
            const int pos = atomicAdd(&lds_rt[e], 1);
            ((int*)&p.tok_e[t])[k] = e; ((int*)&p.tok_pos[t])[k] = pos; ((float*)&p.tok_w[t])[k] = w;
        }
    }
    asm volatile("s_waitcnt vmcnt(0)" ::: "memory");
    __syncthreads();
    if (TIDX() < NE) { const int c_ = lds_rt[TIDX()]; lds_rt[NE + TIDX()] = c_ ? atomicAdd(&p.cnt[l * NE + TIDX()], c_) : 0; }
    __syncthreads();
}
DEVFN void ph_ln1_fix(const Params& p, const int* lds_rt, size_t vt, size_t vs, const int t0, const int t1) {
    const int lane = (TIDX() & 63);
    const size_t wv = vt >> 6, nwv = vs >> 6;
    for (size_t t = (size_t)t0 + wv; t < (size_t)t1; t += nwv) {
        if (lane < 2) { const int e = ((const int*)&p.tok_e[t])[lane]; ((int*)&p.tok_pos[t])[lane] += lds_rt[NE + e]; }
    }
}

DEVFN void ph_moe_perm(const Params& p, int l, size_t vt, size_t vs) {
    const int lane = (TIDX() & 63);
    const size_t wv = vt >> 6, nwv = vs >> 6;
    for (size_t it = wv; it < (size_t)2 * TT; it += nwv) {
        const size_t t = it >> 1; const int k = (int)(it & 1);
        const int e = ((const int*)&p.tok_e[t])[k], pos = ((const int*)&p.tok_pos[t])[k];
        int base = 0;
#pragma unroll
        for (int q = 0; q < NE; ++q) { const int nt = (p.cnt[l * NE + q] + 255) >> 8; base += (q < e) ? nt * 256 : 0; }
        const int row = base + pos;
        const uint4* src = (const uint4*)(p.hb + t * D); uint4* dst = (uint4*)(p.hperm + (size_t)row * D);
#pragma unroll
        for (int q = 0; q < D / 512; ++q) dst[q * 64 + lane] = src[q * 64 + lane];
        if (lane == 0) ((int*)&p.tok_row[t])[k] = row;
    }
}

DEVFN void ph_ln2(const Params& p, int l, size_t vt, size_t vs) {
    const float alpha = DN_ALPHA;
    const int lane = (TIDX() & 63);
    const size_t wv = vt >> 6, nwv = vs >> 6;
    for (size_t t = wv; t < (size_t)TT; t += nwv) {
        const int b = (int)(t / LL), s = (int)(t % LL); const int r = s < CTX ? NB : b;
        const float* m = p.mod + ((size_t)l * NMOD + r) * 6 * D;
        float* xr = p.xs + t * D;
        const int2 rw2 = p.tok_row[t]; const float2 ww = p.tok_w[t];
        const bf16_t* f0 = p.Fperm + (size_t)rw2.x * D; const bf16_t* f1 = p.Fperm + (size_t)rw2.y * D;
        float4 u[LNV];
        float sum = 0.f;
#pragma unroll
        for (int i = 0; i < LNV; ++i) {
            const int d = i * 256 + lane * 4;
            const float4 xv = *(const float4*)(xr + d), gv = *(const float4*)(m + 5 * D + d);
            const uint2 a0 = *(const uint2*)(f0 + d), a1 = *(const uint2*)(f1 + d);
            u[i].x = alpha * xv.x + gv.x * (ww.x * bflo(a0.x) + ww.y * bflo(a1.x)); u[i].y = alpha * xv.y + gv.y * (ww.x * bfhi(a0.x) + ww.y * bfhi(a1.x));
            u[i].z = alpha * xv.z + gv.z * (ww.x * bflo(a0.y) + ww.y * bflo(a1.y)); u[i].w = alpha * xv.w + gv.w * (ww.x * bfhi(a0.y) + ww.y * bfhi(a1.y));
            sum += u[i].x + u[i].y + u[i].z + u[i].w;
        }
        const float mu = wave_sum(sum) * (1.0f / D);
        float sq = 0.f;
#pragma unroll
        for (int i = 0; i < LNV; ++i) { const float a0 = u[i].x - mu, a1 = u[i].y - mu, a2 = u[i].z - mu, a3 = u[i].w - mu; sq += a0 * a0 + a1 * a1 + a2 * a2 + a3 * a3; }
        const float rs = 1.0f / sqrtf(wave_sum(sq) * (1.0f / D) + LN_EPS);
        const float* mn = p.mod + ((size_t)(l + 1 < DEPTH ? l + 1 : l) * NMOD + r) * 6 * D;
#pragma unroll
        for (int i = 0; i < LNV; ++i) {
            const int d = i * 256 + lane * 4;
            const float4 gg = *(const float4*)(p.ln2_g + (size_t)l * D + d), bb = *(const float4*)(p.ln2_b + (size_t)l * D + d);
            float4 xn;
            xn.x = (u[i].x - mu) * rs * gg.x + bb.x; xn.y = (u[i].y - mu) * rs * gg.y + bb.y; xn.z = (u[i].z - mu) * rs * gg.z + bb.z; xn.w = (u[i].w - mu) * rs * gg.w + bb.w;
            if (l < DEPTH - 1) *(float4*)(xr + d) = xn;
            if (l == DEPTH - 1) { if (s >= CTX) *(float4*)(p.out + ((size_t)b * SEQ + (s - CTX)) * D + d) = xn; }
            else {
                const float4 sc = *(const float4*)(mn + D + d), sh = *(const float4*)(mn + d);
                uint2 pk;
                pk.x = (unsigned)f2bf(xn.x * (1.0f + sc.x) + sh.x) | ((unsigned)f2bf(xn.y * (1.0f + sc.y) + sh.y) << 16);
                pk.y = (unsigned)f2bf(xn.z * (1.0f + sc.z) + sh.z) | ((unsigned)f2bf(xn.w * (1.0f + sc.w) + sh.w) << 16);
                *(uint2*)(p.xm + t * D + d) = pk;
            }
        }
    }
}

namespace pg8 {
#define PG8_LAS __attribute__((address_space(3)))
typedef unsigned short bf16_t;
typedef short bf16x8 __attribute__((ext_vector_type(8)));
typedef float f32x4 __attribute__((ext_vector_type(4)));
typedef unsigned u32x4 __attribute__((ext_vector_type(4)));
constexpr int BM = 256, BK = 64, HALF = 128, HTB = HALF * BK * 2  , STAGE_BYTES = 8 * HTB, NXCD = 8, WGM = 8;

__host__ __device__ __forceinline__ int lds_byte(int r, int c) { const int st = (r >> 4) * 2 + (c >> 5), rr = r & 15, cc = c & 31, ob = rr * 64 + cc * 2; return st * 1024 + (ob ^ (((ob >> 9) & 1) << 5)); }
__host__ __device__ __forceinline__ void stage_rc(int b, int& R, int& C) { const int st = b / 1024, sb = b % 1024, swz = sb ^ (((sb >> 9) & 1) << 5); R = (st >> 1) * 16 + swz / 64; C = (st & 1) * 32 + (swz % 64) / 2; }
__host__ __device__ __forceinline__ int perm32(int rho) { const int n = rho >> 4, i = rho & 15; return 8 * (i >> 2) + 4 * n + (i & 3); }

struct Unit { int pm, pn; };
struct Gemm { const bf16_t* A; const bf16_t* Bt; int M, N, K; };

struct StaticOrder {
    int nM, nN, nwg, G, c;
    __host__ __device__ void init(int M, int N, int G_, int c_) { nM = M / BM; nN = N / BM; nwg = nM * nN; G = G_; c = c_; }
    __host__ __device__ bool next(int i, Unit& u) const {
        const long L = (long)i * G + c; if (L >= nwg) return false;
        int wgid = (int)L; { const int q = nwg / NXCD, r = nwg % NXCD, xcd = wgid % NXCD, off = wgid / NXCD; wgid = (xcd < r ? xcd * (q + 1) : r * (q + 1) + (xcd - r) * q) + off; }
        const int nig = WGM * nN, gid = wgid / nig, fm = gid * WGM, gsz = (nM - fm) < WGM ? (nM - fm) : WGM;
        u.pm = fm + ((wgid % nig) % gsz); u.pn = (wgid % nig) / gsz; return true;
    }
    __device__ __forceinline__ void a_ready(const Unit&) const {}
    __device__ __forceinline__ void done(const Unit&) const {}
};
__device__ __forceinline__ unsigned cvt_pk_bf16(float lo, float hi) { return ::cvt_pk_bf16(lo, hi); }
struct EpiF32 {
    static constexpr bool PERM = false, AFTER_DRAIN = false;
    float* C; int ldc; const float* bias;
    __device__ __forceinline__ void operator()(const f32x4 (&acc)[2][2][4][2], const Unit& u, int wr, int wc, int fr, int fq) const {
        const int row0 = u.pm * BM + wr * 64 + fr, col0 = u.pn * BM + wc * 32 + 4 * fq;
        f32x4 bv[2][2];
#pragma unroll
        for (int bj = 0; bj < 2; ++bj)
#pragma unroll
            for (int n = 0; n < 2; ++n) bv[bj][n] = bias ? *(const f32x4*)(bias + col0 + bj * HALF + n * 16) : (f32x4){0.f, 0.f, 0.f, 0.f};
#pragma unroll
        for (int ai = 0; ai < 2; ++ai)
#pragma unroll
            for (int m = 0; m < 4; ++m) { float* rowp = C + (size_t)(row0 + ai * HALF + m * 16) * ldc + col0;
#pragma unroll
                for (int bj = 0; bj < 2; ++bj)
#pragma unroll
                    for (int n = 0; n < 2; ++n) *(f32x4*)(rowp + bj * HALF + n * 16) = acc[ai][bj][m][n] + bv[bj][n]; }
    }
};
template <class Epi, class Sched, bool STAMP = false>
__device__ __forceinline__ void gemm_phase(PG8_LAS unsigned char* lds, const Gemm g, const Sched& S, const Epi& E, unsigned long long* stamps) {
    const int tid = TIDX(), wid = __builtin_amdgcn_readfirstlane(tid >> 6), lane = tid & 63, wr = wid >> 2, wc = wid & 3, fr = lane & 15, fq = lane >> 4;
    const int K = g.K, nt = K / BK;
    int ts_lo = 0, ts_hi = 0, nts = 0; const unsigned long long rt_entry = STAMP ? (unsigned long long)wall_clock64() : 0ull;
#define PG8_STAMP() do { if (STAMP && wid == 0 && nts < 64) { const unsigned long long _c = (unsigned long long)clock64(); \
        ts_lo = (lane == nts) ? (int)(unsigned)_c : ts_lo; ts_hi = (lane == nts) ? (int)(unsigned)(_c >> 32) : ts_hi; ++nts; } } while (0)
    PG8_STAMP();
    unsigned voffA[2], voffB[2];
#pragma unroll
    for (int i = 0; i < 2; ++i) { int R, C; stage_rc(tid * 16 + i * 8192, R, C); const int Rb = Epi::PERM ? ((R & ~31) + perm32(R & 31)) : R;
        voffA[i] = (unsigned)(R * K + C) * 2u; voffB[i] = (unsigned)(Rb * K + C) * 2u; }
    const size_t kstep = (size_t)(BK * 2);
    const size_t hstep = (size_t)HALF * K * 2;
    const size_t tstep = 2 * hstep;
    const unsigned ldsw = (unsigned)wid * 1024u;
    const int aoff = lds_byte(wr * 64 + fr, fq * 8), boff = lds_byte(wc * 32 + fr, fq * 8);
#define PG8_SA(b, h) (((b) * 2 + (h)) * HTB)
#define PG8_SB(b, h) ((4 + (b) * 2 + (h)) * HTB)
#define PG8_STAGE(bufoff, gbase, voff) do { _Pragma("unroll") for (int _i = 0; _i < 2; ++_i) \
        __builtin_amdgcn_global_load_lds((const unsigned*)((const char*)(gbase) + (voff)[_i]), (PG8_LAS unsigned*)(lds + (bufoff) + ldsw + _i * 8192), 16, 0, 0); } while (0)
#define PG8_LDA(dst, b, h) do { _Pragma("unroll") for (int m = 0; m < 4; ++m) _Pragma("unroll") for (int k = 0; k < 2; ++k) dst[m][k] = *(const PG8_LAS bf16x8*)(lds + PG8_SA(b, h) + aoff + m * 2048 + k * 1024); } while (0)
#define PG8_LDB(dst, b, h) do { _Pragma("unroll") for (int n = 0; n < 2; ++n) _Pragma("unroll") for (int k = 0; k < 2; ++k) dst[n][k] = *(const PG8_LAS bf16x8*)(lds + PG8_SB(b, h) + boff + n * 2048 + k * 1024); } while (0)
#define PG8_MMA(ai, bj, At, Bt) do { __builtin_amdgcn_s_setprio(1); _Pragma("unroll") for (int m = 0; m < 4; ++m) _Pragma("unroll") for (int n = 0; n < 2; ++n) _Pragma("unroll") for (int k = 0; k < 2; ++k) \
        acc[ai][bj][m][n] = __builtin_amdgcn_mfma_f32_16x16x32_bf16(Bt[n][k], At[m][k], acc[ai][bj][m][n], 0, 0, 0); __builtin_amdgcn_s_setprio(0); } while (0)
#define PG8_WAIT_V(n) asm volatile("s_waitcnt vmcnt(" #n ")" ::: "memory")
#define PG8_WAIT_L(n) asm volatile("s_waitcnt lgkmcnt(" #n ")" ::: "memory")
#define PG8_BAR __builtin_amdgcn_s_barrier()
#define PG8_SCHED __builtin_amdgcn_sched_barrier(0)
    Unit cur, nxt; int ui = 0;
    if (!S.next(0, cur)) return;
    f32x4 acc[2][2][4][2];
#pragma unroll
    for (int a = 0; a < 2; ++a)
#pragma unroll
        for (int b = 0; b < 2; ++b)
#pragma unroll
            for (int m = 0; m < 4; ++m)
#pragma unroll
                for (int n = 0; n < 2; ++n) acc[a][b][m][n] = (f32x4){0.f, 0.f, 0.f, 0.f};
    bf16x8 At[4][2], B0[2][2], B1[2][2];
    const char* cA = (const char*)g.A + (size_t)cur.pm * tstep; const char* cB = (const char*)g.Bt + (size_t)cur.pn * tstep;
    S.a_ready(cur);
    PG8_STAGE(PG8_SB(0, 0), cB, voffB); PG8_STAGE(PG8_SA(0, 0), cA, voffA); PG8_STAGE(PG8_SB(0, 1), cB + hstep, voffB); PG8_STAGE(PG8_SA(0, 1), cA + hstep, voffA);
    if (wr == 1) PG8_BAR;
    PG8_WAIT_V(4); PG8_BAR;
    PG8_STAGE(PG8_SB(1, 0), cB + kstep, voffB); PG8_STAGE(PG8_SA(1, 0), cA + kstep, voffA); PG8_STAGE(PG8_SB(1, 1), cB + hstep + kstep, voffB);
    PG8_WAIT_V(6); PG8_BAR;
    PG8_STAMP();
    for (;;) {
        const bool has_next = S.next(ui + 1, nxt);
        const char* nA = has_next ? (const char*)g.A + (size_t)nxt.pm * tstep : cA; const char* nB = has_next ? (const char*)g.Bt + (size_t)nxt.pn * tstep : cB;
        for (int t = 0; t < nt; t += 2) {
            const bool last = (t == nt - 2);
            const char* a1 = cA + (size_t)(t + 1) * kstep;
            const char* a2 = last ? nA : cA + (size_t)(t + 2) * kstep; const char* b2 = last ? nB : cB + (size_t)(t + 2) * kstep;
            const char* a3 = a2 + kstep; const char* b3 = b2 + kstep;
            if (last && has_next) S.a_ready(nxt);
            PG8_LDB(B0, 0, 0); PG8_SCHED; PG8_LDA(At, 0, 0); PG8_STAGE(PG8_SA(1, 1), a1 + hstep, voffA);
            PG8_WAIT_L(8); PG8_BAR; PG8_WAIT_L(0); PG8_MMA(0, 0, At, B0); PG8_BAR; PG8_SCHED;
            PG8_LDB(B1, 0, 1); PG8_STAGE(PG8_SB(0, 0), b2, voffB);
            PG8_BAR; PG8_WAIT_L(0); PG8_MMA(0, 1, At, B1); PG8_BAR;
            PG8_LDA(At, 0, 1); PG8_STAGE(PG8_SA(0, 0), a2, voffA);
            PG8_BAR; PG8_WAIT_L(0); PG8_MMA(1, 0, At, B0); PG8_BAR; PG8_SCHED;
            PG8_STAGE(PG8_SB(0, 1), b2 + hstep, voffB);
            PG8_WAIT_V(6); PG8_BAR; PG8_MMA(1, 1, At, B1); PG8_BAR;
            PG8_LDB(B0, 1, 0); PG8_SCHED; PG8_LDA(At, 1, 0); PG8_STAGE(PG8_SA(0, 1), a2 + hstep, voffA);
            PG8_WAIT_L(8); PG8_BAR; PG8_WAIT_L(0); PG8_MMA(0, 0, At, B0); PG8_BAR; PG8_SCHED;
            PG8_LDB(B1, 1, 1); PG8_STAGE(PG8_SB(1, 0), b3, voffB);
            PG8_BAR; PG8_WAIT_L(0); PG8_MMA(0, 1, At, B1); PG8_BAR;
            PG8_LDA(At, 1, 1); PG8_STAGE(PG8_SA(1, 0), a3, voffA);
            PG8_BAR; PG8_WAIT_L(0); PG8_MMA(1, 0, At, B0); PG8_BAR; PG8_SCHED;
            PG8_STAGE(PG8_SB(1, 1), b3 + hstep, voffB);
            PG8_WAIT_V(6); PG8_BAR; PG8_MMA(1, 1, At, B1); PG8_BAR;
        }
        PG8_STAMP();
        if constexpr (!Epi::AFTER_DRAIN) { E(acc, cur, wr, wc, fr, fq); S.done(cur); }
        PG8_STAMP();
        if (!has_next) break;
#pragma unroll
        for (int a = 0; a < 2; ++a)
#pragma unroll
            for (int b = 0; b < 2; ++b)
#pragma unroll
                for (int m = 0; m < 4; ++m)
#pragma unroll
                    for (int n = 0; n < 2; ++n) acc[a][b][m][n] = (f32x4){0.f, 0.f, 0.f, 0.f};
        cur = nxt; cA = nA; cB = nB; ++ui;
    }
    PG8_WAIT_V(0);
    if (wr == 0) PG8_BAR;
    PG8_BAR;
    if constexpr (Epi::AFTER_DRAIN) { E.fused(acc, cur, wr, wc, fr, fq, lds, wid, lane); S.done(cur); }
    PG8_STAMP();
    if (STAMP && wid == 0) { stamps[lane] = lane < nts ? (((unsigned long long)(unsigned)ts_hi << 32) | (unsigned)ts_lo) : 0ull;
        if (lane == 62) stamps[62] = rt_entry; if (lane == 63) stamps[63] = (unsigned long long)wall_clock64(); }
#undef PG8_STAMP
#undef PG8_SA
#undef PG8_SB
#undef PG8_STAGE
#undef PG8_LDA
#undef PG8_LDB
#undef PG8_MMA
#undef PG8_WAIT_V
#undef PG8_WAIT_L
#undef PG8_BAR
#undef PG8_SCHED
}
}

namespace pg8 {
struct EpiBf16N {
    static constexpr bool PERM = true, AFTER_DRAIN = false;
    bf16_t* O; int ldc; int ncols;
    __device__ __forceinline__ void operator()(const f32x4 (&acc)[2][2][4][2], const Unit& u, int wr, int wc, int fr, int fq) const {
        const int row0 = u.pm * BM + wr * 64 + fr; const int col0 = u.pn * BM + wc * 32 + 8 * fq;
#pragma unroll
        for (int ai = 0; ai < 2; ++ai)
#pragma unroll
            for (int m = 0; m < 4; ++m) { bf16_t* rowp = O + (size_t)(row0 + ai * HALF + m * 16) * ldc + col0;
#pragma unroll
                for (int bj = 0; bj < 2; ++bj) { const f32x4 v0 = acc[ai][bj][m][0], v1 = acc[ai][bj][m][1];
                    u32x4 w; w.x = ::cvt_pk_bf16_h(v0[0], v0[1]); w.y = ::cvt_pk_bf16_h(v0[2], v0[3]); w.z = ::cvt_pk_bf16_h(v1[0], v1[1]); w.w = ::cvt_pk_bf16_h(v1[2], v1[3]);
                    if (col0 + bj * HALF < ncols) *(u32x4*)(rowp + bj * HALF) = w; } }
    }
};
struct LatentOrder : StaticOrder {
    __device__ __forceinline__ bool next(int i, Unit& u) const {
        if (!StaticOrder::next(i, u)) return false;
        constexpr int LT = SEQ / 256, CT = CTX / 256;
        u.pm = (u.pm / LT) * (LT + CT) + CT + (u.pm % LT); return true;
    }
};
struct TailOrder {
    int pm0, nM, nN, G, c;
    __device__ __forceinline__ bool next(int i, Unit& u) const {
        if (c >= G) return false;
        const int L = i * G + c; if (L >= (nM - pm0) * nN) return false;
        u.pm = pm0 + L / nN; u.pn = L % nN; return true;
    }
    __device__ __forceinline__ void a_ready(const Unit&) const {}
    __device__ __forceinline__ void done(const Unit&) const {}
};
struct EpiBf16Grp {
    static constexpr bool PERM = true, AFTER_DRAIN = false;
    bf16_t* O; int ldc; int ncu;
    __device__ __forceinline__ void operator()(const f32x4 (&acc)[2][2][4][2], const Unit& u, int wr, int wc, int fr, int fq) const {
        const int row0 = u.pm * BM + wr * 64 + fr; const int col0 = (u.pn % ncu) * BM + wc * 32 + 8 * fq;
#pragma unroll
        for (int ai = 0; ai < 2; ++ai)
#pragma unroll
            for (int m = 0; m < 4; ++m) { bf16_t* rowp = O + (size_t)(row0 + ai * HALF + m * 16) * ldc + col0;
#pragma unroll
                for (int bj = 0; bj < 2; ++bj) { const f32x4 v0 = acc[ai][bj][m][0], v1 = acc[ai][bj][m][1];
                    u32x4 w; w.x = ::cvt_pk_bf16_h(v0[0], v0[1]); w.y = ::cvt_pk_bf16_h(v0[2], v0[3]); w.z = ::cvt_pk_bf16_h(v1[0], v1[1]); w.w = ::cvt_pk_bf16_h(v1[2], v1[3]);
                    *(u32x4*)(rowp + bj * HALF) = w; } }
    }
};
struct MoeOrder {
    const int* cnt; int G, c, ncu;
    __device__ __forceinline__ bool next(int i, Unit& u) const {
        int tot = 0;
#pragma unroll
        for (int k = 0; k < 16; ++k) tot += (cnt[k] + 255) >> 8;
        int rt, cu;
        if ((G & 7) == 0) {
            const int x = c & 7, rank = c >> 3, per = G >> 3;
            const int t0 = (tot * x) >> 3, t1 = (tot * (x + 1)) >> 3;
            const int k = i * per + rank;
            if (k >= (t1 - t0) * ncu) return false;
            rt = t0 + k / ncu; cu = k % ncu;
        } else {
            const long L = (long)i * G + c; rt = (int)(L / ncu); cu = (int)(L % ncu);
            if (rt >= tot) return false;
        }
        int acc = 0, e = -1;
#pragma unroll
        for (int k = 0; k < 16; ++k) { const int nt = (cnt[k] + 255) >> 8; e = (e < 0 && rt < acc + nt) ? k : e; acc += nt; }
        if (e < 0) return false;
        u.pm = rt; u.pn = e * ncu + cu; return true;
    }
    __device__ __forceinline__ void a_ready(const Unit&) const {}
    __device__ __forceinline__ void done(const Unit&) const {}
};
struct EpiSwiGLU {
    static constexpr bool PERM = true, AFTER_DRAIN = false;
    bf16_t* O; int ldc; int ncu;
    __device__ __forceinline__ void operator()(const f32x4 (&acc)[2][2][4][2], const Unit& u, int wr, int wc, int fr, int fq) const {
        const int row0 = u.pm * BM + wr * 64 + fr; const int col0 = (u.pn % ncu) * HALF + wc * 32 + 8 * fq;
#pragma unroll
        for (int ai = 0; ai < 2; ++ai)
#pragma unroll
            for (int m = 0; m < 4; ++m) {
                float hv[8];
#pragma unroll
                for (int n = 0; n < 2; ++n)
#pragma unroll
                    for (int q = 0; q < 4; ++q) { const float g = acc[ai][0][m][n][q], up = acc[ai][1][m][n][q]; hv[4 * n + q] = g / (1.0f + __expf(-g)) * up; }
                u32x4 w; w.x = cvt_pk_bf16(hv[0], hv[1]); w.y = cvt_pk_bf16(hv[2], hv[3]); w.z = cvt_pk_bf16(hv[4], hv[5]); w.w = cvt_pk_bf16(hv[6], hv[7]);
                *(u32x4*)(O + (size_t)(row0 + ai * HALF + m * 16) * ldc + col0) = w;
            }
    }
};
}

#define XB_TMO      128
#define XB_XCNT(j)  (256  + 64 * (j))
#define XB_XSUB(j)  (1280 + 64 * (j))
#define XB_XGEN(j)  (2304 + 64 * (j))
#define XB_TOP      3328
#define XB_TOPGEN   3392
#define XCD_BAR_WORDS 3456
#define XB_SPIN_CAP (1u << 18)
#define LAS __attribute__((address_space(3)))

__device__ __forceinline__ unsigned xb_ld(unsigned* p)              { return __hip_atomic_load(p, __ATOMIC_RELAXED, __HIP_MEMORY_SCOPE_AGENT); }
__device__ __forceinline__ unsigned xb_add(unsigned* p, unsigned v) { return __hip_atomic_fetch_add(p, v, __ATOMIC_RELAXED, __HIP_MEMORY_SCOPE_AGENT); }
__device__ __forceinline__ unsigned xb_xcc_id() { return (unsigned)__builtin_amdgcn_s_getreg((3 << 11) | 20) & 0xFu; }
#define XB_SPIN(cond, bar) do { unsigned _sp = 0; while (cond) { __builtin_amdgcn_s_sleep(1); \
    if ((++_sp & 255u) == 0u) { if (xb_ld(&(bar)[XB_TMO])) break; if (_sp > XB_SPIN_CAP) { atomicAdd(&(bar)[XB_TMO], 1u); break; } } } } while (0)

struct XcdBarrier {
    unsigned* bar; unsigned x;
    volatile LAS unsigned* st;
};

__device__ __forceinline__ XcdBarrier xcd_barrier_post(unsigned* bar, volatile LAS unsigned* st) {
    XcdBarrier b; b.bar = bar; b.x = xb_xcc_id(); b.st = st;
    if (threadIdx.x == 0) (void)xb_add(&bar[XB_XCNT(b.x)], 1u);
    return b;
}
__device__ __forceinline__ void xcd_barrier_complete(unsigned* bar, unsigned x, unsigned& nloc, unsigned& nx) {
    const unsigned G = gridDim.x * gridDim.y * gridDim.z;
    unsigned sum, cnt, mine, sp = 0u;
    for (;;) {
        sum = 0u; cnt = 0u; mine = 0u;
#pragma unroll
        for (unsigned j = 0; j < 16; ++j) { const unsigned c = xb_ld(&bar[XB_XCNT(j)]); sum += c; cnt += (c > 0u) ? 1u : 0u; mine = (j == x) ? c : mine; }
        if (sum == G) break;
        __builtin_amdgcn_s_sleep(1);
        if ((++sp & 255u) == 0u) { if (xb_ld(&bar[XB_TMO])) break; if (sp > XB_SPIN_CAP) { atomicAdd(&bar[XB_TMO], 1u); break; } }
    }
    nloc = mine > 0u ? mine : 1u; nx = cnt > 0u ? cnt : 1u;
}

__device__ __forceinline__ void xcd_barrier(const XcdBarrier& b) {
    asm volatile("s_waitcnt vmcnt(0)" ::: "memory");
    __syncthreads();
    if (threadIdx.x == 0) {
        unsigned* bar = b.bar;
        __builtin_amdgcn_s_waitcnt(0);
        unsigned nloc = b.st[0], nx = b.st[1];
        if (nloc == 0u) { xcd_barrier_complete(bar, b.x, nloc, nx); b.st[0] = nloc; b.st[1] = nx; }
        const unsigned old = xb_add(&bar[XB_XSUB(b.x)], 1u);
        const unsigned gen = old / nloc;
        if (old + 1u == (gen + 1u) * nloc) {
            __builtin_amdgcn_fence(__ATOMIC_RELEASE, "agent");
            asm volatile("s_waitcnt vmcnt(0)" ::: "memory");
            const unsigned og = xb_add(&bar[XB_TOP], 1u);
            const unsigned tg = og / nx;
            if (og + 1u == (tg + 1u) * nx) xb_add(&bar[XB_TOPGEN], 1u);
            else XB_SPIN(xb_ld(&bar[XB_TOPGEN]) == tg, bar);
            __builtin_amdgcn_fence(__ATOMIC_ACQUIRE, "agent");
            xb_add(&bar[XB_XGEN(b.x)], 1u);
            asm volatile("s_waitcnt vmcnt(0)" ::: "memory");
        } else {
            XB_SPIN(xb_ld(&bar[XB_XGEN(b.x)]) == gen, bar);
            __builtin_amdgcn_fence(__ATOMIC_ACQUIRE, "agent");
            asm volatile("s_waitcnt vmcnt(0)" ::: "memory");
        }
    }
    __syncthreads();
}

constexpr int NT = 512;
constexpr int LDS_STAGE = pg8::STAGE_BYTES;
constexpr int LDS_MISC = LDS_STAGE;
constexpr int LDS_RT = LDS_STAGE + 64;
constexpr int LDS_BYTES = LDS_STAGE + 64 + 256;
struct MegaArgs { Params p; unsigned* bar; int reps[16]; };

DEVFN size_t VTF() { return (size_t)blockIdx.x * 512 + (size_t)TIDX(); }
DEVFN int OPQS(int v) { asm volatile("" : "+s"(v)); return v; }
typedef const __attribute__((address_space(4))) MegaArgs* KArgP;
DEVFN int REPS(int k) { KArgP ka = (KArgP)__builtin_amdgcn_kernarg_segment_ptr(); asm volatile("" : "+s"(ka)); return ka->reps[k]; }
DEVFN unsigned* BARP() { KArgP ka = (KArgP)__builtin_amdgcn_kernarg_segment_ptr(); asm volatile("" : "+s"(ka)); return ka->bar; }
DEVFN const Params& PF() { KArgP ka = (KArgP)__builtin_amdgcn_kernarg_segment_ptr(); asm volatile("" : "+s"(ka)); return *(const Params*)&ka->p; }
DEVFN int NBF() { int g = (int)gridDim.x; asm volatile("" : "+s"(g)); return g; }
DEVFN size_t VSF() { return (size_t)NBF() * 512; }
__global__ void __launch_bounds__(NT, 2) k_mega(MegaArgs a) {
    extern __shared__ __attribute__((aligned(16))) unsigned char lds[];
    bf16_t* const smem = (bf16_t*)lds;
    volatile int* const s_unit = (volatile int*)(lds + LDS_MISC + 16);
    static_assert(2 * AT_NSUB * AT_BUF * 2 <= LDS_STAGE && 2 * AT_BUF * 2 + 2048 <= LDS_STAGE && AT_BUF >= NA_BUF && (NT / 64) * RW_STG * 4 <= LDS_STAGE, "LDS carve");
    if (threadIdx.x == 0) *(uint4*)(lds + LDS_MISC) = make_uint4(0u, 0u, 0u, 0u);
    __syncthreads();
    (void)xcd_barrier_post(a.bar, (volatile LAS unsigned*)(lds + LDS_MISC));
#define GRID_BARRIER() do { XcdBarrier b_; b_.bar = BARP(); b_.x = xb_xcc_id(); b_.st = (volatile LAS unsigned*)(lds + LDS_MISC); xcd_barrier(b_); } while (0)
    const Params& p = a.p;
    const int nb = gridDim.x, bx = blockIdx.x;
    const size_t vt = (size_t)bx * NT + threadIdx.x, vs = (size_t)nb * NT;

    ph_init(p, 0, vt, vs);
    for (int r_ = a.reps[12]; r_ > 0; --r_) {
    ph_mod_partial(p, vt, vs);
#pragma unroll 1
    for (int mat = 0; mat < 11; ++mat) conv_mat(p, 0, mat, (unsigned*)smem + (threadIdx.x >> 6) * (64 * 32), bx * 8 + (int)(threadIdx.x >> 6), 0x7fffffff, nb * 8);
    }
    ph_zero16((uint4*)p.WupT, (size_t)DEPTH * NUP * KUP * 2 / 16, vt, vs);
    ph_zero16((uint4*)p.WloT, (size_t)DEPTH * NLO * KLO * 2 / 16, vt, vs);
    GRID_BARRIER();
    ph_mod_final(p, vt, vs);
    ph_transpose(p.mla_w_uq, p.WupT, MLA_QL, NUPQ, DEPTH, (size_t)NUP * KUP, 0, KUP, 0, vt, vs);
    ph_transpose(p.mla_w_ukv, p.WupT, MLA_KVL, NUP - NUPQ, DEPTH, (size_t)NUP * KUP, NUPQ, KUP, MLA_QL, vt, vs);
    for (int dir = 0; dir < 2; ++dir) {
        ph_transpose(p.rw_w_up + (size_t)dir * RW_WL * GD, p.WloT, RW_WL, GD, DEPTH, (size_t)NLO * KLO, dir * GD, KLO, dir * RW_WL, vt, vs, (size_t)2 * RW_WL * GD);
        ph_transpose(p.rw_a_up + (size_t)dir * RW_AL * GD, p.WloT, RW_AL, GD, DEPTH, (size_t)NLO * KLO, 2 * GD + dir * GD, KLO, 2 * RW_WL + dir * RW_AL, vt, vs, (size_t)2 * RW_AL * GD);
    }
    ph_transpose(p.rw_g_up, p.WloT, RW_GL, GD, DEPTH, (size_t)NLO * KLO, 4 * GD, KLO, 2 * RW_WL + 2 * RW_AL, vt, vs);
    GRID_BARRIER();
    ph_modulate(p, 0, vt, vs);
    GRID_BARRIER();

    for (int l = 0; l < DEPTH; ++l) {
        for (int r_ = REPS(0); r_ > 0; --r_)
        {
            pg8::Gemm g{PF().xm, PF().WinT + (size_t)l * N_INP * D, TT, N_INP, D}; pg8::StaticOrder S; S.init(TT, N_INP, NBF(), OPQS(bx));
            pg8::EpiBf16N E{PF().P, N_IN, N_IN};
            pg8::gemm_phase<pg8::EpiBf16N, pg8::StaticOrder, false>((PG8_LAS unsigned char*)lds, g, S, E, nullptr);
            GRID_BARRIER();
        }
        for (int r_ = REPS(1); r_ > 0; --r_) {
        ph_rw_mix(PF(), l, VTF(), VSF());
        ph_mb_prep(PF(), l, VTF(), VSF());
        ph_mla_norm(PF(), l, VTF(), VSF());
        ph_vt_tiles(PF(), 0, smem, OPQS(bx), NBF());
        GRID_BARRIER();
        }
        for (int r_ = REPS(8); r_ > 0; --r_) {
        {
            pg8::Gemm g{PF().pmb, PF().WloT + (size_t)l * NLO * KLO, TT, NLO, KLO}; pg8::StaticOrder S; S.init(TT, NLO, NBF(), OPQS(bx));
            pg8::EpiBf16N E{PF().LO, NLO, NLO};
            pg8::gemm_phase<pg8::EpiBf16N, pg8::StaticOrder, false>((PG8_LAS unsigned char*)lds, g, S, E, nullptr);
        }
        {
            pg8::Gemm g{PF().qkvn, PF().WupT + (size_t)l * NUP * KUP, TT, NUP, KUP}; pg8::StaticOrder S; S.init(TT, NUP, NBF(), OPQS(bx));
            pg8::EpiF32 E{PF().QKVraw, NUP, nullptr};
            pg8::gemm_phase<pg8::EpiF32, pg8::StaticOrder, false>((PG8_LAS unsigned char*)lds, g, S, E, nullptr);
        }
        GRID_BARRIER();
        }
        for (int r_ = REPS(9); r_ > 0; --r_) { ph_rw_prep(PF(), l, VTF(), VSF()); ph_mla_rope(PF(), l, VTF(), VSF()); ph_vt_tiles(PF(), 1, smem, OPQS(bx), NBF()); ph_vt_tiles(PF(), 2, smem, OPQS(bx), NBF()); ph_vt_tiles(PF(), 3, smem, OPQS(bx), NBF()); ph_bc_frag(PF(), OPQS(bx), NBF()); }
        GRID_BARRIER();
        for (int r_ = REPS(10); r_ > 0; --r_) { ph_chunks(PF(), l, (float*)lds, PF().qctr + l * 16 + 8 + (r_ - 1), PF().qctr + l * 16 + 12 + (r_ - 1)); GRID_BARRIER(); }
        {
            constexpr int SEQ_BLOCKS = (NU * 2 * 64 + NT - 1) / NT;
            const int wv = __builtin_amdgcn_readfirstlane((int)(VTF() >> 6));
            for (int r_ = REPS(6); r_ > 0; --r_) {
                if (bx < NU) ph_rw_seq(PF(), lds, OPQS(bx), NU);
                else if (bx < NU + 2 * SEQ_BLOCKS) ph_mb_seq(PF(), wv - NU * (NT / 64), 2 * SEQ_BLOCKS * (NT / 64));
            }
            constexpr int QB = (NT / 64) * 32, RPU = NT / 128;
            const bool with_ctx = l < DEPTH - 1;
            const int n_mla = NB * NH * (SEQ / QB) + (with_ctx ? NB * NH * (CTX / QB) : 0);
            const int n_na = NB * NH * ((SEQ / GRID_W) / RPU) + (with_ctx ? NB * NH * (CTX / QB) : 0);
            for (int r_ = REPS(2); r_ > 0; --r_)
            for (;;) {
                __syncthreads();
                if (threadIdx.x == 0) *s_unit = atomicAdd(&PF().qctr[l * 16 + (r_ - 1)], 1);
                __syncthreads();
                const int u = *s_unit;
                if (u >= 2 * n_mla) break;
                mla_unit<NT>(PF(), smem, u);
            }
            for (int r_ = REPS(7); r_ > 0; --r_)
            for (;;) {
                __syncthreads();
                if (threadIdx.x == 0) *s_unit = atomicAdd(&PF().qctr[l * 16 + 4 + (r_ - 1)], 1);
                __syncthreads();
                const int u = *s_unit;
                if (u >= n_na) break;
                na_unit<NT>(PF(), l, smem, u);
            }
            GRID_BARRIER();
        }
        for (int r_ = REPS(3); r_ > 0; --r_) {
        ph_rw_yout(PF(), l, VTF(), VSF());
        ph_mb_yout(PF(), l, VTF(), VSF());
        ph_mla_combine(PF(), l < DEPTH - 1, VTF(), VSF());
        GRID_BARRIER();
        }
#define OUT_GEMM(SchedT, S_) do { pg8::Gemm g{PF().Ymix, PF().WoutT + (size_t)l * D * D_MIX, TT, D, D_MIX}; pg8::EpiBf16N E{PF().yo, D, D}; \
            pg8::gemm_phase<pg8::EpiBf16N, SchedT, false>((PG8_LAS unsigned char*)lds, g, S_, E, nullptr); } while (0)
#define OUT_NTL() (NBF() >= 64 ? (TT / 256 - OUT_T0) * (D / 256) : 0)
        if (l < DEPTH - 1) {
            constexpr int OUT_T0 = 32;
            for (int r_ = REPS(4); r_ > 0; --r_) {
            { pg8::StaticOrder S; S.init(OUT_T0 * 256, D, NBF(), OPQS(bx)); OUT_GEMM(pg8::StaticOrder, S); }
            GRID_BARRIER();
            }
            if (OPQS(bx) < OUT_NTL() || OUT_NTL() == 0) { pg8::TailOrder S{OUT_T0, TT / 256, D / 256, OUT_NTL() ? OUT_NTL() : NBF(), OPQS(bx)}; OUT_GEMM(pg8::TailOrder, S); }
            else { ph_ln1_route(PF(), l, (float*)lds, (int*)(lds + LDS_RT), (size_t)(OPQS(bx) - OUT_NTL()) * NT + TIDX(), (size_t)(NBF() - OUT_NTL()) * NT, 0, OUT_T0 * 256, true);
                ph_ln1_fix(PF(), (const int*)(lds + LDS_RT), (size_t)(OPQS(bx) - OUT_NTL()) * NT + TIDX(), (size_t)(NBF() - OUT_NTL()) * NT, 0, OUT_T0 * 256); }
            GRID_BARRIER();
            if (OUT_NTL() == 0) { ph_ln1_route(PF(), l, (float*)lds, (int*)(lds + LDS_RT), VTF(), VSF(), 0, TT, true); ph_ln1_fix(PF(), (const int*)(lds + LDS_RT), VTF(), VSF(), 0, TT); }
            else if (OPQS(bx) >= OUT_NTL()) {
                ph_ln1_route(PF(), l, (float*)lds, (int*)(lds + LDS_RT), ((size_t)(TIDX() >> 6) * (NBF() - OUT_NTL()) + (OPQS(bx) - OUT_NTL())) * 64 + (TIDX() & 63), (size_t)(NBF() - OUT_NTL()) * NT, OUT_T0 * 256, TT, false);
                ph_ln1_fix(PF(), (const int*)(lds + LDS_RT), ((size_t)(TIDX() >> 6) * (NBF() - OUT_NTL()) + (OPQS(bx) - OUT_NTL())) * 64 + (TIDX() & 63), (size_t)(NBF() - OUT_NTL()) * NT, OUT_T0 * 256, TT);
            }
        } else {
            for (int r_ = REPS(5); r_ > 0; --r_) {
            { pg8::LatentOrder S; S.init(NB * SEQ, D, NBF(), OPQS(bx)); OUT_GEMM(pg8::LatentOrder, S); }
            GRID_BARRIER();
            }
            ph_ln1_route(PF(), l, (float*)lds, (int*)(lds + LDS_RT), VTF(), VSF(), 0, TT, true);
            ph_ln1_fix(PF(), (const int*)(lds + LDS_RT), VTF(), VSF(), 0, TT);
        }
#undef OUT_GEMM
#undef OUT_NTL
        GRID_BARRIER();
        for (int r_ = REPS(13); r_ > 0; --r_) {
        ph_moe_perm(PF(), l, VTF(), VSF());
        GRID_BARRIER();
        }
        for (int r_ = REPS(14); r_ > 0; --r_) {
        {
            pg8::Gemm g{PF().hperm, PF().WguT + (size_t)l * NE * 2 * D_EXP * D, MPAD, NE * 2 * D_EXP, D};
            pg8::MoeOrder S{PF().cnt + l * NE, NBF(), OPQS(bx), 2 * D_EXP / 256};
            pg8::EpiSwiGLU E{PF().hidp, D_EXP, 2 * D_EXP / 256};
            pg8::gemm_phase<pg8::EpiSwiGLU, pg8::MoeOrder, false>((PG8_LAS unsigned char*)lds, g, S, E, nullptr);
        }
        GRID_BARRIER();
        }
        for (int r_ = REPS(15); r_ > 0; --r_) {
        {
            pg8::Gemm g{PF().hidp, PF().WdT + (size_t)l * NE * D * D_EXP, MPAD, NE * D, D_EXP};
            pg8::MoeOrder S{PF().cnt + l * NE, NBF(), OPQS(bx), D / 256};
            pg8::EpiBf16Grp E{PF().Fperm, D, D / 256};
            pg8::gemm_phase<pg8::EpiBf16Grp, pg8::MoeOrder, false>((PG8_LAS unsigned char*)lds, g, S, E, nullptr);
        }
        GRID_BARRIER();
        }
        ph_ln2(PF(), l, VTF(), VSF());
        GRID_BARRIER();
    }
}

static size_t carve(size_t& off, size_t bytes) { const size_t o = off; off += (bytes + 255) & ~(size_t)255; return o; }

extern "C" void kernel_launch(void* const* d_in, const int* in_sizes, int n_in, void* d_out, int out_size, void* d_ws, size_t ws_size, hipStream_t stream) {
    (void)in_sizes; (void)n_in; (void)out_size;
    MegaArgs a{};
    Params& p = a.p;
    const float* const* in = (const float* const*)d_in;
    p.x = in[0]; p.c = in[1]; p.ctx = in[2]; p.c_ctx = in[3]; p.ada_w = in[4]; p.ada_b = in[5]; p.w_in = in[6]; p.w_out = in[7];
    p.ln1_g = in[8]; p.ln1_b = in[9]; p.ln2_g = in[10]; p.ln2_b = in[11];
    p.rw_mu = in[12]; p.rw_w0 = in[13]; p.rw_w_up = in[14]; p.rw_a0 = in[15]; p.rw_a_up = in[16]; p.rw_g_up = in[17]; p.rw_k_k = in[18]; p.rw_k_a = in[19];
    p.rw_r_k = in[20]; p.rw_gn_g = in[21]; p.rw_gn_b = in[22];
    p.mb_conv_w = in[23]; p.mb_conv_b = in[24]; p.mb_a_log = in[25]; p.mb_dt_bias = in[26]; p.mb_d = in[27]; p.mb_norm_g = in[28];
    p.mla_q_norm = in[29]; p.mla_w_uq = in[30]; p.mla_kv_norm = in[31]; p.mla_w_ukv = in[32]; p.na_rpb = in[33];
    p.router_w = in[34]; p.router_b = in[35]; p.exp_w_gate = in[36]; p.exp_w_up = in[37]; p.exp_w_down = in[38];
    p.out = (float*)d_out;

    char* ws = (char*)d_ws; size_t off = 0;
    a.bar = (unsigned*)(ws + carve(off, (size_t)XCD_BAR_WORDS * 4));
    p.WinT = (bf16_t*)(ws + carve(off, (size_t)DEPTH * N_INP * D * 2));
    p.WoutT = (bf16_t*)(ws + carve(off, (size_t)DEPTH * D * D_MIX * 2));
    p.WguT = (bf16_t*)(ws + carve(off, (size_t)DEPTH * NE * 2 * D_EXP * D * 2));
    p.WdT = (bf16_t*)(ws + carve(off, (size_t)DEPTH * NE * D * D_EXP * 2));
    p.WupT = (bf16_t*)(ws + carve(off, (size_t)DEPTH * NUP * KUP * 2));
    p.WloT = (bf16_t*)(ws + carve(off, (size_t)DEPTH * NLO * KLO * 2));
    p.xs = (float*)(ws + carve(off, (size_t)TT * D * 4));
    p.xm = (bf16_t*)(ws + carve(off, (size_t)TT * D * 2));
    p.mod = (float*)(ws + carve(off, (size_t)DEPTH * NMOD * 6 * D * 4));
    p.modp = (float*)(ws + carve(off, (size_t)DEPTH * (D / 128) * NMOD * 6 * D * 4));
    p.ropecs = (float2*)(ws + carve(off, (size_t)GRID_W * (MLA_ROPE / 4) * 8));
    p.cnt = (int*)(ws + carve(off, (size_t)DEPTH * NE * 4));
    p.qctr = (int*)(ws + carve(off, (size_t)DEPTH * 16 * 4));
    p.tok_e = (int2*)(ws + carve(off, (size_t)TT * 8));
    p.tok_pos = (int2*)(ws + carve(off, (size_t)TT * 8));
    p.tok_row = (int2*)(ws + carve(off, (size_t)TT * 8));
    p.tok_w = (float2*)(ws + carve(off, (size_t)TT * 8));
    p.Ymix = (bf16_t*)(ws + carve(off, (size_t)TT * D_MIX * 2));
    p.naVt = (bf16_t*)(ws + carve(off, (size_t)NB * NH * HD * LL * 2));
    p.mlaO = (float*)(ws + carve(off, (size_t)TT * NH * 2 * MLA_V * 4));
    p.mlaML = (float*)(ws + carve(off, (size_t)TT * NH * 2 * 2 * 4));
    p.hb = (bf16_t*)(ws + carve(off, (size_t)TT * D * 2));
    const size_t regA = off;
    p.P = (bf16_t*)(ws + carve(off, (size_t)TT * N_IN * 2));
    p.pm = (float*)(ws + carve(off, (size_t)TT * RW_IN * 4));
    p.pmb = (bf16_t*)(ws + carve(off, (size_t)TT * KLO * 2));
    p.rwW = (float*)(ws + carve(off, (size_t)2 * TT * GD * 4));
    p.rwB = (float*)(ws + carve(off, (size_t)2 * TT * GD * 4));
    p.rwKD = (float*)(ws + carve(off, (size_t)2 * TT * GD * 4));
    p.rwKK = (float*)(ws + carve(off, (size_t)TT * GD * 4));
    p.rwG = (float*)(ws + carve(off, (size_t)TT * GD * 4));
    {
        const size_t o0 = off; size_t o1 = off, o2 = off;
        p.rwMsT = (bf16_t*)(ws + carve(o1, (size_t)NU * NCHK * HD * HD * 2));
        p.rwSloc = (float*)(ws + carve(o1, (size_t)NU * NCHK * HD * HD * 4));
        p.rwYI = (bf16_t*)(ws + carve(o1, (size_t)NU * LL * HD * 2));
        p.rwYloc = (float*)(ws + carve(o1, (size_t)NU * LL * HD * 4));
        p.LO = (bf16_t*)(ws + carve(o2, (size_t)TT * NLO * 2));
        p.QKVraw = (float*)(ws + carve(o2, (size_t)TT * NUP * 4));
        off = o1 > o2 ? o1 : o2; (void)o0;
    }
    p.xc = (float*)(ws + carve(off, (size_t)TT * MB_CONV_DIM * 4));
    p.dt = (float*)(ws + carve(off, (size_t)TT * 2 * NH * 4));
    p.mbC = (bf16_t*)(ws + carve(off, (size_t)TT * MB_GROUPS * MB_STATE * 2));
    p.mbB = (bf16_t*)(ws + carve(off, (size_t)TT * MB_GROUPS * MB_STATE * 2));
    p.mbXT = (bf16_t*)(ws + carve(off, (size_t)NB * NH * HD * LL * 2));
    p.mbBT = (bf16_t*)(ws + carve(off, (size_t)NB * MB_GROUPS * MB_STATE * LL * 2));
    p.mbCS = (bf16_t*)(ws + carve(off, (size_t)NU * NCHK * HD * MB_STATE * 2));
    p.mbYloc = (bf16_t*)(ws + carve(off, (size_t)NU * LL * HD * 2));
    p.mbCum = (float*)(ws + carve(off, (size_t)NU * LL * 4));
    p.qkvn = (bf16_t*)(ws + carve(off, (size_t)TT * KUP * 2));
    p.Qm = (bf16_t*)(ws + carve(off, (size_t)TT * NH * MLA_QK * 2));
    p.Km = (bf16_t*)(ws + carve(off, (size_t)TT * NH * MLA_QK * 2));
    p.Vt = (bf16_t*)(ws + carve(off, (size_t)TT * NH * MLA_V * 2));
    const size_t endA = off;
    off = regA;
    p.yo = (bf16_t*)(ws + carve(off, (size_t)TT * D * 2));
    p.hperm = (bf16_t*)(ws + carve(off, (size_t)MPAD * D * 2));
    p.hidp = (bf16_t*)(ws + carve(off, (size_t)MPAD * D_EXP * 2));
    p.Fperm = (bf16_t*)(ws + carve(off, (size_t)MPAD * D * 2));
    const size_t endB = off;
    const size_t need = endA > endB ? endA : endB;
    if (need > ws_size) return;

    static int grid = 0;
    if (!grid) {
        int dev = 0, cus = 0, per_cu = 0;
        if (hipGetDevice(&dev) != hipSuccess || hipDeviceGetAttribute(&cus, hipDeviceAttributeMultiprocessorCount, dev) != hipSuccess) { grid = -1; return; }
        if (hipFuncSetAttribute((const void*)k_mega, hipFuncAttributeMaxDynamicSharedMemorySize, LDS_BYTES) != hipSuccess) { grid = -1; return; }
        if (hipOccupancyMaxActiveBlocksPerMultiprocessor(&per_cu, (const void*)k_mega, NT, LDS_BYTES) != hipSuccess) per_cu = 0;
        grid = cus * (per_cu < 1 ? per_cu : 1);
        if (grid <= 0) grid = -1;
    }
    if (grid <= 0) return;
    for (int k = 0; k < 16; ++k) a.reps[k] = 1;
#ifdef PROBE_GROUP
    a.reps[PROBE_GROUP] = 2;
#endif
    (void)hipMemsetAsync(a.bar, 0, (size_t)XCD_BAR_WORDS * 4, stream);
    hipLaunchKernelGGL(k_mega, dim3(grid), dim3(NT), LDS_BYTES, stream, a);
}
```

```cpp
#include <hip/hip_runtime.h>
#include <stdint.h>
#include <stddef.h>
#include <math.h>

#ifndef CFG_SMALL
constexpr int D = 2048, NB = 2, SEQ = 4096, DEPTH = 4, CTX = 256, GRID_W = 64;
constexpr int HD = 64;
constexpr int RW_WL = 64, RW_AL = 64, RW_GL = 128;
constexpr int MB_STATE = 128, MB_GROUPS = 2, MB_CONV = 5;
constexpr int MLA_NOPE = 64, MLA_ROPE = 32;
constexpr int NA_WR = 8, NA_WC = 16;
constexpr int NE = 16, NEG = 4;
#else
constexpr int D = 256, NB = 2, SEQ = 64, DEPTH = 2, CTX = 16, GRID_W = 8;
constexpr int HD = 16;
constexpr int RW_WL = 8, RW_AL = 8, RW_GL = 16;
constexpr int MB_STATE = 16, MB_GROUPS = 2, MB_CONV = 5;
constexpr int MLA_NOPE = 16, MLA_ROPE = 8;
constexpr int NA_WR = 4, NA_WC = 4;
constexpr int NE = 16, NEG = 4;
#endif
constexpr int GD = D / 4, NH = GD / HD, D_MIX = 4 * GD;
constexpr int MLA_QL = 3 * D / 16, MLA_KVL = D / 16;
constexpr int D_EXP = D / 4, EPG = NE / NEG;
constexpr int RW_IN = 3 * GD + 2 * RW_WL + 2 * RW_AL + RW_GL;
constexpr int MB_CONV_DIM = GD + 2 * MB_GROUPS * MB_STATE;
constexpr int MB_IN = GD + MB_CONV_DIM + 2 * NH;
constexpr int MLA_V = HD, MLA_QK = MLA_NOPE + MLA_ROPE;
constexpr int MLA_IN = MLA_QL + MLA_KVL + MLA_ROPE;
constexpr int NA_IN = 3 * GD;
constexpr int N_IN = RW_IN + MB_IN + MLA_IN + NA_IN;
constexpr int OFF_RW = 0, OFF_MB = RW_IN, OFF_MLA = RW_IN + MB_IN, OFF_NA = OFF_MLA + MLA_IN;
constexpr int LL = CTX + SEQ, TT = NB * LL;
constexpr int NMOD = NB + 1;
constexpr int MPAD = ((2 * TT + 255) / 256 + NE) * 256;
constexpr int N_INP = ((N_IN + 255) / 256) * 256;
constexpr int KLO = 2 * RW_WL + 2 * RW_AL + RW_GL, NLO = 5 * GD;
constexpr int KUP = MLA_QL + MLA_KVL, NUPQ = NH * MLA_QK, NUP = NUPQ + NH * (MLA_NOPE + MLA_V);
constexpr float LN_EPS = 1e-6f, RMS_EPS = 1e-6f, RW_GN_EPS = 64e-5f, RW_DECAY_SCALE = 0.606531f, ROUTED_SCALE = 2.5f;
constexpr float ROPE_BASE = 10000.0f;
#define DN_ALPHA (sqrtf(sqrtf(2.0f * (float)DEPTH)))

typedef unsigned short bf16_t;

#define DEVFN __device__ __forceinline__


DEVFN uint32_t f_as_u(float f) { union { float f; uint32_t u; } c; c.f = f; return c.u; }
DEVFN float u_as_f(uint32_t u) { union { float f; uint32_t u; } c; c.u = u; return c.f; }
DEVFN bf16_t f2bf(float f) { uint32_t u = f_as_u(f); u += 0x7fffu + ((u >> 16) & 1u); return (bf16_t)(u >> 16); }
DEVFN float bf2f(bf16_t h) { return u_as_f(((uint32_t)h) << 16); }
DEVFN int TIDX() { int t = (int)threadIdx.x; asm volatile("" : "+v"(t)); return t; }
DEVFN float bflo(unsigned w) { return u_as_f(w << 16); }
DEVFN float bfhi(unsigned w) { return u_as_f(w & 0xffff0000u); }
DEVFN unsigned pk2(float a, float b) { return (unsigned)f2bf(a) | ((unsigned)f2bf(b) << 16); }
DEVFN float sigmoidf_(float x) { return 1.0f / (1.0f + expf(-x)); }
DEVFN float siluf_(float x) { return x * sigmoidf_(x); }
DEVFN float softplusf_(float x) { return x > 20.0f ? x : log1pf(expf(x)); }

struct Params {
    const float *x, *c, *ctx, *c_ctx, *ada_w, *ada_b, *w_in, *w_out, *ln1_g, *ln1_b, *ln2_g, *ln2_b;
    const float *rw_mu, *rw_w0, *rw_w_up, *rw_a0, *rw_a_up, *rw_g_up, *rw_k_k, *rw_k_a, *rw_r_k, *rw_gn_g, *rw_gn_b;
    const float *mb_conv_w, *mb_conv_b, *mb_a_log, *mb_dt_bias, *mb_d, *mb_norm_g;
    const float *mla_q_norm, *mla_w_uq, *mla_kv_norm, *mla_w_ukv, *na_rpb, *router_w, *router_b, *exp_w_gate, *exp_w_up, *exp_w_down;
    float* out;
    bf16_t *WinT, *WoutT, *WguT, *WdT, *WupT;
    float* xs;
    bf16_t* xm;
    float* mod;
    float* modp;
    float2* ropecs;
    bf16_t* P;
    float* pm;
    bf16_t* pmb;
    bf16_t* LO;
    bf16_t* WloT;
    float *rwW, *rwB, *rwKD;
    float *rwKK, *rwG;
    bf16_t* rwMsT;
    float* rwSloc;
    bf16_t* rwYI;
    float* rwYloc;
    float* xc;
    float* dt;
    bf16_t* mbC;
    bf16_t* mbB;
    bf16_t* mbXT;
    bf16_t* mbBT;
    bf16_t* mbCS;
    bf16_t* mbYloc;
    float* mbCum;
    bf16_t* qkvn;
    float* QKVraw;
    int* qctr;
    bf16_t *Qm, *Km, *Vt;
    bf16_t* naVt;
    float* mlaO;
    float* mlaML;
    bf16_t* Ymix;
    bf16_t* yo;
    bf16_t* hb;
    int* cnt;
    int2 *tok_e, *tok_pos, *tok_row;
    float2* tok_w;
    bf16_t *hperm, *hidp, *Fperm;
};

DEVFN void ph_init(const Params& p, int l, size_t vt, size_t vs) {
    const size_t n = (size_t)TT * D;
    for (size_t i = vt; i < n; i += vs) {
        const int d = (int)(i % D); const int t = (int)(i / D); const int b = t / LL, s = t % LL;
        p.xs[i] = s < CTX ? p.ctx[((size_t)b * CTX + s) * D + d] : p.x[((size_t)b * SEQ + (s - CTX)) * D + d];
    }
    for (size_t i = vt; i < (size_t)GRID_W * (MLA_ROPE / 4); i += vs) {
        const int f = (int)(i % (MLA_ROPE / 4)), pos = (int)(i / (MLA_ROPE / 4));
        const float ang = (float)pos * powf(ROPE_BASE, -(float)f / (float)(MLA_ROPE / 4));
        p.ropecs[i] = make_float2(cosf(ang), sinf(ang));
    }
    for (size_t i = vt; i < (size_t)DEPTH * NE; i += vs) p.cnt[i] = 0;
    for (size_t i = vt; i < (size_t)DEPTH * 16; i += vs) p.qctr[i] = 0;
}

DEVFN void ph_transpose(const float* src, bf16_t* dst, int K, int N, int batch, size_t dst_bstride, int dst_row0, int ldd, int col0, size_t vt, size_t vs, size_t src_bstride = 0, int src_ld = 0) {
    if (src_ld == 0) src_ld = N;
    if (src_bstride == 0) src_bstride = (size_t)K * src_ld;
    const size_t total = (size_t)batch * (K / 8) * N;
    for (size_t idx = vt; idx < total; idx += vs) {
        const int n = (int)(idx % N); const int k8 = (int)((idx / N) % (K / 8)); const int bt = (int)(idx / ((size_t)N * (K / 8)));
        const float* sp = src + (size_t)bt * src_bstride + (size_t)(k8 * 8) * src_ld + n;
        uint4 w;
        const size_t sl_ = (size_t)src_ld;
        w.x = (unsigned)f2bf(sp[0]) | ((unsigned)f2bf(sp[sl_]) << 16); w.y = (unsigned)f2bf(sp[2 * sl_]) | ((unsigned)f2bf(sp[3 * sl_]) << 16);
        w.z = (unsigned)f2bf(sp[4 * sl_]) | ((unsigned)f2bf(sp[5 * sl_]) << 16); w.w = (unsigned)f2bf(sp[6 * sl_]) | ((unsigned)f2bf(sp[7 * sl_]) << 16);
        *(uint4*)(dst + (size_t)bt * dst_bstride + (size_t)(dst_row0 + n) * ldd + col0 + k8 * 8) = w;
    }
}
DEVFN void ph_zero16(uint4* dst, size_t n16, size_t vt, size_t vs) { for (size_t i = vt; i < n16; i += vs) dst[i] = make_uint4(0u, 0u, 0u, 0u); }
typedef float tt_f32v2 __attribute__((ext_vector_type(2)));
typedef __bf16 tt_bf16v2 __attribute__((ext_vector_type(2)));
DEVFN unsigned tt_pk(float lo, float hi) { const tt_f32v2 v = {lo, hi}; const tt_bf16v2 r = __builtin_convertvector(v, tt_bf16v2); return __builtin_bit_cast(unsigned, r); }
DEVFN void tr_tiles(const float* src, bf16_t* dst, int K, int N, int batch, size_t dst_bstride, int dst_row0, int ldd, int col0, unsigned* sw, int tile0, int tile_end, int stride, size_t src_bstride = 0, int src_ld = 0) {
    if (src_ld == 0) src_ld = N;
    if (src_bstride == 0) src_bstride = (size_t)K * src_ld;
    const int lane = TIDX() & 63;
    const int kt = K / 64, nt = (N + 63) / 64; const int total = batch * kt * nt < tile_end ? batch * kt * nt : tile_end;
    const int pc = lane & 15, r0 = lane >> 4, q = lane & 7, n0 = lane >> 3;
    int tile = tile0;
    if (tile >= total) return;
    float4 va[8], vb4[8];
#define TT_LOAD(tile_, A_, B_) do { const int tc = (tile_) < total ? (tile_) : total - 1; const int kti = tc % kt, nti = (tc / kt) % nt, bt = tc / (nt * kt); \
        const int nn = nti * 64 + pc * 4; const int nc = nn + 4 <= N ? nn : 0;            \
        const float* sp = src + (size_t)bt * src_bstride + (size_t)(kti * 64 + 2 * r0) * src_ld + nc; \
        _Pragma("unroll") for (int i = 0; i < 8; ++i) { A_[i] = *(const float4*)(sp + (size_t)(8 * i) * src_ld); B_[i] = *(const float4*)(sp + (size_t)(8 * i + 1) * src_ld); } } while (0)
    TT_LOAD(tile, va, vb4);
    for (; tile < total; tile += stride) {
        float4 na[8], nb4[8];
        TT_LOAD(tile + stride, na, nb4);
        __builtin_amdgcn_wave_barrier();
#pragma unroll
        for (int i = 0; i < 8; ++i) {
            unsigned* w = sw + (4 * pc) * 32 + ((r0 + 4 * i) ^ ((pc & 7) << 2));
            w[0] = tt_pk(va[i].x, vb4[i].x); w[32] = tt_pk(va[i].y, vb4[i].y); w[64] = tt_pk(va[i].z, vb4[i].z); w[96] = tt_pk(va[i].w, vb4[i].w);
        }
        __builtin_amdgcn_wave_barrier();
        {
            const int kti = tile % kt, nti = (tile / kt) % nt, bt = tile / (nt * kt);
#pragma unroll
            for (int i = 0; i < 8; ++i) {
                const int n = n0 + 8 * i; const uint4 v = *(const uint4*)(sw + n * 32 + 4 * (q ^ ((n >> 2) & 7)));
                const int gn = nti * 64 + n;
                if (gn < N) *(uint4*)(dst + (size_t)bt * dst_bstride + (size_t)(dst_row0 + gn) * ldd + col0 + kti * 64 + q * 8) = v;
            }
        }
#pragma unroll
        for (int i = 0; i < 8; ++i) { va[i] = na[i]; vb4[i] = nb4[i]; }
    }
#undef TT_LOAD
}
DEVFN void ph_transpose_t(const float* src, bf16_t* dst, int K, int N, int batch, size_t dst_bstride, int dst_row0, int ldd, int col0, bf16_t* smem, int vb, int nvb, size_t src_bstride = 0, int src_ld = 0) {
    const int wid = __builtin_amdgcn_readfirstlane(TIDX() >> 6);
    tr_tiles(src, dst, K, N, batch, dst_bstride, dst_row0, ldd, col0, (unsigned*)smem + wid * (64 * 32), vb * 8 + wid, 0x7fffffff, nvb * 8, src_bstride, src_ld);
}
constexpr int CONV_TB = 8;
constexpr int CV_IN = (D / 64) * ((N_IN + 63) / 64), CV_OUT = (D_MIX / 64) * (D / 64), CV_GU = NE * (D / 64) * 2, CV_DN = NE * (D_EXP / 64) * (D / 64);
static_assert(CV_IN % CONV_TB == 0 && CV_OUT % CONV_TB == 0 && CV_GU % CONV_TB == 0 && CV_DN % CONV_TB == 0, "whole batches");
constexpr int NCONV = (CV_IN + CV_OUT + 8 * CV_GU + CV_DN) / CONV_TB;
DEVFN void conv_mat(const Params& p, int l, int mat, unsigned* sw, int tile0, int tile_end, int stride) {
    const float* src; bf16_t* dst; int K, N, batch, row0, ldd, src_ld; size_t dbs, sbs;
    if (mat == 0) { src = p.w_in + (size_t)l * D * N_IN; dst = p.WinT + (size_t)l * N_INP * D; K = D; N = N_IN; batch = 1; dbs = 0; row0 = 0; ldd = D; sbs = (size_t)D * N_IN; src_ld = N_IN; }
    else if (mat == 1) { src = p.w_out + (size_t)l * D_MIX * D; dst = p.WoutT + (size_t)l * D * D_MIX; K = D_MIX; N = D; batch = 1; dbs = 0; row0 = 0; ldd = D_MIX; sbs = (size_t)D_MIX * D; src_ld = D; }
    else if (mat < 10) { const int cu = (mat - 2) & 3, up = (mat - 2) >> 2; src = (up ? p.exp_w_up : p.exp_w_gate) + (size_t)l * NE * D * D_EXP + cu * 128; dst = p.WguT + (size_t)l * NE * 2 * D_EXP * D;
        K = D; N = 128; batch = NE; dbs = (size_t)2 * D_EXP * D; row0 = cu * 256 + up * 128; ldd = D; sbs = (size_t)D * D_EXP; src_ld = D_EXP; }
    else { src = p.exp_w_down + (size_t)l * NE * D_EXP * D; dst = p.WdT + (size_t)l * NE * D * D_EXP; K = D_EXP; N = D; batch = NE; dbs = (size_t)D * D_EXP; row0 = 0; ldd = D_EXP; sbs = (size_t)D_EXP * D; src_ld = D; }
    tr_tiles(src, dst, K, N, batch, dbs, row0, ldd, 0, sw, tile0, tile_end, stride, sbs, src_ld);
}
DEVFN void conv_item(const Params& p, int l, int bi, unsigned* sw) {
    int mat, b0;
    if (bi < CV_IN / CONV_TB) { mat = 0; b0 = bi; }
    else if (bi < (CV_IN + CV_OUT) / CONV_TB) { mat = 1; b0 = bi - CV_IN / CONV_TB; }
    else if (bi < (CV_IN + CV_OUT + 8 * CV_GU) / CONV_TB) { const int r = bi - (CV_IN + CV_OUT) / CONV_TB; mat = 2 + r / (CV_GU / CONV_TB); b0 = r % (CV_GU / CONV_TB); }
    else { mat = 10; b0 = bi - (CV_IN + CV_OUT + 8 * CV_GU) / CONV_TB; }
    conv_mat(p, l, mat, sw, b0 * CONV_TB, b0 * CONV_TB + CONV_TB, 1);
}

constexpr int MOD_IC = 128, MOD_NC = D / MOD_IC;
DEVFN void ph_mod_partial(const Params& p, size_t vt, size_t vs) {
    constexpr int J4 = 6 * D / 4;
    const size_t total = (size_t)DEPTH * MOD_NC * J4;
    for (size_t idx = vt; idx < total; idx += vs) {
        const int j4 = (int)(idx % J4); const int ic = (int)((idx / J4) % MOD_NC); const int l = (int)(idx / ((size_t)J4 * MOD_NC));
        float4 acc[NMOD];
#pragma unroll
        for (int r = 0; r < NMOD; ++r) acc[r] = make_float4(0.f, 0.f, 0.f, 0.f);
        const float* wp = p.ada_w + ((size_t)l * D + (size_t)ic * MOD_IC) * 6 * D + j4 * 4;
#pragma unroll 8
        for (int i = 0; i < MOD_IC; ++i) {
            const float4 w = *(const float4*)(wp + (size_t)i * 6 * D);
#pragma unroll
            for (int r = 0; r < NMOD; ++r) { const float cv = r < NB ? p.c[r * D + ic * MOD_IC + i] : p.c_ctx[ic * MOD_IC + i]; const float sv = siluf_(cv);
                acc[r].x += sv * w.x; acc[r].y += sv * w.y; acc[r].z += sv * w.z; acc[r].w += sv * w.w; }
        }
#pragma unroll
        for (int r = 0; r < NMOD; ++r) *(float4*)(p.modp + ((((size_t)l * MOD_NC + ic) * NMOD + r) * 6 * D) + j4 * 4) = acc[r];
    }
}
DEVFN void ph_mod_final(const Params& p, size_t vt, size_t vs) {
    const size_t total = (size_t)DEPTH * NMOD * 6 * D;
    for (size_t idx = vt; idx < total; idx += vs) {
        const int j = (int)(idx % (6 * D)); const int r = (int)((idx / (6 * D)) % NMOD); const int l = (int)(idx / ((size_t)6 * D * NMOD));
        float acc = p.ada_b[(size_t)l * 6 * D + j];
        for (int ic = 0; ic < MOD_NC; ++ic) acc += p.modp[(((size_t)l * MOD_NC + ic) * NMOD + r) * 6 * D + j];
        p.mod[idx] = acc;
    }
}

DEVFN void ph_modulate(const Params& p, int l, size_t vt, size_t vs) {
    const size_t n = (size_t)TT * D;
    for (size_t i = vt; i < n; i += vs) {
        const int d = (int)(i % D); const int t = (int)(i / D); const int b = t / LL, s = t % LL; const int r = s < CTX ? NB : b;
        const float* m = p.mod + ((size_t)l * NMOD + r) * 6 * D;
        p.xm[i] = f2bf(p.xs[i] * (1.0f + m[D + d]) + m[d]);
    }
}

typedef short bf16x8_t __attribute__((ext_vector_type(8)));
typedef float f32x16_t __attribute__((ext_vector_type(16)));
typedef __bf16 bf16v2_t __attribute__((ext_vector_type(2)));
typedef float f32v2_t __attribute__((ext_vector_type(2)));
DEVFN unsigned cvt_pk_bf16_h(float lo, float hi) { const f32v2_t v = {lo, hi}; const bf16v2_t r = __builtin_convertvector(v, bf16v2_t); return __builtin_bit_cast(unsigned, r); }
DEVFN unsigned cvt_pk_bf16(float lo, float hi) { unsigned r; asm volatile("v_cvt_pk_bf16_f32 %0, %1, %2" : "=v"(r) : "v"(lo), "v"(hi)); return r; }
union Frag8 { bf16x8_t v; unsigned u[4]; uint2 d2[2]; uint4 q; };


DEVFN void ph_rw_mix(const Params& p, int l, size_t vt, size_t vs) {
    static_assert(RW_IN % 8 == 0 && (3 * GD) % 8 == 0 && (2 * RW_WL) % 8 == 0 && (2 * RW_AL) % 8 == 0, "8-column groups");
    constexpr int NG = RW_IN / 8;
    const size_t n = (size_t)TT * NG;
    for (size_t i = vt; i < n; i += vs) {
        const int col = (int)(i % NG) * 8; const int t = (int)(i / NG); const int s_ = t % LL;
        const bool first = (s_ == 0 || s_ == CTX), last = (s_ == CTX - 1 || s_ == LL - 1);
        const bf16_t* pc = p.P + (size_t)t * N_IN + OFF_RW + col;
        const uint4 cv = *(const uint4*)pc;
        const uint4 pv = first ? make_uint4(0, 0, 0, 0) : *(const uint4*)(pc - N_IN);
        const uint4 nv = last ? make_uint4(0, 0, 0, 0) : *(const uint4*)(pc + N_IN);
        const float* m0 = p.rw_mu + ((size_t)l * 2 + 0) * RW_IN + col; const float* m1 = p.rw_mu + ((size_t)l * 2 + 1) * RW_IN + col;
        const float4 a0 = *(const float4*)m0, a1 = *(const float4*)(m0 + 4), b0 = *(const float4*)m1, b1 = *(const float4*)(m1 + 4);
        const float mu0[8] = {a0.x, a0.y, a0.z, a0.w, a1.x, a1.y, a1.z, a1.w}, mu1[8] = {b0.x, b0.y, b0.z, b0.w, b1.x, b1.y, b1.z, b1.w};
        const unsigned cw[4] = {cv.x, cv.y, cv.z, cv.w}, pw[4] = {pv.x, pv.y, pv.z, pv.w}, nw[4] = {nv.x, nv.y, nv.z, nv.w};
        float o[8];
#pragma unroll
        for (int k = 0; k < 4; ++k) {
            const float v0 = bflo(cw[k]), v1 = bfhi(cw[k]);
            o[2 * k] = v0 + mu0[2 * k] * (bflo(pw[k]) - v0) + mu1[2 * k] * (bflo(nw[k]) - v0);
            o[2 * k + 1] = v1 + mu0[2 * k + 1] * (bfhi(pw[k]) - v1) + mu1[2 * k + 1] * (bfhi(nw[k]) - v1);
        }
        if (col >= 3 * GD && col < 3 * GD + 2 * RW_WL) {
#pragma unroll
            for (int k = 0; k < 8; ++k) o[k] = tanhf(o[k]);
        } else if (col >= 3 * GD + 2 * RW_WL + 2 * RW_AL) {
#pragma unroll
            for (int k = 0; k < 8; ++k) o[k] = sigmoidf_(o[k]);
        }
        float* po = p.pm + (size_t)t * RW_IN + col;
        *(float4*)po = make_float4(o[0], o[1], o[2], o[3]); *(float4*)(po + 4) = make_float4(o[4], o[5], o[6], o[7]);
        if (col >= 3 * GD) *(uint4*)(p.pmb + (size_t)t * KLO + (col - 3 * GD)) = make_uint4(pk2(o[0], o[1]), pk2(o[2], o[3]), pk2(o[4], o[5]), pk2(o[6], o[7]));
    }
}

DEVFN void ph_rw_prep(const Params& p, int l, size_t vt, size_t vs) {
    static_assert(HD == 64, "one head = 16 lanes x 4 columns");
    constexpr int NG = GD / 4;
    const size_t n = (size_t)TT * NG;
    static_assert(512 % NG == 0, "column group fixed per thread");
    const int c = (int)(vt % NG) * 4;
    const float4 kk4 = *(const float4*)(p.rw_k_k + (size_t)l * GD + c), ka4 = *(const float4*)(p.rw_k_a + (size_t)l * GD + c);
    const float4 w0c[2] = {*(const float4*)(p.rw_w0 + ((size_t)l * 2 + 0) * GD + c), *(const float4*)(p.rw_w0 + ((size_t)l * 2 + 1) * GD + c)};
    const float4 a0c[2] = {*(const float4*)(p.rw_a0 + ((size_t)l * 2 + 0) * GD + c), *(const float4*)(p.rw_a0 + ((size_t)l * 2 + 1) * GD + c)};
    for (size_t i = vt; i < n; i += vs) {
        const int t = (int)(i / NG);
        const float4 k4 = *(const float4*)(p.pm + (size_t)t * RW_IN + GD + c);
        const float k[4] = {k4.x, k4.y, k4.z, k4.w}, kkw[4] = {kk4.x, kk4.y, kk4.z, kk4.w}, ka[4] = {ka4.x, ka4.y, ka4.z, ka4.w};
        float kkr[4], ss = 0.f;
#pragma unroll
        for (int q = 0; q < 4; ++q) { kkr[q] = k[q] * kkw[q]; ss += kkr[q] * kkr[q]; }
#pragma unroll
        for (int o = 8; o > 0; o >>= 1) ss += __shfl_xor(ss, o);
        const float rn = 1.0f / sqrtf(fmaxf(ss, 1e-12f));
        const bf16_t* lo = p.LO + (size_t)t * NLO + c;
        float kkv[4];
#pragma unroll
        for (int q = 0; q < 4; ++q) kkv[q] = kkr[q] * rn;
#pragma unroll
        for (int dir = 0; dir < 2; ++dir) {
            const uint2 wl = *(const uint2*)(lo + dir * GD), al = *(const uint2*)(lo + 2 * GD + dir * GD);
            const float4 w0 = w0c[dir], a0 = a0c[dir];
            const float wp[4] = {w0.x + bflo(wl.x), w0.y + bfhi(wl.x), w0.z + bflo(wl.y), w0.w + bfhi(wl.y)};
            const float ap[4] = {a0.x + bflo(al.x), a0.y + bfhi(al.x), a0.z + bflo(al.y), a0.w + bfhi(al.y)};
            float dec[4], bv[4], kd[4];
#pragma unroll
            for (int q = 0; q < 4; ++q) { const float av = sigmoidf_(ap[q]); dec[q] = expf(-RW_DECAY_SCALE * sigmoidf_(wp[q])); bv[q] = kkv[q] * av; kd[q] = k[q] * (1.0f + (av - 1.0f) * ka[q]); }
            const size_t o = ((size_t)dir * TT + t) * GD + c;
            *(float4*)(p.rwW + o) = make_float4(dec[0], dec[1], dec[2], dec[3]); *(float4*)(p.rwB + o) = make_float4(bv[0], bv[1], bv[2], bv[3]); *(float4*)(p.rwKD + o) = make_float4(kd[0], kd[1], kd[2], kd[3]);
        }
        const uint2 gl = *(const uint2*)(lo + 4 * GD);
        *(float4*)(p.rwKK + (size_t)t * GD + c) = make_float4(kkv[0], kkv[1], kkv[2], kkv[3]);
        *(float4*)(p.rwG + (size_t)t * GD + c) = make_float4(bflo(gl.x), bfhi(gl.x), bflo(gl.y), bfhi(gl.y));
    }
}

DEVFN int scan_pos(int dir, int step) {
    if (dir == 0) return step;
    return step < CTX ? (CTX - 1 - step) : (CTX + (SEQ - 1) - (step - CTX));
}

constexpr int CK = 64, NCHK = LL / CK, NU = NB * NH * 2;
constexpr int RWS = 8;
constexpr int RW_ROW = 6 * HD;
constexpr int RW_STG = RWS * RW_ROW;
typedef float f2v __attribute__((ext_vector_type(2)));
template <int MODE>
DEVFN void rw_chunk_item(const Params& p, float* lds_f, const int item) {
    constexpr bool DO_T = MODE != 2, DO_L = MODE != 1;
    static_assert(HD == 64 && CTX % CK == 0 && SEQ % CK == 0 && CK % RWS == 0, "chunking");
    const int lane = (TIDX() & 63);
    float* stg = lds_f + (size_t)__builtin_amdgcn_readfirstlane((TIDX() >> 6)) * RW_STG;
    {
        const int c = item % NCHK, u = item / NCHK;
        const int dir = u % 2, h = (u / 2) % NH, b = u / (2 * NH);
        f2v ST[HD / 2], SL[HD / 2];
#pragma unroll
        for (int j = 0; j < HD / 2; ++j) { ST[j] = (f2v){(2 * j == lane) ? 1.f : 0.f, (2 * j + 1 == lane) ? 1.f : 0.f}; SL[j] = (f2v){0.f, 0.f}; }
        float4 na0, na1, na2, na3, na4, na5, nb0, nb1, nb2, nb3, nb4, nb5;
#define RWC_LOAD1(q_, sub_, X0, X1, X2, X3, X4, X5) do { const int t_ = b * LL + scan_pos(dir, c * CK + (sub_) * RWS + (q_) * 4 + lrow_); \
                X0 = *(const float4*)(p.rwW + ((size_t)dir * TT + t_) * GD + h * HD + lcol_); X1 = *(const float4*)(p.rwB + ((size_t)dir * TT + t_) * GD + h * HD + lcol_); \
                X2 = *(const float4*)(p.rwKD + ((size_t)dir * TT + t_) * GD + h * HD + lcol_); X3 = *(const float4*)(p.rwKK + (size_t)t_ * GD + h * HD + lcol_); \
                X4 = *(const float4*)(p.pm + (size_t)t_ * RW_IN + h * HD + lcol_); X5 = *(const float4*)(p.pm + (size_t)t_ * RW_IN + 2 * GD + h * HD + lcol_); } while (0)
#define RWC_LOAD(sub_) do { int lrow_ = lane >> 4, lcol_ = (lane & 15) * 4; asm volatile("" : "+v"(lrow_), "+v"(lcol_)); \
            RWC_LOAD1(0, sub_, na0, na1, na2, na3, na4, na5); RWC_LOAD1(1, sub_, nb0, nb1, nb2, nb3, nb4, nb5); } while (0)
        RWC_LOAD(0);
#pragma unroll 1
        for (int sub = 0; sub < CK / RWS; ++sub) {
            __builtin_amdgcn_wave_barrier();
            {
                int lrow = lane >> 4, lcol = (lane & 15) * 4;
                asm volatile("" : "+v"(lrow), "+v"(lcol));
                float* d0 = stg + (lrow) * RW_ROW + lcol; float* d1 = stg + (4 + lrow) * RW_ROW + lcol;
                *(float4*)(d0) = na0; *(float4*)(d0 + HD) = na1; *(float4*)(d0 + 2 * HD) = na2; *(float4*)(d0 + 3 * HD) = na3; *(float4*)(d0 + 4 * HD) = na4; *(float4*)(d0 + 5 * HD) = na5;
                *(float4*)(d1) = nb0; *(float4*)(d1 + HD) = nb1; *(float4*)(d1 + 2 * HD) = nb2; *(float4*)(d1 + 3 * HD) = nb3; *(float4*)(d1 + 4 * HD) = nb4; *(float4*)(d1 + 5 * HD) = nb5;
            }
            if (sub + 1 < CK / RWS) RWC_LOAD(sub + 1);
            __builtin_amdgcn_wave_barrier();
#pragma unroll 1
            for (int st = 0; st < RWS; ++st) {
                const float* sv = stg + st * RW_ROW;
                const int gs = c * CK + sub * RWS + st;
                f2v aT = {0.f, 0.f}, aL = {0.f, 0.f};
                float4 kkn = *(const float4*)(sv + 3 * HD);
#pragma unroll
                for (int j = 0; j < HD; j += 4) {
                    const float4 kk = kkn;
                    if (j + 4 < HD) kkn = *(const float4*)(sv + 3 * HD + j + 4);
                    asm volatile("" ::: "memory");
                    const f2v k0 = {kk.x, kk.y}, k1 = {kk.z, kk.w};
                    if (DO_T) { aT += ST[j / 2] * k0; aT += ST[j / 2 + 1] * k1; }
                    if (DO_L) { aL += SL[j / 2] * k0; aL += SL[j / 2 + 1] * k1; }
                }
                const float saT = -(aT.x + aT.y), saL = -(aL.x + aL.y);
                const f2v saT2 = {saT, saT}, saL2 = {saL, saL};
                int ln0 = lane; asm volatile("" : "+v"(ln0));
                const float vi = sv[5 * HD + ln0];
                const f2v vi2 = {vi, vi};
                f2v yT2 = {0.f, 0.f}, yL2 = {0.f, 0.f};
                float4 wn = *(const float4*)(sv), bn = *(const float4*)(sv + HD), kdn = *(const float4*)(sv + 2 * HD), rn = *(const float4*)(sv + 4 * HD);
#pragma unroll
                for (int j = 0; j < HD; j += 4) {
                    const float4 w = wn, bb = bn, kd = kdn, r = rn;
                    if (j + 4 < HD) { wn = *(const float4*)(sv + j + 4); bn = *(const float4*)(sv + HD + j + 4); if (DO_L) kdn = *(const float4*)(sv + 2 * HD + j + 4); rn = *(const float4*)(sv + 4 * HD + j + 4); }
                    asm volatile("" ::: "memory");
                    const f2v w0 = {w.x, w.y}, w1 = {w.z, w.w}, b0 = {bb.x, bb.y}, b1 = {bb.z, bb.w}, r0 = {r.x, r.y}, r1 = {r.z, r.w};
                    if (DO_T) {
                        ST[j / 2] = ST[j / 2] * w0 + saT2 * b0; ST[j / 2 + 1] = ST[j / 2 + 1] * w1 + saT2 * b1;
                        yT2 += ST[j / 2] * r0; yT2 += ST[j / 2 + 1] * r1;
                    }
                    if (DO_L) {
                        const f2v d0 = {kd.x, kd.y}, d1 = {kd.z, kd.w};
                        SL[j / 2] = SL[j / 2] * w0 + saL2 * b0 + vi2 * d0; SL[j / 2 + 1] = SL[j / 2 + 1] * w1 + saL2 * b1 + vi2 * d1;
                        yL2 += SL[j / 2] * r0; yL2 += SL[j / 2 + 1] * r1;
                    }
                }
                int ln = lane; asm volatile("" : "+v"(ln));
                if (DO_T) p.rwYI[((size_t)u * LL + gs) * HD + ln] = f2bf(yT2.x + yT2.y);
                if (DO_L) p.rwYloc[((size_t)u * LL + gs) * HD + ln] = yL2.x + yL2.y;
            }
        }
#undef RWC_LOAD
#undef RWC_LOAD1
        if (DO_T) {
        bf16_t* oT = p.rwMsT + ((size_t)u * NCHK + c) * HD * HD;
#pragma unroll
        for (int j = 0; j < HD; ++j) oT[(size_t)j * HD + lane] = f2bf((j & 1) ? ST[j / 2].y : ST[j / 2].x);
        }
        if (DO_L) {
        float* oL = p.rwSloc + (((size_t)u * NCHK + c) * HD + lane) * HD;
#pragma unroll
        for (int j = 0; j < HD; j += 4) *(float4*)(oL + j) = make_float4(SL[j / 2].x, SL[j / 2].y, SL[j / 2 + 1].x, SL[j / 2 + 1].y);
        }
    }
}

template <bool ISL>
DEVFN void rw_chunk_quarter(const Params& p, float* lds_f, const int item, const int rh) {
    const int lane = (TIDX() & 63);
    float* stg = lds_f + (size_t)__builtin_amdgcn_readfirstlane((TIDX() >> 6)) * RW_STG;
    const int c = item % NCHK, u = item / NCHK;
    const int dir = u % 2, h = (u / 2) % NH, b = u / (2 * NH);
    const int row = rh * 32 + (lane & 31), co = 32 * (lane >> 5);
    f2v S[16];
#pragma unroll
    for (int j = 0; j < 16; ++j) S[j] = ISL ? (f2v){0.f, 0.f} : (f2v){(co + 2 * j == row) ? 1.f : 0.f, (co + 2 * j + 1 == row) ? 1.f : 0.f};
    float4 na0, na1, na2, na3, na4, na5, nb0, nb1, nb2, nb3, nb4, nb5;
#define RWC_LOAD1(q_, sub_, X0, X1, X2, X3, X4, X5) do { const int t_ = b * LL + scan_pos(dir, c * CK + (sub_) * RWS + (q_) * 4 + lrow_); \
            X0 = *(const float4*)(p.rwW + ((size_t)dir * TT + t_) * GD + h * HD + lcol_); X1 = *(const float4*)(p.rwB + ((size_t)dir * TT + t_) * GD + h * HD + lcol_); \
            X2 = *(const float4*)(p.rwKD + ((size_t)dir * TT + t_) * GD + h * HD + lcol_); X3 = *(const float4*)(p.rwKK + (size_t)t_ * GD + h * HD + lcol_); \
            X4 = *(const float4*)(p.pm + (size_t)t_ * RW_IN + h * HD + lcol_); X5 = *(const float4*)(p.pm + (size_t)t_ * RW_IN + 2 * GD + h * HD + lcol_); } while (0)
#define RWC_LOAD(sub_) do { int lrow_ = lane >> 4, lcol_ = (lane & 15) * 4; asm volatile("" : "+v"(lrow_), "+v"(lcol_)); \
        RWC_LOAD1(0, sub_, na0, na1, na2, na3, na4, na5); RWC_LOAD1(1, sub_, nb0, nb1, nb2, nb3, nb4, nb5); } while (0)
    RWC_LOAD(0);
#pragma unroll 1
    for (int sub = 0; sub < CK / RWS; ++sub) {
        __builtin_amdgcn_wave_barrier();
        {
            int lrow = lane >> 4, lcol = (lane & 15) * 4;
            asm volatile("" : "+v"(lrow), "+v"(lcol));
            float* d0 = stg + (lrow) * RW_ROW + lcol; float* d1 = stg + (4 + lrow) * RW_ROW + lcol;
            *(float4*)(d0) = na0; *(float4*)(d0 + HD) = na1; *(float4*)(d0 + 2 * HD) = na2; *(float4*)(d0 + 3 * HD) = na3; *(float4*)(d0 + 4 * HD) = na4; *(float4*)(d0 + 5 * HD) = na5;
            *(float4*)(d1) = nb0; *(float4*)(d1 + HD) = nb1; *(float4*)(d1 + 2 * HD) = nb2; *(float4*)(d1 + 3 * HD) = nb3; *(float4*)(d1 + 4 * HD) = nb4; *(float4*)(d1 + 5 * HD) = nb5;
        }
        if (sub + 1 < CK / RWS) RWC_LOAD(sub + 1);
        __builtin_amdgcn_wave_barrier();
#pragma unroll 1
        for (int st = 0; st < RWS; ++st) {
            int co_ = co; asm volatile("" : "+v"(co_));
            const float* sv = stg + st * RW_ROW + co_;
            const int gs = c * CK + sub * RWS + st;
            f2v a2 = {0.f, 0.f};
#pragma unroll
            for (int j = 0; j < 32; j += 4) {
                const float4 kk = *(const float4*)(sv + 3 * HD + j);
                a2 += S[j / 2] * (f2v){kk.x, kk.y}; a2 += S[j / 2 + 1] * (f2v){kk.z, kk.w};
            }
            float sap = a2.x + a2.y; sap += __shfl_xor(sap, 32);
            const f2v sa2 = {-sap, -sap};
            int rw_ = row; asm volatile("" : "+v"(rw_));
            const float vi = ISL ? stg[st * RW_ROW + 5 * HD + rw_] : 0.f;
            const f2v vi2 = {vi, vi};
            f2v y2 = {0.f, 0.f};
#pragma unroll
            for (int j = 0; j < 32; j += 4) {
                asm volatile("" ::: "memory");
                const float4 w = *(const float4*)(sv + j), bb = *(const float4*)(sv + HD + j), r = *(const float4*)(sv + 4 * HD + j);
                const f2v w0 = {w.x, w.y}, w1 = {w.z, w.w}, b0 = {bb.x, bb.y}, b1 = {bb.z, bb.w}, r0 = {r.x, r.y}, r1 = {r.z, r.w};
                if (ISL) { const float4 kd = *(const float4*)(sv + 2 * HD + j); S[j / 2] = S[j / 2] * w0 + sa2 * b0 + vi2 * (f2v){kd.x, kd.y}; S[j / 2 + 1] = S[j / 2 + 1] * w1 + sa2 * b1 + vi2 * (f2v){kd.z, kd.w}; }
                else { S[j / 2] = S[j / 2] * w0 + sa2 * b0; S[j / 2 + 1] = S[j / 2 + 1] * w1 + sa2 * b1; }
                y2 += S[j / 2] * r0; y2 += S[j / 2 + 1] * r1;
            }
            float yp = y2.x + y2.y; yp += __shfl_xor(yp, 32);
            if (lane < 32) { if (ISL) p.rwYloc[((size_t)u * LL + gs) * HD + rw_] = yp; else p.rwYI[((size_t)u * LL + gs) * HD + rw_] = f2bf(yp); }
        }
    }
#undef RWC_LOAD
#undef RWC_LOAD1
    if (!ISL) {
        bf16_t* oT = p.rwMsT + ((size_t)u * NCHK + c) * HD * HD;
#pragma unroll
        for (int j = 0; j < 32; ++j) oT[(size_t)(co + j) * HD + row] = f2bf((j & 1) ? S[j / 2].y : S[j / 2].x);
    } else {
        float* oL = p.rwSloc + (((size_t)u * NCHK + c) * HD + row) * HD + co;
#pragma unroll
        for (int j = 0; j < 32; j += 4) *(float4*)(oL + j) = make_float4(S[j / 2].x, S[j / 2].y, S[j / 2 + 1].x, S[j / 2 + 1].y);
    }
}

constexpr int RSQ_D = 4;
constexpr int RSQ_SLOT = HD * HD * 2 + HD * HD * 4;
DEVFN void ph_rw_seq(const Params& p, unsigned char* lds_b, int vb, int nvb) {
    static_assert(NCHK % RSQ_D == 0 && RSQ_D == 4 && RSQ_SLOT == 3 * 512 * 16, "chain geometry: 3 x 16 B per thread per chunk");
    const int tid = TIDX(), lane = tid & 63, wave = tid >> 6, li = lane & 31, lh = lane >> 5;
    for (int u = vb; u < NU; u += nvb) {
        const unsigned char* gM = (const unsigned char*)(p.rwMsT + (size_t)u * NCHK * HD * HD);
        const unsigned char* gS = (const unsigned char*)(p.rwSloc + (size_t)u * NCHK * HD * HD);
        uint4 pf[RSQ_D][3];
#define RSQ_LOAD(d, c_) do { pf[d][0] = *(const uint4*)(gM + (size_t)(c_) * (HD * HD * 2) + tid * 16); \
            pf[d][1] = *(const uint4*)(gS + (size_t)(c_) * (HD * HD * 4) + tid * 16); pf[d][2] = *(const uint4*)(gS + (size_t)(c_) * (HD * HD * 4) + 8192 + tid * 16); } while (0)
#pragma unroll
        for (int d = 0; d < RSQ_D; ++d) RSQ_LOAD(d, d);
        f32x16_t X0, X1;
#pragma unroll
        for (int r = 0; r < 16; ++r) { X0[r] = 0.f; X1[r] = 0.f; }
        const int i = wave * 32 + li;
        __syncthreads();
#define RSQ_STEP(d, P0, P1, P2) { \
                const int c = c0 + d; \
                unsigned char* slot = lds_b + (c & 1) * RSQ_SLOT; \
                *(uint4*)(slot + tid * 16) = P0; *(uint4*)(slot + HD * HD * 2 + tid * 16) = P1; *(uint4*)(slot + HD * HD * 2 + 8192 + tid * 16) = P2; \
                if (c + RSQ_D < NCHK) { P0 = *(const uint4*)(gM + (size_t)(c + RSQ_D) * (HD * HD * 2) + tid * 16); P1 = *(const uint4*)(gS + (size_t)(c + RSQ_D) * (HD * HD * 4) + tid * 16); P2 = *(const uint4*)(gS + (size_t)(c + RSQ_D) * (HD * HD * 4) + 8192 + tid * 16); } \
                __syncthreads(); \
                if (wave < 2) { \
                    const bf16_t* ms = (const bf16_t*)slot; const float* sl = (const float*)(slot + HD * HD * 2) + (size_t)i * HD; \
                    Frag8 xb[2][2]; \
_Pragma("unroll") \
                    for (int sp = 0; sp < 2; ++sp) \
_Pragma("unroll") \
                        for (int q = 0; q < 4; ++q) { \
                            xb[0][sp].u[q] = cvt_pk_bf16_h(X0[8 * sp + 2 * q], X0[8 * sp + 2 * q + 1]); \
                            xb[1][sp].u[q] = cvt_pk_bf16_h(X1[8 * sp + 2 * q], X1[8 * sp + 2 * q + 1]); \
                        } \
                    f32x16_t N0, N1; \
_Pragma("unroll") \
                    for (int g = 0; g < 4; ++g) { \
                        const float4 v0 = *(const float4*)(sl + 8 * g + 4 * lh), v1 = *(const float4*)(sl + 32 + 8 * g + 4 * lh); \
                        N0[4 * g] = v0.x; N0[4 * g + 1] = v0.y; N0[4 * g + 2] = v0.z; N0[4 * g + 3] = v0.w; \
                        N1[4 * g] = v1.x; N1[4 * g + 1] = v1.y; N1[4 * g + 2] = v1.z; N1[4 * g + 3] = v1.w; \
                    } \
_Pragma("unroll") \
                    for (int jb = 0; jb < 2; ++jb) \
_Pragma("unroll") \
                        for (int sp = 0; sp < 2; ++sp) { \
                            Frag8 a0, a1; \
                            a0.d2[0] = *(const uint2*)(ms + (li) * HD + 32 * jb + 16 * sp + 4 * lh); a0.d2[1] = *(const uint2*)(ms + (li) * HD + 32 * jb + 16 * sp + 4 * lh + 8); \
                            a1.d2[0] = *(const uint2*)(ms + (32 + li) * HD + 32 * jb + 16 * sp + 4 * lh); a1.d2[1] = *(const uint2*)(ms + (32 + li) * HD + 32 * jb + 16 * sp + 4 * lh + 8); \
                            N0 = __builtin_amdgcn_mfma_f32_32x32x16_bf16(a0.v, xb[jb][sp].v, N0, 0, 0, 0); \
                            N1 = __builtin_amdgcn_mfma_f32_32x32x16_bf16(a1.v, xb[jb][sp].v, N1, 0, 0, 0); \
                        } \
                    float* so = p.rwSloc + (((size_t)u * NCHK + c) * HD + i) * HD; \
_Pragma("unroll") \
                    for (int g = 0; g < 4; ++g) { \
                        *(float4*)(so + 8 * g + 4 * lh) = make_float4(N0[4 * g], N0[4 * g + 1], N0[4 * g + 2], N0[4 * g + 3]); \
                        *(float4*)(so + 32 + 8 * g + 4 * lh) = make_float4(N1[4 * g], N1[4 * g + 1], N1[4 * g + 2], N1[4 * g + 3]); \
                    } \
                    X0 = N0; X1 = N1; \
                } \
 \
            }
        uint4 pa0, pa1, pa2, pb0, pb1, pb2, pc0, pc1, pc2, pd0, pd1, pd2;
        pa0 = pf[0][0]; pa1 = pf[0][1]; pa2 = pf[0][2]; pb0 = pf[1][0]; pb1 = pf[1][1]; pb2 = pf[1][2]; pc0 = pf[2][0]; pc1 = pf[2][1]; pc2 = pf[2][2]; pd0 = pf[3][0]; pd1 = pf[3][1]; pd2 = pf[3][2];
        for (int c0 = 0; c0 < NCHK; c0 += RSQ_D) {
            RSQ_STEP(0, pa0, pa1, pa2) RSQ_STEP(1, pb0, pb1, pb2) RSQ_STEP(2, pc0, pc1, pc2) RSQ_STEP(3, pd0, pd1, pd2)
        }
#undef RSQ_LOAD
#undef RSQ_STEP
        __syncthreads();
    }
}

DEVFN int rev_gs(int s) { return s < CTX ? (CTX - 1 - s) : (CTX + (SEQ - 1) - (s - CTX)); }
DEVFN int rev_chunk(int pbk) { return pbk < CTX / CK ? (CTX / CK - 1 - pbk) : (CTX / CK + (SEQ / CK - 1) - (pbk - CTX / CK)); }

struct RwyT { float4 v0, v1, v2, v3, v4, v5, v6, v7; };
DEVFN RwyT rwy_load(const float* row0, size_t pitch) {
    const int lane = (TIDX() & 63); const int tr = lane >> 4, pc = lane & 15;
    const float* src = row0 + (size_t)tr * pitch + pc * 4;
    RwyT r; r.v0 = *(const float4*)(src); r.v1 = *(const float4*)(src + 4 * pitch); r.v2 = *(const float4*)(src + 8 * pitch); r.v3 = *(const float4*)(src + 12 * pitch);
    r.v4 = *(const float4*)(src + 16 * pitch); r.v5 = *(const float4*)(src + 20 * pitch); r.v6 = *(const float4*)(src + 24 * pitch); r.v7 = *(const float4*)(src + 28 * pitch);
    return r;
}
DEVFN void rwy_put(const RwyT& r, float* tile) {
    const int lane = (TIDX() & 63); const int tr = lane >> 4, pc = lane & 15;
    float* dst = tile + tr * 68 + pc * 4;
    __builtin_amdgcn_wave_barrier();
    *(float4*)(dst) = r.v0; *(float4*)(dst + 4 * 68) = r.v1; *(float4*)(dst + 8 * 68) = r.v2; *(float4*)(dst + 12 * 68) = r.v3;
    *(float4*)(dst + 16 * 68) = r.v4; *(float4*)(dst + 20 * 68) = r.v5; *(float4*)(dst + 24 * 68) = r.v6; *(float4*)(dst + 28 * 68) = r.v7;
    __builtin_amdgcn_wave_barrier();
}
DEVFN void ph_rw_yout(const Params& p, int l, float* lds_f, size_t vt, size_t vs) {
    const int lane = (TIDX() & 63), lq = lane & 31, lh = lane >> 5;
    float* tile = lds_f + (size_t)__builtin_amdgcn_readfirstlane(TIDX() >> 6) * 4096;
    bf16_t* otile = (bf16_t*)(tile + 32 * 68);
    const int wv = __builtin_amdgcn_readfirstlane((int)(vt >> 6)), nwv = (int)(vs >> 6);
    const int nbk = nwv >> 3, nmb = NB * MB_GROUPS * NCHK;
    const int skip = (nbk >= 64 && nmb > nbk && nmb <= nbk + nbk / 4) ? nmb - nbk : 0;
    if ((wv >> 3) < skip) return;
    const int wvs = (wv & 7) * (nbk - skip) + ((wv >> 3) - skip);
    for (int item = wvs; item < NB * NH * NCHK; item += 8 * (nbk - skip)) {
        const int pbk = item % NCHK, h = (item / NCHK) % NH, b = item / (NCHK * NH);
        f32x16_t acc[2][2];
#pragma unroll
        for (int dir = 0; dir < 2; ++dir) {
            const int u = (b * NH + h) * 2 + dir;
            const int c = dir == 0 ? pbk : rev_chunk(pbk);
            int gs[2];
#pragma unroll
            for (int tb = 0; tb < 2; ++tb) { const int s_ = CK * pbk + 32 * tb + lq; gs[tb] = dir == 0 ? s_ : rev_gs(s_); }
#pragma unroll
            for (int tb = 0; tb < 2; ++tb) {
                const float* yl = p.rwYloc + ((size_t)u * LL + gs[tb]) * HD;
#pragma unroll
                for (int ib = 0; ib < 2; ++ib)
#pragma unroll
                    for (int g = 0; g < 4; ++g) {
                        const float4 v = *(const float4*)(yl + 32 * ib + 8 * g + 4 * lh);
                        if (dir == 0) { acc[ib][tb][4 * g] = v.x; acc[ib][tb][4 * g + 1] = v.y; acc[ib][tb][4 * g + 2] = v.z; acc[ib][tb][4 * g + 3] = v.w; }
                        else { acc[ib][tb][4 * g] += v.x; acc[ib][tb][4 * g + 1] += v.y; acc[ib][tb][4 * g + 2] += v.z; acc[ib][tb][4 * g + 3] += v.w; }
                    }
            }
            if (c > 0) {
                const float* st = p.rwSloc + ((size_t)u * NCHK + (c - 1)) * HD * HD;
#pragma unroll
                for (int ks = 0; ks < 4; ++ks) {
                    Frag8 a[2];
#pragma unroll
                    for (int ib = 0; ib < 2; ++ib) {
                        const float4 lo = *(const float4*)(st + (size_t)(32 * ib + lq) * HD + 16 * ks + 8 * lh), hi = *(const float4*)(st + (size_t)(32 * ib + lq) * HD + 16 * ks + 8 * lh + 4);
                        a[ib].u[0] = cvt_pk_bf16_h(lo.x, lo.y); a[ib].u[1] = cvt_pk_bf16_h(lo.z, lo.w); a[ib].u[2] = cvt_pk_bf16_h(hi.x, hi.y); a[ib].u[3] = cvt_pk_bf16_h(hi.z, hi.w);
                    }
#pragma unroll
                    for (int tb = 0; tb < 2; ++tb) {
                        const bf16x8_t bq = *(const bf16x8_t*)(p.rwYI + ((size_t)u * LL + gs[tb]) * HD + 16 * ks + 8 * lh);
#pragma unroll
                        for (int ib = 0; ib < 2; ++ib) acc[ib][tb] = __builtin_amdgcn_mfma_f32_32x32x16_bf16(a[ib].v, bq, acc[ib][tb], 0, 0, 0);
                    }
                }
            }
        }
#pragma unroll
        for (int tb = 0; tb < 2; ++tb) {
            const int t = b * LL + CK * pbk + 32 * tb + lq;
            float sum = 0.f;
#pragma unroll
            for (int ib = 0; ib < 2; ++ib)
#pragma unroll
                for (int r = 0; r < 16; ++r) sum += acc[ib][tb][r];
            sum += __shfl_xor(sum, 32);
            const float mu = sum * (1.0f / HD);
            float sq = 0.f;
#pragma unroll
            for (int ib = 0; ib < 2; ++ib)
#pragma unroll
                for (int r = 0; r < 16; ++r) { const float d = acc[ib][tb][r] - mu; sq += d * d; }
            sq += __shfl_xor(sq, 32);
            const float rs = 1.0f / sqrtf(sq * (1.0f / HD) + RW_GN_EPS);
            const size_t t0r = (size_t)(b * LL + CK * pbk + 32 * tb);
            const float* pr0 = p.pm + t0r * RW_IN + h * HD;
            const RwyT tr_ = rwy_load(pr0, RW_IN), tk_ = rwy_load(pr0 + GD, RW_IN), tv_ = rwy_load(pr0 + 2 * GD, RW_IN), tg_ = rwy_load(p.rwG + t0r * GD + h * HD, GD);
            float4 r4[8];
            rwy_put(tr_, tile);
#pragma unroll
            for (int q = 0; q < 8; ++q) r4[q] = *(const float4*)(tile + lq * 68 + 32 * (q >> 2) + 8 * (q & 3) + 4 * lh);
            rwy_put(tk_, tile);
            float bon = 0.f;
#pragma unroll
            for (int q = 0; q < 8; ++q) {
                const int i0 = 32 * (q >> 2) + 8 * (q & 3) + 4 * lh;
                const float4 k4 = *(const float4*)(tile + lq * 68 + i0), rk = *(const float4*)(p.rw_r_k + (size_t)l * GD + h * HD + i0);
                bon += r4[q].x * k4.x * rk.x + r4[q].y * k4.y * rk.y + r4[q].z * k4.z * rk.z + r4[q].w * k4.w * rk.w;
            }
            bon += __shfl_xor(bon, 32);
            rwy_put(tv_, tile);
            float4 v4[8];
#pragma unroll
            for (int q = 0; q < 8; ++q) v4[q] = *(const float4*)(tile + lq * 68 + 32 * (q >> 2) + 8 * (q & 3) + 4 * lh);
            rwy_put(tg_, tile);
#pragma unroll
            for (int ib = 0; ib < 2; ++ib)
#pragma unroll
                for (int g = 0; g < 4; ++g) {
                    const int i0 = 32 * ib + 8 * g + 4 * lh;
                    const float4 g4 = *(const float4*)(tile + lq * 68 + i0), vv = v4[4 * ib + g];
                    const float4 gg = *(const float4*)(p.rw_gn_g + (size_t)l * GD + h * HD + i0), gb = *(const float4*)(p.rw_gn_b + (size_t)l * GD + h * HD + i0);
                    const float o0 = ((acc[ib][tb][4 * g] - mu) * rs * gg.x + gb.x + bon * vv.x) * g4.x, o1 = ((acc[ib][tb][4 * g + 1] - mu) * rs * gg.y + gb.y + bon * vv.y) * g4.y;
                    const float o2 = ((acc[ib][tb][4 * g + 2] - mu) * rs * gg.z + gb.z + bon * vv.z) * g4.z, o3 = ((acc[ib][tb][4 * g + 3] - mu) * rs * gg.w + gb.w + bon * vv.w) * g4.w;
                    uint2 w; w.x = cvt_pk_bf16_h(o0, o1); w.y = cvt_pk_bf16_h(o2, o3);
                    *(uint2*)(otile + lq * 72 + i0) = w;
                }
            __builtin_amdgcn_wave_barrier();
#pragma unroll
            for (int i = 0; i < 4; ++i) {
                const int tr = (lane >> 3) + 8 * i, q8 = lane & 7;
                *(uint4*)(p.Ymix + (t0r + tr) * D_MIX + 0 * GD + h * HD + q8 * 8) = *(const uint4*)(otile + tr * 72 + q8 * 8);
            }
            __builtin_amdgcn_wave_barrier();
        }
    }
}

DEVFN size_t mb_frag_off(int t, int nn) {
    const int grp = nn >> 7, n = nn & 127;
    return ((size_t)((t >> 6) * MB_GROUPS + grp)) * (64 * MB_STATE) + (size_t)((((((t >> 5) & 1) * 8 + (n >> 4)) * 2 + ((n >> 3) & 1)) * 32 + (t & 31)) * 8);
}
DEVFN int tile_frag_off(int r, int pc) { return ((((r >> 5) * 4 + (pc >> 1)) * 2 + (pc & 1)) * 32 + (r & 31)) * 8; }
DEVFN void ph_mb_prep(const Params& p, int l, size_t vt, size_t vs) {
    static_assert(MB_CONV_DIM % 8 == 0 && MB_CONV == 5 && (GD + MB_GROUPS * MB_STATE) % 8 == 0, "8-channel groups");
    constexpr int NG = MB_CONV_DIM / 8;
    const size_t n = (size_t)TT * NG;
    static_assert(512 % NG == 0, "channel group fixed per thread");
    const int c = (int)(vt % NG) * 8;
    const float4 b0 = *(const float4*)(p.mb_conv_b + (size_t)l * MB_CONV_DIM + c), b1 = *(const float4*)(p.mb_conv_b + (size_t)l * MB_CONV_DIM + c + 4);
    float4 wq0[MB_CONV], wq1[MB_CONV];
#pragma unroll
    for (int j = 0; j < MB_CONV; ++j) { const float* wp = p.mb_conv_w + ((size_t)l * MB_CONV + j) * MB_CONV_DIM + c; wq0[j] = *(const float4*)wp; wq1[j] = *(const float4*)(wp + 4); }
    for (size_t i = vt; i < n; i += vs) {
        const int t = (int)(i / NG); const int s_ = t % LL;
        const int lo = s_ < CTX ? 0 : CTX, hi = s_ < CTX ? CTX : LL;
        float acc[8] = {b0.x, b0.y, b0.z, b0.w, b1.x, b1.y, b1.z, b1.w};
#pragma unroll
        for (int j = 0; j < MB_CONV; ++j) {
            const int so = s_ + j - MB_CONV / 2;
            if (so >= lo && so < hi) {
                const uint4 xv = *(const uint4*)(p.P + (size_t)(t + j - MB_CONV / 2) * N_IN + OFF_MB + GD + c);
                const float4 w0 = wq0[j], w1 = wq1[j];
                acc[0] += w0.x * bflo(xv.x); acc[1] += w0.y * bfhi(xv.x); acc[2] += w0.z * bflo(xv.y); acc[3] += w0.w * bfhi(xv.y);
                acc[4] += w1.x * bflo(xv.z); acc[5] += w1.y * bfhi(xv.z); acc[6] += w1.z * bflo(xv.w); acc[7] += w1.w * bfhi(xv.w);
            }
        }
#pragma unroll
        for (int k = 0; k < 8; ++k) acc[k] = siluf_(acc[k]);
        float* xo = p.xc + (size_t)t * MB_CONV_DIM + c;
        *(float4*)xo = make_float4(acc[0], acc[1], acc[2], acc[3]); *(float4*)(xo + 4) = make_float4(acc[4], acc[5], acc[6], acc[7]);
    }
    const size_t n2 = (size_t)TT * 2 * NH;
    for (size_t i = vt; i < n2; i += vs) {
        const int q = (int)(i % (2 * NH)); const int t = (int)(i / (2 * NH));
        p.dt[i] = softplusf_(bf2f(p.P[(size_t)t * N_IN + OFF_MB + GD + MB_CONV_DIM + q]) + p.mb_dt_bias[(size_t)l * 2 * NH + q]);
    }
}

DEVFN void ph_bc_frag(const Params& p, int vb, int nvb) {
    const int tid = TIDX(); const int r = tid >> 3, pc = tid & 7;
    for (int u = vb; u < (TT / 64) * 8; u += nvb) {
        const int nb4 = u & 3, isC = (u >> 2) & 1, tb = u >> 3;
        const int t = tb * 64 + r; const int nn = nb4 * 64 + pc * 8;
        const float* src = p.xc + (size_t)t * MB_CONV_DIM + GD + isC * (MB_GROUPS * MB_STATE) + nn;
        const float4 a = *(const float4*)src, c4 = *(const float4*)(src + 4);
        *(uint4*)((isC ? p.mbC : p.mbB) + mb_frag_off(t, nn)) = make_uint4(pk2(a.x, a.y), pk2(a.z, a.w), pk2(c4.x, c4.y), pk2(c4.z, c4.w));
    }
}

constexpr int MB_STG = 256;
DEVFN void mb_chunk_item(const Params& p, int l, float* lds_f, const int item) {
    static_assert(MB_STATE == 128 && HD == 64 && CK == 64, "mamba chunk geometry");
    const int lane = (TIDX() & 63), lq = lane & 31, lh = lane >> 5;
    (void)lds_f;
    const int pbk = item % NCHK, dir = (item / NCHK) & 1, h = (item / (2 * NCHK)) % NH, b = item / (2 * NCHK * NH);
    const int grp = h / (NH / MB_GROUPS), u = (b * NH + h) * 2 + dir;
    const int c = dir == 0 ? pbk : rev_chunk(pbk);
    const int t0 = b * LL + CK * pbk;
    const float A = -expf(p.mb_a_log[((size_t)l * 2 + dir) * NH + h]);
    const float dtv = p.dt[(size_t)(t0 + lane) * 2 * NH + dir * NH + h];
    float cum = dtv * A;
#pragma unroll
    for (int o = 1; o < 64; o <<= 1) { const float v = __shfl(cum, dir == 0 ? lane - o : lane + o); if (dir == 0 ? lane >= o : lane + o < 64) cum += v; }
    const float ctot = __shfl(cum, dir == 0 ? 63 : 0);
    const int gs = dir == 0 ? CK * pbk + lane : rev_gs(CK * pbk + lane);
    p.mbCum[(size_t)u * LL + gs] = cum;
    const float wsc = expf(ctot - cum) * dtv;
    f32x16_t G[2][2];
#pragma unroll
    for (int st = 0; st < 2; ++st)
#pragma unroll
        for (int tt = 0; tt < 2; ++tt)
#pragma unroll
            for (int r = 0; r < 16; ++r) G[st][tt][r] = 0.f;
    const bf16_t* Bg = p.mbB + (size_t)((t0 >> 6) * MB_GROUPS + grp) * (64 * MB_STATE); const bf16_t* Cg = p.mbC + (size_t)((t0 >> 6) * MB_GROUPS + grp) * (64 * MB_STATE);
#pragma unroll
    for (int ks = 0; ks < 8; ++ks) {
        bf16x8_t af[2], bfg[2];
#pragma unroll
        for (int q = 0; q < 2; ++q) { af[q] = *(const bf16x8_t*)(Bg + (((q * 8 + ks) * 2 + lh) * 32 + lq) * 8); bfg[q] = *(const bf16x8_t*)(Cg + (((q * 8 + ks) * 2 + lh) * 32 + lq) * 8); }
#pragma unroll
        for (int st = 0; st < 2; ++st)
#pragma unroll
            for (int tt = 0; tt < 2; ++tt) G[st][tt] = __builtin_amdgcn_mfma_f32_32x32x16_bf16(af[st], bfg[tt], G[st][tt], 0, 0, 0);
    }
    Frag8 pf[2][2][2];
#pragma unroll
    for (int tt = 0; tt < 2; ++tt) {
        const int et = 32 * tt + lq; const float cumt = __shfl(cum, et);
#pragma unroll
        for (int st = 0; st < 2; ++st) {
            float mv[16];
#pragma unroll
            for (int g = 0; g < 4; ++g) {
                const int es0 = 32 * st + 8 * g + 4 * lh;
                const float csv[4] = {__shfl(cum, es0), __shfl(cum, es0 + 1), __shfl(cum, es0 + 2), __shfl(cum, es0 + 3)};
                const float dtq[4] = {__shfl(dtv, es0), __shfl(dtv, es0 + 1), __shfl(dtv, es0 + 2), __shfl(dtv, es0 + 3)};
#pragma unroll
                for (int q = 0; q < 4; ++q) { const int es = es0 + q; const bool on = dir == 0 ? es <= et : es >= et; mv[4 * g + q] = on ? G[st][tt][4 * g + q] * expf(fminf(cumt - csv[q], 0.f)) * dtq[q] : 0.f; }
            }
#pragma unroll
            for (int sp = 0; sp < 2; ++sp)
#pragma unroll
                for (int j = 0; j < 4; ++j) pf[st][tt][sp].u[j] = cvt_pk_bf16_h(mv[8 * sp + 2 * j], mv[8 * sp + 2 * j + 1]);
        }
    }
    const bf16_t* Xg = p.mbXT + ((size_t)(b * NH + h) * NCHK + pbk) * 4096;
    {
        f32x16_t Y[2][2];
#pragma unroll
        for (int pt = 0; pt < 2; ++pt)
#pragma unroll
            for (int tt = 0; tt < 2; ++tt)
#pragma unroll
                for (int r = 0; r < 16; ++r) Y[pt][tt][r] = 0.f;
#pragma unroll
        for (int st = 0; st < 2; ++st)
#pragma unroll
            for (int sp = 0; sp < 2; ++sp) {
                Frag8 xa[2];
#pragma unroll
                for (int pt = 0; pt < 2; ++pt) { const bf16_t* xr = Xg + (((pt * 4 + 2 * st + sp) * 2) * 32 + lq) * 8 + 4 * lh; xa[pt].d2[0] = *(const uint2*)xr; xa[pt].d2[1] = *(const uint2*)(xr + 32 * 8); }
#pragma unroll
                for (int pt = 0; pt < 2; ++pt)
#pragma unroll
                    for (int tt = 0; tt < 2; ++tt) Y[pt][tt] = __builtin_amdgcn_mfma_f32_32x32x16_bf16(xa[pt].v, pf[st][tt][sp].v, Y[pt][tt], 0, 0, 0);
            }
#pragma unroll
        for (int tt = 0; tt < 2; ++tt) {
            bf16_t* yo = p.mbYloc + ((size_t)u * NCHK + pbk) * 4096 + tt * 2048;
#pragma unroll
            for (int pt = 0; pt < 2; ++pt)
#pragma unroll
                for (int g = 0; g < 4; ++g) { uint2 w; w.x = cvt_pk_bf16_h(Y[pt][tt][4 * g], Y[pt][tt][4 * g + 1]); w.y = cvt_pk_bf16_h(Y[pt][tt][4 * g + 2], Y[pt][tt][4 * g + 3]); *(uint2*)(yo + (((pt * 4 + g) * 32 + lq) * 2 + lh) * 4) = w; }
        }
    }
    {
        const bf16_t* BTg = p.mbBT + ((size_t)((b * MB_GROUPS + grp) * 2) * NCHK + pbk) * 4096;
        f32x16_t Cs[4][2];
#pragma unroll
        for (int nt = 0; nt < 4; ++nt)
#pragma unroll
            for (int pt = 0; pt < 2; ++pt)
#pragma unroll
                for (int r = 0; r < 16; ++r) Cs[nt][pt][r] = 0.f;
#pragma unroll
        for (int ks = 0; ks < 4; ++ks) {
            const int ew = 16 * ks + 8 * lh;
            const float4 w0 = make_float4(__shfl(wsc, ew), __shfl(wsc, ew + 1), __shfl(wsc, ew + 2), __shfl(wsc, ew + 3)), w1 = make_float4(__shfl(wsc, ew + 4), __shfl(wsc, ew + 5), __shfl(wsc, ew + 6), __shfl(wsc, ew + 7));
            bf16x8_t xb[2];
#pragma unroll
            for (int pt = 0; pt < 2; ++pt) xb[pt] = *(const bf16x8_t*)(Xg + (((pt * 4 + ks) * 2 + lh) * 32 + lq) * 8);
#pragma unroll
            for (int nt = 0; nt < 4; ++nt) {
                const uint4 bw = *(const uint4*)(BTg + (size_t)(nt >> 1) * NCHK * 4096 + ((((nt & 1) * 4 + ks) * 2 + lh) * 32 + lq) * 8);
                Frag8 a; a.u[0] = cvt_pk_bf16_h(bflo(bw.x) * w0.x, bfhi(bw.x) * w0.y); a.u[1] = cvt_pk_bf16_h(bflo(bw.y) * w0.z, bfhi(bw.y) * w0.w);
                a.u[2] = cvt_pk_bf16_h(bflo(bw.z) * w1.x, bfhi(bw.z) * w1.y); a.u[3] = cvt_pk_bf16_h(bflo(bw.w) * w1.z, bfhi(bw.w) * w1.w);
#pragma unroll
                for (int pt = 0; pt < 2; ++pt) Cs[nt][pt] = __builtin_amdgcn_mfma_f32_32x32x16_bf16(a.v, xb[pt], Cs[nt][pt], 0, 0, 0);
            }
        }
#pragma unroll
        for (int pt = 0; pt < 2; ++pt) {
            bf16_t* o = p.mbCS + ((size_t)u * NCHK + c) * HD * MB_STATE + pt * 4096;
#pragma unroll
            for (int nt = 0; nt < 4; ++nt)
#pragma unroll
                for (int g = 0; g < 4; ++g) { uint2 w; w.x = cvt_pk_bf16_h(Cs[nt][pt][4 * g], Cs[nt][pt][4 * g + 1]); w.y = cvt_pk_bf16_h(Cs[nt][pt][4 * g + 2], Cs[nt][pt][4 * g + 3]); *(uint2*)(o + (((nt * 4 + g) * 32 + lq) * 2 + lh) * 4) = w; }
        }
    }
}

constexpr int N_RW_PAIRS = NU * NCHK, N_RW_MERGED = 2048 < N_RW_PAIRS ? 2048 : N_RW_PAIRS;
constexpr int N_RW_ITEMS = N_RW_MERGED + 4 * (N_RW_PAIRS - N_RW_MERGED), N_MB_ITEMS = NB * NH * 2 * NCHK;
DEVFN void ph_chunks(const Params& p, int l, float* lds_f, int* ctr, int* cctr) {
    const int lane = (TIDX() & 63);
    const int wid = __builtin_amdgcn_readfirstlane(TIDX() >> 6);
    const bool conv = l < DEPTH - 1;
#define CONV_DRAIN() do { for (;;) { int it = 0; if (lane == 0) it = atomicAdd(cctr, 1); it = __builtin_amdgcn_readfirstlane(it); if (it >= NCONV) break; \
        conv_item(p, l + 1, it, (unsigned*)(lds_f + (size_t)wid * RW_STG)); } } while (0)
    if (conv && wid == 7) CONV_DRAIN();
    for (;;) {
        int it = 0;
        if (lane == 0) it = atomicAdd(ctr, 1);
        it = __builtin_amdgcn_readfirstlane(it);
        if (it >= N_RW_ITEMS + N_MB_ITEMS) break;
        if (it < N_RW_MERGED) rw_chunk_item<0>(p, lds_f, it);
        else if (it < N_RW_ITEMS) { const int h4 = it - N_RW_MERGED; if (h4 & 2) rw_chunk_quarter<true>(p, lds_f, N_RW_MERGED + (h4 >> 2), h4 & 1); else rw_chunk_quarter<false>(p, lds_f, N_RW_MERGED + (h4 >> 2), h4 & 1); }
        else mb_chunk_item(p, l, lds_f, it - N_RW_ITEMS);
    }
    if (conv) CONV_DRAIN();
#undef CONV_DRAIN
}

DEVFN void ph_mb_seq(const Params& p, int wv, int nwv) {
    constexpr int DQ = 4;
    static_assert(NCHK % DQ == 0, "ring depth");
    const int lane = (TIDX() & 63);
    for (int item = wv; item < NU * 4; item += nwv) {
        const int q4 = item & 3, u = item >> 2;
        float X[32];
#pragma unroll
        for (int k = 0; k < 32; ++k) X[k] = 0.f;
        const size_t eo = (size_t)q4 * 2048 + (size_t)lane * 32;
        uint4 pf[DQ][4]; float dq[DQ];
#define MSQ_LOAD(d, c_) do { const uint4* src_ = (const uint4*)(p.mbCS + ((size_t)u * NCHK + (c_)) * HD * MB_STATE + eo); \
            _Pragma("unroll") for (int k = 0; k < 4; ++k) pf[d][k] = src_[k]; dq[d] = p.mbCum[(size_t)u * LL + (c_) * CK + CK - 1]; } while (0)
#pragma unroll
        for (int d = 0; d < DQ; ++d) MSQ_LOAD(d, d);
        for (int c0 = 0; c0 < NCHK; c0 += DQ) {
#pragma unroll
            for (int d = 0; d < DQ; ++d) {
                const int c = c0 + d;
                const float dtot = expf(dq[d]);
                uint4 o[4];
#pragma unroll
                for (int k = 0; k < 4; ++k) {
                    const unsigned w[4] = {pf[d][k].x, pf[d][k].y, pf[d][k].z, pf[d][k].w}; unsigned ow[4];
#pragma unroll
                    for (int m = 0; m < 4; ++m) {
                        X[8 * k + 2 * m] = dtot * X[8 * k + 2 * m] + u_as_f(w[m] << 16); X[8 * k + 2 * m + 1] = dtot * X[8 * k + 2 * m + 1] + u_as_f(w[m] & 0xffff0000u);
                        ow[m] = cvt_pk_bf16(X[8 * k + 2 * m], X[8 * k + 2 * m + 1]);
                    }
                    o[k] = make_uint4(ow[0], ow[1], ow[2], ow[3]);
                }
                if (c + DQ < NCHK) MSQ_LOAD(d, c + DQ);
                uint4* dst = (uint4*)(p.mbCS + ((size_t)u * NCHK + c) * HD * MB_STATE + eo);
#pragma unroll
                for (int k = 0; k < 4; ++k) dst[k] = o[k];
            }
        }
#undef MSQ_LOAD
    }
}

DEVFN void ph_mb_yout(const Params& p, int l, size_t vt, size_t vs) {
    constexpr int HPG = NH / MB_GROUPS;
    const int lane = (TIDX() & 63), lq = lane & 31, lh = lane >> 5;
    const int wv = __builtin_amdgcn_readfirstlane((int)(vt >> 6)), nwv = (int)(vs >> 6);
    const int wvs = (wv & 7) * (nwv >> 3) + (wv >> 3);
    for (int item = nwv - 1 - wvs; item < NB * MB_GROUPS * NCHK * 2; item += nwv) {
        const int tb = item & 1, pbk = (item >> 1) % NCHK, grp = ((item >> 1) / NCHK) % MB_GROUPS, b = (item >> 1) / (NCHK * MB_GROUPS);
        const int s_ = CK * pbk + 32 * tb + lq, t = b * LL + s_;
        const int gsd[2] = {s_, rev_gs(s_)};
        const int cd[2] = {pbk, rev_chunk(pbk)};
        const bf16_t* cfp = p.mbC + mb_frag_off(t, grp * MB_STATE + 8 * lh);
        f32x16_t acc[HPG][2];
#pragma unroll
        for (int hh = 0; hh < HPG; ++hh)
#pragma unroll
            for (int pt = 0; pt < 2; ++pt)
#pragma unroll
                for (int r = 0; r < 16; ++r) acc[hh][pt][r] = 0.f;
#pragma unroll
        for (int hh = 0; hh < HPG; ++hh) {
            const int h = grp * HPG + hh;
#pragma unroll
            for (int dir = 0; dir < 2; ++dir) {
                const int u = (b * NH + h) * 2 + dir, c = cd[dir];
                if (c > 0) {
                    const bf16_t* st = p.mbCS + ((size_t)u * NCHK + (c - 1)) * HD * MB_STATE;
                    f32x16_t d0, d1;
#pragma unroll
                    for (int r = 0; r < 16; ++r) { d0[r] = 0.f; d1[r] = 0.f; }
#pragma unroll
                    for (int ks = 0; ks < 8; ++ks) {
                        if ((ks & 1) == 0) asm volatile("" ::: "memory");
                        const bf16x8_t a0 = *(const bf16x8_t*)(st + ((((ks >> 1) * 4 + 2 * (ks & 1) + lh) * 32 + lq) * 2) * 4), a1 = *(const bf16x8_t*)(st + 4096 + ((((ks >> 1) * 4 + 2 * (ks & 1) + lh) * 32 + lq) * 2) * 4);
                        const bf16x8_t cfk = *(const bf16x8_t*)(cfp + ks * 512);
                        d0 = __builtin_amdgcn_mfma_f32_32x32x16_bf16(a0, cfk, d0, 0, 0, 0);
                        d1 = __builtin_amdgcn_mfma_f32_32x32x16_bf16(a1, cfk, d1, 0, 0, 0);
                    }
                    const float ec = expf(p.mbCum[(size_t)u * LL + gsd[dir]]);
#pragma unroll
                    for (int r = 0; r < 16; ++r) { acc[hh][0][r] += ec * d0[r]; acc[hh][1][r] += ec * d1[r]; }
                }
            }
        }
        float ss = 0.f;
#pragma unroll
        for (int hh = 0; hh < HPG; ++hh) {
            const int h = grp * HPG + hh;
            const float dsk = p.mb_d[(size_t)l * NH + h];
#pragma unroll
            for (int pt = 0; pt < 2; ++pt)
#pragma unroll
                for (int g = 0; g < 4; ++g) {
                    asm volatile("" ::: "memory");
                    const int p0 = 32 * pt + 8 * g + 4 * lh, ch = h * HD + p0;
                    float yl[4] = {0.f, 0.f, 0.f, 0.f};
#pragma unroll
                    for (int dir = 0; dir < 2; ++dir) {
                            const int u = (b * NH + h) * 2 + dir;
                            const uint2 w = *(const uint2*)(p.mbYloc + ((size_t)u * NCHK + pbk) * 4096 + tb * 2048 + (((pt * 4 + g) * 32 + lq) * 2 + lh) * 4);
                            yl[0] += u_as_f(w.x << 16); yl[1] += u_as_f(w.x & 0xffff0000u); yl[2] += u_as_f(w.y << 16); yl[3] += u_as_f(w.y & 0xffff0000u);
                        }
                    const float4 x4 = *(const float4*)(p.xc + (size_t)t * MB_CONV_DIM + ch);
                    const uint2 zw = *(const uint2*)(p.P + (size_t)t * N_IN + OFF_MB + ch);
                    const float z0 = u_as_f(zw.x << 16), z1 = u_as_f(zw.x & 0xffff0000u), z2 = u_as_f(zw.y << 16), z3 = u_as_f(zw.y & 0xffff0000u);
                    const float v0 = (acc[hh][pt][4 * g] + yl[0] + dsk * x4.x) * siluf_(z0), v1 = (acc[hh][pt][4 * g + 1] + yl[1] + dsk * x4.y) * siluf_(z1);
                    const float v2 = (acc[hh][pt][4 * g + 2] + yl[2] + dsk * x4.z) * siluf_(z2), v3 = (acc[hh][pt][4 * g + 3] + yl[3] + dsk * x4.w) * siluf_(z3);
                    acc[hh][pt][4 * g] = v0; acc[hh][pt][4 * g + 1] = v1; acc[hh][pt][4 * g + 2] = v2; acc[hh][pt][4 * g + 3] = v3;
                    ss += v0 * v0 + v1 * v1 + v2 * v2 + v3 * v3;
                }
        }
        ss += __shfl_xor(ss, 32);
        const float rs = 1.0f / sqrtf(ss * (1.0f / (GD / MB_GROUPS)) + RMS_EPS);
#pragma unroll
        for (int hh = 0; hh < HPG; ++hh)
#pragma unroll
            for (int pt = 0; pt < 2; ++pt)
#pragma unroll
                for (int g = 0; g < 4; ++g) {
                    asm volatile("" ::: "memory");
                    const int ch = (grp * HPG + hh) * HD + 32 * pt + 8 * g + 4 * lh;
                    const float4 ng = *(const float4*)(p.mb_norm_g + (size_t)l * GD + ch);
                    uint2 w; w.x = cvt_pk_bf16(acc[hh][pt][4 * g] * rs * ng.x, acc[hh][pt][4 * g + 1] * rs * ng.y); w.y = cvt_pk_bf16(acc[hh][pt][4 * g + 2] * rs * ng.z, acc[hh][pt][4 * g + 3] * rs * ng.w);
                    *(uint2*)(p.Ymix + (size_t)t * D_MIX + 1 * GD + ch) = w;
                }
    }
}

DEVFN void ph_mb_yout_wg(const Params& p, int l, float* lds_f, const int wg, const int nwg) {
    constexpr int HPG = NH / MB_GROUPS, TLD = 72;
    static_assert(HPG * 2 == 8, "eight waves = four heads x two token halves");
    const int lane = (TIDX() & 63), lq = lane & 31, lh = lane >> 5;
    const int wid = __builtin_amdgcn_readfirstlane(TIDX() >> 6), hh = wid >> 1, tb = wid & 1;
    float* ssb = lds_f;
    bf16_t* tile = (bf16_t*)(lds_f + 2 * HPG * 32) + wid * (32 * TLD);
    for (int item = wg; item < NB * MB_GROUPS * NCHK; item += nwg) {
        const int pbk = item % NCHK, grp = (item / NCHK) % MB_GROUPS, b = item / (NCHK * MB_GROUPS);
        const int h = grp * HPG + hh;
        const int s_ = CK * pbk + 32 * tb + lq, t = b * LL + s_;
        const int gsd[2] = {s_, rev_gs(s_)};
        const int cd[2] = {pbk, rev_chunk(pbk)};
        const bf16_t* cfp = p.mbC + mb_frag_off(t, grp * MB_STATE + 8 * lh);
        bf16x8_t cf[8];
#pragma unroll
        for (int ks = 0; ks < 8; ++ks) cf[ks] = *(const bf16x8_t*)(cfp + ks * 512);
        f32x16_t acc[2];
#pragma unroll
        for (int pt = 0; pt < 2; ++pt)
#pragma unroll
            for (int r = 0; r < 16; ++r) acc[pt][r] = 0.f;
#pragma unroll
        for (int dir = 0; dir < 2; ++dir) {
            const int u = (b * NH + h) * 2 + dir, c = cd[dir];
            if (c > 0) {
                const bf16_t* st = p.mbCS + ((size_t)u * NCHK + (c - 1)) * HD * MB_STATE;
                const float cum = p.mbCum[(size_t)u * LL + gsd[dir]];
                bf16x8_t a0[8], a1[8];
#pragma unroll
                for (int ks = 0; ks < 8; ++ks) { a0[ks] = *(const bf16x8_t*)(st + (ks >> 1) * 1024 + (ks & 1) * 512 + lh * 256 + lq * 8); a1[ks] = *(const bf16x8_t*)(st + 4096 + (ks >> 1) * 1024 + (ks & 1) * 512 + lh * 256 + lq * 8); }
                f32x16_t d0, d1;
#pragma unroll
                for (int r = 0; r < 16; ++r) { d0[r] = 0.f; d1[r] = 0.f; }
#pragma unroll
                for (int ks = 0; ks < 8; ++ks) {
                    d0 = __builtin_amdgcn_mfma_f32_32x32x16_bf16(a0[ks], cf[ks], d0, 0, 0, 0);
                    d1 = __builtin_amdgcn_mfma_f32_32x32x16_bf16(a1[ks], cf[ks], d1, 0, 0, 0);
                }
                const float ec = expf(cum);
#pragma unroll
                for (int r = 0; r < 16; ++r) { acc[0][r] += ec * d0[r]; acc[1][r] += ec * d1[r]; }
            }
        }
        float ss = 0.f;
        const float dsk = p.mb_d[(size_t)l * NH + h];
#pragma unroll
        for (int pt = 0; pt < 2; ++pt)
#pragma unroll
            for (int g = 0; g < 4; ++g) {
                const int p0 = 32 * pt + 8 * g + 4 * lh, ch = h * HD + p0;
                float yl[4] = {0.f, 0.f, 0.f, 0.f};
#pragma unroll
                for (int dir = 0; dir < 2; ++dir) {
                    const int u = (b * NH + h) * 2 + dir;
                    const uint2 w = *(const uint2*)(p.mbYloc + ((size_t)u * NCHK + pbk) * 4096 + tb * 2048 + (((pt * 4 + g) * 32 + lq) * 2 + lh) * 4);
                    yl[0] += u_as_f(w.x << 16); yl[1] += u_as_f(w.x & 0xffff0000u); yl[2] += u_as_f(w.y << 16); yl[3] += u_as_f(w.y & 0xffff0000u);
                }
                const float4 x4 = *(const float4*)(p.xc + (size_t)t * MB_CONV_DIM + ch);
                const uint2 zw = *(const uint2*)(p.P + (size_t)t * N_IN + OFF_MB + ch);
                const float z0 = u_as_f(zw.x << 16), z1 = u_as_f(zw.x & 0xffff0000u), z2 = u_as_f(zw.y << 16), z3 = u_as_f(zw.y & 0xffff0000u);
                const float v0 = (acc[pt][4 * g] + yl[0] + dsk * x4.x) * siluf_(z0), v1 = (acc[pt][4 * g + 1] + yl[1] + dsk * x4.y) * siluf_(z1);
                const float v2 = (acc[pt][4 * g + 2] + yl[2] + dsk * x4.z) * siluf_(z2), v3 = (acc[pt][4 * g + 3] + yl[3] + dsk * x4.w) * siluf_(z3);
                acc[pt][4 * g] = v0; acc[pt][4 * g + 1] = v1; acc[pt][4 * g + 2] = v2; acc[pt][4 * g + 3] = v3;
                ss += v0 * v0 + v1 * v1 + v2 * v2 + v3 * v3;
            }
        ss += __shfl_xor(ss, 32);
        if (lane < 32) ssb[(tb * HPG + hh) * 32 + lq] = ss;
        __syncthreads();
        float tot = 0.f;
#pragma unroll
        for (int q = 0; q < HPG; ++q) tot += ssb[(tb * HPG + q) * 32 + lq];
        const float rs = 1.0f / sqrtf(tot * (1.0f / (GD / MB_GROUPS)) + RMS_EPS);
#pragma unroll
        for (int pt = 0; pt < 2; ++pt)
#pragma unroll
            for (int g = 0; g < 4; ++g) {
                const int p0 = 32 * pt + 8 * g + 4 * lh;
                const float4 ng = *(const float4*)(p.mb_norm_g + (size_t)l * GD + h * HD + p0);
                uint2 w; w.x = cvt_pk_bf16_h(acc[pt][4 * g] * rs * ng.x, acc[pt][4 * g + 1] * rs * ng.y); w.y = cvt_pk_bf16_h(acc[pt][4 * g + 2] * rs * ng.z, acc[pt][4 * g + 3] * rs * ng.w);
                *(uint2*)(tile + lq * TLD + p0) = w;
            }
        __builtin_amdgcn_wave_barrier();
#pragma unroll
        for (int i = 0; i < 4; ++i) {
            const int tr = (lane >> 3) + 8 * i, q = lane & 7;
            const uint4 v = *(const uint4*)(tile + tr * TLD + q * 8);
            *(uint4*)(p.Ymix + (size_t)(b * LL + CK * pbk + 32 * tb + tr) * D_MIX + 1 * GD + h * HD + q * 8) = v;
        }
        __syncthreads();
    }
}

DEVFN void ph_mla_norm(const Params& p, int l, size_t vt, size_t vs) {
    static_assert(KUP == 512 && MLA_QL % 8 == 0, "one wave = one token: 64 lanes x 8 lora channels (q | kv)");
    const int lane = (TIDX() & 63);
    const size_t wv = vt >> 6, nwv = vs >> 6;
    const bool isq = lane * 8 < MLA_QL;
    for (size_t t = wv; t < (size_t)TT; t += nwv) {
        const uint4 xv = *(const uint4*)(p.P + t * N_IN + OFF_MLA + lane * 8);
        float x[8] = {bflo(xv.x), bfhi(xv.x), bflo(xv.y), bfhi(xv.y), bflo(xv.z), bfhi(xv.z), bflo(xv.w), bfhi(xv.w)};
        float ss = 0.f;
#pragma unroll
        for (int k = 0; k < 8; ++k) ss += x[k] * x[k];
        float sq = isq ? ss : 0.f, sk = isq ? 0.f : ss;
#pragma unroll
        for (int o = 32; o > 0; o >>= 1) { sq += __shfl_xor(sq, o); sk += __shfl_xor(sk, o); }
        const float rs = isq ? 1.0f / sqrtf(sq / MLA_QL + RMS_EPS) : 1.0f / sqrtf(sk / MLA_KVL + RMS_EPS);
        const float* gp = isq ? p.mla_q_norm + (size_t)l * MLA_QL + lane * 8 : p.mla_kv_norm + (size_t)l * MLA_KVL + (lane * 8 - MLA_QL);
        const float4 g0 = *(const float4*)gp, g1 = *(const float4*)(gp + 4);
        *(uint4*)(p.qkvn + t * KUP + lane * 8) = make_uint4(pk2(x[0] * rs * g0.x, x[1] * rs * g0.y), pk2(x[2] * rs * g0.z, x[3] * rs * g0.w), pk2(x[4] * rs * g1.x, x[5] * rs * g1.y), pk2(x[6] * rs * g1.z, x[7] * rs * g1.w));
    }
}

DEVFN void ph_mla_rope(const Params& p, int l, size_t vt, size_t vs) {
    static_assert(MLA_NOPE % 8 == 0 && MLA_ROPE == 32 && MLA_ROPE / 4 == 8, "rope groups: [axis][half][8 freqs]");
    constexpr int NGQ = MLA_QK / 8, NGN = MLA_NOPE / 8;
    const float qscale = 1.4426950408889634f / sqrtf((float)MLA_QK);
    const size_t n = (size_t)TT * NH * NGQ;
    for (size_t id = vt; id < n; id += vs) {
        const int g = (int)(id % NGQ); const int h = (int)((id / NGQ) % NH); const int t = (int)(id / ((size_t)NGQ * NH)); const int b = t / LL, s_ = t % LL; const bool lat = s_ >= CTX; const int tl = s_ - CTX;
        bf16_t* qo = p.Qm + ((size_t)(b * NH + h) * LL + s_) * MLA_QK + g * 8; bf16_t* ko = p.Km + ((size_t)(b * NH + h) * LL + s_) * MLA_QK + g * 8;
        const float* q = p.QKVraw + (size_t)t * NUP + h * MLA_QK;
        if (g < NGN) {
            const float4 q0 = *(const float4*)(q + g * 8), q1 = *(const float4*)(q + g * 8 + 4);
            const float* kv = p.QKVraw + (size_t)t * NUP + NUPQ + h * (MLA_NOPE + MLA_V) + g * 8;
            const float4 k0 = *(const float4*)kv, k1 = *(const float4*)(kv + 4);
            *(uint4*)qo = make_uint4(pk2(q0.x * qscale, q0.y * qscale), pk2(q0.z * qscale, q0.w * qscale), pk2(q1.x * qscale, q1.y * qscale), pk2(q1.z * qscale, q1.w * qscale));
            *(uint4*)ko = make_uint4(pk2(k0.x, k0.y), pk2(k0.z, k0.w), pk2(k1.x, k1.y), pk2(k1.z, k1.w));
        } else {
            const int e0 = (g - NGN) * 8; const int axis = e0 / 16, half = (e0 / 8) & 1;
            const float* qa = q + MLA_NOPE + axis * 16;
            const float4 x10 = *(const float4*)qa, x11 = *(const float4*)(qa + 4), x20 = *(const float4*)(qa + 8), x21 = *(const float4*)(qa + 12);
            const float qx1[8] = {x10.x, x10.y, x10.z, x10.w, x11.x, x11.y, x11.z, x11.w}, qx2[8] = {x20.x, x20.y, x20.z, x20.w, x21.x, x21.y, x21.z, x21.w};
            const bf16_t* kp = p.P + (size_t)t * N_IN + OFF_MLA + MLA_QL + MLA_KVL + axis * 16;
            const uint4 kw1 = *(const uint4*)kp, kw2 = *(const uint4*)(kp + 8);
            const float kx1[8] = {bflo(kw1.x), bfhi(kw1.x), bflo(kw1.y), bfhi(kw1.y), bflo(kw1.z), bfhi(kw1.z), bflo(kw1.w), bfhi(kw1.w)};
            const float kx2[8] = {bflo(kw2.x), bfhi(kw2.x), bflo(kw2.y), bfhi(kw2.y), bflo(kw2.z), bfhi(kw2.z), bflo(kw2.w), bfhi(kw2.w)};
            float qv[8], kvv[8];
            const int pos = lat ? (axis == 0 ? tl / GRID_W : tl % GRID_W) : 0;
#pragma unroll
            for (int f = 0; f < 8; ++f) {
                float cs = 1.f, sn = 0.f;
                if (lat) { const float2 t2 = p.ropecs[pos * 8 + f]; cs = t2.x; sn = t2.y; }
                qv[f] = (half == 0 ? qx1[f] * cs - qx2[f] * sn : qx2[f] * cs + qx1[f] * sn) * qscale;
                kvv[f] = half == 0 ? kx1[f] * cs - kx2[f] * sn : kx2[f] * cs + kx1[f] * sn;
            }
            *(uint4*)qo = make_uint4(pk2(qv[0], qv[1]), pk2(qv[2], qv[3]), pk2(qv[4], qv[5]), pk2(qv[6], qv[7]));
            *(uint4*)ko = make_uint4(pk2(kvv[0], kvv[1]), pk2(kvv[2], kvv[3]), pk2(kvv[4], kvv[5]), pk2(kvv[6], kvv[7]));
        }
    }
}

DEVFN void ph_vt_tiles(const Params& p, int mode, bf16_t* smem, int vb, int nvb) {
    static_assert(HD == 64 && MLA_V == 64 && LL % 64 == 0 && MB_STATE == 128, "64 x 64 tiles");
    const int tid = TIDX(); const int r = tid >> 3, pc = tid & 7;
    const int nrow = mode == 3 ? NB * MB_GROUPS * 2 : NB * NH;
    const int NTL = nrow * (LL / 64);
    constexpr int TLD = 72;
    for (int u = vb; u < NTL; u += nvb) {
        const int tb = u % (LL / 64), bh = u / (LL / 64);
        int b, h;
        if (mode == 3) { b = bh / (MB_GROUPS * 2); h = bh % (MB_GROUPS * 2); } else { b = bh / NH; h = bh % NH; }
        const int t = b * LL + tb * 64 + r;
        unsigned w[4];
        if (mode == 0) { const uint4 v = *(const uint4*)(p.P + (size_t)t * N_IN + OFF_NA + 2 * GD + h * HD + pc * 8); w[0] = v.x; w[1] = v.y; w[2] = v.z; w[3] = v.w; }
        else {
            const float* src = mode == 1 ? p.QKVraw + (size_t)t * NUP + NUPQ + h * (MLA_NOPE + MLA_V) + MLA_NOPE + pc * 8
                             : mode == 2 ? p.xc + (size_t)t * MB_CONV_DIM + h * HD + pc * 8
                                         : p.xc + (size_t)t * MB_CONV_DIM + GD + h * 64 + pc * 8;
            const float4 a = *(const float4*)src, c4 = *(const float4*)(src + 4);
            w[0] = pk2(a.x, a.y); w[1] = pk2(a.z, a.w); w[2] = pk2(c4.x, c4.y); w[3] = pk2(c4.z, c4.w);
        }
        __syncthreads();
#pragma unroll
        for (int k = 0; k < 4; ++k) { smem[(pc * 8 + 2 * k) * TLD + r] = (bf16_t)(w[k] & 0xffffu); smem[(pc * 8 + 2 * k + 1) * TLD + r] = (bf16_t)(w[k] >> 16); }
        __syncthreads();
        const uint4 o = *(const uint4*)(smem + r * TLD + pc * 8);
        bf16_t* base = mode == 0 ? p.naVt : mode == 1 ? p.Vt : mode == 2 ? p.mbXT : p.mbBT;
        if (mode >= 2) *(uint4*)(base + ((size_t)bh * (LL / 64) + tb) * 4096 + tile_frag_off(r, pc)) = o;
        else *(uint4*)(base + ((size_t)bh * 64 + r) * LL + tb * 64 + pc * 8) = o;
    }
    __syncthreads();
}

constexpr int AT_KLD = 104, AT_VLD = 68, AT_TK = 64;
constexpr int AT_BUF = AT_TK * AT_KLD + MLA_V * AT_VLD;
constexpr int AT_NSUB = 2;
template <int NTH>
DEVFN void mla_unit(const Params& p, bf16_t* smem, const int u2) {
    const int u = u2 >> 1, kh = u2 & 1;
    static_assert(MLA_QK == 96 && MLA_V == 64, "attention tiles are written for d_qk 96 / d_v 64");
    constexpr int NWV = NTH / 64, QB = NWV * 32;
    constexpr int NCHUNK1 = AT_TK * (MLA_QK / 8) + MLA_V * (AT_TK / 8);
    constexpr int NCHUNK = AT_NSUB * NCHUNK1;
    constexpr int NCH = (NCHUNK + NTH - 1) / NTH;
    constexpr int STAGE = AT_NSUB * AT_BUF;
    static_assert((CTX / AT_TK) % AT_NSUB == 0 && (LL / AT_TK) % AT_NSUB == 0, "whole stages");
    const int tid = TIDX(), lane = tid & 63, wave = tid >> 6, lq = lane & 31, lh = lane >> 5;
    const int n_lat = NB * NH * (SEQ / QB);
    {
        int bh, qbase, nkeys;
        if (u < n_lat) { bh = u / (SEQ / QB); qbase = CTX + (u % (SEQ / QB)) * QB; nkeys = LL; }
        else { const int u2 = u - n_lat; bh = u2 / (CTX / QB); qbase = (u2 % (CTX / QB)) * QB; nkeys = CTX; }
        const bf16_t* Kg = p.Km + (size_t)bh * LL * MLA_QK; const bf16_t* Vg = p.Vt + (size_t)bh * MLA_V * LL;
        const int q0 = qbase + wave * 32;
        bf16x8_t qf[6];
#pragma unroll
        for (int ks = 0; ks < 6; ++ks) qf[ks] = *(const bf16x8_t*)(p.Qm + ((size_t)bh * LL + q0 + lq) * MLA_QK + ks * 16 + lh * 8);
        f32x16_t o0, o1;
#pragma unroll
        for (int r = 0; r < 16; ++r) { o0[r] = 0.f; o1[r] = 0.f; }
        float m_i = -1e30f, l_i = 0.f;
        const int nst_all = nkeys / (AT_TK * AT_NSUB); const int nstages = nst_all / 2 + ((nst_all & 1) && kh == 0 ? 1 : 0);
        const int st_base = kh == 0 ? 0 : nst_all - nstages;
        uint4 stg[NCH];
#define MLA_LOAD(st_) do { _Pragma("unroll") for (int i = 0; i < NCH; ++i) { const int c = tid + i * NTH; const int sub = c / NCHUNK1, cc = c % NCHUNK1; const int k1 = ((st_base + (st_)) * AT_NSUB + sub) * AT_TK; \
            if (c < NCHUNK) { if (cc < AT_TK * 12) { const int key = cc / 12, ch = cc % 12; stg[i] = *(const uint4*)(Kg + (size_t)(k1 + key) * MLA_QK + ch * 8); } \
                              else { const int c2 = cc - AT_TK * 12; const int d = c2 / 8, ch = c2 % 8; stg[i] = *(const uint4*)(Vg + (size_t)d * LL + k1 + ch * 8); } } } } while (0)
#define MLA_STORE(buf_) do { _Pragma("unroll") for (int i = 0; i < NCH; ++i) { const int c = tid + i * NTH; const int sub = c / NCHUNK1, cc = c % NCHUNK1; bf16_t* dK = smem + (buf_) * STAGE + sub * AT_BUF; \
            if (c < NCHUNK) { if (cc < AT_TK * 12) { const int key = cc / 12, ch = cc % 12; *(uint4*)(dK + key * AT_KLD + ch * 8) = stg[i]; } \
                              else { const int c2 = cc - AT_TK * 12; const int d = c2 / 8, ch = c2 % 8; uint2* dst = (uint2*)(dK + AT_TK * AT_KLD + d * AT_VLD + ch * 8); dst[0] = make_uint2(stg[i].x, stg[i].y); dst[1] = make_uint2(stg[i].z, stg[i].w); } } } } while (0)
        MLA_LOAD(0);
        __syncthreads();
        MLA_STORE(0);
        __syncthreads();
        for (int st = 0; st < nstages; ++st) {
            const bool more = st + 1 < nstages;
            if (more) MLA_LOAD(st + 1);
            static_assert(AT_NSUB == 2, "two sub-tiles per stage");
            const bf16_t* sKa = smem + (st & 1) * STAGE; const bf16_t* sKb = sKa + AT_BUF;
            f32x16_t sa0, sa1, sb0, sb1;
#pragma unroll
            for (int r = 0; r < 16; ++r) { sa0[r] = 0.f; sa1[r] = 0.f; sb0[r] = 0.f; sb1[r] = 0.f; }
#pragma unroll
            for (int ks = 0; ks < 6; ++ks) {
                const bf16x8_t a0 = *(const bf16x8_t*)(sKa + (lq) * AT_KLD + ks * 16 + lh * 8), a1 = *(const bf16x8_t*)(sKa + (32 + lq) * AT_KLD + ks * 16 + lh * 8);
                sa0 = __builtin_amdgcn_mfma_f32_32x32x16_bf16(a0, qf[ks], sa0, 0, 0, 0);
                sa1 = __builtin_amdgcn_mfma_f32_32x32x16_bf16(a1, qf[ks], sa1, 0, 0, 0);
            }
#pragma unroll
            for (int ks = 0; ks < 6; ++ks) {
                const bf16x8_t a0 = *(const bf16x8_t*)(sKb + (lq) * AT_KLD + ks * 16 + lh * 8), a1 = *(const bf16x8_t*)(sKb + (32 + lq) * AT_KLD + ks * 16 + lh * 8);
                sb0 = __builtin_amdgcn_mfma_f32_32x32x16_bf16(a0, qf[ks], sb0, 0, 0, 0);
                sb1 = __builtin_amdgcn_mfma_f32_32x32x16_bf16(a1, qf[ks], sb1, 0, 0, 0);
            }
            __builtin_amdgcn_sched_barrier(0);
#define MLA_SOFTMAX_PV(s0, s1, sV) do { \
            float mx = -1e30f; \
            _Pragma("unroll") for (int r = 0; r < 16; ++r) mx = fmaxf(mx, fmaxf(s0[r], s1[r])); \
            mx = fmaxf(mx, __shfl_xor(mx, 32)); \
            const float m_new = fmaxf(m_i, mx); \
            const float alpha = __builtin_amdgcn_exp2f(m_i - m_new); \
            float rs = 0.f; \
            _Pragma("unroll") for (int r = 0; r < 16; ++r) { s0[r] = __builtin_amdgcn_exp2f(s0[r] - m_new); s1[r] = __builtin_amdgcn_exp2f(s1[r] - m_new); rs += s0[r] + s1[r]; } \
            rs += __shfl_xor(rs, 32); \
            l_i = l_i * alpha + rs; m_i = m_new; \
            if (__builtin_amdgcn_ballot_w64(alpha != 1.0f) != 0ull) { \
                _Pragma("unroll") for (int r = 0; r < 16; ++r) { o0[r] *= alpha; o1[r] *= alpha; } \
            } \
            Frag8 pf[2][2]; \
            _Pragma("unroll") for (int sp = 0; sp < 2; ++sp) \
                _Pragma("unroll") for (int j = 0; j < 4; ++j) { \
                    pf[0][sp].u[j] = cvt_pk_bf16_h(s0[8 * sp + 2 * j], s0[8 * sp + 2 * j + 1]); \
                    pf[1][sp].u[j] = cvt_pk_bf16_h(s1[8 * sp + 2 * j], s1[8 * sp + 2 * j + 1]); \
                } \
            _Pragma("unroll") for (int kb = 0; kb < 2; ++kb) \
                _Pragma("unroll") for (int sp = 0; sp < 2; ++sp) { \
                    const int kofs = kb * 32 + sp * 16 + lh * 4; \
                    Frag8 va, vb2; \
                    va.d2[0] = *(const uint2*)((sV) + (lq) * AT_VLD + kofs); va.d2[1] = *(const uint2*)((sV) + (lq) * AT_VLD + kofs + 8); \
                    vb2.d2[0] = *(const uint2*)((sV) + (32 + lq) * AT_VLD + kofs); vb2.d2[1] = *(const uint2*)((sV) + (32 + lq) * AT_VLD + kofs + 8); \
                    o0 = __builtin_amdgcn_mfma_f32_32x32x16_bf16(va.v, pf[kb][sp].v, o0, 0, 0, 0); \
                    o1 = __builtin_amdgcn_mfma_f32_32x32x16_bf16(vb2.v, pf[kb][sp].v, o1, 0, 0, 0); \
                } } while (0)
            MLA_SOFTMAX_PV(sa0, sa1, sKa + AT_TK * AT_KLD);
            MLA_SOFTMAX_PV(sb0, sb1, sKb + AT_TK * AT_KLD);
#undef MLA_SOFTMAX_PV
            if (more) MLA_STORE((st + 1) & 1);
            __syncthreads();
        }
#undef MLA_LOAD
#undef MLA_STORE
        const int b = bh / NH, h = bh % NH;
        const size_t rec = ((size_t)(b * LL + q0 + lq) * NH + h) * 2 + kh;
        float* orow = p.mlaO + rec * MLA_V;
#pragma unroll
        for (int g = 0; g < 4; ++g) {
            *(float4*)(orow + 8 * g + 4 * lh) = make_float4(o0[4 * g], o0[4 * g + 1], o0[4 * g + 2], o0[4 * g + 3]);
            *(float4*)(orow + 32 + 8 * g + 4 * lh) = make_float4(o1[4 * g], o1[4 * g + 1], o1[4 * g + 2], o1[4 * g + 3]);
        }
        if (lh == 0) *(float2*)(p.mlaML + rec * 2) = make_float2(m_i, l_i);
    }
}

DEVFN void mla_combine_one(const Params& p, bool with_ctx, size_t i, float2 ml0, float2 ml1, float4 a, float4 c) {
    const int d4 = (int)(i % (MLA_V / 4)); const size_t th = i / (MLA_V / 4); const int h = (int)(th % NH); const size_t t = th / NH;
    if (!with_ctx && (int)(t % LL) < CTX) return;
    const float m = fmaxf(ml0.x, ml1.x);
    const float e0 = __builtin_amdgcn_exp2f(ml0.x - m), e1 = __builtin_amdgcn_exp2f(ml1.x - m);
    const float inv = 1.0f / (ml0.y * e0 + ml1.y * e1);
    uint2 w; w.x = pk2((a.x * e0 + c.x * e1) * inv, (a.y * e0 + c.y * e1) * inv); w.y = pk2((a.z * e0 + c.z * e1) * inv, (a.w * e0 + c.w * e1) * inv);
    *(uint2*)(p.Ymix + t * D_MIX + 2 * GD + h * MLA_V + d4 * 4) = w;
}
DEVFN void ph_mla_combine(const Params& p, bool with_ctx, size_t vt, size_t vs) {
    const size_t n = (size_t)TT * NH * (MLA_V / 4);
#define MC_LOAD(i_, M0, M1, A_, C_) do { const size_t ic_ = (i_) < n ? (i_) : n - 1; const int d4_ = (int)(ic_ % (MLA_V / 4)); const size_t th_ = ic_ / (MLA_V / 4); \
        M0 = *(const float2*)(p.mlaML + (th_ * 2 + 0) * 2); M1 = *(const float2*)(p.mlaML + (th_ * 2 + 1) * 2); \
        A_ = *(const float4*)(p.mlaO + (th_ * 2 + 0) * MLA_V + d4_ * 4); C_ = *(const float4*)(p.mlaO + (th_ * 2 + 1) * MLA_V + d4_ * 4); } while (0)
    for (size_t i = vt; i < n; i += 4 * vs) {
        float2 m00, m01, m10, m11, m20, m21, m30, m31; float4 a0, c0, a1, c1, a2, c2, a3, c3;
        MC_LOAD(i, m00, m01, a0, c0); MC_LOAD(i + vs, m10, m11, a1, c1); MC_LOAD(i + 2 * vs, m20, m21, a2, c2); MC_LOAD(i + 3 * vs, m30, m31, a3, c3);
        mla_combine_one(p, with_ctx, i, m00, m01, a0, c0);
        if (i + vs < n) mla_combine_one(p, with_ctx, i + vs, m10, m11, a1, c1);
        if (i + 2 * vs < n) mla_combine_one(p, with_ctx, i + 2 * vs, m20, m21, a2, c2);
        if (i + 3 * vs < n) mla_combine_one(p, with_ctx, i + 3 * vs, m30, m31, a3, c3);
    }
#undef MC_LOAD
}

constexpr int NA_KLD = 72, NA_VLD = 68;
constexpr int NA_BUF = AT_TK * NA_KLD + HD * NA_VLD;
template <int NTH>
DEVFN void na_unit(const Params& p, int l, bf16_t* smem, const int u) {
    static_assert(HD == 64 && GRID_W == 64 && NA_WR == 8 && NA_WC == 16 && SEQ / GRID_W == 64, "natten tiles are written for a 64x64 grid, 8x16 window");
    constexpr int NWV = NTH / 64, QB = NWV * 32, RPU = NWV / 2, NLR = NA_WR + RPU - 1, NCT = CTX / AT_TK, ROWS = SEQ / GRID_W;
    constexpr int NCHUNK = AT_TK * (HD / 8) + HD * (AT_TK / 8);
    constexpr int NCH = (NCHUNK + NTH - 1) / NTH;
    constexpr int BW = 2 * NA_WC - 1, BH = 2 * NA_WR - 1;
    const float sc2 = 1.4426950408889634f / sqrtf((float)HD);
    const int tid = TIDX(), lane = tid & 63, wave = tid >> 6, lq = lane & 31, lh = lane >> 5;
    float* sbias = (float*)(smem + 2 * NA_BUF);
    const int n_lat = NB * NH * (ROWS / RPU);
    {
        const bool is_lat = u < n_lat;
        int bh, r0 = 0, rstart = 0, sq, ntiles;
        if (is_lat) { bh = u / (ROWS / RPU); r0 = (u % (ROWS / RPU)) * RPU; rstart = r0 - NA_WR / 2; rstart = rstart < 0 ? 0 : (rstart > ROWS - NLR ? ROWS - NLR : rstart);
                      sq = CTX + (r0 + (wave >> 1)) * GRID_W + 32 * (wave & 1) + lq; ntiles = NLR + NCT; }
        else { const int u2 = u - n_lat; bh = u2 / (CTX / QB); sq = (u2 % (CTX / QB)) * QB + wave * 32 + lq; ntiles = NCT; }
        const int b = bh / NH, h = bh % NH;
        const int qr = r0 + (wave >> 1), qc = 32 * (wave & 1) + lq;
        int rs = qr - NA_WR / 2; rs = rs < 0 ? 0 : (rs > ROWS - NA_WR ? ROWS - NA_WR : rs);
        int cs = qc - NA_WC / 2; cs = cs < 0 ? 0 : (cs > GRID_W - NA_WC ? GRID_W - NA_WC : cs);
        const bf16_t* Kg = p.P + (size_t)b * LL * N_IN + OFF_NA + GD + h * HD;
        const bf16_t* Vg = p.naVt + (size_t)bh * HD * LL;
        bf16x8_t qf[4];
#pragma unroll
        for (int ks = 0; ks < 4; ++ks) qf[ks] = *(const bf16x8_t*)(p.P + (size_t)(b * LL + sq) * N_IN + OFF_NA + h * HD + ks * 16 + lh * 8);
        f32x16_t o0, o1;
#pragma unroll
        for (int r = 0; r < 16; ++r) { o0[r] = 0.f; o1[r] = 0.f; }
        float m_i = -1e30f, l_i = 0.f;
        uint4 stg[NCH];
#define NA_KBASE(ti) ((is_lat && (ti) < NLR) ? (CTX + (rstart + (ti)) * GRID_W) : (((ti) - (is_lat ? NLR : 0)) * AT_TK))
#define NA_LOAD(ti) do { const int kb_ = NA_KBASE(ti); _Pragma("unroll") for (int i = 0; i < NCH; ++i) { const int c = tid + i * NTH; \
            if (c < AT_TK * 8) { const int key = c / 8, ch = c % 8; stg[i] = *(const uint4*)(Kg + (size_t)(kb_ + key) * N_IN + ch * 8); } \
            else if (c < NCHUNK) { const int c2 = c - AT_TK * 8; const int d = c2 / 8, ch = c2 % 8; stg[i] = *(const uint4*)(Vg + (size_t)d * LL + kb_ + ch * 8); } } } while (0)
#define NA_STORE(buf) do { bf16_t* dK_ = smem + (buf) * NA_BUF; _Pragma("unroll") for (int i = 0; i < NCH; ++i) { const int c = tid + i * NTH; \
            if (c < AT_TK * 8) { const int key = c / 8, ch = c % 8; *(uint4*)(dK_ + key * NA_KLD + ch * 8) = stg[i]; } \
            else if (c < NCHUNK) { const int c2 = c - AT_TK * 8; const int d = c2 / 8, ch = c2 % 8; uint2* dst = (uint2*)(dK_ + AT_TK * NA_KLD + d * NA_VLD + ch * 8); dst[0] = make_uint2(stg[i].x, stg[i].y); dst[1] = make_uint2(stg[i].z, stg[i].w); } } } while (0)
        NA_LOAD(0);
        __syncthreads();
        NA_STORE(0);
        for (int i = tid; i < BH * BW; i += NTH) sbias[i] = p.na_rpb[((size_t)l * NH + h) * BH * BW + i] * 1.4426950408889634f;
        __syncthreads();
        for (int tile = 0; tile < ntiles; ++tile) {
            const bf16_t* sK = smem + (tile & 1) * NA_BUF; const bf16_t* sV = sK + AT_TK * NA_KLD;
            const bool more = tile + 1 < ntiles;
            if (more) NA_LOAD(tile + 1);
            const bool local = is_lat && tile < NLR;
            const int kr = rstart + tile;
            const bool active = !local || (kr >= rs && kr < rs + NA_WR);
            if (active) {
                f32x16_t s0, s1;
#pragma unroll
                for (int r = 0; r < 16; ++r) { s0[r] = 0.f; s1[r] = 0.f; }
#pragma unroll
                for (int ks = 0; ks < 4; ++ks) {
                    const bf16x8_t a0 = *(const bf16x8_t*)(sK + (lq) * NA_KLD + ks * 16 + lh * 8);
                    const bf16x8_t a1 = *(const bf16x8_t*)(sK + (32 + lq) * NA_KLD + ks * 16 + lh * 8);
                    s0 = __builtin_amdgcn_mfma_f32_32x32x16_bf16(a0, qf[ks], s0, 0, 0, 0);
                    s1 = __builtin_amdgcn_mfma_f32_32x32x16_bf16(a1, qf[ks], s1, 0, 0, 0);
                }
                if (local) {
                    const float* brow = sbias + (kr - qr + NA_WR - 1) * BW;
#pragma unroll
                    for (int r = 0; r < 16; ++r) {
                        const int kc0 = (r & 3) + 8 * (r >> 2) + 4 * lh, kc1 = kc0 + 32;
                        const bool v0 = (unsigned)(kc0 - cs) < (unsigned)NA_WC, v1 = (unsigned)(kc1 - cs) < (unsigned)NA_WC;
                        s0[r] = v0 ? s0[r] * sc2 + brow[kc0 - qc + NA_WC - 1] : -1e30f;
                        s1[r] = v1 ? s1[r] * sc2 + brow[kc1 - qc + NA_WC - 1] : -1e30f;
                    }
                } else {
#pragma unroll
                    for (int r = 0; r < 16; ++r) { s0[r] *= sc2; s1[r] *= sc2; }
                }
                float mx = -1e30f;
#pragma unroll
                for (int r = 0; r < 16; ++r) mx = fmaxf(mx, fmaxf(s0[r], s1[r]));
                mx = fmaxf(mx, __shfl_xor(mx, 32));
                const float m_new = fmaxf(m_i, mx);
                const float alpha = __builtin_amdgcn_exp2f(m_i - m_new);
                float rsum = 0.f;
#pragma unroll
                for (int r = 0; r < 16; ++r) { s0[r] = __builtin_amdgcn_exp2f(s0[r] - m_new); s1[r] = __builtin_amdgcn_exp2f(s1[r] - m_new); rsum += s0[r] + s1[r]; }
                rsum += __shfl_xor(rsum, 32);
                l_i = l_i * alpha + rsum; m_i = m_new;
                if (__builtin_amdgcn_ballot_w64(alpha != 1.0f) != 0ull) {
#pragma unroll
                    for (int r = 0; r < 16; ++r) { o0[r] *= alpha; o1[r] *= alpha; }
                }
                Frag8 pf[2][2];
#pragma unroll
                for (int sp = 0; sp < 2; ++sp)
#pragma unroll
                    for (int j = 0; j < 4; ++j) {
                        pf[0][sp].u[j] = cvt_pk_bf16_h(s0[8 * sp + 2 * j], s0[8 * sp + 2 * j + 1]);
                        pf[1][sp].u[j] = cvt_pk_bf16_h(s1[8 * sp + 2 * j], s1[8 * sp + 2 * j + 1]);
                    }
#pragma unroll
                for (int kb = 0; kb < 2; ++kb)
#pragma unroll
                    for (int sp = 0; sp < 2; ++sp) {
                        const int kofs = kb * 32 + sp * 16 + lh * 4;
                        Frag8 va, vb2;
                        va.d2[0] = *(const uint2*)(sV + (lq) * NA_VLD + kofs); va.d2[1] = *(const uint2*)(sV + (lq) * NA_VLD + kofs + 8);
                        vb2.d2[0] = *(const uint2*)(sV + (32 + lq) * NA_VLD + kofs); vb2.d2[1] = *(const uint2*)(sV + (32 + lq) * NA_VLD + kofs + 8);
                        o0 = __builtin_amdgcn_mfma_f32_32x32x16_bf16(va.v, pf[kb][sp].v, o0, 0, 0, 0);
                        o1 = __builtin_amdgcn_mfma_f32_32x32x16_bf16(vb2.v, pf[kb][sp].v, o1, 0, 0, 0);
                    }
            }
            if (more) NA_STORE((tile + 1) & 1);
            __syncthreads();
        }
#undef NA_KBASE
#undef NA_LOAD
#undef NA_STORE
        const float inv = 1.0f / l_i;
        bf16_t* yrow = p.Ymix + (size_t)(b * LL + sq) * D_MIX + 3 * GD + h * HD;
#pragma unroll
        for (int g = 0; g < 4; ++g) {
            uint2 w0, w1;
            w0.x = cvt_pk_bf16(o0[4 * g] * inv, o0[4 * g + 1] * inv); w0.y = cvt_pk_bf16(o0[4 * g + 2] * inv, o0[4 * g + 3] * inv);
            w1.x = cvt_pk_bf16(o1[4 * g] * inv, o1[4 * g + 1] * inv); w1.y = cvt_pk_bf16(o1[4 * g + 2] * inv, o1[4 * g + 3] * inv);
            *(uint2*)(yrow + 8 * g + 4 * lh) = w0; *(uint2*)(yrow + 32 + 8 * g + 4 * lh) = w1;
        }
    }
}

DEVFN float wave_sum(float v) {
#pragma unroll
    for (int o = 32; o > 0; o >>= 1) v += __shfl_xor(v, o);
    return v;
}
constexpr int LNV = D / 256;

DEVFN void ph_ln1_route(const Params& p, int l, float* lds_f, int* lds_rt, size_t vt, size_t vs, const int t0, const int t1, const bool stage) {
    static_assert(NE * D * 4 <= 128 * 1024, "router matrix fits the LDS stage region");
    const float alpha = DN_ALPHA;
    const int lane = (TIDX() & 63);
    const size_t wv = vt >> 6, nwv = vs >> 6;
    __syncthreads();
    if (TIDX() < 2 * NE) lds_rt[TIDX()] = 0;
    if (stage) for (int i = TIDX(); i < D * NE / 4; i += 512) {
        const float4 w4 = *(const float4*)(p.router_w + (size_t)i * 4); const int d = (i * 4) / NE, e0 = (i * 4) % NE;
        lds_f[(e0 + 0) * D + d] = w4.x; lds_f[(e0 + 1) * D + d] = w4.y; lds_f[(e0 + 2) * D + d] = w4.z; lds_f[(e0 + 3) * D + d] = w4.w;
    }
    __syncthreads();
    for (size_t t = (size_t)t0 + wv; t < (size_t)t1; t += nwv) {
        const int b = (int)(t / LL), s = (int)(t % LL); const int r = s < CTX ? NB : b;
        if (l == DEPTH - 1 && s < CTX) continue;
        const float* m = p.mod + ((size_t)l * NMOD + r) * 6 * D;
        float* xr = p.xs + t * D; const bf16_t* yr = p.yo + t * D;
        float4 u[LNV];
        float sum = 0.f;
#pragma unroll
        for (int i = 0; i < LNV; ++i) {
            const int d = i * 256 + lane * 4;
            const float4 xv = *(const float4*)(xr + d); const uint2 yw = *(const uint2*)(yr + d); const float4 gv = *(const float4*)(m + 2 * D + d);
            u[i].x = alpha * xv.x + gv.x * bflo(yw.x); u[i].y = alpha * xv.y + gv.y * bfhi(yw.x); u[i].z = alpha * xv.z + gv.z * bflo(yw.y); u[i].w = alpha * xv.w + gv.w * bfhi(yw.y);
            sum += u[i].x + u[i].y + u[i].z + u[i].w;
        }
        const float mu = wave_sum(sum) * (1.0f / D);
        float sq = 0.f;
#pragma unroll
        for (int i = 0; i < LNV; ++i) { const float a0 = u[i].x - mu, a1 = u[i].y - mu, a2 = u[i].z - mu, a3 = u[i].w - mu; sq += a0 * a0 + a1 * a1 + a2 * a2 + a3 * a3; }
        const float rs = 1.0f / sqrtf(wave_sum(sq) * (1.0f / D) + LN_EPS);
        float lg[NE];
#pragma unroll
        for (int e = 0; e < NE; ++e) lg[e] = 0.f;
#pragma unroll
        for (int i = 0; i < LNV; ++i) {
            const int d = i * 256 + lane * 4;
            const float4 gg = *(const float4*)(p.ln1_g + (size_t)l * D + d), bb = *(const float4*)(p.ln1_b + (size_t)l * D + d);
            const float4 sc = *(const float4*)(m + 4 * D + d), sh = *(const float4*)(m + 3 * D + d);
            float4 xn;
            xn.x = (u[i].x - mu) * rs * gg.x + bb.x; xn.y = (u[i].y - mu) * rs * gg.y + bb.y; xn.z = (u[i].z - mu) * rs * gg.z + bb.z; xn.w = (u[i].w - mu) * rs * gg.w + bb.w;
            *(float4*)(xr + d) = xn;
            float hv[4];
            hv[0] = xn.x * (1.0f + sc.x) + sh.x; hv[1] = xn.y * (1.0f + sc.y) + sh.y; hv[2] = xn.z * (1.0f + sc.z) + sh.z; hv[3] = xn.w * (1.0f + sc.w) + sh.w;
            uint2 pk; pk.x = (unsigned)f2bf(hv[0]) | ((unsigned)f2bf(hv[1]) << 16); pk.y = (unsigned)f2bf(hv[2]) | ((unsigned)f2bf(hv[3]) << 16);
            *(uint2*)(p.hb + t * D + d) = pk;
            asm volatile("" ::: "memory");
#pragma unroll
            for (int e = 0; e < NE; ++e) { const float4 w4 = *(const float4*)(lds_f + e * D + d); lg[e] += hv[0] * w4.x + hv[1] * w4.y + hv[2] * w4.z + hv[3] * w4.w; }
        }
#pragma unroll
        for (int e = 0; e < NE; ++e) lg[e] = wave_sum(lg[e]);
        float gbest = -1e30f; int e1 = 0, e2 = 1; float w1 = 0.f, w2 = 0.f;
#pragma unroll
        for (int g = 0; g < NEG; ++g) {
            float m1 = -1e30f, m2 = -1e30f, s1 = 0.f, s2 = 0.f; int i1 = 0, i2 = 0;
#pragma unroll
            for (int i = 0; i < EPG; ++i) {
                const float scv = sigmoidf_(lg[g * EPG + i]); const float v = scv + p.router_b[g * EPG + i];
                if (v > m1) { m2 = m1; i2 = i1; s2 = s1; m1 = v; i1 = g * EPG + i; s1 = scv; }
                else if (v > m2) { m2 = v; i2 = g * EPG + i; s2 = scv; }
            }
            if (m1 + m2 > gbest) { gbest = m1 + m2; e1 = i1; e2 = i2; w1 = s1; w2 = s2; }
        }
        const float wn = ROUTED_SCALE / (w1 + w2);
        if (lane < 2) {
            const int k = lane;
            const int e = k == 0 ? e1 : e2; const float w = (k == 0 ? w1 : w2) * wn;
            const int pos = atomicAdd(&lds_rt[e], 1);
            ((int*)&p.tok_e[t])[k] = e; ((int*)&p.tok_pos[t])[k] = pos; ((float*)&p.tok_w[t])[k] = w;
        }
    }
    asm volatile("s_waitcnt vmcnt(0)" ::: "memory");
    __syncthreads();
    if (TIDX() < NE) { const int c_ = lds_rt[TIDX()]; lds_rt[NE + TIDX()] = c_ ? atomicAdd(&p.cnt[l * NE + TIDX()], c_) : 0; }
    __syncthreads();
}
DEVFN void ph_ln1_fix(const Params& p, const int* lds_rt, size_t vt, size_t vs, const int t0, const int t1) {
    const int lane = (TIDX() & 63);
    const size_t wv = vt >> 6, nwv = vs >> 6;
    for (size_t t = (size_t)t0 + wv; t < (size_t)t1; t += nwv) {
        if (lane < 2) { const int e = ((const int*)&p.tok_e[t])[lane]; ((int*)&p.tok_pos[t])[lane] += lds_rt[NE + e]; }
    }
}

DEVFN void ph_moe_perm(const Params& p, int l, size_t vt, size_t vs) {
    const int lane = (TIDX() & 63);
    const size_t wv = vt >> 6, nwv = vs >> 6;
    static_assert(D / 512 == 4, "a row is four 16-byte pieces per lane");
#define MP_SKIP(it_) (l == DEPTH - 1 && (int)(((it_) >> 1) % LL) < CTX)
#define MP_LOAD(it_, E_, P_, A0, A1, A2, A3) do { const size_t t_ = (it_) >> 1; const int k_ = (int)((it_) & 1); E_ = ((const int*)&p.tok_e[t_])[k_]; P_ = ((const int*)&p.tok_pos[t_])[k_]; \
        const uint4* src_ = (const uint4*)(p.hb + t_ * D); A0 = src_[lane]; A1 = src_[64 + lane]; A2 = src_[128 + lane]; A3 = src_[192 + lane]; } while (0)
#define MP_STORE(it_, E_, P_, A0, A1, A2, A3) do { if (!MP_SKIP(it_)) { int base_ = 0; \
        _Pragma("unroll") for (int q = 0; q < NE; ++q) { const int nt_ = (p.cnt[l * NE + q] + 255) >> 8; base_ += (q < E_) ? nt_ * 256 : 0; } \
        const int row_ = base_ + P_; uint4* dst_ = (uint4*)(p.hperm + (size_t)row_ * D); dst_[lane] = A0; dst_[64 + lane] = A1; dst_[128 + lane] = A2; dst_[192 + lane] = A3; \
        if (lane == 0) ((int*)&p.tok_row[(it_) >> 1])[(it_) & 1] = row_; } } while (0)
    size_t it = wv;
    for (; it + 2 * nwv < (size_t)2 * TT; it += 3 * nwv) {
        int e0, p0, e1, p1, e2, p2; uint4 a0, a1, a2, a3, b0, b1, b2, b3, c0, c1, c2, c3;
        MP_LOAD(it, e0, p0, a0, a1, a2, a3); MP_LOAD(it + nwv, e1, p1, b0, b1, b2, b3); MP_LOAD(it + 2 * nwv, e2, p2, c0, c1, c2, c3);
        MP_STORE(it, e0, p0, a0, a1, a2, a3); MP_STORE(it + nwv, e1, p1, b0, b1, b2, b3); MP_STORE(it + 2 * nwv, e2, p2, c0, c1, c2, c3);
    }
    for (; it < (size_t)2 * TT; it += nwv) { int e0, p0; uint4 a0, a1, a2, a3; MP_LOAD(it, e0, p0, a0, a1, a2, a3); MP_STORE(it, e0, p0, a0, a1, a2, a3); }
#undef MP_LOAD
#undef MP_STORE
#undef MP_SKIP
}

DEVFN void ph_ln2(const Params& p, int l, size_t vt, size_t vs) {
    const float alpha = DN_ALPHA;
    const int lane = (TIDX() & 63);
    const size_t wv = vt >> 6, nwv = vs >> 6;
    for (size_t t = wv; t < (size_t)TT; t += nwv) {
        const int b = (int)(t / LL), s = (int)(t % LL); const int r = s < CTX ? NB : b;
        if (l == DEPTH - 1 && s < CTX) continue;
        const float* m = p.mod + ((size_t)l * NMOD + r) * 6 * D;
        float* xr = p.xs + t * D;
        const int2 rw2 = p.tok_row[t]; const float2 ww = p.tok_w[t];
        const bf16_t* f0 = p.Fperm + (size_t)rw2.x * D; const bf16_t* f1 = p.Fperm + (size_t)rw2.y * D;
        float4 u[LNV];
        float sum = 0.f;
#pragma unroll
        for (int i = 0; i < LNV; ++i) {
            const int d = i * 256 + lane * 4;
            const float4 xv = *(const float4*)(xr + d), gv = *(const float4*)(m + 5 * D + d);
            const uint2 a0 = *(const uint2*)(f0 + d), a1 = *(const uint2*)(f1 + d);
            u[i].x = alpha * xv.x + gv.x * (ww.x * bflo(a0.x) + ww.y * bflo(a1.x)); u[i].y = alpha * xv.y + gv.y * (ww.x * bfhi(a0.x) + ww.y * bfhi(a1.x));
            u[i].z = alpha * xv.z + gv.z * (ww.x * bflo(a0.y) + ww.y * bflo(a1.y)); u[i].w = alpha * xv.w + gv.w * (ww.x * bfhi(a0.y) + ww.y * bfhi(a1.y));
            sum += u[i].x + u[i].y + u[i].z + u[i].w;
        }
        const float* mn = p.mod + ((size_t)(l + 1 < DEPTH ? l + 1 : l) * NMOD + r) * 6 * D;
        float4 ggv[LNV], bbv[LNV];
#pragma unroll
        for (int i = 0; i < LNV; ++i) {
            const int d = i * 256 + lane * 4;
            ggv[i] = *(const float4*)(p.ln2_g + (size_t)l * D + d); bbv[i] = *(const float4*)(p.ln2_b + (size_t)l * D + d);
        }
        asm volatile("" ::: "memory");
        const float mu = wave_sum(sum) * (1.0f / D);
        float sq = 0.f;
#pragma unroll
        for (int i = 0; i < LNV; ++i) { const float a0 = u[i].x - mu, a1 = u[i].y - mu, a2 = u[i].z - mu, a3 = u[i].w - mu; sq += a0 * a0 + a1 * a1 + a2 * a2 + a3 * a3; }
        const float rs = 1.0f / sqrtf(wave_sum(sq) * (1.0f / D) + LN_EPS);
#pragma unroll
        for (int i = 0; i < LNV; ++i) {
            const int d = i * 256 + lane * 4;
            const float4 gg = ggv[i], bb = bbv[i];
            float4 xn;
            xn.x = (u[i].x - mu) * rs * gg.x + bb.x; xn.y = (u[i].y - mu) * rs * gg.y + bb.y; xn.z = (u[i].z - mu) * rs * gg.z + bb.z; xn.w = (u[i].w - mu) * rs * gg.w + bb.w;
            if (l < DEPTH - 1) *(float4*)(xr + d) = xn;
            if (l == DEPTH - 1) { if (s >= CTX) *(float4*)(p.out + ((size_t)b * SEQ + (s - CTX)) * D + d) = xn; }
            else {
                const float4 sc = *(const float4*)(mn + D + d), sh = *(const float4*)(mn + d);
                uint2 pk;
                pk.x = (unsigned)f2bf(xn.x * (1.0f + sc.x) + sh.x) | ((unsigned)f2bf(xn.y * (1.0f + sc.y) + sh.y) << 16);
                pk.y = (unsigned)f2bf(xn.z * (1.0f + sc.z) + sh.z) | ((unsigned)f2bf(xn.w * (1.0f + sc.w) + sh.w) << 16);
                *(uint2*)(p.xm + t * D + d) = pk;
            }
        }
    }
}

namespace pg8 {
#define PG8_LAS __attribute__((address_space(3)))
typedef unsigned short bf16_t;
typedef short bf16x8 __attribute__((ext_vector_type(8)));
typedef float f32x4 __attribute__((ext_vector_type(4)));
typedef unsigned u32x4 __attribute__((ext_vector_type(4)));
constexpr int BM = 256, BK = 64, HALF = 128, HTB = HALF * BK * 2  , STAGE_BYTES = 8 * HTB, NXCD = 8, WGM = 8;

__host__ __device__ __forceinline__ int lds_byte(int r, int c) { const int st = (r >> 4) * 2 + (c >> 5), rr = r & 15, cc = c & 31, ob = rr * 64 + cc * 2; return st * 1024 + (ob ^ (((ob >> 9) & 1) << 5)); }
__host__ __device__ __forceinline__ void stage_rc(int b, int& R, int& C) { const int st = b / 1024, sb = b % 1024, swz = sb ^ (((sb >> 9) & 1) << 5); R = (st >> 1) * 16 + swz / 64; C = (st & 1) * 32 + (swz % 64) / 2; }
__host__ __device__ __forceinline__ int perm32(int rho) { const int n = rho >> 4, i = rho & 15; return 8 * (i >> 2) + 4 * n + (i & 3); }

struct Unit { int pm, pn; };
struct Gemm { const bf16_t* A; const bf16_t* Bt; int M, N, K; };

struct StaticOrder {
    int nM, nN, nwg, G, c;
    __host__ __device__ void init(int M, int N, int G_, int c_) { nM = M / BM; nN = N / BM; nwg = nM * nN; G = G_; c = c_; }
    __host__ __device__ bool next(int i, Unit& u) const {
        const long L = (long)i * G + c; if (L >= nwg) return false;
        int wgid = (int)L; { const int q = nwg / NXCD, r = nwg % NXCD, xcd = wgid % NXCD, off = wgid / NXCD; wgid = (xcd < r ? xcd * (q + 1) : r * (q + 1) + (xcd - r) * q) + off; }
        const int nig = WGM * nN, gid = wgid / nig, fm = gid * WGM, gsz = (nM - fm) < WGM ? (nM - fm) : WGM;
        u.pm = fm + ((wgid % nig) % gsz); u.pn = (wgid % nig) / gsz; return true;
    }
    __device__ __forceinline__ void a_ready(const Unit&) const {}
    __device__ __forceinline__ void done(const Unit&) const {}
};
__device__ __forceinline__ unsigned cvt_pk_bf16(float lo, float hi) { return ::cvt_pk_bf16(lo, hi); }
struct EpiF32 {
    static constexpr bool PERM = false, AFTER_DRAIN = false;
    float* C; int ldc; const float* bias;
    __device__ __forceinline__ void operator()(const f32x4 (&acc)[2][2][4][2], const Unit& u, int wr, int wc, int fr, int fq) const {
        const int row0 = u.pm * BM + wr * 64 + fr, col0 = u.pn * BM + wc * 32 + 4 * fq;
        f32x4 bv[2][2];
#pragma unroll
        for (int bj = 0; bj < 2; ++bj)
#pragma unroll
            for (int n = 0; n < 2; ++n) bv[bj][n] = bias ? *(const f32x4*)(bias + col0 + bj * HALF + n * 16) : (f32x4){0.f, 0.f, 0.f, 0.f};
#pragma unroll
        for (int ai = 0; ai < 2; ++ai)
#pragma unroll
            for (int m = 0; m < 4; ++m) { float* rowp = C + (size_t)(row0 + ai * HALF + m * 16) * ldc + col0;
#pragma unroll
                for (int bj = 0; bj < 2; ++bj)
#pragma unroll
                    for (int n = 0; n < 2; ++n) *(f32x4*)(rowp + bj * HALF + n * 16) = acc[ai][bj][m][n] + bv[bj][n]; }
    }
};
template <class Epi, class Sched, bool STAMP = false>
__device__ __forceinline__ void gemm_phase(PG8_LAS unsigned char* lds, const Gemm g, const Sched& S, const Epi& E, unsigned long long* stamps) {
    const int tid = TIDX(), wid = __builtin_amdgcn_readfirstlane(tid >> 6), lane = tid & 63, wr = wid >> 2, wc = wid & 3, fr = lane & 15, fq = lane >> 4;
    const int K = g.K, nt = K / BK;
    int ts_lo = 0, ts_hi = 0, nts = 0; const unsigned long long rt_entry = STAMP ? (unsigned long long)wall_clock64() : 0ull;
#define PG8_STAMP() do { if (STAMP && wid == 0 && nts < 64) { const unsigned long long _c = (unsigned long long)clock64(); \
        ts_lo = (lane == nts) ? (int)(unsigned)_c : ts_lo; ts_hi = (lane == nts) ? (int)(unsigned)(_c >> 32) : ts_hi; ++nts; } } while (0)
    PG8_STAMP();
    unsigned voffA[2], voffB[2];
#pragma unroll
    for (int i = 0; i < 2; ++i) { int R, C; stage_rc(tid * 16 + i * 8192, R, C); const int Rb = Epi::PERM ? ((R & ~31) + perm32(R & 31)) : R;
        voffA[i] = (unsigned)(R * K + C) * 2u; voffB[i] = (unsigned)(Rb * K + C) * 2u; }
    const size_t kstep = (size_t)(BK * 2);
    const size_t hstep = (size_t)HALF * K * 2;
    const size_t tstep = 2 * hstep;
    const unsigned ldsw = (unsigned)wid * 1024u;
    const int aoff = lds_byte(wr * 64 + fr, fq * 8), boff = lds_byte(wc * 32 + fr, fq * 8);
#define PG8_SA(b, h) (((b) * 2 + (h)) * HTB)
#define PG8_SB(b, h) ((4 + (b) * 2 + (h)) * HTB)
#define PG8_STAGE(bufoff, gbase, voff) do { _Pragma("unroll") for (int _i = 0; _i < 2; ++_i) \
        __builtin_amdgcn_global_load_lds((const unsigned*)((const char*)(gbase) + (voff)[_i]), (PG8_LAS unsigned*)(lds + (bufoff) + ldsw + _i * 8192), 16, 0, 0); } while (0)
#define PG8_LDA(dst, b, h) do { _Pragma("unroll") for (int m = 0; m < 4; ++m) _Pragma("unroll") for (int k = 0; k < 2; ++k) dst[m][k] = *(const PG8_LAS bf16x8*)(lds + PG8_SA(b, h) + aoff + m * 2048 + k * 1024); } while (0)
#define PG8_LDB(dst, b, h) do { _Pragma("unroll") for (int n = 0; n < 2; ++n) _Pragma("unroll") for (int k = 0; k < 2; ++k) dst[n][k] = *(const PG8_LAS bf16x8*)(lds + PG8_SB(b, h) + boff + n * 2048 + k * 1024); } while (0)
#define PG8_MMA(ai, bj, At, Bt) do { __builtin_amdgcn_s_setprio(1); _Pragma("unroll") for (int m = 0; m < 4; ++m) _Pragma("unroll") for (int n = 0; n < 2; ++n) _Pragma("unroll") for (int k = 0; k < 2; ++k) \
        acc[ai][bj][m][n] = __builtin_amdgcn_mfma_f32_16x16x32_bf16(Bt[n][k], At[m][k], acc[ai][bj][m][n], 0, 0, 0); __builtin_amdgcn_s_setprio(0); } while (0)
#define PG8_WAIT_V(n) asm volatile("s_waitcnt vmcnt(" #n ")" ::: "memory")
#define PG8_WAIT_L(n) asm volatile("s_waitcnt lgkmcnt(" #n ")" ::: "memory")
#define PG8_BAR __builtin_amdgcn_s_barrier()
#define PG8_SCHED __builtin_amdgcn_sched_barrier(0)
    Unit cur, nxt; int ui = 0;
    if (!S.next(0, cur)) return;
    f32x4 acc[2][2][4][2];
#pragma unroll
    for (int a = 0; a < 2; ++a)
#pragma unroll
        for (int b = 0; b < 2; ++b)
#pragma unroll
            for (int m = 0; m < 4; ++m)
#pragma unroll
                for (int n = 0; n < 2; ++n) acc[a][b][m][n] = (f32x4){0.f, 0.f, 0.f, 0.f};
    bf16x8 At[4][2], B0[2][2], B1[2][2];
    const char* cA = (const char*)g.A + (size_t)cur.pm * tstep; const char* cB = (const char*)g.Bt + (size_t)cur.pn * tstep;
    S.a_ready(cur);
    PG8_STAGE(PG8_SB(0, 0), cB, voffB); PG8_STAGE(PG8_SA(0, 0), cA, voffA); PG8_STAGE(PG8_SB(0, 1), cB + hstep, voffB); PG8_STAGE(PG8_SA(0, 1), cA + hstep, voffA);
    if (wr == 1) PG8_BAR;
    PG8_WAIT_V(4); PG8_BAR;
    PG8_STAGE(PG8_SB(1, 0), cB + kstep, voffB); PG8_STAGE(PG8_SA(1, 0), cA + kstep, voffA); PG8_STAGE(PG8_SB(1, 1), cB + hstep + kstep, voffB);
    PG8_WAIT_V(6); PG8_BAR;
    PG8_STAMP();
    for (;;) {
        const bool has_next = S.next(ui + 1, nxt);
        const char* nA = has_next ? (const char*)g.A + (size_t)nxt.pm * tstep : cA; const char* nB = has_next ? (const char*)g.Bt + (size_t)nxt.pn * tstep : cB;
        for (int t = 0; t < nt; t += 2) {
            const bool last = (t == nt - 2);
            const char* a1 = cA + (size_t)(t + 1) * kstep;
            const char* a2 = last ? nA : cA + (size_t)(t + 2) * kstep; const char* b2 = last ? nB : cB + (size_t)(t + 2) * kstep;
            const char* a3 = a2 + kstep; const char* b3 = b2 + kstep;
            if (last && has_next) S.a_ready(nxt);
            PG8_LDB(B0, 0, 0); PG8_SCHED; PG8_LDA(At, 0, 0); PG8_STAGE(PG8_SA(1, 1), a1 + hstep, voffA);
            PG8_WAIT_L(8); PG8_BAR; PG8_WAIT_L(0); PG8_MMA(0, 0, At, B0); PG8_BAR; PG8_SCHED;
            PG8_LDB(B1, 0, 1); PG8_STAGE(PG8_SB(0, 0), b2, voffB);
            PG8_BAR; PG8_WAIT_L(0); PG8_MMA(0, 1, At, B1); PG8_BAR;
            PG8_LDA(At, 0, 1); PG8_STAGE(PG8_SA(0, 0), a2, voffA);
            PG8_BAR; PG8_WAIT_L(0); PG8_MMA(1, 0, At, B0); PG8_BAR; PG8_SCHED;
            PG8_STAGE(PG8_SB(0, 1), b2 + hstep, voffB);
            PG8_WAIT_V(6); PG8_BAR; PG8_MMA(1, 1, At, B1); PG8_BAR;
            PG8_LDB(B0, 1, 0); PG8_SCHED; PG8_LDA(At, 1, 0); PG8_STAGE(PG8_SA(0, 1), a2 + hstep, voffA);
            PG8_WAIT_L(8); PG8_BAR; PG8_WAIT_L(0); PG8_MMA(0, 0, At, B0); PG8_BAR; PG8_SCHED;
            PG8_LDB(B1, 1, 1); PG8_STAGE(PG8_SB(1, 0), b3, voffB);
            PG8_BAR; PG8_WAIT_L(0); PG8_MMA(0, 1, At, B1); PG8_BAR;
            PG8_LDA(At, 1, 1); PG8_STAGE(PG8_SA(1, 0), a3, voffA);
            PG8_BAR; PG8_WAIT_L(0); PG8_MMA(1, 0, At, B0); PG8_BAR; PG8_SCHED;
            PG8_STAGE(PG8_SB(1, 1), b3 + hstep, voffB);
            PG8_WAIT_V(6); PG8_BAR; PG8_MMA(1, 1, At, B1); PG8_BAR;
        }
        PG8_STAMP();
        if constexpr (!Epi::AFTER_DRAIN) { E(acc, cur, wr, wc, fr, fq); S.done(cur); }
        PG8_STAMP();
        if (!has_next) break;
#pragma unroll
        for (int a = 0; a < 2; ++a)
#pragma unroll
            for (int b = 0; b < 2; ++b)
#pragma unroll
                for (int m = 0; m < 4; ++m)
#pragma unroll
                    for (int n = 0; n < 2; ++n) acc[a][b][m][n] = (f32x4){0.f, 0.f, 0.f, 0.f};
        cur = nxt; cA = nA; cB = nB; ++ui;
    }
    PG8_WAIT_V(0);
    if (wr == 0) PG8_BAR;
    PG8_BAR;
    if constexpr (Epi::AFTER_DRAIN) { E.fused(acc, cur, wr, wc, fr, fq, lds, wid, lane); S.done(cur); }
    PG8_STAMP();
    if (STAMP && wid == 0) { stamps[lane] = lane < nts ? (((unsigned long long)(unsigned)ts_hi << 32) | (unsigned)ts_lo) : 0ull;
        if (lane == 62) stamps[62] = rt_entry; if (lane == 63) stamps[63] = (unsigned long long)wall_clock64(); }
#undef PG8_STAMP
#undef PG8_SA
#undef PG8_SB
#undef PG8_STAGE
#undef PG8_LDA
#undef PG8_LDB
#undef PG8_MMA
#undef PG8_WAIT_V
#undef PG8_WAIT_L
#undef PG8_BAR
#undef PG8_SCHED
}
}

namespace pg8 {
struct EpiBf16N {
    static constexpr bool PERM = true, AFTER_DRAIN = false;
    bf16_t* O; int ldc; int ncols;
    __device__ __forceinline__ void operator()(const f32x4 (&acc)[2][2][4][2], const Unit& u, int wr, int wc, int fr, int fq) const {
        const int row0 = u.pm * BM + wr * 64 + fr; const int col0 = u.pn * BM + wc * 32 + 8 * fq;
#pragma unroll
        for (int ai = 0; ai < 2; ++ai)
#pragma unroll
            for (int m = 0; m < 4; ++m) { bf16_t* rowp = O + (size_t)(row0 + ai * HALF + m * 16) * ldc + col0;
#pragma unroll
                for (int bj = 0; bj < 2; ++bj) { const f32x4 v0 = acc[ai][bj][m][0], v1 = acc[ai][bj][m][1];
                    u32x4 w; w.x = ::cvt_pk_bf16_h(v0[0], v0[1]); w.y = ::cvt_pk_bf16_h(v0[2], v0[3]); w.z = ::cvt_pk_bf16_h(v1[0], v1[1]); w.w = ::cvt_pk_bf16_h(v1[2], v1[3]);
                    if (col0 + bj * HALF < ncols) *(u32x4*)(rowp + bj * HALF) = w; } }
    }
};
struct LatentOrder : StaticOrder {
    __device__ __forceinline__ bool next(int i, Unit& u) const {
        if (!StaticOrder::next(i, u)) return false;
        constexpr int LT = SEQ / 256, CT = CTX / 256;
        u.pm = (u.pm / LT) * (LT + CT) + CT + (u.pm % LT); return true;
    }
};
struct TailOrder {
    int pm0, nM, nN, G, c;
    __device__ __forceinline__ bool next(int i, Unit& u) const {
        if (c >= G) return false;
        const int L = i * G + c; if (L >= (nM - pm0) * nN) return false;
        u.pm = pm0 + L / nN; u.pn = L % nN; return true;
    }
    __device__ __forceinline__ void a_ready(const Unit&) const {}
    __device__ __forceinline__ void done(const Unit&) const {}
};
struct EpiBf16Grp {
    static constexpr bool PERM = true, AFTER_DRAIN = false;
    bf16_t* O; int ldc; int ncu;
    __device__ __forceinline__ void operator()(const f32x4 (&acc)[2][2][4][2], const Unit& u, int wr, int wc, int fr, int fq) const {
        const int row0 = u.pm * BM + wr * 64 + fr; const int col0 = (u.pn % ncu) * BM + wc * 32 + 8 * fq;
#pragma unroll
        for (int ai = 0; ai < 2; ++ai)
#pragma unroll
            for (int m = 0; m < 4; ++m) { bf16_t* rowp = O + (size_t)(row0 + ai * HALF + m * 16) * ldc + col0;
#pragma unroll
                for (int bj = 0; bj < 2; ++bj) { const f32x4 v0 = acc[ai][bj][m][0], v1 = acc[ai][bj][m][1];
                    u32x4 w; w.x = ::cvt_pk_bf16_h(v0[0], v0[1]); w.y = ::cvt_pk_bf16_h(v0[2], v0[3]); w.z = ::cvt_pk_bf16_h(v1[0], v1[1]); w.w = ::cvt_pk_bf16_h(v1[2], v1[3]);
                    *(u32x4*)(rowp + bj * HALF) = w; } }
    }
};
struct MoeOrder {
    const int* cnt; int G, c, ncu;
    __device__ __forceinline__ bool next(int i, Unit& u) const {
        int tot = 0;
#pragma unroll
        for (int k = 0; k < 16; ++k) tot += (cnt[k] + 255) >> 8;
        int rt, cu;
        if ((G & 7) == 0) {
            const int x = c & 7, rank = c >> 3, per = G >> 3;
            const int t0 = (tot * x) >> 3, t1 = (tot * (x + 1)) >> 3;
            const int k = i * per + rank;
            if (k >= (t1 - t0) * ncu) return false;
            rt = t0 + k / ncu; cu = k % ncu;
        } else {
            const long L = (long)i * G + c; rt = (int)(L / ncu); cu = (int)(L % ncu);
            if (rt >= tot) return false;
        }
        int acc = 0, e = -1;
#pragma unroll
        for (int k = 0; k < 16; ++k) { const int nt = (cnt[k] + 255) >> 8; e = (e < 0 && rt < acc + nt) ? k : e; acc += nt; }
        if (e < 0) return false;
        u.pm = rt; u.pn = e * ncu + cu; return true;
    }
    __device__ __forceinline__ void a_ready(const Unit&) const {}
    __device__ __forceinline__ void done(const Unit&) const {}
};
struct EpiSwiGLU {
    static constexpr bool PERM = true, AFTER_DRAIN = false;
    bf16_t* O; int ldc; int ncu;
    __device__ __forceinline__ void operator()(const f32x4 (&acc)[2][2][4][2], const Unit& u, int wr, int wc, int fr, int fq) const {
        const int row0 = u.pm * BM + wr * 64 + fr; const int col0 = (u.pn % ncu) * HALF + wc * 32 + 8 * fq;
#pragma unroll
        for (int ai = 0; ai < 2; ++ai)
#pragma unroll
            for (int m = 0; m < 4; ++m) {
                float hv[8];
#pragma unroll
                for (int n = 0; n < 2; ++n)
#pragma unroll
                    for (int q = 0; q < 4; ++q) { const float g = acc[ai][0][m][n][q], up = acc[ai][1][m][n][q]; hv[4 * n + q] = g / (1.0f + __expf(-g)) * up; }
                u32x4 w; w.x = cvt_pk_bf16(hv[0], hv[1]); w.y = cvt_pk_bf16(hv[2], hv[3]); w.z = cvt_pk_bf16(hv[4], hv[5]); w.w = cvt_pk_bf16(hv[6], hv[7]);
                *(u32x4*)(O + (size_t)(row0 + ai * HALF + m * 16) * ldc + col0) = w;
            }
    }
};
}

#define XB_TMO      128
#define XB_XCNT(j)  (256  + 64 * (j))
#define XB_XSUB(j)  (1280 + 64 * (j))
#define XB_XGEN(j)  (2304 + 64 * (j))
#define XB_TOP      3328
#define XB_TOPGEN   3392
#define XCD_BAR_WORDS 3456
#define XB_SPIN_CAP (1u << 18)
#define LAS __attribute__((address_space(3)))

__device__ __forceinline__ unsigned xb_ld(unsigned* p)              { return __hip_atomic_load(p, __ATOMIC_RELAXED, __HIP_MEMORY_SCOPE_AGENT); }
__device__ __forceinline__ unsigned xb_add(unsigned* p, unsigned v) { return __hip_atomic_fetch_add(p, v, __ATOMIC_RELAXED, __HIP_MEMORY_SCOPE_AGENT); }
__device__ __forceinline__ unsigned xb_xcc_id() { return (unsigned)__builtin_amdgcn_s_getreg((3 << 11) | 20) & 0xFu; }
#define XB_SPIN(cond, bar) do { unsigned _sp = 0; while (cond) { __builtin_amdgcn_s_sleep(1); \
    if ((++_sp & 255u) == 0u) { if (xb_ld(&(bar)[XB_TMO])) break; if (_sp > XB_SPIN_CAP) { atomicAdd(&(bar)[XB_TMO], 1u); break; } } } } while (0)

struct XcdBarrier {
    unsigned* bar; unsigned x;
    volatile LAS unsigned* st;
};

__device__ __forceinline__ XcdBarrier xcd_barrier_post(unsigned* bar, volatile LAS unsigned* st) {
    XcdBarrier b; b.bar = bar; b.x = xb_xcc_id(); b.st = st;
    if (threadIdx.x == 0) (void)xb_add(&bar[XB_XCNT(b.x)], 1u);
    return b;
}
__device__ __forceinline__ void xcd_barrier_complete(unsigned* bar, unsigned x, unsigned& nloc, unsigned& nx) {
    const unsigned G = gridDim.x * gridDim.y * gridDim.z;
    unsigned sum, cnt, mine, sp = 0u;
    for (;;) {
        sum = 0u; cnt = 0u; mine = 0u;
#pragma unroll
        for (unsigned j = 0; j < 16; ++j) { const unsigned c = xb_ld(&bar[XB_XCNT(j)]); sum += c; cnt += (c > 0u) ? 1u : 0u; mine = (j == x) ? c : mine; }
        if (sum == G) break;
        __builtin_amdgcn_s_sleep(1);
        if ((++sp & 255u) == 0u) { if (xb_ld(&bar[XB_TMO])) break; if (sp > XB_SPIN_CAP) { atomicAdd(&bar[XB_TMO], 1u); break; } }
    }
    nloc = mine > 0u ? mine : 1u; nx = cnt > 0u ? cnt : 1u;
}

__device__ __forceinline__ void xcd_barrier(const XcdBarrier& b) {
    asm volatile("s_waitcnt vmcnt(0)" ::: "memory");
    __syncthreads();
    if (threadIdx.x == 0) {
        unsigned* bar = b.bar;
        __builtin_amdgcn_s_waitcnt(0);
        unsigned nloc = b.st[0], nx = b.st[1];
        if (nloc == 0u) { xcd_barrier_complete(bar, b.x, nloc, nx); b.st[0] = nloc; b.st[1] = nx; }
        const unsigned old = xb_add(&bar[XB_XSUB(b.x)], 1u);
        const unsigned gen = old / nloc;
        if (old + 1u == (gen + 1u) * nloc) {
            __builtin_amdgcn_fence(__ATOMIC_RELEASE, "agent");
            asm volatile("s_waitcnt vmcnt(0)" ::: "memory");
            const unsigned og = xb_add(&bar[XB_TOP], 1u);
            const unsigned tg = og / nx;
            if (og + 1u == (tg + 1u) * nx) xb_add(&bar[XB_TOPGEN], 1u);
            else XB_SPIN(xb_ld(&bar[XB_TOPGEN]) == tg, bar);
            __builtin_amdgcn_fence(__ATOMIC_ACQUIRE, "agent");
            xb_add(&bar[XB_XGEN(b.x)], 1u);
            asm volatile("s_waitcnt vmcnt(0)" ::: "memory");
        } else {
            XB_SPIN(xb_ld(&bar[XB_XGEN(b.x)]) == gen, bar);
            __builtin_amdgcn_fence(__ATOMIC_ACQUIRE, "agent");
            asm volatile("s_waitcnt vmcnt(0)" ::: "memory");
        }
    }
    __syncthreads();
}

constexpr int NT = 512;
constexpr int LDS_STAGE = pg8::STAGE_BYTES;
constexpr int LDS_MISC = LDS_STAGE;
constexpr int LDS_RT = LDS_STAGE + 64;
constexpr int LDS_BYTES = LDS_STAGE + 64 + 256;
struct MegaArgs { Params p; unsigned* bar; int reps[16]; };

DEVFN size_t VTF() { return (size_t)blockIdx.x * 512 + (size_t)TIDX(); }
DEVFN int OPQS(int v) { asm volatile("" : "+s"(v)); return v; }
typedef const __attribute__((address_space(4))) MegaArgs* KArgP;
DEVFN int REPS(int k) { KArgP ka = (KArgP)__builtin_amdgcn_kernarg_segment_ptr(); asm volatile("" : "+s"(ka)); return ka->reps[k]; }
DEVFN unsigned* BARP() { KArgP ka = (KArgP)__builtin_amdgcn_kernarg_segment_ptr(); asm volatile("" : "+s"(ka)); return ka->bar; }
DEVFN const Params& PF() { KArgP ka = (KArgP)__builtin_amdgcn_kernarg_segment_ptr(); asm volatile("" : "+s"(ka)); return *(const Params*)&ka->p; }
DEVFN int NBF() { int g = (int)gridDim.x; asm volatile("" : "+s"(g)); return g; }
DEVFN size_t VSF() { return (size_t)NBF() * 512; }
__global__ void __launch_bounds__(NT, 2) k_mega(MegaArgs a) {
    extern __shared__ __attribute__((aligned(16))) unsigned char lds[];
    bf16_t* const smem = (bf16_t*)lds;
    volatile int* const s_unit = (volatile int*)(lds + LDS_MISC + 16);
    static_assert(2 * AT_NSUB * AT_BUF * 2 <= LDS_STAGE && 2 * AT_BUF * 2 + 2048 <= LDS_STAGE && AT_BUF >= NA_BUF && (NT / 64) * RW_STG * 4 <= LDS_STAGE, "LDS carve");
    if (threadIdx.x == 0) *(uint4*)(lds + LDS_MISC) = make_uint4(0u, 0u, 0u, 0u);
    __syncthreads();
    (void)xcd_barrier_post(a.bar, (volatile LAS unsigned*)(lds + LDS_MISC));
#define GRID_BARRIER() do { XcdBarrier b_; b_.bar = BARP(); b_.x = xb_xcc_id(); b_.st = (volatile LAS unsigned*)(lds + LDS_MISC); xcd_barrier(b_); } while (0)
    const Params& p = a.p;
    const int nb = gridDim.x, bx = blockIdx.x;
    const size_t vt = (size_t)bx * NT + threadIdx.x, vs = (size_t)nb * NT;

    ph_init(p, 0, vt, vs);
    for (int r_ = a.reps[12]; r_ > 0; --r_) {
    ph_mod_partial(p, vt, vs);
#pragma unroll 1
    for (int mat = 0; mat < 11; ++mat) conv_mat(p, 0, mat, (unsigned*)smem + (threadIdx.x >> 6) * (64 * 32), bx * 8 + (int)(threadIdx.x >> 6), 0x7fffffff, nb * 8);
    }
    ph_zero16((uint4*)p.WupT, (size_t)DEPTH * NUP * KUP * 2 / 16, vt, vs);
    ph_zero16((uint4*)p.WloT, (size_t)DEPTH * NLO * KLO * 2 / 16, vt, vs);
    GRID_BARRIER();
    ph_mod_final(p, vt, vs);
    ph_transpose(p.mla_w_uq, p.WupT, MLA_QL, NUPQ, DEPTH, (size_t)NUP * KUP, 0, KUP, 0, vt, vs);
    ph_transpose(p.mla_w_ukv, p.WupT, MLA_KVL, NUP - NUPQ, DEPTH, (size_t)NUP * KUP, NUPQ, KUP, MLA_QL, vt, vs);
    for (int dir = 0; dir < 2; ++dir) {
        ph_transpose(p.rw_w_up + (size_t)dir * RW_WL * GD, p.WloT, RW_WL, GD, DEPTH, (size_t)NLO * KLO, dir * GD, KLO, dir * RW_WL, vt, vs, (size_t)2 * RW_WL * GD);
        ph_transpose(p.rw_a_up + (size_t)dir * RW_AL * GD, p.WloT, RW_AL, GD, DEPTH, (size_t)NLO * KLO, 2 * GD + dir * GD, KLO, 2 * RW_WL + dir * RW_AL, vt, vs, (size_t)2 * RW_AL * GD);
    }
    ph_transpose(p.rw_g_up, p.WloT, RW_GL, GD, DEPTH, (size_t)NLO * KLO, 4 * GD, KLO, 2 * RW_WL + 2 * RW_AL, vt, vs);
    GRID_BARRIER();
    ph_modulate(p, 0, vt, vs);
    GRID_BARRIER();

    for (int l = 0; l < DEPTH; ++l) {
        for (int r_ = REPS(0); r_ > 0; --r_)
        {
            pg8::Gemm g{PF().xm, PF().WinT + (size_t)l * N_INP * D, TT, N_INP, D}; pg8::StaticOrder S; S.init(TT, N_INP, NBF(), OPQS(bx));
            pg8::EpiBf16N E{PF().P, N_IN, N_IN};
            pg8::gemm_phase<pg8::EpiBf16N, pg8::StaticOrder, false>((PG8_LAS unsigned char*)lds, g, S, E, nullptr);
            GRID_BARRIER();
        }
        for (int r_ = REPS(1); r_ > 0; --r_) {
        ph_rw_mix(PF(), l, VTF(), VSF());
        ph_mb_prep(PF(), l, VTF(), VSF());
        ph_mla_norm(PF(), l, VTF(), VSF());
        ph_vt_tiles(PF(), 0, smem, OPQS(bx), NBF());
        GRID_BARRIER();
        }
        for (int r_ = REPS(8); r_ > 0; --r_) {
        {
            pg8::Gemm g{PF().pmb, PF().WloT + (size_t)l * NLO * KLO, TT, NLO, KLO}; pg8::StaticOrder S; S.init(TT, NLO, NBF(), OPQS(bx));
            pg8::EpiBf16N E{PF().LO, NLO, NLO};
            pg8::gemm_phase<pg8::EpiBf16N, pg8::StaticOrder, false>((PG8_LAS unsigned char*)lds, g, S, E, nullptr);
        }
        {
            pg8::Gemm g{PF().qkvn, PF().WupT + (size_t)l * NUP * KUP, TT, NUP, KUP}; pg8::StaticOrder S; S.init(TT, NUP, NBF(), OPQS(bx));
            pg8::EpiF32 E{PF().QKVraw, NUP, nullptr};
            pg8::gemm_phase<pg8::EpiF32, pg8::StaticOrder, false>((PG8_LAS unsigned char*)lds, g, S, E, nullptr);
        }
        GRID_BARRIER();
        }
        for (int r_ = REPS(9); r_ > 0; --r_) { ph_rw_prep(PF(), l, VTF(), VSF()); ph_mla_rope(PF(), l, VTF(), VSF()); ph_vt_tiles(PF(), 1, smem, OPQS(bx), NBF()); ph_vt_tiles(PF(), 2, smem, OPQS(bx), NBF()); ph_vt_tiles(PF(), 3, smem, OPQS(bx), NBF()); ph_bc_frag(PF(), OPQS(bx), NBF()); }
        GRID_BARRIER();
        for (int r_ = REPS(10); r_ > 0; --r_) { ph_chunks(PF(), l, (float*)lds, PF().qctr + l * 16 + 8 + (r_ - 1), PF().qctr + l * 16 + 12 + (r_ - 1)); GRID_BARRIER(); }
        {
            constexpr int SEQ_BLOCKS = (NU * 2 * 64 + NT - 1) / NT;
            const int wv = __builtin_amdgcn_readfirstlane((int)(VTF() >> 6));
            for (int r_ = REPS(6); r_ > 0; --r_) {
                if (bx < NU) ph_rw_seq(PF(), lds, OPQS(bx), NU);
                else if (bx < NU + 2 * SEQ_BLOCKS) ph_mb_seq(PF(), wv - NU * (NT / 64), 2 * SEQ_BLOCKS * (NT / 64));
            }
            constexpr int QB = (NT / 64) * 32, RPU = NT / 128;
            const bool with_ctx = l < DEPTH - 1;
            const int n_mla = NB * NH * (SEQ / QB) + (with_ctx ? NB * NH * (CTX / QB) : 0);
            const int n_na = NB * NH * ((SEQ / GRID_W) / RPU) + (with_ctx ? NB * NH * (CTX / QB) : 0);
            for (int r_ = REPS(2); r_ > 0; --r_)
            for (;;) {
                __syncthreads();
                if (threadIdx.x == 0) *s_unit = atomicAdd(&PF().qctr[l * 16 + (r_ - 1)], 1);
                __syncthreads();
                const int u = *s_unit;
                if (u >= 2 * n_mla) break;
                mla_unit<NT>(PF(), smem, u);
            }
            for (int r_ = REPS(7); r_ > 0; --r_)
            for (;;) {
                __syncthreads();
                if (threadIdx.x == 0) *s_unit = atomicAdd(&PF().qctr[l * 16 + 4 + (r_ - 1)], 1);
                __syncthreads();
                const int u = *s_unit;
                if (u >= n_na) break;
                na_unit<NT>(PF(), l, smem, u);
            }
            GRID_BARRIER();
        }
        for (int r_ = REPS(3); r_ > 0; --r_) {
        ph_mb_yout_wg(PF(), l, (float*)lds, OPQS(bx), NBF());
        ph_rw_yout(PF(), l, (float*)lds, VTF(), VSF());
        if ((TIDX() >> 6) >= 5) ph_mla_combine(PF(), l < DEPTH - 1, ((size_t)OPQS(bx) * 3 + ((TIDX() >> 6) - 5)) * 64 + (TIDX() & 63), (size_t)NBF() * 3 * 64);
        GRID_BARRIER();
        }
#define OUT_GEMM(SchedT, S_) do { pg8::Gemm g{PF().Ymix, PF().WoutT + (size_t)l * D * D_MIX, TT, D, D_MIX}; pg8::EpiBf16N E{PF().yo, D, D}; \
            pg8::gemm_phase<pg8::EpiBf16N, SchedT, false>((PG8_LAS unsigned char*)lds, g, S_, E, nullptr); } while (0)
#define OUT_NTL() (NBF() >= 64 ? (TT / 256 - OUT_T0) * (D / 256) : 0)
        if (l < DEPTH - 1) {
            constexpr int OUT_T0 = 32;
            for (int r_ = REPS(4); r_ > 0; --r_) {
            { pg8::StaticOrder S; S.init(OUT_T0 * 256, D, NBF(), OPQS(bx)); OUT_GEMM(pg8::StaticOrder, S); }
            GRID_BARRIER();
            }
            if (OPQS(bx) < OUT_NTL() || OUT_NTL() == 0) { pg8::TailOrder S{OUT_T0, TT / 256, D / 256, OUT_NTL() ? OUT_NTL() : NBF(), OPQS(bx)}; OUT_GEMM(pg8::TailOrder, S); }
            else { ph_ln1_route(PF(), l, (float*)lds, (int*)(lds + LDS_RT), (size_t)(OPQS(bx) - OUT_NTL()) * NT + TIDX(), (size_t)(NBF() - OUT_NTL()) * NT, 0, OUT_T0 * 256, true);
                ph_ln1_fix(PF(), (const int*)(lds + LDS_RT), (size_t)(OPQS(bx) - OUT_NTL()) * NT + TIDX(), (size_t)(NBF() - OUT_NTL()) * NT, 0, OUT_T0 * 256); }
            GRID_BARRIER();
            if (OUT_NTL() == 0) { ph_ln1_route(PF(), l, (float*)lds, (int*)(lds + LDS_RT), VTF(), VSF(), 0, TT, true); ph_ln1_fix(PF(), (const int*)(lds + LDS_RT), VTF(), VSF(), 0, TT); }
            else if (OPQS(bx) >= OUT_NTL()) {
                ph_ln1_route(PF(), l, (float*)lds, (int*)(lds + LDS_RT), ((size_t)(TIDX() >> 6) * (NBF() - OUT_NTL()) + (OPQS(bx) - OUT_NTL())) * 64 + (TIDX() & 63), (size_t)(NBF() - OUT_NTL()) * NT, OUT_T0 * 256, TT, false);
                ph_ln1_fix(PF(), (const int*)(lds + LDS_RT), ((size_t)(TIDX() >> 6) * (NBF() - OUT_NTL()) + (OPQS(bx) - OUT_NTL())) * 64 + (TIDX() & 63), (size_t)(NBF() - OUT_NTL()) * NT, OUT_T0 * 256, TT);
            }
        } else {
            for (int r_ = REPS(5); r_ > 0; --r_) {
            { pg8::LatentOrder S; S.init(NB * SEQ, D, NBF(), OPQS(bx)); OUT_GEMM(pg8::LatentOrder, S); }
            GRID_BARRIER();
            }
            ph_ln1_route(PF(), l, (float*)lds, (int*)(lds + LDS_RT), VTF(), VSF(), 0, TT, true);
            ph_ln1_fix(PF(), (const int*)(lds + LDS_RT), VTF(), VSF(), 0, TT);
        }
#undef OUT_GEMM
#undef OUT_NTL
        GRID_BARRIER();
        for (int r_ = REPS(13); r_ > 0; --r_) {
        ph_moe_perm(PF(), l, VTF(), VSF());
        GRID_BARRIER();
        }
        for (int r_ = REPS(14); r_ > 0; --r_) {
        {
            pg8::Gemm g{PF().hperm, PF().WguT + (size_t)l * NE * 2 * D_EXP * D, MPAD, NE * 2 * D_EXP, D};
            pg8::MoeOrder S{PF().cnt + l * NE, NBF(), OPQS(bx), 2 * D_EXP / 256};
            pg8::EpiSwiGLU E{PF().hidp, D_EXP, 2 * D_EXP / 256};
            pg8::gemm_phase<pg8::EpiSwiGLU, pg8::MoeOrder, false>((PG8_LAS unsigned char*)lds, g, S, E, nullptr);
        }
        GRID_BARRIER();
        }
        for (int r_ = REPS(15); r_ > 0; --r_) {
        {
            pg8::Gemm g{PF().hidp, PF().WdT + (size_t)l * NE * D * D_EXP, MPAD, NE * D, D_EXP};
            pg8::MoeOrder S{PF().cnt + l * NE, NBF(), OPQS(bx), D / 256};
            pg8::EpiBf16Grp E{PF().Fperm, D, D / 256};
            pg8::gemm_phase<pg8::EpiBf16Grp, pg8::MoeOrder, false>((PG8_LAS unsigned char*)lds, g, S, E, nullptr);
        }
        GRID_BARRIER();
        }
        ph_ln2(PF(), l, VTF(), VSF());
        GRID_BARRIER();
    }
}

static size_t carve(size_t& off, size_t bytes) { const size_t o = off; off += (bytes + 255) & ~(size_t)255; return o; }

extern "C" void kernel_launch(void* const* d_in, const int* in_sizes, int n_in, void* d_out, int out_size, void* d_ws, size_t ws_size, hipStream_t stream) {
    (void)in_sizes; (void)n_in; (void)out_size;
    MegaArgs a{};
    Params& p = a.p;
    const float* const* in = (const float* const*)d_in;
    p.x = in[0]; p.c = in[1]; p.ctx = in[2]; p.c_ctx = in[3]; p.ada_w = in[4]; p.ada_b = in[5]; p.w_in = in[6]; p.w_out = in[7];
    p.ln1_g = in[8]; p.ln1_b = in[9]; p.ln2_g = in[10]; p.ln2_b = in[11];
    p.rw_mu = in[12]; p.rw_w0 = in[13]; p.rw_w_up = in[14]; p.rw_a0 = in[15]; p.rw_a_up = in[16]; p.rw_g_up = in[17]; p.rw_k_k = in[18]; p.rw_k_a = in[19];
    p.rw_r_k = in[20]; p.rw_gn_g = in[21]; p.rw_gn_b = in[22];
    p.mb_conv_w = in[23]; p.mb_conv_b = in[24]; p.mb_a_log = in[25]; p.mb_dt_bias = in[26]; p.mb_d = in[27]; p.mb_norm_g = in[28];
    p.mla_q_norm = in[29]; p.mla_w_uq = in[30]; p.mla_kv_norm = in[31]; p.mla_w_ukv = in[32]; p.na_rpb = in[33];
    p.router_w = in[34]; p.router_b = in[35]; p.exp_w_gate = in[36]; p.exp_w_up = in[37]; p.exp_w_down = in[38];
    p.out = (float*)d_out;

    char* ws = (char*)d_ws; size_t off = 0;
    a.bar = (unsigned*)(ws + carve(off, (size_t)XCD_BAR_WORDS * 4));
    p.WinT = (bf16_t*)(ws + carve(off, (size_t)DEPTH * N_INP * D * 2));
    p.WoutT = (bf16_t*)(ws + carve(off, (size_t)DEPTH * D * D_MIX * 2));
    p.WguT = (bf16_t*)(ws + carve(off, (size_t)DEPTH * NE * 2 * D_EXP * D * 2));
    p.WdT = (bf16_t*)(ws + carve(off, (size_t)DEPTH * NE * D * D_EXP * 2));
    p.WupT = (bf16_t*)(ws + carve(off, (size_t)DEPTH * NUP * KUP * 2));
    p.WloT = (bf16_t*)(ws + carve(off, (size_t)DEPTH * NLO * KLO * 2));
    p.xs = (float*)(ws + carve(off, (size_t)TT * D * 4));
    p.xm = (bf16_t*)(ws + carve(off, (size_t)TT * D * 2));
    p.mod = (float*)(ws + carve(off, (size_t)DEPTH * NMOD * 6 * D * 4));
    p.modp = (float*)(ws + carve(off, (size_t)DEPTH * (D / 128) * NMOD * 6 * D * 4));
    p.ropecs = (float2*)(ws + carve(off, (size_t)GRID_W * (MLA_ROPE / 4) * 8));
    p.cnt = (int*)(ws + carve(off, (size_t)DEPTH * NE * 4));
    p.qctr = (int*)(ws + carve(off, (size_t)DEPTH * 16 * 4));
    p.tok_e = (int2*)(ws + carve(off, (size_t)TT * 8));
    p.tok_pos = (int2*)(ws + carve(off, (size_t)TT * 8));
    p.tok_row = (int2*)(ws + carve(off, (size_t)TT * 8));
    p.tok_w = (float2*)(ws + carve(off, (size_t)TT * 8));
    p.Ymix = (bf16_t*)(ws + carve(off, (size_t)TT * D_MIX * 2));
    p.naVt = (bf16_t*)(ws + carve(off, (size_t)NB * NH * HD * LL * 2));
    p.mlaO = (float*)(ws + carve(off, (size_t)TT * NH * 2 * MLA_V * 4));
    p.mlaML = (float*)(ws + carve(off, (size_t)TT * NH * 2 * 2 * 4));
    p.hb = (bf16_t*)(ws + carve(off, (size_t)TT * D * 2));
    const size_t regA = off;
    p.P = (bf16_t*)(ws + carve(off, (size_t)TT * N_IN * 2));
    p.pm = (float*)(ws + carve(off, (size_t)TT * RW_IN * 4));
    p.pmb = (bf16_t*)(ws + carve(off, (size_t)TT * KLO * 2));
    p.rwW = (float*)(ws + carve(off, (size_t)2 * TT * GD * 4));
    p.rwB = (float*)(ws + carve(off, (size_t)2 * TT * GD * 4));
    p.rwKD = (float*)(ws + carve(off, (size_t)2 * TT * GD * 4));
    p.rwKK = (float*)(ws + carve(off, (size_t)TT * GD * 4));
    p.rwG = (float*)(ws + carve(off, (size_t)TT * GD * 4));
    {
        const size_t o0 = off; size_t o1 = off, o2 = off;
        p.rwMsT = (bf16_t*)(ws + carve(o1, (size_t)NU * NCHK * HD * HD * 2));
        p.rwSloc = (float*)(ws + carve(o1, (size_t)NU * NCHK * HD * HD * 4));
        p.rwYI = (bf16_t*)(ws + carve(o1, (size_t)NU * LL * HD * 2));
        p.rwYloc = (float*)(ws + carve(o1, (size_t)NU * LL * HD * 4));
        p.LO = (bf16_t*)(ws + carve(o2, (size_t)TT * NLO * 2));
        p.QKVraw = (float*)(ws + carve(o2, (size_t)TT * NUP * 4));
        off = o1 > o2 ? o1 : o2; (void)o0;
    }
    p.xc = (float*)(ws + carve(off, (size_t)TT * MB_CONV_DIM * 4));
    p.dt = (float*)(ws + carve(off, (size_t)TT * 2 * NH * 4));
    p.mbC = (bf16_t*)(ws + carve(off, (size_t)TT * MB_GROUPS * MB_STATE * 2));
    p.mbB = (bf16_t*)(ws + carve(off, (size_t)TT * MB_GROUPS * MB_STATE * 2));
    p.mbXT = (bf16_t*)(ws + carve(off, (size_t)NB * NH * HD * LL * 2));
    p.mbBT = (bf16_t*)(ws + carve(off, (size_t)NB * MB_GROUPS * MB_STATE * LL * 2));
    p.mbCS = (bf16_t*)(ws + carve(off, (size_t)NU * NCHK * HD * MB_STATE * 2));
    p.mbYloc = (bf16_t*)(ws + carve(off, (size_t)NU * LL * HD * 2));
    p.mbCum = (float*)(ws + carve(off, (size_t)NU * LL * 4));
    p.qkvn = (bf16_t*)(ws + carve(off, (size_t)TT * KUP * 2));
    p.Qm = (bf16_t*)(ws + carve(off, (size_t)TT * NH * MLA_QK * 2));
    p.Km = (bf16_t*)(ws + carve(off, (size_t)TT * NH * MLA_QK * 2));
    p.Vt = (bf16_t*)(ws + carve(off, (size_t)TT * NH * MLA_V * 2));
    const size_t endA = off;
    off = regA;
    p.yo = (bf16_t*)(ws + carve(off, (size_t)TT * D * 2));
    p.hperm = (bf16_t*)(ws + carve(off, (size_t)MPAD * D * 2));
    p.hidp = (bf16_t*)(ws + carve(off, (size_t)MPAD * D_EXP * 2));
    p.Fperm = (bf16_t*)(ws + carve(off, (size_t)MPAD * D * 2));
    const size_t endB = off;
    const size_t need = endA > endB ? endA : endB;
    if (need > ws_size) return;

    static int grid = 0;
    if (!grid) {
        int dev = 0, cus = 0, per_cu = 0;
        if (hipGetDevice(&dev) != hipSuccess || hipDeviceGetAttribute(&cus, hipDeviceAttributeMultiprocessorCount, dev) != hipSuccess) { grid = -1; return; }
        if (hipFuncSetAttribute((const void*)k_mega, hipFuncAttributeMaxDynamicSharedMemorySize, LDS_BYTES) != hipSuccess) { grid = -1; return; }
        if (hipOccupancyMaxActiveBlocksPerMultiprocessor(&per_cu, (const void*)k_mega, NT, LDS_BYTES) != hipSuccess) per_cu = 0;
        grid = cus * (per_cu < 1 ? per_cu : 1);
        if (grid <= 0) grid = -1;
    }
    if (grid <= 0) return;
    for (int k = 0; k < 16; ++k) a.reps[k] = 1;
#ifdef PROBE_GROUP
    a.reps[PROBE_GROUP] = 2;
#endif
    (void)hipMemsetAsync(a.bar, 0, (size_t)XCD_BAR_WORDS * 4, stream);
    hipLaunchKernelGGL(k_mega, dim3(grid), dim3(NT), LDS_BYTES, stream, a);
}
```
